# Optimizing an MI355X kernel written in HIP

```python
import jax, jax.numpy as jnp
from jax import lax
import numpy as np

D_MODEL = 2048
BATCH = 1
SEQ = 8192
DEPTH = 2

GRID_W = 64
HEAD_DIM = 128
NA_HEADS = 4
NA_WIN_ROWS = 8
NA_WIN_COLS = 16
MLA_HEADS = 6
MLA_Q_RANK = 512
MLA_KV_RANK = 256
MLA_NOPE = 128
MLA_ROPE = 64
MLA_V = 128
MLA_Q_BLOCK = 128
ROPE_THETA = 10000.0
SWA_HEADS = 6
SWA_KV_HEADS = 2
SWA_WINDOW = 128
SWA_BLOCK = 128

D_A = NA_HEADS * HEAD_DIM
D_B = MLA_HEADS * MLA_V
D_C = SWA_HEADS * HEAD_DIM
D_MIX = D_A + D_B + D_C
IN_A = 3 * D_A
IN_B = MLA_Q_RANK + MLA_KV_RANK + MLA_ROPE
IN_C = (SWA_HEADS + 2 * SWA_KV_HEADS) * HEAD_DIM
D_IN = IN_A + IN_B + IN_C
D_FF = -(-8 * D_MODEL // (3 * 256)) * 256

DEEPNORM_ALPHA = (2 * DEPTH) ** 0.25
DEEPNORM_BETA = (8 * DEPTH) ** -0.25
LN_EPS = 1e-5
RMS_EPS = 1e-6
NEG_INF = -1e30

kernel_name = "hybrid_parallel_heads_encoder"


def layer_norm(x, g, b):
    xf = x.astype(jnp.float32)
    mu = xf.mean(-1, keepdims=True)
    var = jnp.square(xf - mu).mean(-1, keepdims=True)
    return ((xf - mu) * lax.rsqrt(var + LN_EPS) * g.astype(jnp.float32) + b.astype(jnp.float32)).astype(x.dtype)


def rms_norm(x, g):
    xf = x.astype(jnp.float32)
    ms = jnp.square(xf).mean(-1, keepdims=True)
    return (xf * lax.rsqrt(ms + RMS_EPS) * g.astype(jnp.float32)).astype(x.dtype)


def rope(x, pos):
    half = x.shape[-1] // 2
    inv = ROPE_THETA ** (-jnp.arange(half, dtype=jnp.float32) / half)
    ang = pos.astype(jnp.float32)[:, None] * inv[None, :]
    cos = jnp.cos(ang)[:, None, :]
    sin = jnp.sin(ang)[:, None, :]
    x1 = x[..., :half].astype(jnp.float32)
    x2 = x[..., half:].astype(jnp.float32)
    return jnp.concatenate([x1 * cos - x2 * sin, x2 * cos + x1 * sin], axis=-1).astype(x.dtype)


def neighbourhood_attention(q, k, v, rpb):
    B, S, H, d = q.shape
    rows = S // GRID_W
    kh = min(NA_WIN_ROWS, rows)
    r = jnp.arange(rows)
    r0 = jnp.clip(r - kh // 2, 0, rows - kh)
    row_idx = r0[:, None] + jnp.arange(kh)[None, :]
    col = jnp.arange(GRID_W)
    c0 = jnp.clip(col - NA_WIN_COLS // 2, 0, GRID_W - NA_WIN_COLS)
    col_in = (col[None, :] >= c0[:, None]) & (col[None, :] < c0[:, None] + NA_WIN_COLS)
    qg = q.reshape(B, rows, GRID_W, H, d)
    kg = k.reshape(B, rows, GRID_W, H, d)[:, row_idx]
    vg = v.reshape(B, rows, GRID_W, H, d)[:, row_idx]
    s = jnp.einsum('brqhd,brkwhd->bhrqkw', qg, kg).astype(jnp.float32) * (d ** -0.5)
    roff = row_idx - r[:, None] + (NA_WIN_ROWS - 1)
    coff = jnp.clip(col[None, :] - col[:, None], -(NA_WIN_COLS - 1), NA_WIN_COLS - 1) + (NA_WIN_COLS - 1)
    bias = rpb.astype(jnp.float32)[:, roff[:, None, :, None], coff[None, :, None, :]]
    s = jnp.where(col_in[None, None, None, :, None, :], s + bias[None], NEG_INF)
    p = jax.nn.softmax(s.reshape(B, H, rows, GRID_W, kh * GRID_W), axis=-1)
    p = p.reshape(B, H, rows, GRID_W, kh, GRID_W).astype(v.dtype)
    o = jnp.einsum('bhrqkw,brkwhd->brqhd', p, vg)
    return o.reshape(B, S, H * d)


def latent_attention(c_q, c_kv, k_rope, q_norm_g, kv_norm_g, w_uq, w_ukv, pos):
    B, S, _ = c_q.shape
    H = MLA_HEADS
    q = (rms_norm(c_q, q_norm_g) @ w_uq).reshape(B, S, H, MLA_NOPE + MLA_ROPE)
    q_nope = q[..., :MLA_NOPE]
    q_pe = rope(q[..., MLA_NOPE:], pos)
    kv = (rms_norm(c_kv, kv_norm_g) @ w_ukv).reshape(B, S, H, MLA_NOPE + MLA_V)
    k_nope = kv[..., :MLA_NOPE]
    v = kv[..., MLA_NOPE:]
    k_pe = rope(k_rope[:, :, None, :], pos)[:, :, 0]
    scale = (MLA_NOPE + MLA_ROPE) ** -0.5
    nb = S // MLA_Q_BLOCK
    qn_blocks = q_nope.reshape(B, nb, MLA_Q_BLOCK, H, MLA_NOPE).transpose(1, 0, 2, 3, 4)
    qp_blocks = q_pe.reshape(B, nb, MLA_Q_BLOCK, H, MLA_ROPE).transpose(1, 0, 2, 3, 4)

    def one_block(blk):
        qn, qp = blk
        s = jnp.einsum('bqhd,bkhd->bhqk', qn, k_nope) + jnp.einsum('bqhr,bkr->bhqk', qp, k_pe)
        p = jax.nn.softmax(s.astype(jnp.float32) * scale, axis=-1).astype(v.dtype)
        return jnp.einsum('bhqk,bkhd->bqhd', p, v)

    o = lax.map(one_block, (qn_blocks, qp_blocks))
    return o.transpose(1, 0, 2, 3, 4).reshape(B, S, H * MLA_V)


def windowed_gqa(q, k, v, sink):
    B, S, H, d = q.shape
    hkv = k.shape[2]
    G = H // hkv
    T = SWA_BLOCK
    nb = S // T
    qb = q.reshape(B, nb, T, hkv, G, d)

    def band(x):
        xp = jnp.pad(x.reshape(B, nb, T, hkv, d), ((0, 0), (1, 1), (0, 0), (0, 0), (0, 0)))
        return jnp.concatenate([xp[:, :-2], xp[:, 1:-1], xp[:, 2:]], axis=2)

    kb = band(k)
    vb = band(v)
    s = jnp.einsum('bnqhgd,bnshd->bhgnqs', qb, kb).astype(jnp.float32) * (d ** -0.5)
    blk = jnp.arange(nb)[:, None]
    qpos = blk * T + jnp.arange(T)[None, :]
    kpos = (blk - 1) * T + jnp.arange(3 * T)[None, :]
    dist = jnp.abs(qpos[:, :, None] - kpos[:, None, :])
    valid = (dist <= SWA_WINDOW) & (kpos[:, None, :] >= 0) & (kpos[:, None, :] < S)
    slopes = jnp.asarray(np.array([2.0 ** (-8.0 * (i + 1) / H) for i in range(H)], dtype=np.float32))
    s = s - slopes.reshape(hkv, G)[None, :, :, None, None, None] * dist.astype(jnp.float32)[None, None, None]
    s = jnp.where(valid[None, None, None], s, NEG_INF)
    sink_l = jnp.broadcast_to(sink.astype(jnp.float32).reshape(1, hkv, G, 1, 1, 1), s.shape[:-1] + (1,))
    p = jax.nn.softmax(jnp.concatenate([s, sink_l], axis=-1), axis=-1)[..., :-1].astype(v.dtype)
    o = jnp.einsum('bhgnqs,bnshd->bnqhgd', p, vb)
    return o.reshape(B, S, H * d)


def setup_inputs(seed: int = 0) -> dict:
    key = jax.random.key(seed)
    ks = jax.random.split(key, 20)
    L, D = DEPTH, D_MODEL
    nrm = jax.random.normal
    beta = DEEPNORM_BETA
    col_scale = np.ones((D_IN,), dtype=np.float32)
    col_scale[2 * D_A:3 * D_A] = beta
    v_c0 = IN_A + IN_B + (SWA_HEADS + SWA_KV_HEADS) * HEAD_DIM
    col_scale[v_c0:v_c0 + SWA_KV_HEADS * HEAD_DIM] = beta
    ukv_scale = np.ones((MLA_HEADS, MLA_NOPE + MLA_V), dtype=np.float32)
    ukv_scale[:, MLA_NOPE:] = beta
    ukv_scale = ukv_scale.reshape(-1)
    return {
        "x": nrm(ks[0], (BATCH, SEQ, D), jnp.float32),
        "c": nrm(ks[1], (BATCH, D), jnp.float32),
        "w_ada": nrm(ks[2], (L, D, 6 * D), jnp.float32) * (0.1 * D ** -0.5),
        "b_ada": nrm(ks[3], (L, 6 * D), jnp.float32) * 0.01,
        "w_in": nrm(ks[4], (L, D, D_IN), jnp.float32) * (D ** -0.5) * jnp.asarray(col_scale),
        "na_rpb": nrm(ks[5], (L, NA_HEADS, 2 * NA_WIN_ROWS - 1, 2 * NA_WIN_COLS - 1), jnp.float32) * 0.1,
        "mla_q_norm": 1.0 + 0.02 * nrm(ks[6], (L, MLA_Q_RANK), jnp.float32),
        "mla_kv_norm": 1.0 + 0.02 * nrm(ks[7], (L, MLA_KV_RANK), jnp.float32),
        "mla_w_uq": nrm(ks[8], (L, MLA_Q_RANK, MLA_HEADS * (MLA_NOPE + MLA_ROPE)), jnp.float32) * (MLA_Q_RANK ** -0.5),
        "mla_w_ukv": nrm(ks[9], (L, MLA_KV_RANK, MLA_HEADS * (MLA_NOPE + MLA_V)), jnp.float32) * (MLA_KV_RANK ** -0.5) * jnp.asarray(ukv_scale),
        "swa_sink": nrm(ks[10], (L, SWA_HEADS), jnp.float32) * 0.5,
        "out_norm_g": 1.0 + 0.02 * nrm(ks[11], (L, D_MIX), jnp.float32),
        "w_o": nrm(ks[12], (L, D_MIX, D), jnp.float32) * (D_MIX ** -0.5) * beta,
        "ln1_g": 1.0 + 0.02 * nrm(ks[13], (L, D), jnp.float32),
        "ln1_b": 0.02 * nrm(ks[14], (L, D), jnp.float32),
        "w_gu": nrm(ks[15], (L, D, 2 * D_FF), jnp.float32) * (D ** -0.5),
        "w_down": nrm(ks[16], (L, D_FF, D), jnp.float32) * (D_FF ** -0.5) * beta,
        "ln2_g": 1.0 + 0.02 * nrm(ks[17], (L, D), jnp.float32),
        "ln2_b": 0.02 * nrm(ks[18], (L, D), jnp.float32),
    }


def reference(x, c, w_ada, b_ada, w_in, na_rpb, mla_q_norm, mla_kv_norm, mla_w_uq, mla_w_ukv,
              swa_sink, out_norm_g, w_o, ln1_g, ln1_b, w_gu, w_down, ln2_g, ln2_b):
    B, S, D = x.shape
    pos = jnp.arange(S, dtype=jnp.int32)
    cond = jax.nn.silu(c)
    for l in range(DEPTH):
        mod = cond @ w_ada[l] + b_ada[l]
        sh1, sc1, g1, sh2, sc2, g2 = [m[:, None, :] for m in jnp.split(mod, 6, axis=-1)]

        u = x * (1.0 + sc1) + sh1
        proj = u @ w_in[l]
        pa = proj[..., :IN_A]
        pb = proj[..., IN_A:IN_A + IN_B]
        pc = proj[..., IN_A + IN_B:]

        qa = pa[..., :D_A].reshape(B, S, NA_HEADS, HEAD_DIM)
        ka = pa[..., D_A:2 * D_A].reshape(B, S, NA_HEADS, HEAD_DIM)
        va = pa[..., 2 * D_A:].reshape(B, S, NA_HEADS, HEAD_DIM)
        ya = neighbourhood_attention(qa, ka, va, na_rpb[l])

        cq = pb[..., :MLA_Q_RANK]
        ckv = pb[..., MLA_Q_RANK:MLA_Q_RANK + MLA_KV_RANK]
        kr = pb[..., MLA_Q_RANK + MLA_KV_RANK:]
        yb = latent_attention(cq, ckv, kr, mla_q_norm[l], mla_kv_norm[l], mla_w_uq[l], mla_w_ukv[l], pos)

        dq = SWA_HEADS * HEAD_DIM
        dk = SWA_KV_HEADS * HEAD_DIM
        qc = pc[..., :dq].reshape(B, S, SWA_HEADS, HEAD_DIM)
        kc = pc[..., dq:dq + dk].reshape(B, S, SWA_KV_HEADS, HEAD_DIM)
        vc = pc[..., dq + dk:].reshape(B, S, SWA_KV_HEADS, HEAD_DIM)
        yc = windowed_gqa(qc, kc, vc, swa_sink[l])

        gn = out_norm_g[l]
        y = jnp.concatenate([rms_norm(ya, gn[:D_A]),
                             rms_norm(yb, gn[D_A:D_A + D_B]),
                             rms_norm(yc, gn[D_A + D_B:])], axis=-1)
        x = layer_norm(DEEPNORM_ALPHA * x + (1.0 + g1) * (y @ w_o[l]), ln1_g[l], ln1_b[l])

        u = x * (1.0 + sc2) + sh2
        gu = u @ w_gu[l]
        h = jax.nn.silu(gu[..., :D_FF]) * gu[..., D_FF:]
        x = layer_norm(DEEPNORM_ALPHA * x + (1.0 + g2) * (h @ w_down[l]), ln2_g[l], ln2_b[l])
    return x
```

```cpp
#include <hip/hip_runtime.h>
#include <hip/hip_cooperative_groups.h>
#include <cstdio>
#include <cstdint>
namespace cg = cooperative_groups;
namespace pg8 {
#define PG8_LAS __attribute__((address_space(3)))
typedef unsigned short bf16_t;
typedef short bf16x8 __attribute__((ext_vector_type(8)));
typedef float f32x4 __attribute__((ext_vector_type(4)));
typedef unsigned u32x4 __attribute__((ext_vector_type(4)));
constexpr int BM = 256, BK = 64, HALF = 128, HTB = HALF * BK * 2  , STAGE_BYTES = 8 * HTB, NXCD = 8, WGM = 8;

__host__ __device__ __forceinline__ int lds_byte(int r, int c) { const int st = (r >> 4) * 2 + (c >> 5), rr = r & 15, cc = c & 31, ob = rr * 64 + cc * 2; return st * 1024 + (ob ^ (((ob >> 9) & 1) << 5)); }
__host__ __device__ __forceinline__ void stage_rc(int b, int& R, int& C) { const int st = b / 1024, sb = b % 1024, swz = sb ^ (((sb >> 9) & 1) << 5); R = (st >> 1) * 16 + swz / 64; C = (st & 1) * 32 + (swz % 64) / 2; }
__host__ __device__ __forceinline__ int perm32(int rho) { const int n = rho >> 4, i = rho & 15; return 8 * (i >> 2) + 4 * n + (i & 3); }

struct Unit { int pm, pn; };
struct Gemm { const bf16_t* A; const bf16_t* Bt; int M, N, K, lda; };

struct StaticOrder {
    int nM, nN, nwg, G, c;
    __host__ __device__ void init(int M, int N, int G_, int c_) { nM = M / BM; nN = N / BM; nwg = nM * nN; G = G_; c = c_; }
    __host__ __device__ bool next(int i, Unit& u) const {
        const long L = (long)i * G + c; if (L >= nwg) return false;
        int wgid = (int)L; { const int q = nwg / NXCD, r = nwg % NXCD, xcd = wgid % NXCD, off = wgid / NXCD; wgid = (xcd < r ? xcd * (q + 1) : r * (q + 1) + (xcd - r) * q) + off; }
        const int nig = WGM * nN, gid = wgid / nig, fm = gid * WGM, gsz = (nM - fm) < WGM ? (nM - fm) : WGM;
        u.pm = fm + ((wgid % nig) % gsz); u.pn = (wgid % nig) / gsz; return true;
    }
    __device__ __forceinline__ void a_ready(const Unit&) const {}
    __device__ __forceinline__ void done(const Unit&) const {}
};

struct ListOrder {
    int nN, n, L0, L1;
    __host__ __device__ bool next(int i, Unit& u) const { if (i >= n) return false; const int L = i == 0 ? L0 : L1; u.pm = L / nN; u.pn = L % nN; return true; }
    __device__ __forceinline__ void a_ready(const Unit&) const {}
    __device__ __forceinline__ void done(const Unit&) const {}
};
__device__ __forceinline__ unsigned cvt_pk_bf16(float lo, float hi) { unsigned r; asm volatile("v_cvt_pk_bf16_f32 %0, %1, %2" : "=v"(r) : "v"(lo), "v"(hi)); return r; }
typedef float f32x2 __attribute__((ext_vector_type(2)));
__device__ __forceinline__ u32x4 pack8(const f32x4 v0, const f32x4 v1) { u32x4 w; w.x = cvt_pk_bf16(v0[0], v0[1]); w.y = cvt_pk_bf16(v0[2], v0[3]); w.z = cvt_pk_bf16(v1[0], v1[1]); w.w = cvt_pk_bf16(v1[2], v1[3]); return w; }
struct EpiStore {
    static constexpr bool PERM = true, AFTER_DRAIN = false;
    bf16_t* O; int ldc;
    __device__ __forceinline__ void operator()(const f32x4 (&acc)[2][2][4][2], const Unit& u, int wr, int wc, int fr, int fq) const {
        const int row0 = u.pm * BM + wr * 64 + fr, col0 = u.pn * BM + wc * 32 + 8 * fq;
#pragma unroll
        for (int ai = 0; ai < 2; ++ai)
#pragma unroll
            for (int m = 0; m < 4; ++m) { bf16_t* rowp = O + (size_t)(row0 + ai * HALF + m * 16) * ldc + col0;
#pragma unroll
                for (int bj = 0; bj < 2; ++bj) *(u32x4*)(rowp + bj * HALF) = pack8(acc[ai][bj][m][0], acc[ai][bj][m][1]); }
    }
};
struct EpiProj {
    static constexpr bool PERM = true, AFTER_DRAIN = false;
    bf16_t* O; int ldc; float* ssq; const float* rope; bf16_t* Kb; int ldk;
    __device__ __forceinline__ void operator()(const f32x4 (&acc)[2][2][4][2], const Unit& u, int wr, int wc, int fr, int fq) const {
        const int row0 = u.pm * BM + wr * 64 + fr, col0 = u.pn * BM + wc * 32 + 8 * fq;
#pragma unroll
        for (int ai = 0; ai < 2; ++ai)
#pragma unroll
            for (int m = 0; m < 4; ++m) { const int row = row0 + ai * HALF + m * 16; bf16_t* rowp = O + (size_t)row * ldc + col0; float sq = 0.f;
#pragma unroll
                for (int bj = 0; bj < 2; ++bj) { const u32x4 w = pack8(acc[ai][bj][m][0], acc[ai][bj][m][1]); *(u32x4*)(rowp + bj * HALF) = w;
#pragma unroll
                    for (int e = 0; e < 4; ++e) { const float lo = __uint_as_float(w[e] << 16), hi = __uint_as_float(w[e] & 0xffff0000u); sq += lo * lo + hi * hi; } }
                if (u.pn >= 6 && u.pn <= 8) { sq += __shfl_xor(sq, 16); sq += __shfl_xor(sq, 32); if (fq == 0) ssq[((size_t)row * 3 + (u.pn - 6)) * 4 + wc] = sq; }
                if (u.pn == 9 && wc < 2) { const int ib = wc * 16 + 4 * fq; const f32x4 v0 = acc[ai][0][m][0], v1 = acc[ai][0][m][1];
                    const f32x4 c = *(const f32x4*)(rope + (size_t)row * 64 + ib), sn = *(const f32x4*)(rope + (size_t)row * 64 + 32 + ib);
                    f32x4 a, b;
                    a[0] = v0[0] * c[0] - v0[1] * sn[0]; a[1] = v0[1] * c[0] + v0[0] * sn[0];
                    a[2] = v0[2] * c[1] - v0[3] * sn[1]; a[3] = v0[3] * c[1] + v0[2] * sn[1];
                    b[0] = v1[0] * c[2] - v1[1] * sn[2]; b[1] = v1[1] * c[2] + v1[0] * sn[2];
                    b[2] = v1[2] * c[3] - v1[3] * sn[3]; b[3] = v1[3] * c[3] + v1[2] * sn[3];
                    const u32x4 w = pack8(a, b);
#pragma unroll
                    for (int h = 0; h < 6; ++h) *(u32x4*)(Kb + (size_t)row * ldk + 192 * h + 128 + wc * 32 + 8 * fq) = w; }
                if (m & 1) asm volatile("" ::: "memory"); }
    }
};
struct EpiQ {
    static constexpr bool PERM = true, AFTER_DRAIN = false;
    bf16_t* O; int ldc; const float* ssq; const float* rope;
    __device__ __forceinline__ void operator()(const f32x4 (&acc)[2][2][4][2], const Unit& u, int wr, int wc, int fr, int fq) const {
        const int row0 = u.pm * BM + wr * 64 + fr;
        float sc[2][4];
        { f32x4 q0[2][4], q1[2][4];
#pragma unroll
          for (int ai = 0; ai < 2; ++ai)
#pragma unroll
            for (int m = 0; m < 4; ++m) { const float* p = ssq + (size_t)(row0 + ai * HALF + m * 16) * 12; q0[ai][m] = *(const f32x4*)p; q1[ai][m] = *(const f32x4*)(p + 4); }
#pragma unroll
          for (int ai = 0; ai < 2; ++ai)
#pragma unroll
            for (int m = 0; m < 4; ++m) { const f32x4 a = q0[ai][m], b = q1[ai][m];
                sc[ai][m] = 1.0f / sqrtf((((a[0] + a[1]) + (a[2] + a[3])) + ((b[0] + b[1]) + (b[2] + b[3]))) * (1.0f / 512.0f) + 1e-6f); } }
#pragma unroll
        for (int ai = 0; ai < 2; ++ai)
#pragma unroll
            for (int m = 0; m < 4; ++m) { const int row = row0 + ai * HALF + m * 16; const float s = sc[ai][m];
#pragma unroll
                for (int bj = 0; bj < 2; ++bj) {
                    const int cb = u.pn * BM + bj * HALF + wc * 32, hc = cb % 192;
                    f32x4 v0 = acc[ai][bj][m][0] * s, v1 = acc[ai][bj][m][1] * s;
                    if (hc >= 128) {
                        const int ib = (hc - 128) / 2 + 4 * fq;
                        const f32x4 c = *(const f32x4*)(rope + (size_t)row * 64 + ib), sn = *(const f32x4*)(rope + (size_t)row * 64 + 32 + ib);
                        f32x4 a, b;
                        a[0] = v0[0] * c[0] - v0[1] * sn[0]; a[1] = v0[1] * c[0] + v0[0] * sn[0];
                        a[2] = v0[2] * c[1] - v0[3] * sn[1]; a[3] = v0[3] * c[1] + v0[2] * sn[1];
                        b[0] = v1[0] * c[2] - v1[1] * sn[2]; b[1] = v1[1] * c[2] + v1[0] * sn[2];
                        b[2] = v1[2] * c[3] - v1[3] * sn[3]; b[3] = v1[3] * c[3] + v1[2] * sn[3];
                        v0 = a; v1 = b;
                    }
                    *(u32x4*)(O + (size_t)row * ldc + cb + 8 * fq) = pack8(v0, v1);
                }
                if (m == 3) asm volatile("" ::: "memory"); }
    }
};
struct EpiKV {
    static constexpr bool PERM = true, AFTER_DRAIN = false;
    bf16_t* Kb; int ldk; bf16_t* Vb; int ldv; const float* ssq;
    __device__ __forceinline__ void operator()(const f32x4 (&acc)[2][2][4][2], const Unit& u, int wr, int wc, int fr, int fq) const {
        const int row0 = u.pm * BM + wr * 64 + fr, cin = wc * 32 + 8 * fq;
        f32x4 q2[2][4];
#pragma unroll
        for (int ai = 0; ai < 2; ++ai)
#pragma unroll
            for (int m = 0; m < 4; ++m) q2[ai][m] = *(const f32x4*)(ssq + (size_t)(row0 + ai * HALF + m * 16) * 12 + 8);
#pragma unroll
        for (int ai = 0; ai < 2; ++ai)
#pragma unroll
            for (int m = 0; m < 4; ++m) { const int row = row0 + ai * HALF + m * 16; const f32x4 a = q2[ai][m];
                const float s = 1.0f / sqrtf(((a[0] + a[1]) + (a[2] + a[3])) * (1.0f / 256.0f) + 1e-6f);
                *(u32x4*)(Kb + (size_t)row * ldk + 192 * u.pn + cin) = pack8(acc[ai][0][m][0] * s, acc[ai][0][m][1] * s);
                *(u32x4*)(Vb + (size_t)row * ldv + 128 * u.pn + cin) = pack8(acc[ai][1][m][0] * s, acc[ai][1][m][1] * s); }
    }
};
struct EpiRes {
    static constexpr bool PERM = false, AFTER_DRAIN = false;
    const float* xres; float* z; const float* gate; float alpha; int ldc;
    __device__ __forceinline__ void operator()(const f32x4 (&acc)[2][2][4][2], const Unit& u, int wr, int wc, int fr, int fq) const {
        const int row0 = u.pm * BM + wr * 64 + fr, col0 = u.pn * BM + wc * 32 + 4 * fq;
        f32x4 gv[2][2];
#pragma unroll
        for (int bj = 0; bj < 2; ++bj)
#pragma unroll
            for (int n = 0; n < 2; ++n) gv[bj][n] = *(const f32x4*)(gate + col0 + bj * HALF + n * 16) + 1.0f;
#pragma unroll
        for (int ai = 0; ai < 2; ++ai)
#pragma unroll
            for (int m = 0; m < 4; ++m) { const size_t off = (size_t)(row0 + ai * HALF + m * 16) * ldc + col0;
#pragma unroll
                for (int bj = 0; bj < 2; ++bj)
#pragma unroll
                    for (int n = 0; n < 2; ++n) { const f32x4 xr = *(const f32x4*)(xres + off + bj * HALF + n * 16);
                        *(f32x4*)(z + off + bj * HALF + n * 16) = xr * alpha + gv[bj][n] * acc[ai][bj][m][n]; }
                if (m == 3) asm volatile("" ::: "memory"); }
    }
};
struct EpiSwiglu {
    static constexpr bool PERM = true, AFTER_DRAIN = false;
    bf16_t* H; int ldc;
    __device__ __forceinline__ void operator()(const f32x4 (&acc)[2][2][4][2], const Unit& u, int wr, int wc, int fr, int fq) const {
        const int row0 = u.pm * BM + wr * 64 + fr, col0 = u.pn * HALF + wc * 32 + 8 * fq;
#pragma unroll
        for (int ai = 0; ai < 2; ++ai)
#pragma unroll
            for (int m = 0; m < 4; ++m) { f32x4 h[2];
#pragma unroll
                for (int n = 0; n < 2; ++n) { const f32x4 g = acc[ai][0][m][n], up = acc[ai][1][m][n];
#pragma unroll
                    for (int j = 0; j < 4; ++j) h[n][j] = g[j] * __builtin_amdgcn_rcpf(1.0f + __builtin_amdgcn_exp2f(-1.4426950408889634f * g[j])) * up[j]; }
                *(u32x4*)(H + (size_t)(row0 + ai * HALF + m * 16) * ldc + col0) = pack8(h[0], h[1]); }
    }
};
template <class Epi, class Sched, bool ALIGN_EPI = false, bool SP2 = false>
__device__ __forceinline__ void gemm_phase(PG8_LAS unsigned char* lds, const Gemm g, const Sched& S, const Epi& E) {
    int tid_ = threadIdx.x; asm volatile("" : "+v"(tid_)); const int tid = tid_, wid = __builtin_amdgcn_readfirstlane(tid >> 6), lane = tid & 63, wr = wid >> 2, wc = wid & 3, fr = lane & 15, fq = lane >> 4;
    int Kv_ = g.K, lda_ = g.lda; asm volatile("" : "+s"(Kv_), "+s"(lda_)); const int K = Kv_, nt = K / BK;
    unsigned voffA[2], voffB[2];
#pragma unroll
    for (int i = 0; i < 2; ++i) { int R, C; stage_rc(tid * 16 + i * 8192, R, C); const int Rb = Epi::PERM ? ((R & ~31) + perm32(R & 31)) : R;
        voffA[i] = (unsigned)(R * lda_ + C) * 2u; voffB[i] = (unsigned)(Rb * K + C) * 2u; }
    const size_t kstep = (size_t)(BK * 2);
    const size_t hstepA = (size_t)HALF * lda_ * 2, hstepB = (size_t)HALF * K * 2;
    const size_t tstepA = 2 * hstepA, tstepB = 2 * hstepB;
    const unsigned ldsw = (unsigned)wid * 1024u;
    const int aoff = lds_byte(wr * 64 + fr, fq * 8), boff = lds_byte(wc * 32 + fr, fq * 8);
#define PG8_SA(b, h) (((b) * 2 + (h)) * HTB)
#define PG8_SB(b, h) ((4 + (b) * 2 + (h)) * HTB)
#define PG8_STAGE(bufoff, gbase, voff) do { _Pragma("unroll") for (int _i = 0; _i < 2; ++_i) \
        __builtin_amdgcn_global_load_lds((const unsigned*)((const char*)(gbase) + (voff)[_i]), (PG8_LAS unsigned*)(lds + (bufoff) + ldsw + _i * 8192), 16, 0, 0); } while (0)
#define PG8_LDA(dst, b, h) do { _Pragma("unroll") for (int m = 0; m < 4; ++m) _Pragma("unroll") for (int k = 0; k < 2; ++k) dst[m][k] = *(const PG8_LAS bf16x8*)(lds + PG8_SA(b, h) + aoff + m * 2048 + k * 1024); } while (0)
#define PG8_LDB(dst, b, h) do { _Pragma("unroll") for (int n = 0; n < 2; ++n) _Pragma("unroll") for (int k = 0; k < 2; ++k) dst[n][k] = *(const PG8_LAS bf16x8*)(lds + PG8_SB(b, h) + boff + n * 2048 + k * 1024); } while (0)
#define PG8_MMA(ai, bj, At, Bt) do { __builtin_amdgcn_s_setprio(1); _Pragma("unroll") for (int m = 0; m < 4; ++m) _Pragma("unroll") for (int n = 0; n < 2; ++n) _Pragma("unroll") for (int k = 0; k < 2; ++k) \
        acc[ai][bj][m][n] = __builtin_amdgcn_mfma_f32_16x16x32_bf16(Bt[n][k], At[m][k], acc[ai][bj][m][n], 0, 0, 0); __builtin_amdgcn_s_setprio(0); } while (0)
#define PG8_WAIT_V(n) asm volatile("s_waitcnt vmcnt(" #n ")" ::: "memory")
#define PG8_WAIT_L(n) asm volatile("s_waitcnt lgkmcnt(" #n ")" ::: "memory")
#define PG8_BAR __builtin_amdgcn_s_barrier()
#define PG8_SCHED __builtin_amdgcn_sched_barrier(0)
    Unit cur, nxt; int ui = 0;
    if (!S.next(0, cur)) return;
    f32x4 acc[2][2][4][2];
#pragma unroll
    for (int a = 0; a < 2; ++a)
#pragma unroll
        for (int b = 0; b < 2; ++b)
#pragma unroll
            for (int m = 0; m < 4; ++m)
#pragma unroll
                for (int n = 0; n < 2; ++n) acc[a][b][m][n] = (f32x4){0.f, 0.f, 0.f, 0.f};
    bf16x8 At[4][2], B0[2][2], B1[2][2];
    const char* cA = (const char*)g.A + (size_t)cur.pm * tstepA; const char* cB = (const char*)g.Bt + (size_t)cur.pn * tstepB;
    S.a_ready(cur);
    if constexpr (SP2) {
        PG8_STAGE(PG8_SB(0, 0), cB, voffB); PG8_STAGE(PG8_SB(0, 1), cB + hstepB, voffB); PG8_STAGE(PG8_SA(0, 0), cA, voffA); PG8_STAGE(PG8_SA(0, 1), cA + hstepA, voffA);
        if (wr == 1) PG8_BAR;
        PG8_WAIT_V(2); PG8_BAR;
        PG8_STAGE(PG8_SB(1, 0), cB + kstep, voffB); PG8_STAGE(PG8_SA(1, 0), cA + kstep, voffA); PG8_STAGE(PG8_SB(1, 1), cB + hstepB + kstep, voffB);
        PG8_WAIT_V(6); PG8_BAR;
    } else {
        PG8_STAGE(PG8_SB(0, 0), cB, voffB); PG8_STAGE(PG8_SA(0, 0), cA, voffA); PG8_STAGE(PG8_SB(0, 1), cB + hstepB, voffB); PG8_STAGE(PG8_SA(0, 1), cA + hstepA, voffA);
        if (wr == 1) PG8_BAR;
        PG8_WAIT_V(4); PG8_BAR;
        PG8_STAGE(PG8_SB(1, 0), cB + kstep, voffB); PG8_STAGE(PG8_SA(1, 0), cA + kstep, voffA); PG8_STAGE(PG8_SB(1, 1), cB + hstepB + kstep, voffB);
        PG8_WAIT_V(6); PG8_BAR;
    }
    for (;;) {
        const bool has_next = S.next(ui + 1, nxt);
        const char* nA = has_next ? (const char*)g.A + (size_t)nxt.pm * tstepA : cA; const char* nB = has_next ? (const char*)g.Bt + (size_t)nxt.pn * tstepB : cB;
        for (int t = 0; t < nt; t += 2) {
            const bool last = (t == nt - 2);
            const char* a1 = cA + (size_t)(t + 1) * kstep;
            const char* a2 = last ? nA : cA + (size_t)(t + 2) * kstep; const char* b2 = last ? nB : cB + (size_t)(t + 2) * kstep;
            const char* a3 = a2 + kstep; const char* b3 = b2 + kstep;
            if (last && has_next) S.a_ready(nxt);
            if constexpr (SP2) {
            PG8_LDB(B0, 0, 0); PG8_LDB(B1, 0, 1); PG8_SCHED; PG8_LDA(At, 0, 0); PG8_STAGE(PG8_SA(1, 1), a1 + hstepA, voffA);
            PG8_WAIT_V(8); PG8_WAIT_L(0); PG8_BAR; PG8_MMA(0, 0, At, B0); PG8_MMA(0, 1, At, B1); PG8_BAR; PG8_SCHED;
            PG8_LDA(At, 0, 1); PG8_STAGE(PG8_SB(0, 0), b2, voffB); PG8_STAGE(PG8_SB(0, 1), b2 + hstepB, voffB); PG8_STAGE(PG8_SA(0, 0), a2, voffA);
            PG8_WAIT_V(8); PG8_WAIT_L(0); PG8_BAR; PG8_MMA(1, 0, At, B0); PG8_MMA(1, 1, At, B1); PG8_BAR; PG8_SCHED;
            PG8_LDB(B0, 1, 0); PG8_LDB(B1, 1, 1); PG8_SCHED; PG8_LDA(At, 1, 0); PG8_STAGE(PG8_SA(0, 1), a2 + hstepA, voffA);
            PG8_WAIT_V(8); PG8_WAIT_L(0); PG8_BAR; PG8_MMA(0, 0, At, B0); PG8_MMA(0, 1, At, B1); PG8_BAR; PG8_SCHED;
            PG8_LDA(At, 1, 1); PG8_STAGE(PG8_SB(1, 0), b3, voffB); PG8_STAGE(PG8_SB(1, 1), b3 + hstepB, voffB); PG8_STAGE(PG8_SA(1, 0), a3, voffA);
            PG8_WAIT_V(8); PG8_WAIT_L(0); PG8_BAR; PG8_MMA(1, 0, At, B0); PG8_MMA(1, 1, At, B1); PG8_BAR; PG8_SCHED;
            } else {
            PG8_LDB(B0, 0, 0); PG8_SCHED; PG8_LDA(At, 0, 0); PG8_STAGE(PG8_SA(1, 1), a1 + hstepA, voffA);
            PG8_WAIT_L(8); PG8_BAR; PG8_WAIT_L(0); PG8_MMA(0, 0, At, B0); PG8_BAR; PG8_SCHED;
            PG8_LDB(B1, 0, 1); PG8_STAGE(PG8_SB(0, 0), b2, voffB);
            PG8_BAR; PG8_WAIT_L(0); PG8_MMA(0, 1, At, B1); PG8_BAR;
            PG8_LDA(At, 0, 1); PG8_STAGE(PG8_SA(0, 0), a2, voffA);
            PG8_BAR; PG8_WAIT_L(0); PG8_MMA(1, 0, At, B0); PG8_BAR; PG8_SCHED;
            PG8_STAGE(PG8_SB(0, 1), b2 + hstepB, voffB);
            PG8_WAIT_V(6); PG8_BAR; PG8_MMA(1, 1, At, B1); PG8_BAR;
            PG8_LDB(B0, 1, 0); PG8_SCHED; PG8_LDA(At, 1, 0); PG8_STAGE(PG8_SA(0, 1), a2 + hstepA, voffA);
            PG8_WAIT_L(8); PG8_BAR; PG8_WAIT_L(0); PG8_MMA(0, 0, At, B0); PG8_BAR; PG8_SCHED;
            PG8_LDB(B1, 1, 1); PG8_STAGE(PG8_SB(1, 0), b3, voffB);
            PG8_BAR; PG8_WAIT_L(0); PG8_MMA(0, 1, At, B1); PG8_BAR;
            PG8_LDA(At, 1, 1); PG8_STAGE(PG8_SA(1, 0), a3, voffA);
            PG8_BAR; PG8_WAIT_L(0); PG8_MMA(1, 0, At, B0); PG8_BAR; PG8_SCHED;
            PG8_STAGE(PG8_SB(1, 1), b3 + hstepB, voffB);
            PG8_WAIT_V(6); PG8_BAR; PG8_MMA(1, 1, At, B1); PG8_BAR;
            }
        }
        if constexpr (ALIGN_EPI) { if (wr == 0) PG8_BAR; }
        if constexpr (!Epi::AFTER_DRAIN) { E(acc, cur, wr, wc, fr, fq); S.done(cur); }
        if (!has_next) break;
#pragma unroll
        for (int a = 0; a < 2; ++a)
#pragma unroll
            for (int b = 0; b < 2; ++b)
#pragma unroll
                for (int m = 0; m < 4; ++m)
#pragma unroll
                    for (int n = 0; n < 2; ++n) acc[a][b][m][n] = (f32x4){0.f, 0.f, 0.f, 0.f};
        cur = nxt; cA = nA; cB = nB; ++ui;
        if constexpr (ALIGN_EPI) { if (wr == 1) PG8_BAR; }
    }
    PG8_WAIT_V(0);
    if constexpr (!ALIGN_EPI) { if (wr == 0) PG8_BAR; }
    PG8_BAR;
    if constexpr (Epi::AFTER_DRAIN) { E.fused(acc, cur, wr, wc, fr, fq, lds, wid, lane); S.done(cur); }
#undef PG8_SA
#undef PG8_SB
#undef PG8_STAGE
#undef PG8_LDA
#undef PG8_LDB
#undef PG8_MMA
#undef PG8_WAIT_V
#undef PG8_WAIT_L
#undef PG8_BAR
#undef PG8_SCHED
}
}

#define LAS __attribute__((address_space(3)))
typedef unsigned short bf16_t;
typedef float f32x4 __attribute__((ext_vector_type(4)));
typedef unsigned u32x4 __attribute__((ext_vector_type(4)));
typedef unsigned u32x2 __attribute__((ext_vector_type(2)));
constexpr int S = 8192, DM = 2048, DEPTH = 2, DIN = 3648, DINP = 3840, DFF = 5632;
constexpr int QLD = 1280, KLD = 1152, VLD = 768;
constexpr int C_QA = 0, C_KA = 512, C_VA = 1024, C_CQ = 1536, C_CKV = 2048, C_KR = 2304, C_QC = 2368, C_KC = 3136, C_VC = 3392;
constexpr float ALPHA = 1.4142135623730951f;
constexpr size_t al256(size_t x) { return (x + 255) / 256 * 256; }
constexpr size_t SZ_WIN = (size_t)DINP * DM * 2, SZ_WUQ = (size_t)1280 * 512 * 2, SZ_WUKV = (size_t)1536 * 256 * 2, SZ_WO = (size_t)DM * DM * 2, SZ_WGU = (size_t)2 * DFF * DM * 2, SZ_WDN = (size_t)DM * DFF * 2;
constexpr size_t O_WIN = 0, O_WUQ = O_WIN + SZ_WIN, O_WUKV = O_WUQ + SZ_WUQ, O_WO = O_WUKV + SZ_WUKV, O_WGU = O_WO + SZ_WO, O_WDN = O_WGU + SZ_WGU, SZ_WL = O_WDN + SZ_WDN;
constexpr size_t WS_W = 0;
constexpr size_t WS_MOD = al256(WS_W + DEPTH * SZ_WL);
constexpr size_t WS_ROPE = al256(WS_MOD + (size_t)DEPTH * 6 * DM * 4);
constexpr size_t WS_RSQ = al256(WS_ROPE + (size_t)S * 64 * 4);
constexpr size_t WS_RSKV = al256(WS_RSQ + (size_t)S * 4);
constexpr size_t WS_X = al256(WS_RSKV + (size_t)S * 4);
constexpr size_t WS_U = al256(WS_X + (size_t)S * DM * 4);
constexpr size_t WS_PROJ = al256(WS_U + (size_t)S * DM * 2);
constexpr size_t WS_Q = al256(WS_PROJ + (size_t)S * DINP * 2);
constexpr size_t WS_K = al256(WS_Q + (size_t)S * QLD * 2);
constexpr size_t WS_V = al256(WS_K + (size_t)S * KLD * 2);
constexpr size_t WS_Y = al256(WS_V + (size_t)S * VLD * 2);
constexpr size_t WS_H = al256(WS_Y + (size_t)S * DM * 2);
constexpr size_t WS_PART = al256(WS_H + (size_t)S * DFF * 2);
constexpr size_t WS_STAT = al256(WS_PART + (size_t)4 * S * VLD * 2);
constexpr size_t WS_SSQ = al256(WS_STAT + (size_t)4 * 6 * S * 2 * 4);
constexpr size_t WS_BAR0_ = WS_SSQ + (size_t)S * 12 * 4;
constexpr size_t WS_BAR = al256(WS_BAR0_);
constexpr size_t WS_END = al256(WS_BAR + 16384);
constexpr int TAB_OFF = pg8::STAGE_BYTES, LDS_BYTES = pg8::STAGE_BYTES + 256;
constexpr int NTHREADS = 512;

struct Args { const float* in[19]; float* out; unsigned char* ws; int ph_lo, ph_hi; };
struct Tab {
    const LAS unsigned* t;
    __device__ __forceinline__ unsigned long long ld(int i) const { const unsigned lo = __builtin_amdgcn_readfirstlane(t[2 * i]), hi = __builtin_amdgcn_readfirstlane(t[2 * i + 1]); return ((unsigned long long)hi << 32) | lo; }
    __device__ __forceinline__ const float* in(int i) const { return (const float*)ld(i); }
    __device__ __forceinline__ float* out() const { return (float*)ld(19); }
    __device__ __forceinline__ unsigned char* wsp() const { return (unsigned char*)ld(20); }
};

__device__ __forceinline__ float bf2f(unsigned short b) { return __uint_as_float((unsigned)b << 16); }
__device__ __forceinline__ float wave_sum(float v) {
#pragma unroll
    for (int o = 32; o; o >>= 1) v += __shfl_xor(v, o);
    return v; }
using pg8::cvt_pk_bf16;
__device__ __forceinline__ int otid() { int t = threadIdx.x; asm volatile("" : "+v"(t)); return t; }

__device__ __forceinline__ void phase_mod(const Tab tb, unsigned char* lds_g) {
    unsigned char* ws_ = tb.wsp(); const float* in1 = tb.in(1); const float* in2 = tb.in(2); const float* in3 = tb.in(3);
    float* condL = (float*)lds_g; f32x4* red = (f32x4*)(lds_g + 8192);
    const int tid = otid();
    const float* c = in1;
    for (int i = tid; i < DM; i += NTHREADS) { const float v = c[i]; condL[i] = v / (1.0f + __expf(-v)); }
    __syncthreads();
    float* mod = (float*)(ws_ + WS_MOD);
    const int cl = tid & 31, kg = tid >> 5;
    for (int item = blockIdx.x; item < DEPTH * 96; item += gridDim.x) {
        const int l = item / 96, cgp = item % 96;
        const float* W = in2 + (size_t)l * DM * 6 * DM + (size_t)(kg * 128) * (6 * DM) + cgp * 128 + 4 * cl;
        f32x4 acc = {0.f, 0.f, 0.f, 0.f};
#pragma unroll 8
        for (int kk = 0; kk < 128; ++kk) { const f32x4 w = __builtin_nontemporal_load((const f32x4*)(W + (size_t)kk * (6 * DM))); acc += w * condL[kg * 128 + kk]; }
        red[kg * 32 + cl] = acc;
        __syncthreads();
        if (tid < 128) { float s = 0.f; const float* rf = (const float*)red;
            for (int g = 0; g < 16; ++g) s += rf[g * 128 + tid];
            mod[l * 6 * DM + cgp * 128 + tid] = s + in3[l * 6 * DM + cgp * 128 + tid]; }
        __syncthreads();
    }
}

template <int PERMT>
__device__ __forceinline__ int dst_row(int n) {
    if (PERMT == 1) { const int h = n / 192, d = n % 192; if (d < 128) return n; const int j = d - 128; return h * 192 + 128 + 2 * (j & 31) + (j >> 5); }
    if (PERMT == 3) { if (n < C_KR || n >= C_KR + 64) return n; const int j = n - C_KR; return C_KR + 2 * (j & 31) + (j >> 5); }
    if (PERMT == 2) { if (n < DFF) return 256 * (n >> 7) + (n & 127); const int m = n - DFF; return 256 * (m >> 7) + 128 + (m & 127); }
    return n;
}
template <int PERMT>
__device__ __forceinline__ void transpose_job(const float* __restrict__ src, bf16_t* __restrict__ dst, int K, int N, int Npad, const float* __restrict__ kscale, unsigned char* lds_g) {
    float* T = (float*)lds_g;
    const int tid = otid(), nkt = K / 64, nnt = (N + 255) / 256, ntiles = nkt * nnt;
    for (int t = blockIdx.x; t < ntiles; t += gridDim.x) {
        const int k0 = (t % nkt) * 64, n0 = (t / nkt) * 256;
        { const int kk = tid >> 6, n4 = tid & 63; const bool ok = n0 + 4 * n4 < N; f32x4 v[8];
#pragma unroll
          for (int i = 0; i < 8; ++i) { const int k = k0 + kk + 8 * i; v[i] = ok ? __builtin_nontemporal_load((const f32x4*)(src + (size_t)k * N + n0 + 4 * n4)) : (f32x4){0.f, 0.f, 0.f, 0.f}; }
#pragma unroll
          for (int i = 0; i < 8; ++i) { const int k = k0 + kk + 8 * i; if (kscale) v[i] = v[i] * kscale[k];
              float* tp = T + (kk + 8 * i) * 257 + 4 * n4; tp[0] = v[i][0]; tp[1] = v[i][1]; tp[2] = v[i][2]; tp[3] = v[i][3]; } }
        __syncthreads();
        { const int n = tid >> 1, ks = tid & 1;
          if (n0 + n < N) { bf16_t* dp = dst + (size_t)dst_row<PERMT>(n0 + n) * K + k0 + 32 * ks;
#pragma unroll
            for (int eb = 0; eb < 4; ++eb) { float v[8];
#pragma unroll
              for (int e = 0; e < 8; ++e) v[e] = T[(32 * ks + 8 * eb + e) * 257 + n];
              u32x4 w; w.x = cvt_pk_bf16(v[0], v[1]); w.y = cvt_pk_bf16(v[2], v[3]); w.z = cvt_pk_bf16(v[4], v[5]); w.w = cvt_pk_bf16(v[6], v[7]);
              *(u32x4*)(dp + 8 * eb) = w; } } }
        __syncthreads();
    }
    const size_t nz = (size_t)(Npad - N) * K / 8;
    for (size_t i = (size_t)blockIdx.x * NTHREADS + tid; i < nz; i += (size_t)gridDim.x * NTHREADS) *(u32x4*)(dst + (size_t)N * K + i * 8) = (u32x4){0u, 0u, 0u, 0u};
}

__device__ __forceinline__ void modulate_rows(const float* __restrict__ x, const float* __restrict__ sc, const float* __restrict__ sh, bf16_t* __restrict__ u) {
    const size_t n8 = (size_t)S * DM / 8;
    for (size_t i = (size_t)blockIdx.x * NTHREADS + otid(); i < n8; i += (size_t)gridDim.x * NTHREADS) {
        const int col = (int)((i * 8) % DM);
        const f32x4 x0 = *(const f32x4*)(x + i * 8), x1 = *(const f32x4*)(x + i * 8 + 4);
        const f32x4 s0 = *(const f32x4*)(sc + col) + 1.0f, s1 = *(const f32x4*)(sc + col + 4) + 1.0f;
        const f32x4 h0 = *(const f32x4*)(sh + col), h1 = *(const f32x4*)(sh + col + 4);
        *(u32x4*)(u + i * 8) = pg8::pack8(x0 * s0 + h0, x1 * s1 + h1);
    }
}

__device__ __forceinline__ void rope_table(float* __restrict__ rope) {
    for (int i = blockIdx.x * NTHREADS + otid(); i < S * 32; i += gridDim.x * NTHREADS) {
        const int pos = i >> 5, j = i & 31;
        const float inv = exp2f(-(float)j * (13.287712379549449f / 32.0f));
        const float ang = (float)pos * inv;
        const double rev = (double)ang * 0.15915494309189535;
        const double fr = rev - floor(rev);
        const float ar = (float)(fr * 6.283185307179586);
        rope[(size_t)pos * 64 + j] = cosf(ar); rope[(size_t)pos * 64 + 32 + j] = sinf(ar);
    }
}

__device__ __forceinline__ void phase_prep(unsigned char* ws_) {
    const bf16_t* proj = (const bf16_t*)(ws_ + WS_PROJ); const float* rope = (const float*)(ws_ + WS_ROPE);
    float* rsq = (float*)(ws_ + WS_RSQ); float* rskv = (float*)(ws_ + WS_RSKV); bf16_t* Kb = (bf16_t*)(ws_ + WS_K);
    const int tid_o = otid(), lane = tid_o & 63, wave = tid_o >> 6;
    for (int r = blockIdx.x * 8 + wave; r < S; r += gridDim.x * 8) {
        const bf16_t* pr = proj + (size_t)r * DINP;
        { const u32x4 w = *(const u32x4*)(pr + C_CQ + 8 * lane); float ss = 0.f;
#pragma unroll
          for (int e = 0; e < 4; ++e) { const float lo = __uint_as_float(w[e] << 16), hi = __uint_as_float(w[e] & 0xffff0000u); ss += lo * lo + hi * hi; }
          ss = wave_sum(ss); if (lane == 0) rsq[r] = 1.0f / sqrtf(ss * (1.0f / 512.0f) + 1e-6f); }
        { const u32x2 w = *(const u32x2*)(pr + C_CKV + 4 * lane); float ss = 0.f;
#pragma unroll
          for (int e = 0; e < 2; ++e) { const float lo = __uint_as_float(w[e] << 16), hi = __uint_as_float(w[e] & 0xffff0000u); ss += lo * lo + hi * hi; }
          ss = wave_sum(ss); if (lane == 0) rskv[r] = 1.0f / sqrtf(ss * (1.0f / 256.0f) + 1e-6f); }
        { const int i = lane & 31; const float x1 = bf2f(pr[C_KR + i]), x2 = bf2f(pr[C_KR + 32 + i]);
          const float c = rope[(size_t)r * 64 + i], sn = rope[(size_t)r * 64 + 32 + i];
          const unsigned w = cvt_pk_bf16(x1 * c - x2 * sn, x2 * c + x1 * sn);
          const int hb = (lane >> 5) * 3;
#pragma unroll
          for (int h = 0; h < 3; ++h) *(unsigned*)(Kb + (size_t)r * KLD + (hb + h) * 192 + 128 + 2 * i) = w; }
    }
}

__device__ __forceinline__ void phase_ynorm(unsigned char* ws_) {
    bf16_t* y = (bf16_t*)(ws_ + WS_Y); const bf16_t* part = (const bf16_t*)(ws_ + WS_PART); const float* stat = (const float*)(ws_ + WS_STAT);
    const int tid_o = otid(), lane = tid_o & 63, wave = tid_o >> 6;
    const bool lowhalf = lane < 32;
    for (int r = blockIdx.x * 8 + wave; r < S; r += gridDim.x * 8) {
        bf16_t* yr = y + (size_t)r * DM;
        float v[4][8]; float ss[4];
#pragma unroll
        for (int j = 0; j < 4; ++j) {
            const bool fromPart = (j == 1) || (j == 2 && lowhalf);
            if (!fromPart) { const u32x4 w = *(const u32x4*)(yr + j * 512 + 8 * lane);
#pragma unroll
                for (int e = 0; e < 4; ++e) { v[j][2 * e] = __uint_as_float(w[e] << 16); v[j][2 * e + 1] = __uint_as_float(w[e] & 0xffff0000u); } }
            else { const int yb = j * 512 + 8 * lane - 512, h = yb >> 7; float m[4], lw[4];
#pragma unroll
                for (int i = 0; i < 4; ++i) { const float* st = stat + ((size_t)(i * 6 + h) * S + r) * 2; m[i] = st[0]; lw[i] = st[1]; }
                const float M = fmaxf(fmaxf(m[0], m[1]), fmaxf(m[2], m[3])); float W = 0.f;
#pragma unroll
                for (int i = 0; i < 4; ++i) { lw[i] *= __builtin_amdgcn_exp2f(m[i] - M); W += lw[i]; }
                const float rW = 1.0f / W;
#pragma unroll
                for (int e = 0; e < 8; ++e) v[j][e] = 0.f;
#pragma unroll
                for (int i = 0; i < 4; ++i) { const u32x4 w = *(const u32x4*)(part + ((size_t)i * S + r) * VLD + yb); const float wi = lw[i] * rW;
#pragma unroll
                    for (int e = 0; e < 4; ++e) { v[j][2 * e] += wi * __uint_as_float(w[e] << 16); v[j][2 * e + 1] += wi * __uint_as_float(w[e] & 0xffff0000u); } } }
            float sq = 0.f;
#pragma unroll
            for (int e = 0; e < 8; ++e) sq += v[j][e] * v[j][e];
            ss[j] = sq;
        }
        const float sA = wave_sum(ss[0]);
        const float sB = wave_sum(ss[1] + (lowhalf ? ss[2] : 0.f));
        const float sC = wave_sum(ss[3] + (lowhalf ? 0.f : ss[2]));
        const float rA = 1.0f / sqrtf(sA * (1.0f / 512.0f) + 1e-6f), rB = 1.0f / sqrtf(sB * (1.0f / 768.0f) + 1e-6f), rC = 1.0f / sqrtf(sC * (1.0f / 768.0f) + 1e-6f);
#pragma unroll
        for (int j = 0; j < 4; ++j) { const float sc = j == 0 ? rA : (j == 1 ? rB : (j == 2 ? (lowhalf ? rB : rC) : rC)); u32x4 o;
#pragma unroll
            for (int e = 0; e < 4; ++e) o[e] = cvt_pk_bf16(v[j][2 * e] * sc, v[j][2 * e + 1] * sc);
            *(u32x4*)(yr + j * 512 + 8 * lane) = o; }
    }
}

__device__ __forceinline__ void phase_ln(const float* z, float* xo, const float* __restrict__ g, const float* __restrict__ b, const float* __restrict__ sc, const float* __restrict__ sh, bf16_t* __restrict__ u) {
    const int tid_o = otid(), lane = tid_o & 63, wave = tid_o >> 6;
    const int stride = gridDim.x * 8;
    for (int r = blockIdx.x * 8 + wave; r < S; r += 2 * stride) {
        const bool hasB = r + stride < S; const int rr[2] = {r, hasB ? r + stride : r};
        f32x4 v[2][8]; float s[2] = {0.f, 0.f};
#pragma unroll
        for (int k = 0; k < 2; ++k) { const float* zr = z + (size_t)rr[k] * DM;
#pragma unroll
            for (int j = 0; j < 8; ++j) v[k][j] = *(const f32x4*)(zr + j * 256 + 4 * lane); }
#pragma unroll
        for (int k = 0; k < 2; ++k)
#pragma unroll
            for (int j = 0; j < 8; ++j) s[k] += (v[k][j][0] + v[k][j][1]) + (v[k][j][2] + v[k][j][3]);
        float mean[2], rstd[2];
#pragma unroll
        for (int k = 0; k < 2; ++k) { mean[k] = wave_sum(s[k]) * (1.0f / DM); float q = 0.f;
#pragma unroll
            for (int j = 0; j < 8; ++j) { const f32x4 d = v[k][j] - mean[k]; q += (d[0] * d[0] + d[1] * d[1]) + (d[2] * d[2] + d[3] * d[3]); }
            rstd[k] = 1.0f / sqrtf(wave_sum(q) * (1.0f / DM) + 1e-5f); }
#pragma unroll
        for (int j = 0; j < 8; ++j) { const int col = j * 256 + 4 * lane;
            const f32x4 gg = *(const f32x4*)(g + col), bb = *(const f32x4*)(b + col);
            f32x4 s1 = {0.f, 0.f, 0.f, 0.f}, h1 = {0.f, 0.f, 0.f, 0.f};
            if (u) { s1 = *(const f32x4*)(sc + col) + 1.0f; h1 = *(const f32x4*)(sh + col); }
#pragma unroll
            for (int k = 0; k < 2; ++k) { if (k == 1 && !hasB) continue;
                const f32x4 o = (v[k][j] - mean[k]) * rstd[k] * gg + bb;
                *(f32x4*)(xo + (size_t)rr[k] * DM + col) = o;
                if (u) { const f32x4 m = o * s1 + h1; u32x2 w; w.x = cvt_pk_bf16(m[0], m[1]); w.y = cvt_pk_bf16(m[2], m[3]); *(u32x2*)(u + (size_t)rr[k] * DM + col) = w; } } }
    }
}

template <int MODE>
__device__ __forceinline__ void naive_attn(unsigned char* ws_, const float* rpb, const float* sink, int l) {
    constexpr int DQK = MODE == 1 ? 192 : 128, NJ = DQK / 64, H = MODE == 0 ? 4 : 6;
    const bf16_t* proj = (const bf16_t*)(ws_ + WS_PROJ); bf16_t* y = (bf16_t*)(ws_ + WS_Y);
    const int tid_o = otid(), lane = tid_o & 63, wave = tid_o >> 6;
    for (int it = blockIdx.x * 8 + wave; it < S * H; it += gridDim.x * 8) {
        const int h = it / S, q = it % S;
        const bf16_t *Qp, *Kp, *Vp; int ldk, ldv, ycol; float scale;
        if (MODE == 0) { Qp = proj + (size_t)q * DINP + C_QA + 128 * h; Kp = proj + C_KA + 128 * h; Vp = proj + C_VA + 128 * h; ldk = DINP; ldv = DINP; ycol = 128 * h; scale = 0.08838834764831845f; }
        else if (MODE == 1) { Qp = (const bf16_t*)(ws_ + WS_Q) + (size_t)q * QLD + 192 * h; Kp = (const bf16_t*)(ws_ + WS_K) + 192 * h; Vp = (const bf16_t*)(ws_ + WS_V) + 128 * h; ldk = KLD; ldv = VLD; ycol = 512 + 128 * h; scale = 0.07216878364870322f; }
        else { Qp = proj + (size_t)q * DINP + C_QC + 128 * h; Kp = proj + C_KC + 128 * (h / 3); Vp = proj + C_VC + 128 * (h / 3); ldk = DINP; ldv = DINP; ycol = 1280 + 128 * h; scale = 0.08838834764831845f; }
        float qv[NJ];
#pragma unroll
        for (int j = 0; j < NJ; ++j) qv[j] = bf2f(Qp[64 * j + lane]) * scale;
        float m = -1e30f, ls = 0.f, o0 = 0.f, o1 = 0.f; int nkeys, klo = 0, r = 0, col = 0, r0 = 0, c0 = 0; float slope = 0.f;
        if (MODE == 0) { r = q >> 6; col = q & 63; r0 = min(max(r - 4, 0), 120); c0 = min(max(col - 8, 0), 48); nkeys = 128; }
        else if (MODE == 1) nkeys = S;
        else { klo = max(0, q - 128); nkeys = min(S - 1, q + 128) - klo + 1; m = sink[l * 6 + h]; ls = 1.f; slope = exp2f(-8.0f * (float)(h + 1) / 6.0f); }
        for (int kk = 0; kk < nkeys; ++kk) {
            int key; float bias = 0.f;
            if (MODE == 0) { const int krow = r0 + (kk >> 4), kcol = c0 + (kk & 15); key = krow * 64 + kcol; bias = rpb[((l * 4 + h) * 15 + (krow - r + 7)) * 31 + (kcol - col + 15)]; }
            else if (MODE == 1) key = kk;
            else { key = klo + kk; bias = -slope * fabsf((float)(q - key)); }
            float part = 0.f;
#pragma unroll
            for (int j = 0; j < NJ; ++j) part += qv[j] * bf2f(Kp[(size_t)key * ldk + 64 * j + lane]);
            const float s = wave_sum(part) + bias;
            const float mn = fmaxf(m, s), al = __expf(m - mn), p = __expf(s - mn);
            ls = ls * al + p;
            o0 = o0 * al + p * bf2f(Vp[(size_t)key * ldv + lane]); o1 = o1 * al + p * bf2f(Vp[(size_t)key * ldv + 64 + lane]);
            m = mn;
        }
        const float inv = 1.0f / ls;
        y[(size_t)q * DM + ycol + lane] = (bf16_t)(cvt_pk_bf16(o0 * inv, 0.f) & 0xffffu);
        y[(size_t)q * DM + ycol + 64 + lane] = (bf16_t)(cvt_pk_bf16(o1 * inv, 0.f) & 0xffffu);
    }
}

#define XB_TMO      128
#define XB_XCNT(j)  (256  + 64 * (j))
#define XB_XSUB(j)  (1280 + 64 * (j))
#define XB_XGEN(j)  (2304 + 64 * (j))
#define XB_TOP      3328
#define XB_TOPGEN   3392
#define XCD_BAR_WORDS 3456
#define XB_SPIN_CAP (1u << 18)

__device__ __forceinline__ unsigned xb_ld(unsigned* p)              { return __hip_atomic_load(p, __ATOMIC_RELAXED, __HIP_MEMORY_SCOPE_AGENT); }
__device__ __forceinline__ unsigned xb_add(unsigned* p, unsigned v) { return __hip_atomic_fetch_add(p, v, __ATOMIC_RELAXED, __HIP_MEMORY_SCOPE_AGENT); }
__device__ __forceinline__ unsigned xb_xcc_id() { return (unsigned)__builtin_amdgcn_s_getreg((3 << 11) | 20) & 0xFu; }
#define XB_SPIN(cond, bar) do { unsigned _sp = 0; while (cond) { __builtin_amdgcn_s_sleep(1); \
    if ((++_sp & 255u) == 0u) { if (xb_ld(&(bar)[XB_TMO])) break; if (_sp > XB_SPIN_CAP) { atomicAdd(&(bar)[XB_TMO], 1u); break; } } } } while (0)

struct XcdBarrier {
    unsigned* bar; unsigned x;
    volatile LAS unsigned* st;
};

__device__ __forceinline__ XcdBarrier xcd_barrier_post(unsigned* bar, volatile LAS unsigned* st) {
    XcdBarrier b; b.bar = bar; b.x = xb_xcc_id(); b.st = st;
    if (threadIdx.x == 0) (void)xb_add(&bar[XB_XCNT(b.x)], 1u);
    return b;
}
__device__ __forceinline__ void xcd_barrier_complete(unsigned* bar, unsigned x, unsigned& nloc, unsigned& nx) {
    const unsigned G = gridDim.x * gridDim.y * gridDim.z;
    unsigned sum, cnt, mine, sp = 0u;
    for (;;) {
        sum = 0u; cnt = 0u; mine = 0u;
#pragma unroll
        for (unsigned j = 0; j < 16; ++j) { const unsigned c = xb_ld(&bar[XB_XCNT(j)]); sum += c; cnt += (c > 0u) ? 1u : 0u; mine = (j == x) ? c : mine; }
        if (sum == G) break;
        __builtin_amdgcn_s_sleep(1);
        if ((++sp & 255u) == 0u) { if (xb_ld(&bar[XB_TMO])) break; if (sp > XB_SPIN_CAP) { atomicAdd(&bar[XB_TMO], 1u); break; } }
    }
    nloc = mine > 0u ? mine : 1u; nx = cnt > 0u ? cnt : 1u;
}

__device__ __forceinline__ void xcd_barrier(const XcdBarrier& b) {
    asm volatile("s_waitcnt vmcnt(0)" ::: "memory");
    __syncthreads();
    if (threadIdx.x == 0) {
        unsigned* bar = b.bar;
        __builtin_amdgcn_s_waitcnt(0);
        unsigned nloc = b.st[0], nx = b.st[1];
        if (nloc == 0u) { xcd_barrier_complete(bar, b.x, nloc, nx); b.st[0] = nloc; b.st[1] = nx; }
        const unsigned old = xb_add(&bar[XB_XSUB(b.x)], 1u);
        const unsigned gen = old / nloc;
        if (old + 1u == (gen + 1u) * nloc) {
            __builtin_amdgcn_fence(__ATOMIC_RELEASE, "agent");
            asm volatile("s_waitcnt vmcnt(0)" ::: "memory");
            const unsigned og = xb_add(&bar[XB_TOP], 1u);
            const unsigned tg = og / nx;
            if (og + 1u == (tg + 1u) * nx) xb_add(&bar[XB_TOPGEN], 1u);
            else XB_SPIN(xb_ld(&bar[XB_TOPGEN]) == tg, bar);
            __builtin_amdgcn_fence(__ATOMIC_ACQUIRE, "agent");
            xb_add(&bar[XB_XGEN(b.x)], 1u);
            asm volatile("s_waitcnt vmcnt(0)" ::: "memory");
        } else {
            XB_SPIN(xb_ld(&bar[XB_XGEN(b.x)]) == gen, bar);
            __builtin_amdgcn_fence(__ATOMIC_ACQUIRE, "agent");
            asm volatile("s_waitcnt vmcnt(0)" ::: "memory");
        }
    }
    __syncthreads();
}


namespace att {
typedef short bf16x8 __attribute__((ext_vector_type(8)));
typedef short s16x4 __attribute__((ext_vector_type(4)));
typedef float f32x16 __attribute__((ext_vector_type(16)));
#define ATT_SBAR() __builtin_amdgcn_sched_barrier(0)
#define ATT_BAR() do { asm volatile("s_waitcnt lgkmcnt(0)" ::: "memory"); __builtin_amdgcn_s_barrier(); asm volatile("" ::: "memory"); } while (0)
constexpr float LOG2E = 1.4426950408889634f, NEGM = -1e30f;
constexpr int KVSPLIT = 4;
__device__ __forceinline__ int crow(int r, int hi) { return (r & 3) + 8 * (r >> 2) + 4 * hi; }
__device__ __forceinline__ unsigned cvtpk(float lo, float hi) { unsigned r; asm volatile("v_cvt_pk_bf16_f32 %0, %1, %2" : "=v"(r) : "v"(lo), "v"(hi)); return r; }
template <int DQK> __device__ __forceinline__ int kswz_x(int row) { return DQK == 128 ? (((row & 7) | (((row >> 4) & 1) << 3)) << 4) : (((row >> 1) & 7) << 4); }
template <int DQK> __device__ __forceinline__ int kswz(int row, int colB) { return row * (DQK * 2) + (colB ^ kswz_x<DQK>(row)); }
__device__ __forceinline__ int v_st(int k, int c) { const int kk = (k & ~0xC) | ((k & 4) << 1) | ((k & 8) >> 1); return ((kk >> 3) * 4 + (c >> 5)) * 512 + ((kk & 7) * 32 + (c & 31)) * 2; }
__device__ __forceinline__ int v_rd_base(int lane) { return ((lane & 3) << 3) | (((lane >> 2) & 3) << 6) | (((lane >> 4) & 1) << 5) | (((lane >> 5) & 1) << 8); }
constexpr int v_rd_off(int d0, int ks, int half) { return d0 * 512 + ks * 4096 + half * 2048; }
template <int OFF> __device__ __forceinline__ s16x4 tr_read(int vb) { s16x4 r; asm volatile("ds_read_b64_tr_b16 %0, %1 offset:%2" : "=&v"(r) : "v"(vb), "i"(OFF) : "memory"); return r; }
struct VFrag { s16x4 l0, h0, l1, h1, l2, h2, l3, h3; };
template <int D0> __device__ __forceinline__ void pv_read(VFrag& f, int vb) {
  f.l0 = tr_read<v_rd_off(D0, 0, 0)>(vb); f.h0 = tr_read<v_rd_off(D0, 0, 1)>(vb); f.l1 = tr_read<v_rd_off(D0, 1, 0)>(vb); f.h1 = tr_read<v_rd_off(D0, 1, 1)>(vb);
  f.l2 = tr_read<v_rd_off(D0, 2, 0)>(vb); f.h2 = tr_read<v_rd_off(D0, 2, 1)>(vb); f.l3 = tr_read<v_rd_off(D0, 3, 0)>(vb); f.h3 = tr_read<v_rd_off(D0, 3, 1)>(vb);
}
__device__ __forceinline__ void pv_mma(f32x16& od, const VFrag& f, bf16x8 pa0, bf16x8 pa1, bf16x8 pa2, bf16x8 pa3) {
#define ATT_PK(L, H) (bf16x8){L[0], L[1], L[2], L[3], H[0], H[1], H[2], H[3]}
  od = __builtin_amdgcn_mfma_f32_32x32x16_bf16(pa0, ATT_PK(f.l0, f.h0), od, 0, 0, 0);
  od = __builtin_amdgcn_mfma_f32_32x32x16_bf16(pa1, ATT_PK(f.l1, f.h1), od, 0, 0, 0);
  od = __builtin_amdgcn_mfma_f32_32x32x16_bf16(pa2, ATT_PK(f.l2, f.h2), od, 0, 0, 0);
  od = __builtin_amdgcn_mfma_f32_32x32x16_bf16(pa3, ATT_PK(f.l3, f.h3), od, 0, 0, 0);
#undef ATT_PK
}
__device__ __forceinline__ void pv_d0(f32x16* o, int vb, bf16x8 pa0, bf16x8 pa1, bf16x8 pa2, bf16x8 pa3) {
  VFrag fa, fb;
  pv_read<0>(fa, vb); pv_read<1>(fb, vb);
  asm volatile("s_waitcnt lgkmcnt(8)" ::: "memory"); ATT_SBAR(); pv_mma(o[0], fa, pa0, pa1, pa2, pa3); ATT_SBAR();
  pv_read<2>(fa, vb);
  asm volatile("s_waitcnt lgkmcnt(8)" ::: "memory"); ATT_SBAR(); pv_mma(o[1], fb, pa0, pa1, pa2, pa3); ATT_SBAR();
  pv_read<3>(fb, vb);
  asm volatile("s_waitcnt lgkmcnt(8)" ::: "memory"); ATT_SBAR(); pv_mma(o[2], fa, pa0, pa1, pa2, pa3); ATT_SBAR();
  asm volatile("s_waitcnt lgkmcnt(0)" ::: "memory"); ATT_SBAR(); pv_mma(o[3], fb, pa0, pa1, pa2, pa3);
}
typedef float f32x2 __attribute__((ext_vector_type(2)));
template <bool RAW>
__device__ __forceinline__ void softmax_tile(f32x16& p0, f32x16& p1, float Cs, float& m_reg, float& l_reg, float& alpha, bf16x8& pa0, bf16x8& pa1, bf16x8& pa2, bf16x8& pa3) {
  float pmax = fmaxf(fmaxf(p0[0], p0[1]), p1[0]);
#pragma unroll
  for (int r = 2; r < 16; r += 2) pmax = fmaxf(fmaxf(pmax, p0[r]), p0[r + 1]);
#pragma unroll
  for (int r = 1; r < 15; r += 2) pmax = fmaxf(fmaxf(pmax, p1[r]), p1[r + 1]);
  pmax = fmaxf(pmax, p1[15]);
  { auto rr = __builtin_amdgcn_permlane32_swap(__float_as_uint(pmax), __float_as_uint(pmax), false, false); pmax = fmaxf(__uint_as_float(rr[0]), __uint_as_float(rr[1])); }
  if (RAW) pmax *= Cs;
  const float mn = fmaxf(m_reg, pmax); alpha = __builtin_amdgcn_exp2f(m_reg - mn); m_reg = mn;
#pragma unroll
  for (int r = 0; r < 16; ++r) { p0[r] = __builtin_amdgcn_exp2f(RAW ? fmaf(p0[r], Cs, -mn) : p0[r] - mn); p1[r] = __builtin_amdgcn_exp2f(RAW ? fmaf(p1[r], Cs, -mn) : p1[r] - mn); }
  f32x2 ps2 = {0.f, 0.f};
#pragma unroll
  for (int r = 0; r < 16; r += 2) { ps2 += (f32x2){p0[r], p0[r + 1]}; ps2 += (f32x2){p1[r], p1[r + 1]}; }
  float ps = ps2[0] + ps2[1];
  { auto rr = __builtin_amdgcn_permlane32_swap(__float_as_uint(ps), __float_as_uint(ps), false, false); ps = __uint_as_float(rr[0]) + __uint_as_float(rr[1]); }
  l_reg = l_reg * alpha + ps;
#define ATT_PK4(P, BASE, OUT) do { unsigned a0 = cvtpk(P[BASE + 0], P[BASE + 1]), a1 = cvtpk(P[BASE + 2], P[BASE + 3]);   \
    unsigned b0 = cvtpk(P[BASE + 4], P[BASE + 5]), b1 = cvtpk(P[BASE + 6], P[BASE + 7]);                              \
    auto r0 = __builtin_amdgcn_permlane32_swap(a0, b0, false, false); auto r1 = __builtin_amdgcn_permlane32_swap(a1, b1, false, false); \
    u32x4 w = {r0[0], r1[0], r0[1], r1[1]}; OUT = *reinterpret_cast<bf16x8*>(&w); } while (0)
  ATT_PK4(p0, 0, pa0); ATT_PK4(p0, 8, pa1); ATT_PK4(p1, 0, pa2); ATT_PK4(p1, 8, pa3);
#undef ATT_PK4
}

template <int MODE>
__device__ __forceinline__ void attn_unit(unsigned char* ws_, const float* rpb, const float* sink, int l, int h, int qb, int kvq, unsigned char* lds_g) {
  constexpr int DQK = MODE == 1 ? 192 : 128, ND = DQK / 16, NCH = DQK / 64;
  constexpr int SHM_V = 64 * 128 * 2, SHM_K = 64 * DQK * 2, OFF_K = 3 * SHM_V, OFF_WS = OFF_K + 3 * SHM_K, OFF_RPB = OFF_WS + 8 * 64 * 4;
  const int tid = otid(), wid = tid >> 6, lane = tid & 63, r32 = lane & 31, hi = lane >> 5;
  LAS unsigned char* ldl = (LAS unsigned char*)lds_g;
  const bf16_t* proj = (const bf16_t*)(ws_ + WS_PROJ);
  const bf16_t *Qp, *Kp, *Vp; int ldq, ldk, ldv, ycol; float C;
  if (MODE == 0) { Qp = proj + C_QA + 128 * h; Kp = proj + C_KA + 128 * h; Vp = proj + C_VA + 128 * h; ldq = ldk = ldv = DINP; ycol = 128 * h; C = 0.08838834764831845f * LOG2E; }
  else if (MODE == 1) { Qp = (const bf16_t*)(ws_ + WS_Q) + 192 * h; Kp = (const bf16_t*)(ws_ + WS_K) + 192 * h; Vp = (const bf16_t*)(ws_ + WS_V) + 128 * h; ldq = QLD; ldk = KLD; ldv = VLD; ycol = 512 + 128 * h; C = 0.07216878364870322f * LOG2E; }
  else { Qp = proj + C_QC + 128 * h; Kp = proj + C_KC + 128 * (h / 3); Vp = proj + C_VC + 128 * (h / 3); ldq = ldk = ldv = DINP; ycol = 1280 + 128 * h; C = 0.08838834764831845f * LOG2E; }
  const int q0 = qb * 256, qi = q0 + wid * 32 + r32;
  int T0, T1, tw0, tw1, wrow = 0, qcol = 0, c0 = 0; float slope2 = 0.f;
  if (MODE == 1) { T0 = tw0 = kvq * (S / 64 / KVSPLIT); T1 = tw1 = T0 + S / 64 / KVSPLIT; }
  else if (MODE == 0) { const int R = qb * 4; T0 = min(max(R - 4, 0), 120); T1 = min(max(R - 1, 0), 120) + 8; wrow = R + (wid >> 1); tw0 = min(max(wrow - 4, 0), 120); tw1 = tw0 + 8;
                        qcol = (wid & 1) * 32 + r32; c0 = min(max(qcol - 8, 0), 48); }
  else { T0 = max(0, (q0 - 128) >> 6); T1 = min(S / 64, ((q0 + 255 + 128) >> 6) + 1); const int qw = q0 + wid * 32; tw0 = max(0, (qw - 128) >> 6); tw1 = min(S / 64, ((qw + 31 + 128) >> 6) + 1);
         slope2 = exp2f(-8.0f * (float)(h + 1) / 6.0f) * LOG2E; }
  LAS float* wsl = (LAS float*)(ldl + OFF_WS) + wid * 64; LAS float* li_l = wsl; LAS float* al_l = wsl + 32;
  LAS float* rpbL = (LAS float*)(ldl + OFF_RPB);
  if (MODE == 0) { for (int i = tid; i < 465; i += NTHREADS) rpbL[i] = rpb[(l * 4 + h) * 465 + i] * LOG2E; }
  float m_reg = -1e29f, l_reg = 0.f;
  if (MODE == 2) { m_reg = sink[l * 6 + h] * LOG2E; l_reg = 1.f; }
  f32x16 o[4] = {}; bf16x8 qr[ND];
  { const bf16_t* Qw = Qp + (size_t)qi * ldq + hi * 8;
#pragma unroll
    for (int d0 = 0; d0 < ND; ++d0) qr[d0] = *(const bf16x8*)(Qw + d0 * 16); }
  unsigned kg[NCH], vg[2];
#pragma unroll
  for (int i = 0; i < NCH; ++i) { const int X = (wid + 8 * i) * 1024 + lane * 16, row = X / (DQK * 2), cs = X % (DQK * 2), colB = cs ^ kswz_x<DQK>(row); kg[i] = (unsigned)(row * ldk + (colB >> 1)) * 2u; }
#pragma unroll
  for (int i = 0; i < 2; ++i) { const int X = (wid + 8 * i) * 1024 + lane * 16, st = X >> 9, w = X & 511, kk = ((st >> 2) << 3) | (w >> 6), c = ((st & 3) << 5) | ((w & 63) >> 1);
    const int k = (kk & ~0xC) | ((kk & 4) << 1) | ((kk & 8) >> 1); vg[i] = (unsigned)(k * ldv + c) * 2u; }
  const int vb0 = (int)(uintptr_t)lds_g + v_rd_base(lane);
  const int kbase0 = (int)(uintptr_t)lds_g + OFF_K;
  constexpr int NKO = DQK == 192 ? 4 : ND;
  int ko[NKO];
#pragma unroll
  for (int d0 = 0; d0 < NKO; ++d0) ko[d0] = kswz<DQK>(r32, (d0 * 16 + hi * 8) * 2);
#define ATT_KO(d0_) (DQK == 192 ? ko[(d0_) & 3] + ((d0_) >> 2) * 128 : ko[(d0_) % NKO])
  const int wslab = __builtin_amdgcn_readfirstlane(wid) * 1024;
#define ATT_DMA(t, b) do { const char* kt_ = (const char*)(Kp + (size_t)(t) * 64 * ldk); const char* vt_ = (const char*)(Vp + (size_t)(t) * 64 * ldv); \
    _Pragma("unroll") for (int i_ = 0; i_ < NCH; ++i_) __builtin_amdgcn_global_load_lds((const unsigned*)(kt_ + kg[i_]), (LAS unsigned*)(ldl + OFF_K + (b) * SHM_K + wslab + i_ * 8192), 16, 0, 0); \
    _Pragma("unroll") for (int i_ = 0; i_ < 2; ++i_) __builtin_amdgcn_global_load_lds((const unsigned*)(vt_ + vg[i_]), (LAS unsigned*)(ldl + (b) * SHM_V + wslab + i_ * 8192), 16, 0, 0); } while (0)
  __syncthreads();
  ATT_DMA(T0, 0); if (T0 + 1 < T1) { ATT_DMA(T0 + 1, 1); asm volatile("s_waitcnt vmcnt(%0)" :: "n"(NCH + 2) : "memory"); } else asm volatile("s_waitcnt vmcnt(0)" ::: "memory");
  ATT_BAR();
  int b = 0, bn = 2;
#pragma unroll 1
  for (int j = T0; j < T1; ++j) {
    const bool vis_ = (j >= tw0 && j < tw1);
    if (vis_) {
      f32x16 p0 = {}, p1 = {};
      ATT_SBAR();
      {
        const int kbase = kbase0 + b * SHM_K;
        bf16x8 fa[3], fb[3];
#define ATT_KRD(d0_) do { const int ad_ = kbase + ATT_KO(d0_); \
          asm volatile("ds_read_b128 %0, %1" : "=v"(fa[(d0_) % 3]) : "v"(ad_) : "memory"); \
          asm volatile("ds_read_b128 %0, %1 offset:%2" : "=v"(fb[(d0_) % 3]) : "v"(ad_), "i"(32 * DQK * 2) : "memory"); } while (0)
        ATT_KRD(0); ATT_KRD(1);
#pragma unroll
        for (int d0 = 0; d0 < ND; ++d0) {
          if (d0 + 2 < ND) { ATT_KRD(d0 + 2); asm volatile("s_waitcnt lgkmcnt(4)" ::: "memory"); }
          else if (d0 + 1 < ND) asm volatile("s_waitcnt lgkmcnt(2)" ::: "memory");
          else asm volatile("s_waitcnt lgkmcnt(0)" ::: "memory");
          ATT_SBAR();
          p0 = __builtin_amdgcn_mfma_f32_32x32x16_bf16(fa[d0 % 3], qr[d0], p0, 0, 0, 0);
          p1 = __builtin_amdgcn_mfma_f32_32x32x16_bf16(fb[d0 % 3], qr[d0], p1, 0, 0, 0);
          ATT_SBAR(); }
#undef ATT_KRD
      }
      ATT_SBAR();
      if (MODE == 0) {
        const int dr31 = (j - wrow + 7) * 31 + 15 - qcol;
#pragma unroll
        for (int r = 0; r < 16; ++r) { const int kc = crow(r, hi);
          { const bool v = (kc >= c0) && (kc < c0 + 16); const float bb = rpbL[v ? dr31 + kc : 0]; p0[r] = v ? fmaf(p0[r], C, bb) : NEGM; }
          { const int kc1 = kc + 32; const bool v = (kc1 >= c0) && (kc1 < c0 + 16); const float bb = rpbL[v ? dr31 + kc1 : 0]; p1[r] = v ? fmaf(p1[r], C, bb) : NEGM; } }
      } else if (MODE == 2) {
        const int kb = j * 64;
#pragma unroll
        for (int r = 0; r < 16; ++r) { const int k = kb + crow(r, hi);
          { const int d = abs(qi - k); p0[r] = d <= 128 ? fmaf(p0[r], C, -slope2 * (float)d) : NEGM; }
          { const int d = abs(qi - k - 32); p1[r] = d <= 128 ? fmaf(p1[r], C, -slope2 * (float)d) : NEGM; } }
      }
      float alpha; bf16x8 pa0, pa1, pa2, pa3;
      softmax_tile<MODE == 1>(p0, p1, C, m_reg, l_reg, alpha, pa0, pa1, pa2, pa3);
      if (__any(alpha < 1.f)) { if (hi == 0) al_l[r32] = alpha; asm volatile("s_waitcnt lgkmcnt(0)" ::: "memory");
#pragma unroll
        for (int r = 0; r < 16; ++r) { const float av = al_l[crow(r, hi)];
#pragma unroll
          for (int d = 0; d < 4; ++d) o[d][r] *= av; }
        asm volatile("s_waitcnt lgkmcnt(0)" ::: "memory"); }
      ATT_SBAR();
      pv_d0(o, vb0 + b * SHM_V, pa0, pa1, pa2, pa3);
    }
#if defined(PROBE_ATT_VALU)
    if (MODE == 1) { float dx_ = m_reg;
#pragma unroll
      for (int i_ = 0; i_ < 32; ++i_) asm volatile("v_exp_f32 %0, %0" : "+v"(dx_));
      asm volatile("" :: "v"(dx_)); }
#endif
#if defined(PROBE_ATT_LDS)
    if (MODE == 1) { bf16x8 t_; const int ad_ = (int)(uintptr_t)lds_g + OFF_K + b * SHM_K + kswz<DQK>(r32, hi * 16);
#pragma unroll
      for (int i_ = 0; i_ < 24; ++i_) asm volatile("ds_read_b128 %0, %1 offset:%2" : "=v"(t_) : "v"(ad_), "i"((i_ % 12) * 32) : "memory");
      asm volatile("s_waitcnt lgkmcnt(0)" ::: "memory"); asm volatile("" :: "v"(t_)); }
#endif
#if defined(PROBE_ATT_MFMA)
    if (MODE == 1) { f32x4 da_ = {0.f, 0.f, 0.f, 0.f};
#pragma unroll
      for (int i_ = 0; i_ < 80; ++i_) da_ = __builtin_amdgcn_mfma_f32_16x16x32_bf16(qr[0], qr[1], da_, 0, 0, 0);
      asm volatile("" :: "v"(da_)); }
#endif
    ATT_SBAR();
    if (j + 2 < T1) ATT_DMA(j + 2, bn);
    if (j + 2 < T1) asm volatile("s_waitcnt vmcnt(%0)" :: "n"(NCH + 2) : "memory"); else asm volatile("s_waitcnt vmcnt(0)" ::: "memory");
    ATT_BAR();
    b = b == 2 ? 0 : b + 1; bn = bn == 2 ? 0 : bn + 1;
  }
  if (hi == 0) li_l[r32] = l_reg; asm volatile("s_waitcnt lgkmcnt(0)" ::: "memory");
  bf16_t* Ow; int ldo;
  if (MODE == 1) { Ow = (bf16_t*)(ws_ + WS_PART) + ((size_t)kvq * S + q0 + wid * 32) * VLD + 128 * h + r32; ldo = VLD;
    if (hi == 0) { float* st = (float*)(ws_ + WS_STAT) + ((size_t)(kvq * 6 + h) * S + qi) * 2; st[0] = m_reg; st[1] = l_reg; } }
  else { Ow = (bf16_t*)(ws_ + WS_Y) + (size_t)(q0 + wid * 32) * DM + ycol + r32; ldo = DM; }
#pragma unroll
  for (int r = 0; r < 16; ++r) { const int orow = crow(r, hi); const float rl = __builtin_amdgcn_rcpf(li_l[orow]);
#pragma unroll
    for (int d0 = 0; d0 < 4; ++d0) Ow[(size_t)orow * ldo + d0 * 32] = (bf16_t)(cvtpk(o[d0][r] * rl, 0.f) & 0xffffu); }
  asm volatile("s_waitcnt lgkmcnt(0)" ::: "memory");
  __syncthreads();
#undef ATT_DMA
#undef ATT_KO
}
}

#ifndef NAIVE_ATTN
#define NAIVE_ATTN 0
#endif
#ifndef MK_MULTI
#define MK_MULTI 0
#endif
constexpr int N_PHASES = 2 + 10 * DEPTH;
__device__ __forceinline__ int opq(int v) { asm volatile("" : "+s"(v)); return v; }

__global__ void __launch_bounds__(NTHREADS) fwd_megakernel(Args a) {
    extern __shared__ __attribute__((aligned(16))) unsigned char lds[];
    cg::grid_group grid = cg::this_grid();
    const int lo = a.ph_lo, hi = a.ph_hi;
    const int G = gridDim.x;
    { LAS unsigned long long* tw = (LAS unsigned long long*)((LAS unsigned char*)lds + TAB_OFF);
#pragma unroll
      for (int i = 0; i < 19; ++i) if ((int)threadIdx.x == i) tw[i] = (unsigned long long)a.in[i];
      if (threadIdx.x == 19) tw[19] = (unsigned long long)a.out;
      if (threadIdx.x == 20) tw[20] = (unsigned long long)a.ws;
      if (threadIdx.x < 4) ((LAS unsigned*)((LAS unsigned char*)lds + TAB_OFF + 192))[threadIdx.x] = 0u;
      __syncthreads(); }
    (void)xcd_barrier_post((unsigned*)(a.ws + WS_BAR), (volatile LAS unsigned*)((LAS unsigned char*)lds + TAB_OFF + 192));
    if (a.ph_lo < 0) grid.sync();
    const Tab T{(const LAS unsigned*)((LAS unsigned char*)lds + TAB_OFF)};
#define ws (T.wsp())
#define mod ((float*)(ws + WS_MOD))
#define U ((bf16_t*)(ws + WS_U))
#define PROJ ((bf16_t*)(ws + WS_PROJ))
#define Qb ((bf16_t*)(ws + WS_Q))
#define Kb ((bf16_t*)(ws + WS_K))
#define Vb ((bf16_t*)(ws + WS_V))
#define Y ((bf16_t*)(ws + WS_Y))
#define Hb ((bf16_t*)(ws + WS_H))
#define X ((float*)(ws + WS_X))
#define rope ((float*)(ws + WS_ROPE))
#define rsq ((float*)(ws + WS_RSQ))
#define rskv ((float*)(ws + WS_RSKV))
    PG8_LAS unsigned char* ldsl = (PG8_LAS unsigned char*)lds;
#ifndef PHM
#define PHM 0xFFFFF
#endif
#ifndef ATM
#define ATM 7
#endif
#define EN(b) ((PHM >> (b)) & 1)
#ifndef PROBE_PH
#define PROBE_PH -1
#endif
#ifndef PROBE_N
#define PROBE_N 2
#endif
#define REPK(k) for (int rep_ = 0; rep_ < ((k) == PROBE_PH ? PROBE_N : 1); ++rep_)
#define IN(k) (lo <= (k) && (k) < hi)
#define GBAR() do { XcdBarrier b_; b_.bar = (unsigned*)(ws + WS_BAR); b_.x = xb_xcc_id(); b_.st = (volatile LAS unsigned*)((LAS unsigned char*)lds + TAB_OFF + 192); xcd_barrier(b_); } while (0)
#define SEAM(k) do { if (IN(k) && IN((k) + 1)) GBAR(); } while (0)

#ifdef PROBE_SYNCS
    for (int i_ = 0; i_ < PROBE_SYNCS; ++i_) GBAR();
#endif
    if (EN(0) && IN(0)) REPK(0) { phase_mod(T, lds); }
    SEAM(0);
    if (EN(1) && IN(1)) REPK(1) {
        for (int l = 0; l < DEPTH; ++l) {
            transpose_job<3>(T.in(4) + (size_t)l * DM * DIN, (bf16_t*)(ws + WS_W + (size_t)l * SZ_WL + O_WIN), DM, DIN, DINP, nullptr, lds);
            transpose_job<1>(T.in(8) + (size_t)l * 512 * 1152, (bf16_t*)(ws + WS_W + (size_t)l * SZ_WL + O_WUQ), 512, 1152, 1280, T.in(6) + l * 512, lds);
            transpose_job<0>(T.in(9) + (size_t)l * 256 * 1536, (bf16_t*)(ws + WS_W + (size_t)l * SZ_WL + O_WUKV), 256, 1536, 1536, T.in(7) + l * 256, lds);
            transpose_job<0>(T.in(12) + (size_t)l * DM * DM, (bf16_t*)(ws + WS_W + (size_t)l * SZ_WL + O_WO), DM, DM, DM, T.in(11) + l * DM, lds);
            transpose_job<2>(T.in(15) + (size_t)l * DM * 2 * DFF, (bf16_t*)(ws + WS_W + (size_t)l * SZ_WL + O_WGU), DM, 2 * DFF, 2 * DFF, nullptr, lds);
            transpose_job<0>(T.in(16) + (size_t)l * DFF * DM, (bf16_t*)(ws + WS_W + (size_t)l * SZ_WL + O_WDN), DFF, DM, DM, nullptr, lds);
        }
        modulate_rows(T.in(0), mod + 1 * DM, mod + 0 * DM, U);
        rope_table(rope);
    }
    SEAM(1);
#pragma unroll 1
    for (int l = 0; l < DEPTH; ++l) {
        const int pb = 2 + 10 * l;
        if (EN(2) && IN(pb + 0)) REPK(2) {
            pg8::Gemm g{U, (const bf16_t*)(ws + WS_W + (size_t)l * SZ_WL + O_WIN), S, DINP, DM, DM}; pg8::StaticOrder So; So.init(S, DINP, opq(G), opq((int)blockIdx.x));
            pg8::EpiProj E{PROJ, DINP, (float*)(ws + WS_SSQ), rope, Kb, KLD};
            pg8::gemm_phase<pg8::EpiProj, pg8::StaticOrder, true, true>(ldsl, g, So, E);
        }
        SEAM(pb + 0);
        if (EN(4) && IN(pb + 2)) REPK(4) {
            { const int bq = opq((int)blockIdx.x), Gq = opq(G);
#pragma unroll 1
              for (int it = 0; ; ++it) {
                int q0 = -1, kv0 = -1, kv1 = -1, na = -1, sw0 = -1, sw1 = -1;
                if (Gq == 256) { if (it == 0) {
                    if (bq < 96) { na = bq; q0 = bq; }
                    else if (bq < 128) { na = bq; kv0 = 2 * (bq - 96); kv1 = kv0 + 1; }
                    else if (bq < 192) { sw0 = bq - 128; q0 = 96 + (bq - 128); kv0 = 64 + 2 * (bq - 128); kv1 = kv0 + 1; }
                    else { sw0 = 64 + (bq - 192); sw1 = 128 + (bq - 192); } } }
                else { const int L = bq + it * Gq; if (L < 160) q0 = L; if (L < 192) { kv0 = L; sw0 = L; } if (L < 128) na = L; }
                if ((q0 & kv0 & na & sw0) < 0 && q0 < 0 && kv0 < 0 && na < 0 && sw0 < 0) break;
                if (q0 >= 0) { pg8::Gemm g{PROJ + C_CQ, (const bf16_t*)(ws + WS_W + (size_t)l * SZ_WL + O_WUQ), S, 1280, 512, DINP}; pg8::ListOrder So{5, 1, q0, 0};
                  pg8::EpiQ E{Qb, QLD, (const float*)(ws + WS_SSQ), rope};
                  pg8::gemm_phase<pg8::EpiQ, pg8::ListOrder, true, true>(ldsl, g, So, E); }
                if (kv0 >= 0) { pg8::Gemm g{PROJ + C_CKV, (const bf16_t*)(ws + WS_W + (size_t)l * SZ_WL + O_WUKV), S, 1536, 256, DINP}; pg8::ListOrder So{6, kv1 >= 0 ? 2 : 1, kv0, kv1};
                  pg8::EpiKV E{Kb, KLD, Vb, VLD, (const float*)(ws + WS_SSQ)};
                  pg8::gemm_phase<pg8::EpiKV, pg8::ListOrder, true, true>(ldsl, g, So, E); }
                if (na >= 0) { if (ATM & 2) att::attn_unit<0>(ws, T.in(5), T.in(10), l, na >> 5, na & 31, 0, lds); }
#pragma unroll 1
                for (int i2 = 0; i2 < 2; ++i2) { const int u = i2 ? sw1 : sw0; if (u >= 0) { if (ATM & 4) att::attn_unit<2>(ws, T.in(5), T.in(10), l, u >> 5, u & 31, 0, lds); } }
              } }
        }
        SEAM(pb + 2);
        if (EN(5) && IN(pb + 3)) REPK(5) {
#if NAIVE_ATTN
            naive_attn<0>(ws, T.in(5), T.in(10), l); naive_attn<2>(ws, T.in(5), T.in(10), l); naive_attn<1>(ws, T.in(5), T.in(10), l);
#else
            const int Gq = opq(G);
            for (int su = opq((int)blockIdx.x); su < 192 * att::KVSPLIT; su += Gq) {
                int combo, qb; if (Gq == 256) { combo = (su & 7) + 8 * (su >> 8); qb = (su & 255) >> 3; } else { combo = su >> 5; qb = su & 31; }
                unsigned char* wsp_ = ws;
                if (ATM & 1) att::attn_unit<1>(wsp_, nullptr, nullptr, l, combo >> 2, qb, combo & 3, lds);
            }
#endif
        }
        SEAM(pb + 3);
        if (EN(6) && IN(pb + 4)) phase_ynorm(ws);
        SEAM(pb + 4);
        if (EN(7) && IN(pb + 5)) {
            pg8::Gemm g{Y, (const bf16_t*)(ws + WS_W + (size_t)l * SZ_WL + O_WO), S, DM, DM, DM}; pg8::StaticOrder So; So.init(S, DM, opq(G), opq((int)blockIdx.x));
            pg8::EpiRes E{l == 0 ? T.in(0) : (const float*)X, X, mod + (size_t)l * 6 * DM + 2 * DM, ALPHA, DM};
            pg8::gemm_phase<pg8::EpiRes, pg8::StaticOrder, true, true>(ldsl, g, So, E);
        }
        SEAM(pb + 5);
#ifdef PROBE_LN
        if (EN(8) && IN(pb + 6)) phase_ln(X, (float*)(ws + WS_H), T.in(13) + l * DM, T.in(14) + l * DM, mod + (size_t)l * 6 * DM + 4 * DM, mod + (size_t)l * 6 * DM + 3 * DM, (bf16_t*)(ws + WS_PART));
#endif
        if (EN(8) && IN(pb + 6)) phase_ln(X, X, T.in(13) + l * DM, T.in(14) + l * DM, mod + (size_t)l * 6 * DM + 4 * DM, mod + (size_t)l * 6 * DM + 3 * DM, U);
        SEAM(pb + 6);
        if (EN(9) && IN(pb + 7)) REPK(9) {
            pg8::Gemm g{U, (const bf16_t*)(ws + WS_W + (size_t)l * SZ_WL + O_WGU), S, 2 * DFF, DM, DM}; pg8::StaticOrder So; So.init(S, 2 * DFF, opq(G), opq((int)blockIdx.x));
            pg8::EpiSwiglu E{Hb, DFF};
            pg8::gemm_phase<pg8::EpiSwiglu, pg8::StaticOrder, true, true>(ldsl, g, So, E);
        }
        SEAM(pb + 7);
        if (EN(10) && IN(pb + 8)) {
            pg8::Gemm g{Hb, (const bf16_t*)(ws + WS_W + (size_t)l * SZ_WL + O_WDN), S, DM, DFF, DFF}; pg8::StaticOrder So; So.init(S, DM, opq(G), opq((int)blockIdx.x));
            pg8::EpiRes E{X, X, mod + (size_t)l * 6 * DM + 5 * DM, ALPHA, DM};
            pg8::gemm_phase<pg8::EpiRes, pg8::StaticOrder, true, true>(ldsl, g, So, E);
        }
        SEAM(pb + 8);
        if (EN(11) && IN(pb + 9)) {
            const bool last = (l == DEPTH - 1);
            const float* modn = mod + (size_t)(last ? l : l + 1) * 6 * DM;
            phase_ln(X, last ? T.out() : X, T.in(17) + l * DM, T.in(18) + l * DM, last ? nullptr : modn + 1 * DM, last ? nullptr : modn + 0 * DM, last ? nullptr : U);
        }
        SEAM(pb + 9);
    }
#undef IN
#undef SEAM
#undef ws
#undef mod
#undef U
#undef PROJ
#undef Qb
#undef Kb
#undef Vb
#undef Y
#undef Hb
#undef X
#undef rope
#undef rsq
#undef rskv
}

extern "C" void kernel_launch(void* const* d_in, const int* in_sizes, int n_in, void* d_out, int out_size, void* d_ws, size_t ws_size, hipStream_t stream) {
    static int grid = 0;
    if (grid == 0) {
        if (n_in != 19 || out_size != S * DM || ws_size < WS_END) { fprintf(stderr, "kernel_launch: unexpected shapes (n_in %d out %d ws %zu need %zu)\n", n_in, out_size, ws_size, (size_t)WS_END); grid = -1; return; }
        int dev = 0, cus = 0, per_cu = 0;
        hipGetDevice(&dev); hipDeviceGetAttribute(&cus, hipDeviceAttributeMultiprocessorCount, dev);
        if (hipFuncSetAttribute((const void*)fwd_megakernel, hipFuncAttributeMaxDynamicSharedMemorySize, LDS_BYTES) != hipSuccess) { fprintf(stderr, "kernel_launch: hipFuncSetAttribute failed\n"); grid = -1; return; }
        if (hipOccupancyMaxActiveBlocksPerMultiprocessor(&per_cu, (const void*)fwd_megakernel, NTHREADS, LDS_BYTES) != hipSuccess || per_cu < 1) { fprintf(stderr, "kernel_launch: occupancy query gave %d\n", per_cu); per_cu = 1; }
        (void)hipGetLastError();
        grid = cus;
    }
    if (grid < 0) return;
    if (hipMemsetAsync((char*)d_ws + WS_BAR, 0, 16384, stream) != hipSuccess) { fprintf(stderr, "kernel_launch: memset of the barrier words failed\n"); return; }
    Args a{};
    for (int i = 0; i < 19; ++i) a.in[i] = (const float*)d_in[i];
    a.out = (float*)d_out; a.ws = (unsigned char*)d_ws;
#if MK_MULTI
    for (int p = 0; p < N_PHASES; ++p) { a.ph_lo = p; a.ph_hi = p + 1; hipLaunchKernelGGL(fwd_megakernel, dim3(grid), dim3(NTHREADS), LDS_BYTES, stream, a); }
#else
    a.ph_lo = 0; a.ph_hi = N_PHASES;
    void* args[] = {&a};
    hipError_t e = hipLaunchCooperativeKernel((const void*)fwd_megakernel, dim3(grid), dim3(NTHREADS), args, LDS_BYTES, stream);
    if (e != hipSuccess) fprintf(stderr, "kernel_launch: cooperative launch failed: %s (grid %d)\n", hipGetErrorString(e), grid);
#endif
}
```

```cpp
#include <hip/hip_runtime.h>
#include <hip/hip_cooperative_groups.h>
#include <cstdio>
#include <cstdint>
namespace cg = cooperative_groups;
namespace pg8 {
#define PG8_LAS __attribute__((address_space(3)))
typedef unsigned short bf16_t;
typedef short bf16x8 __attribute__((ext_vector_type(8)));
typedef float f32x4 __attribute__((ext_vector_type(4)));
typedef unsigned u32x4 __attribute__((ext_vector_type(4)));
constexpr int BM = 256, BK = 64, HALF = 128, HTB = HALF * BK * 2  , STAGE_BYTES = 8 * HTB, NXCD = 8, WGM = 8;

__host__ __device__ __forceinline__ int lds_byte(int r, int c) { const int st = (r >> 4) * 2 + (c >> 5), rr = r & 15, cc = c & 31, ob = rr * 64 + cc * 2; return st * 1024 + (ob ^ (((ob >> 9) & 1) << 5)); }
__host__ __device__ __forceinline__ void stage_rc(int b, int& R, int& C) { const int st = b / 1024, sb = b % 1024, swz = sb ^ (((sb >> 9) & 1) << 5); R = (st >> 1) * 16 + swz / 64; C = (st & 1) * 32 + (swz % 64) / 2; }
__host__ __device__ __forceinline__ int perm32(int rho) { const int n = rho >> 4, i = rho & 15; return 8 * (i >> 2) + 4 * n + (i & 3); }

struct Unit { int pm, pn; };
struct Gemm { const bf16_t* A; const bf16_t* Bt; int M, N, K, lda; };

struct StaticOrder {
    int nM, nN, nwg, G, c;
    __host__ __device__ void init(int M, int N, int G_, int c_) { nM = M / BM; nN = N / BM; nwg = nM * nN; G = G_; c = c_; }
    __host__ __device__ bool next(int i, Unit& u) const {
        const long L = (long)i * G + c; if (L >= nwg) return false;
        int wgid = (int)L; { const int q = nwg / NXCD, r = nwg % NXCD, xcd = wgid % NXCD, off = wgid / NXCD; wgid = (xcd < r ? xcd * (q + 1) : r * (q + 1) + (xcd - r) * q) + off; }
        const int nig = WGM * nN, gid = wgid / nig, fm = gid * WGM, gsz = (nM - fm) < WGM ? (nM - fm) : WGM;
        u.pm = fm + ((wgid % nig) % gsz); u.pn = (wgid % nig) / gsz; return true;
    }
    __device__ __forceinline__ void a_ready(const Unit&) const {}
    __device__ __forceinline__ void done(const Unit&) const {}
};

struct ListOrder {
    int nN, n, L0, L1;
    __host__ __device__ bool next(int i, Unit& u) const { if (i >= n) return false; const int L = i == 0 ? L0 : L1; u.pm = L / nN; u.pn = L % nN; return true; }
    __device__ __forceinline__ void a_ready(const Unit&) const {}
    __device__ __forceinline__ void done(const Unit&) const {}
};
__device__ __forceinline__ unsigned cvt_pk_bf16(float lo, float hi) { unsigned r; asm volatile("v_cvt_pk_bf16_f32 %0, %1, %2" : "=v"(r) : "v"(lo), "v"(hi)); return r; }
typedef float f32x2 __attribute__((ext_vector_type(2)));
__device__ __forceinline__ u32x4 pack8(const f32x4 v0, const f32x4 v1) { u32x4 w; w.x = cvt_pk_bf16(v0[0], v0[1]); w.y = cvt_pk_bf16(v0[2], v0[3]); w.z = cvt_pk_bf16(v1[0], v1[1]); w.w = cvt_pk_bf16(v1[2], v1[3]); return w; }
struct EpiStore {
    static constexpr bool PERM = true, AFTER_DRAIN = false;
    bf16_t* O; int ldc;
    __device__ __forceinline__ void operator()(const f32x4 (&acc)[2][2][4][2], const Unit& u, int wr, int wc, int fr, int fq) const {
        const int row0 = u.pm * BM + wr * 64 + fr, col0 = u.pn * BM + wc * 32 + 8 * fq;
#pragma unroll
        for (int ai = 0; ai < 2; ++ai)
#pragma unroll
            for (int m = 0; m < 4; ++m) { bf16_t* rowp = O + (size_t)(row0 + ai * HALF + m * 16) * ldc + col0;
#pragma unroll
                for (int bj = 0; bj < 2; ++bj) *(u32x4*)(rowp + bj * HALF) = pack8(acc[ai][bj][m][0], acc[ai][bj][m][1]); }
    }
};
struct EpiProj {
    static constexpr bool PERM = true, AFTER_DRAIN = false;
    bf16_t* O; int ldc; float* ssq; const float* rope; bf16_t* Kb; int ldk;
    __device__ __forceinline__ void operator()(const f32x4 (&acc)[2][2][4][2], const Unit& u, int wr, int wc, int fr, int fq) const {
        const int row0 = u.pm * BM + wr * 64 + fr, col0 = u.pn * BM + wc * 32 + 8 * fq;
#pragma unroll
        for (int ai = 0; ai < 2; ++ai)
#pragma unroll
            for (int m = 0; m < 4; ++m) { const int row = row0 + ai * HALF + m * 16; bf16_t* rowp = O + (size_t)row * ldc + col0; float sq = 0.f;
#pragma unroll
                for (int bj = 0; bj < 2; ++bj) { const u32x4 w = pack8(acc[ai][bj][m][0], acc[ai][bj][m][1]); *(u32x4*)(rowp + bj * HALF) = w;
#pragma unroll
                    for (int e = 0; e < 4; ++e) { const float lo = __uint_as_float(w[e] << 16), hi = __uint_as_float(w[e] & 0xffff0000u); sq += lo * lo + hi * hi; } }
                if (u.pn >= 6 && u.pn <= 8) { sq += __shfl_xor(sq, 16); sq += __shfl_xor(sq, 32); if (fq == 0) ssq[((size_t)row * 3 + (u.pn - 6)) * 4 + wc] = sq; }
                if (u.pn == 9 && wc < 2) { const int ib = wc * 16 + 4 * fq; const f32x4 v0 = acc[ai][0][m][0], v1 = acc[ai][0][m][1];
                    const f32x4 c = *(const f32x4*)(rope + (size_t)row * 64 + ib), sn = *(const f32x4*)(rope + (size_t)row * 64 + 32 + ib);
                    f32x4 a, b;
                    a[0] = v0[0] * c[0] - v0[1] * sn[0]; a[1] = v0[1] * c[0] + v0[0] * sn[0];
                    a[2] = v0[2] * c[1] - v0[3] * sn[1]; a[3] = v0[3] * c[1] + v0[2] * sn[1];
                    b[0] = v1[0] * c[2] - v1[1] * sn[2]; b[1] = v1[1] * c[2] + v1[0] * sn[2];
                    b[2] = v1[2] * c[3] - v1[3] * sn[3]; b[3] = v1[3] * c[3] + v1[2] * sn[3];
                    const u32x4 w = pack8(a, b);
#pragma unroll
                    for (int h = 0; h < 6; ++h) *(u32x4*)(Kb + (size_t)row * ldk + 192 * h + 128 + wc * 32 + 8 * fq) = w; }
                if (m & 1) asm volatile("" ::: "memory"); }
    }
};
struct EpiQ {
    static constexpr bool PERM = true, AFTER_DRAIN = false;
    bf16_t* O; int ldc; const float* ssq; const float* rope;
    __device__ __forceinline__ void operator()(const f32x4 (&acc)[2][2][4][2], const Unit& u, int wr, int wc, int fr, int fq) const {
        const int row0 = u.pm * BM + wr * 64 + fr;
        float sc[2][4];
        { f32x4 q0[2][4], q1[2][4];
#pragma unroll
          for (int ai = 0; ai < 2; ++ai)
#pragma unroll
            for (int m = 0; m < 4; ++m) { const float* p = ssq + (size_t)(row0 + ai * HALF + m * 16) * 12; q0[ai][m] = *(const f32x4*)p; q1[ai][m] = *(const f32x4*)(p + 4); }
#pragma unroll
          for (int ai = 0; ai < 2; ++ai)
#pragma unroll
            for (int m = 0; m < 4; ++m) { const f32x4 a = q0[ai][m], b = q1[ai][m];
                sc[ai][m] = 1.0f / sqrtf((((a[0] + a[1]) + (a[2] + a[3])) + ((b[0] + b[1]) + (b[2] + b[3]))) * (1.0f / 512.0f) + 1e-6f); } }
#pragma unroll
        for (int ai = 0; ai < 2; ++ai)
#pragma unroll
            for (int m = 0; m < 4; ++m) { const int row = row0 + ai * HALF + m * 16; const float s = sc[ai][m];
#pragma unroll
                for (int bj = 0; bj < 2; ++bj) {
                    const int cb = u.pn * BM + bj * HALF + wc * 32, hc = cb % 192;
                    f32x4 v0 = acc[ai][bj][m][0] * s, v1 = acc[ai][bj][m][1] * s;
                    if (hc >= 128) {
                        const int ib = (hc - 128) / 2 + 4 * fq;
                        const f32x4 c = *(const f32x4*)(rope + (size_t)row * 64 + ib), sn = *(const f32x4*)(rope + (size_t)row * 64 + 32 + ib);
                        f32x4 a, b;
                        a[0] = v0[0] * c[0] - v0[1] * sn[0]; a[1] = v0[1] * c[0] + v0[0] * sn[0];
                        a[2] = v0[2] * c[1] - v0[3] * sn[1]; a[3] = v0[3] * c[1] + v0[2] * sn[1];
                        b[0] = v1[0] * c[2] - v1[1] * sn[2]; b[1] = v1[1] * c[2] + v1[0] * sn[2];
                        b[2] = v1[2] * c[3] - v1[3] * sn[3]; b[3] = v1[3] * c[3] + v1[2] * sn[3];
                        v0 = a; v1 = b;
                    }
                    *(u32x4*)(O + (size_t)row * ldc + cb + 8 * fq) = pack8(v0, v1);
                }
                if (m == 3) asm volatile("" ::: "memory"); }
    }
};
struct EpiKV {
    static constexpr bool PERM = true, AFTER_DRAIN = false;
    bf16_t* Kb; int ldk; bf16_t* Vb; int ldv; const float* ssq;
    __device__ __forceinline__ void operator()(const f32x4 (&acc)[2][2][4][2], const Unit& u, int wr, int wc, int fr, int fq) const {
        const int row0 = u.pm * BM + wr * 64 + fr, cin = wc * 32 + 8 * fq;
        f32x4 q2[2][4];
#pragma unroll
        for (int ai = 0; ai < 2; ++ai)
#pragma unroll
            for (int m = 0; m < 4; ++m) q2[ai][m] = *(const f32x4*)(ssq + (size_t)(row0 + ai * HALF + m * 16) * 12 + 8);
#pragma unroll
        for (int ai = 0; ai < 2; ++ai)
#pragma unroll
            for (int m = 0; m < 4; ++m) { const int row = row0 + ai * HALF + m * 16; const f32x4 a = q2[ai][m];
                const float s = 1.0f / sqrtf(((a[0] + a[1]) + (a[2] + a[3])) * (1.0f / 256.0f) + 1e-6f);
                *(u32x4*)(Kb + (size_t)row * ldk + 192 * u.pn + cin) = pack8(acc[ai][0][m][0] * s, acc[ai][0][m][1] * s);
                *(u32x4*)(Vb + (size_t)row * ldv + 128 * u.pn + cin) = pack8(acc[ai][1][m][0] * s, acc[ai][1][m][1] * s); }
    }
};
struct EpiRes {
    static constexpr bool PERM = false, AFTER_DRAIN = false;
    const float* xres; float* z; const float* gate; float alpha; int ldc;
    __device__ __forceinline__ void operator()(const f32x4 (&acc)[2][2][4][2], const Unit& u, int wr, int wc, int fr, int fq) const {
        const int row0 = u.pm * BM + wr * 64 + fr, col0 = u.pn * BM + wc * 32 + 4 * fq;
        f32x4 gv[2][2];
#pragma unroll
        for (int bj = 0; bj < 2; ++bj)
#pragma unroll
            for (int n = 0; n < 2; ++n) gv[bj][n] = *(const f32x4*)(gate + col0 + bj * HALF + n * 16) + 1.0f;
#pragma unroll
        for (int ai = 0; ai < 2; ++ai)
#pragma unroll
            for (int m = 0; m < 4; ++m) { const size_t off = (size_t)(row0 + ai * HALF + m * 16) * ldc + col0;
#pragma unroll
                for (int bj = 0; bj < 2; ++bj)
#pragma unroll
                    for (int n = 0; n < 2; ++n) { const f32x4 xr = *(const f32x4*)(xres + off + bj * HALF + n * 16);
                        *(f32x4*)(z + off + bj * HALF + n * 16) = xr * alpha + gv[bj][n] * acc[ai][bj][m][n]; }
                if (m == 3) asm volatile("" ::: "memory"); }
    }
};
struct EpiSwiglu {
    static constexpr bool PERM = true, AFTER_DRAIN = false;
    bf16_t* H; int ldc;
    __device__ __forceinline__ void operator()(const f32x4 (&acc)[2][2][4][2], const Unit& u, int wr, int wc, int fr, int fq) const {
        const int row0 = u.pm * BM + wr * 64 + fr, col0 = u.pn * HALF + wc * 32 + 8 * fq;
#pragma unroll
        for (int ai = 0; ai < 2; ++ai)
#pragma unroll
            for (int m = 0; m < 4; ++m) { f32x4 h[2];
#pragma unroll
                for (int n = 0; n < 2; ++n) { const f32x4 g = acc[ai][0][m][n], up = acc[ai][1][m][n];
#pragma unroll
                    for (int j = 0; j < 4; ++j) h[n][j] = g[j] * __builtin_amdgcn_rcpf(1.0f + __builtin_amdgcn_exp2f(-1.4426950408889634f * g[j])) * up[j]; }
                *(u32x4*)(H + (size_t)(row0 + ai * HALF + m * 16) * ldc + col0) = pack8(h[0], h[1]); }
    }
};
template <class Epi, class Sched, bool ALIGN_EPI = false, bool SP2 = false>
__device__ __forceinline__ void gemm_phase(PG8_LAS unsigned char* lds, const Gemm g, const Sched& S, const Epi& E) {
    int tid_ = threadIdx.x; asm volatile("" : "+v"(tid_)); const int tid = tid_, wid = __builtin_amdgcn_readfirstlane(tid >> 6), lane = tid & 63, wr = wid >> 2, wc = wid & 3, fr = lane & 15, fq = lane >> 4;
    int Kv_ = g.K, lda_ = g.lda; asm volatile("" : "+s"(Kv_), "+s"(lda_)); const int K = Kv_, nt = K / BK;
    unsigned voffA[2], voffB[2];
#pragma unroll
    for (int i = 0; i < 2; ++i) { int R, C; stage_rc(tid * 16 + i * 8192, R, C); const int Rb = Epi::PERM ? ((R & ~31) + perm32(R & 31)) : R;
        voffA[i] = (unsigned)(R * lda_ + C) * 2u; voffB[i] = (unsigned)(Rb * K + C) * 2u; }
    const size_t kstep = (size_t)(BK * 2);
    const size_t hstepA = (size_t)HALF * lda_ * 2, hstepB = (size_t)HALF * K * 2;
    const size_t tstepA = 2 * hstepA, tstepB = 2 * hstepB;
    const unsigned ldsw = (unsigned)wid * 1024u;
    const int aoff = lds_byte(wr * 64 + fr, fq * 8), boff = lds_byte(wc * 32 + fr, fq * 8);
#define PG8_SA(b, h) (((b) * 2 + (h)) * HTB)
#define PG8_SB(b, h) ((4 + (b) * 2 + (h)) * HTB)
#define PG8_STAGE(bufoff, gbase, voff) do { _Pragma("unroll") for (int _i = 0; _i < 2; ++_i) \
        __builtin_amdgcn_global_load_lds((const unsigned*)((const char*)(gbase) + (voff)[_i]), (PG8_LAS unsigned*)(lds + (bufoff) + ldsw + _i * 8192), 16, 0, 0); } while (0)
#define PG8_LDA(dst, b, h) do { _Pragma("unroll") for (int m = 0; m < 4; ++m) _Pragma("unroll") for (int k = 0; k < 2; ++k) dst[m][k] = *(const PG8_LAS bf16x8*)(lds + PG8_SA(b, h) + aoff + m * 2048 + k * 1024); } while (0)
#define PG8_LDB(dst, b, h) do { _Pragma("unroll") for (int n = 0; n < 2; ++n) _Pragma("unroll") for (int k = 0; k < 2; ++k) dst[n][k] = *(const PG8_LAS bf16x8*)(lds + PG8_SB(b, h) + boff + n * 2048 + k * 1024); } while (0)
#define PG8_MMA(ai, bj, At, Bt) do { __builtin_amdgcn_s_setprio(1); _Pragma("unroll") for (int m = 0; m < 4; ++m) _Pragma("unroll") for (int n = 0; n < 2; ++n) _Pragma("unroll") for (int k = 0; k < 2; ++k) \
        acc[ai][bj][m][n] = __builtin_amdgcn_mfma_f32_16x16x32_bf16(Bt[n][k], At[m][k], acc[ai][bj][m][n], 0, 0, 0); __builtin_amdgcn_s_setprio(0); } while (0)
#define PG8_WAIT_V(n) asm volatile("s_waitcnt vmcnt(" #n ")" ::: "memory")
#define PG8_WAIT_L(n) asm volatile("s_waitcnt lgkmcnt(" #n ")" ::: "memory")
#define PG8_BAR __builtin_amdgcn_s_barrier()
#define PG8_SCHED __builtin_amdgcn_sched_barrier(0)
    Unit cur, nxt; int ui = 0;
    if (!S.next(0, cur)) return;
    f32x4 acc[2][2][4][2];
#pragma unroll
    for (int a = 0; a < 2; ++a)
#pragma unroll
        for (int b = 0; b < 2; ++b)
#pragma unroll
            for (int m = 0; m < 4; ++m)
#pragma unroll
                for (int n = 0; n < 2; ++n) acc[a][b][m][n] = (f32x4){0.f, 0.f, 0.f, 0.f};
    bf16x8 At[4][2], B0[2][2], B1[2][2];
    const char* cA = (const char*)g.A + (size_t)cur.pm * tstepA; const char* cB = (const char*)g.Bt + (size_t)cur.pn * tstepB;
    S.a_ready(cur);
    if constexpr (SP2) {
        PG8_STAGE(PG8_SB(0, 0), cB, voffB); PG8_STAGE(PG8_SB(0, 1), cB + hstepB, voffB); PG8_STAGE(PG8_SA(0, 0), cA, voffA); PG8_STAGE(PG8_SA(0, 1), cA + hstepA, voffA);
        if (wr == 1) PG8_BAR;
        PG8_WAIT_V(2); PG8_BAR;
        PG8_STAGE(PG8_SB(1, 0), cB + kstep, voffB); PG8_STAGE(PG8_SA(1, 0), cA + kstep, voffA); PG8_STAGE(PG8_SB(1, 1), cB + hstepB + kstep, voffB);
        PG8_WAIT_V(6); PG8_BAR;
    } else {
        PG8_STAGE(PG8_SB(0, 0), cB, voffB); PG8_STAGE(PG8_SA(0, 0), cA, voffA); PG8_STAGE(PG8_SB(0, 1), cB + hstepB, voffB); PG8_STAGE(PG8_SA(0, 1), cA + hstepA, voffA);
        if (wr == 1) PG8_BAR;
        PG8_WAIT_V(4); PG8_BAR;
        PG8_STAGE(PG8_SB(1, 0), cB + kstep, voffB); PG8_STAGE(PG8_SA(1, 0), cA + kstep, voffA); PG8_STAGE(PG8_SB(1, 1), cB + hstepB + kstep, voffB);
        PG8_WAIT_V(6); PG8_BAR;
    }
    for (;;) {
        const bool has_next = S.next(ui + 1, nxt);
        const char* nA = has_next ? (const char*)g.A + (size_t)nxt.pm * tstepA : cA; const char* nB = has_next ? (const char*)g.Bt + (size_t)nxt.pn * tstepB : cB;
        for (int t = 0; t < nt; t += 2) {
            const bool last = (t == nt - 2);
            const char* a1 = cA + (size_t)(t + 1) * kstep;
            const char* a2 = last ? nA : cA + (size_t)(t + 2) * kstep; const char* b2 = last ? nB : cB + (size_t)(t + 2) * kstep;
            const char* a3 = a2 + kstep; const char* b3 = b2 + kstep;
            if (last && has_next) S.a_ready(nxt);
            if constexpr (SP2) {
            PG8_LDB(B0, 0, 0); PG8_LDB(B1, 0, 1); PG8_SCHED; PG8_LDA(At, 0, 0); PG8_STAGE(PG8_SA(1, 1), a1 + hstepA, voffA);
            PG8_WAIT_V(8); PG8_WAIT_L(0); PG8_BAR; PG8_MMA(0, 0, At, B0); PG8_MMA(0, 1, At, B1); PG8_BAR; PG8_SCHED;
            PG8_LDA(At, 0, 1); PG8_STAGE(PG8_SB(0, 0), b2, voffB); PG8_STAGE(PG8_SB(0, 1), b2 + hstepB, voffB); PG8_STAGE(PG8_SA(0, 0), a2, voffA);
            PG8_WAIT_V(8); PG8_WAIT_L(0); PG8_BAR; PG8_MMA(1, 0, At, B0); PG8_MMA(1, 1, At, B1); PG8_BAR; PG8_SCHED;
            PG8_LDB(B0, 1, 0); PG8_LDB(B1, 1, 1); PG8_SCHED; PG8_LDA(At, 1, 0); PG8_STAGE(PG8_SA(0, 1), a2 + hstepA, voffA);
            PG8_WAIT_V(8); PG8_WAIT_L(0); PG8_BAR; PG8_MMA(0, 0, At, B0); PG8_MMA(0, 1, At, B1); PG8_BAR; PG8_SCHED;
            PG8_LDA(At, 1, 1); PG8_STAGE(PG8_SB(1, 0), b3, voffB); PG8_STAGE(PG8_SB(1, 1), b3 + hstepB, voffB); PG8_STAGE(PG8_SA(1, 0), a3, voffA);
            PG8_WAIT_V(8); PG8_WAIT_L(0); PG8_BAR; PG8_MMA(1, 0, At, B0); PG8_MMA(1, 1, At, B1); PG8_BAR; PG8_SCHED;
            } else {
            PG8_LDB(B0, 0, 0); PG8_SCHED; PG8_LDA(At, 0, 0); PG8_STAGE(PG8_SA(1, 1), a1 + hstepA, voffA);
            PG8_WAIT_L(8); PG8_BAR; PG8_WAIT_L(0); PG8_MMA(0, 0, At, B0); PG8_BAR; PG8_SCHED;
            PG8_LDB(B1, 0, 1); PG8_STAGE(PG8_SB(0, 0), b2, voffB);
            PG8_BAR; PG8_WAIT_L(0); PG8_MMA(0, 1, At, B1); PG8_BAR;
            PG8_LDA(At, 0, 1); PG8_STAGE(PG8_SA(0, 0), a2, voffA);
            PG8_BAR; PG8_WAIT_L(0); PG8_MMA(1, 0, At, B0); PG8_BAR; PG8_SCHED;
            PG8_STAGE(PG8_SB(0, 1), b2 + hstepB, voffB);
            PG8_WAIT_V(6); PG8_BAR; PG8_MMA(1, 1, At, B1); PG8_BAR;
            PG8_LDB(B0, 1, 0); PG8_SCHED; PG8_LDA(At, 1, 0); PG8_STAGE(PG8_SA(0, 1), a2 + hstepA, voffA);
            PG8_WAIT_L(8); PG8_BAR; PG8_WAIT_L(0); PG8_MMA(0, 0, At, B0); PG8_BAR; PG8_SCHED;
            PG8_LDB(B1, 1, 1); PG8_STAGE(PG8_SB(1, 0), b3, voffB);
            PG8_BAR; PG8_WAIT_L(0); PG8_MMA(0, 1, At, B1); PG8_BAR;
            PG8_LDA(At, 1, 1); PG8_STAGE(PG8_SA(1, 0), a3, voffA);
            PG8_BAR; PG8_WAIT_L(0); PG8_MMA(1, 0, At, B0); PG8_BAR; PG8_SCHED;
            PG8_STAGE(PG8_SB(1, 1), b3 + hstepB, voffB);
            PG8_WAIT_V(6); PG8_BAR; PG8_MMA(1, 1, At, B1); PG8_BAR;
            }
        }
        if constexpr (ALIGN_EPI) { if (wr == 0) PG8_BAR; }
        if constexpr (!Epi::AFTER_DRAIN) { E(acc, cur, wr, wc, fr, fq); S.done(cur); }
        if (!has_next) break;
#pragma unroll
        for (int a = 0; a < 2; ++a)
#pragma unroll
            for (int b = 0; b < 2; ++b)
#pragma unroll
                for (int m = 0; m < 4; ++m)
#pragma unroll
                    for (int n = 0; n < 2; ++n) acc[a][b][m][n] = (f32x4){0.f, 0.f, 0.f, 0.f};
        cur = nxt; cA = nA; cB = nB; ++ui;
        if constexpr (ALIGN_EPI) { if (wr == 1) PG8_BAR; }
    }
    PG8_WAIT_V(0);
    if constexpr (!ALIGN_EPI) { if (wr == 0) PG8_BAR; }
    PG8_BAR;
    if constexpr (Epi::AFTER_DRAIN) { E.fused(acc, cur, wr, wc, fr, fq, lds, wid, lane); S.done(cur); }
#undef PG8_SA
#undef PG8_SB
#undef PG8_STAGE
#undef PG8_LDA
#undef PG8_LDB
#undef PG8_MMA
#undef PG8_WAIT_V
#undef PG8_WAIT_L
#undef PG8_BAR
#undef PG8_SCHED
}
}

#define LAS __attribute__((address_space(3)))
typedef unsigned short bf16_t;
typedef float f32x4 __attribute__((ext_vector_type(4)));
typedef unsigned u32x4 __attribute__((ext_vector_type(4)));
typedef unsigned u32x2 __attribute__((ext_vector_type(2)));
constexpr int S = 8192, DM = 2048, DEPTH = 2, DIN = 3648, DINP = 3840, DFF = 5632;
constexpr int QLD = 1280, KLD = 1152, VLD = 768;
constexpr int C_QA = 0, C_KA = 512, C_VA = 1024, C_CQ = 1536, C_CKV = 2048, C_KR = 2304, C_QC = 2368, C_KC = 3136, C_VC = 3392;
constexpr float ALPHA = 1.4142135623730951f;
constexpr size_t al256(size_t x) { return (x + 255) / 256 * 256; }
constexpr size_t SZ_WIN = (size_t)DINP * DM * 2, SZ_WUQ = (size_t)1280 * 512 * 2, SZ_WUKV = (size_t)1536 * 256 * 2, SZ_WO = (size_t)DM * DM * 2, SZ_WGU = (size_t)2 * DFF * DM * 2, SZ_WDN = (size_t)DM * DFF * 2;
constexpr size_t O_WIN = 0, O_WUQ = O_WIN + SZ_WIN, O_WUKV = O_WUQ + SZ_WUQ, O_WO = O_WUKV + SZ_WUKV, O_WGU = O_WO + SZ_WO, O_WDN = O_WGU + SZ_WGU, SZ_WL = O_WDN + SZ_WDN;
constexpr size_t WS_W = 0;
constexpr size_t WS_MOD = al256(WS_W + DEPTH * SZ_WL);
constexpr size_t WS_ROPE = al256(WS_MOD + (size_t)DEPTH * 6 * DM * 4);
constexpr size_t WS_RSQ = al256(WS_ROPE + (size_t)S * 64 * 4);
constexpr size_t WS_RSKV = al256(WS_RSQ + (size_t)S * 4);
constexpr size_t WS_X = al256(WS_RSKV + (size_t)S * 4);
constexpr size_t WS_U = al256(WS_X + (size_t)S * DM * 4);
constexpr size_t WS_PROJ = al256(WS_U + (size_t)S * DM * 2);
constexpr size_t WS_Q = al256(WS_PROJ + (size_t)S * DINP * 2);
constexpr size_t WS_K = al256(WS_Q + (size_t)S * QLD * 2);
constexpr size_t WS_V = al256(WS_K + (size_t)S * KLD * 2);
constexpr size_t WS_Y = al256(WS_V + (size_t)S * VLD * 2);
constexpr size_t WS_H = al256(WS_Y + (size_t)S * DM * 2);
constexpr size_t WS_PART = al256(WS_H + (size_t)S * DFF * 2);
constexpr size_t WS_STAT = al256(WS_PART + (size_t)4 * S * VLD * 2);
constexpr size_t WS_SSQ = al256(WS_STAT + (size_t)4 * 6 * S * 2 * 4);
constexpr size_t WS_BAR0_ = WS_SSQ + (size_t)S * 12 * 4;
constexpr size_t WS_BAR = al256(WS_BAR0_);
constexpr size_t WS_END = al256(WS_BAR + 16384);
constexpr int TAB_OFF = pg8::STAGE_BYTES, LDS_BYTES = pg8::STAGE_BYTES + 256;
constexpr int NTHREADS = 512;

struct Args { const float* in[19]; float* out; unsigned char* ws; int ph_lo, ph_hi; };
struct Tab {
    const LAS unsigned* t;
    __device__ __forceinline__ unsigned long long ld(int i) const { const unsigned lo = __builtin_amdgcn_readfirstlane(t[2 * i]), hi = __builtin_amdgcn_readfirstlane(t[2 * i + 1]); return ((unsigned long long)hi << 32) | lo; }
    __device__ __forceinline__ const float* in(int i) const { return (const float*)ld(i); }
    __device__ __forceinline__ float* out() const { return (float*)ld(19); }
    __device__ __forceinline__ unsigned char* wsp() const { return (unsigned char*)ld(20); }
};

__device__ __forceinline__ float bf2f(unsigned short b) { return __uint_as_float((unsigned)b << 16); }
__device__ __forceinline__ float wave_sum(float v) {
#pragma unroll
    for (int o = 32; o; o >>= 1) v += __shfl_xor(v, o);
    return v; }
using pg8::cvt_pk_bf16;
__device__ __forceinline__ int otid() { int t = threadIdx.x; asm volatile("" : "+v"(t)); return t; }

__device__ __forceinline__ void phase_mod(const Tab tb, unsigned char* lds_g) {
    unsigned char* ws_ = tb.wsp(); const float* in1 = tb.in(1); const float* in2 = tb.in(2); const float* in3 = tb.in(3);
    float* condL = (float*)lds_g; f32x4* red = (f32x4*)(lds_g + 8192);
    const int tid = otid();
    const float* c = in1;
    for (int i = tid; i < DM; i += NTHREADS) { const float v = c[i]; condL[i] = v / (1.0f + __expf(-v)); }
    __syncthreads();
    float* mod = (float*)(ws_ + WS_MOD);
    const int cl = tid & 31, kg = tid >> 5;
    for (int item = blockIdx.x; item < DEPTH * 96; item += gridDim.x) {
        const int l = item / 96, cgp = item % 96;
        const float* W = in2 + (size_t)l * DM * 6 * DM + (size_t)(kg * 128) * (6 * DM) + cgp * 128 + 4 * cl;
        f32x4 acc = {0.f, 0.f, 0.f, 0.f};
#pragma unroll 8
        for (int kk = 0; kk < 128; ++kk) { const f32x4 w = __builtin_nontemporal_load((const f32x4*)(W + (size_t)kk * (6 * DM))); acc += w * condL[kg * 128 + kk]; }
        red[kg * 32 + cl] = acc;
        __syncthreads();
        if (tid < 128) { float s = 0.f; const float* rf = (const float*)red;
            for (int g = 0; g < 16; ++g) s += rf[g * 128 + tid];
            mod[l * 6 * DM + cgp * 128 + tid] = s + in3[l * 6 * DM + cgp * 128 + tid]; }
        __syncthreads();
    }
}

template <int PERMT>
__device__ __forceinline__ int dst_row(int n) {
    if (PERMT == 1) { const int h = n / 192, d = n % 192; if (d < 128) return n; const int j = d - 128; return h * 192 + 128 + 2 * (j & 31) + (j >> 5); }
    if (PERMT == 3) { if (n < C_KR || n >= C_KR + 64) return n; const int j = n - C_KR; return C_KR + 2 * (j & 31) + (j >> 5); }
    if (PERMT == 2) { if (n < DFF) return 256 * (n >> 7) + (n & 127); const int m = n - DFF; return 256 * (m >> 7) + 128 + (m & 127); }
    return n;
}
template <int PERMT>
__device__ __forceinline__ void transpose_job(const float* __restrict__ src, bf16_t* __restrict__ dst, int K, int N, int Npad, const float* __restrict__ kscale, unsigned char* lds_g, int first, int stride) {
    float* T = (float*)lds_g;
    const int tid = otid(), nkt = K / 64, nnt = (N + 255) / 256, ntiles = nkt * nnt;
    for (int t = first; t < ntiles; t += stride) {
        const int k0 = (t % nkt) * 64, n0 = (t / nkt) * 256;
        { const int kk = tid >> 6, n4 = tid & 63; const bool ok = n0 + 4 * n4 < N; f32x4 v[8];
#pragma unroll
          for (int i = 0; i < 8; ++i) { const int k = k0 + kk + 8 * i; v[i] = ok ? __builtin_nontemporal_load((const f32x4*)(src + (size_t)k * N + n0 + 4 * n4)) : (f32x4){0.f, 0.f, 0.f, 0.f}; }
#pragma unroll
          for (int i = 0; i < 8; ++i) { const int k = k0 + kk + 8 * i; if (kscale) v[i] = v[i] * kscale[k];
              float* tp = T + (kk + 8 * i) * 257 + 4 * n4; tp[0] = v[i][0]; tp[1] = v[i][1]; tp[2] = v[i][2]; tp[3] = v[i][3]; } }
        __syncthreads();
        { const int n = tid >> 1, ks = tid & 1;
          if (n0 + n < N) { bf16_t* dp = dst + (size_t)dst_row<PERMT>(n0 + n) * K + k0 + 32 * ks;
#pragma unroll
            for (int eb = 0; eb < 4; ++eb) { float v[8];
#pragma unroll
              for (int e = 0; e < 8; ++e) v[e] = T[(32 * ks + 8 * eb + e) * 257 + n];
              u32x4 w; w.x = cvt_pk_bf16(v[0], v[1]); w.y = cvt_pk_bf16(v[2], v[3]); w.z = cvt_pk_bf16(v[4], v[5]); w.w = cvt_pk_bf16(v[6], v[7]);
              *(u32x4*)(dp + 8 * eb) = w; } } }
        __syncthreads();
    }
    const size_t nz = (size_t)(Npad - N) * K / 8;
    for (size_t i = (size_t)blockIdx.x * NTHREADS + tid; i < nz; i += (size_t)gridDim.x * NTHREADS) *(u32x4*)(dst + (size_t)N * K + i * 8) = (u32x4){0u, 0u, 0u, 0u};
}

__device__ __forceinline__ void modulate_rows(const float* __restrict__ x, const float* __restrict__ sc, const float* __restrict__ sh, bf16_t* __restrict__ u) {
    const size_t n8 = (size_t)S * DM / 8;
    for (size_t i = (size_t)blockIdx.x * NTHREADS + otid(); i < n8; i += (size_t)gridDim.x * NTHREADS) {
        const int col = (int)((i * 8) % DM);
        const f32x4 x0 = *(const f32x4*)(x + i * 8), x1 = *(const f32x4*)(x + i * 8 + 4);
        const f32x4 s0 = *(const f32x4*)(sc + col) + 1.0f, s1 = *(const f32x4*)(sc + col + 4) + 1.0f;
        const f32x4 h0 = *(const f32x4*)(sh + col), h1 = *(const f32x4*)(sh + col + 4);
        *(u32x4*)(u + i * 8) = pg8::pack8(x0 * s0 + h0, x1 * s1 + h1);
    }
}

__device__ __forceinline__ void rope_table(float* __restrict__ rope) {
    for (int i = blockIdx.x * NTHREADS + otid(); i < S * 32; i += gridDim.x * NTHREADS) {
        const int pos = i >> 5, j = i & 31;
        const float inv = exp2f(-(float)j * (13.287712379549449f / 32.0f));
        const float ang = (float)pos * inv;
        const double rev = (double)ang * 0.15915494309189535;
        const double fr = rev - floor(rev);
        const float ar = (float)(fr * 6.283185307179586);
        rope[(size_t)pos * 64 + j] = cosf(ar); rope[(size_t)pos * 64 + 32 + j] = sinf(ar);
    }
}

__device__ __forceinline__ void phase_prep(unsigned char* ws_) {
    const bf16_t* proj = (const bf16_t*)(ws_ + WS_PROJ); const float* rope = (const float*)(ws_ + WS_ROPE);
    float* rsq = (float*)(ws_ + WS_RSQ); float* rskv = (float*)(ws_ + WS_RSKV); bf16_t* Kb = (bf16_t*)(ws_ + WS_K);
    const int tid_o = otid(), lane = tid_o & 63, wave = tid_o >> 6;
    for (int r = blockIdx.x * 8 + wave; r < S; r += gridDim.x * 8) {
        const bf16_t* pr = proj + (size_t)r * DINP;
        { const u32x4 w = *(const u32x4*)(pr + C_CQ + 8 * lane); float ss = 0.f;
#pragma unroll
          for (int e = 0; e < 4; ++e) { const float lo = __uint_as_float(w[e] << 16), hi = __uint_as_float(w[e] & 0xffff0000u); ss += lo * lo + hi * hi; }
          ss = wave_sum(ss); if (lane == 0) rsq[r] = 1.0f / sqrtf(ss * (1.0f / 512.0f) + 1e-6f); }
        { const u32x2 w = *(const u32x2*)(pr + C_CKV + 4 * lane); float ss = 0.f;
#pragma unroll
          for (int e = 0; e < 2; ++e) { const float lo = __uint_as_float(w[e] << 16), hi = __uint_as_float(w[e] & 0xffff0000u); ss += lo * lo + hi * hi; }
          ss = wave_sum(ss); if (lane == 0) rskv[r] = 1.0f / sqrtf(ss * (1.0f / 256.0f) + 1e-6f); }
        { const int i = lane & 31; const float x1 = bf2f(pr[C_KR + i]), x2 = bf2f(pr[C_KR + 32 + i]);
          const float c = rope[(size_t)r * 64 + i], sn = rope[(size_t)r * 64 + 32 + i];
          const unsigned w = cvt_pk_bf16(x1 * c - x2 * sn, x2 * c + x1 * sn);
          const int hb = (lane >> 5) * 3;
#pragma unroll
          for (int h = 0; h < 3; ++h) *(unsigned*)(Kb + (size_t)r * KLD + (hb + h) * 192 + 128 + 2 * i) = w; }
    }
}

__device__ __forceinline__ void phase_ynorm(unsigned char* ws_) {
    bf16_t* y = (bf16_t*)(ws_ + WS_Y); const bf16_t* part = (const bf16_t*)(ws_ + WS_PART); const float* stat = (const float*)(ws_ + WS_STAT);
    const int tid_o = otid(), lane = tid_o & 63, wave = tid_o >> 6;
    const bool lowhalf = lane < 32;
    for (int r = blockIdx.x * 8 + wave; r < S; r += gridDim.x * 8) {
        bf16_t* yr = y + (size_t)r * DM;
        float v[4][8]; float ss[4];
#pragma unroll
        for (int j = 0; j < 4; ++j) {
            const bool fromPart = (j == 1) || (j == 2 && lowhalf);
            if (!fromPart) { const u32x4 w = *(const u32x4*)(yr + j * 512 + 8 * lane);
#pragma unroll
                for (int e = 0; e < 4; ++e) { v[j][2 * e] = __uint_as_float(w[e] << 16); v[j][2 * e + 1] = __uint_as_float(w[e] & 0xffff0000u); } }
            else { const int yb = j * 512 + 8 * lane - 512, h = yb >> 7; float m[4], lw[4];
#pragma unroll
                for (int i = 0; i < 4; ++i) { const float* st = stat + ((size_t)(i * 6 + h) * S + r) * 2; m[i] = st[0]; lw[i] = st[1]; }
                const float M = fmaxf(fmaxf(m[0], m[1]), fmaxf(m[2], m[3])); float W = 0.f;
#pragma unroll
                for (int i = 0; i < 4; ++i) { lw[i] *= __builtin_amdgcn_exp2f(m[i] - M); W += lw[i]; }
                const float rW = 1.0f / W;
#pragma unroll
                for (int e = 0; e < 8; ++e) v[j][e] = 0.f;
#pragma unroll
                for (int i = 0; i < 4; ++i) { const u32x4 w = *(const u32x4*)(part + ((size_t)i * S + r) * VLD + yb); const float wi = lw[i] * rW;
#pragma unroll
                    for (int e = 0; e < 4; ++e) { v[j][2 * e] += wi * __uint_as_float(w[e] << 16); v[j][2 * e + 1] += wi * __uint_as_float(w[e] & 0xffff0000u); } } }
            float sq = 0.f;
#pragma unroll
            for (int e = 0; e < 8; ++e) sq += v[j][e] * v[j][e];
            ss[j] = sq;
        }
        const float sA = wave_sum(ss[0]);
        const float sB = wave_sum(ss[1] + (lowhalf ? ss[2] : 0.f));
        const float sC = wave_sum(ss[3] + (lowhalf ? 0.f : ss[2]));
        const float rA = 1.0f / sqrtf(sA * (1.0f / 512.0f) + 1e-6f), rB = 1.0f / sqrtf(sB * (1.0f / 768.0f) + 1e-6f), rC = 1.0f / sqrtf(sC * (1.0f / 768.0f) + 1e-6f);
#pragma unroll
        for (int j = 0; j < 4; ++j) { const float sc = j == 0 ? rA : (j == 1 ? rB : (j == 2 ? (lowhalf ? rB : rC) : rC)); u32x4 o;
#pragma unroll
            for (int e = 0; e < 4; ++e) o[e] = cvt_pk_bf16(v[j][2 * e] * sc, v[j][2 * e + 1] * sc);
            *(u32x4*)(yr + j * 512 + 8 * lane) = o; }
    }
}

__device__ __forceinline__ void phase_ln(const float* z, float* xo, const float* __restrict__ g, const float* __restrict__ b, const float* __restrict__ sc, const float* __restrict__ sh, bf16_t* __restrict__ u) {
    const int tid_o = otid(), lane = tid_o & 63, wave = tid_o >> 6;
    const int stride = gridDim.x * 8;
    for (int r = blockIdx.x * 8 + wave; r < S; r += 2 * stride) {
        const bool hasB = r + stride < S; const int rr[2] = {r, hasB ? r + stride : r};
        f32x4 v[2][8]; float s[2] = {0.f, 0.f};
#pragma unroll
        for (int k = 0; k < 2; ++k) { const float* zr = z + (size_t)rr[k] * DM;
#pragma unroll
            for (int j = 0; j < 8; ++j) v[k][j] = *(const f32x4*)(zr + j * 256 + 4 * lane); }
#pragma unroll
        for (int k = 0; k < 2; ++k)
#pragma unroll
            for (int j = 0; j < 8; ++j) s[k] += (v[k][j][0] + v[k][j][1]) + (v[k][j][2] + v[k][j][3]);
        float mean[2], rstd[2];
#pragma unroll
        for (int k = 0; k < 2; ++k) { mean[k] = wave_sum(s[k]) * (1.0f / DM); float q = 0.f;
#pragma unroll
            for (int j = 0; j < 8; ++j) { const f32x4 d = v[k][j] - mean[k]; q += (d[0] * d[0] + d[1] * d[1]) + (d[2] * d[2] + d[3] * d[3]); }
            rstd[k] = 1.0f / sqrtf(wave_sum(q) * (1.0f / DM) + 1e-5f); }
#pragma unroll
        for (int j = 0; j < 8; ++j) { const int col = j * 256 + 4 * lane;
            const f32x4 gg = *(const f32x4*)(g + col), bb = *(const f32x4*)(b + col);
            f32x4 s1 = {0.f, 0.f, 0.f, 0.f}, h1 = {0.f, 0.f, 0.f, 0.f};
            if (u) { s1 = *(const f32x4*)(sc + col) + 1.0f; h1 = *(const f32x4*)(sh + col); }
#pragma unroll
            for (int k = 0; k < 2; ++k) { if (k == 1 && !hasB) continue;
                const f32x4 o = (v[k][j] - mean[k]) * rstd[k] * gg + bb;
                *(f32x4*)(xo + (size_t)rr[k] * DM + col) = o;
                if (u) { const f32x4 m = o * s1 + h1; u32x2 w; w.x = cvt_pk_bf16(m[0], m[1]); w.y = cvt_pk_bf16(m[2], m[3]); *(u32x2*)(u + (size_t)rr[k] * DM + col) = w; } } }
    }
}

template <int MODE>
__device__ __forceinline__ void naive_attn(unsigned char* ws_, const float* rpb, const float* sink, int l) {
    constexpr int DQK = MODE == 1 ? 192 : 128, NJ = DQK / 64, H = MODE == 0 ? 4 : 6;
    const bf16_t* proj = (const bf16_t*)(ws_ + WS_PROJ); bf16_t* y = (bf16_t*)(ws_ + WS_Y);
    const int tid_o = otid(), lane = tid_o & 63, wave = tid_o >> 6;
    for (int it = blockIdx.x * 8 + wave; it < S * H; it += gridDim.x * 8) {
        const int h = it / S, q = it % S;
        const bf16_t *Qp, *Kp, *Vp; int ldk, ldv, ycol; float scale;
        if (MODE == 0) { Qp = proj + (size_t)q * DINP + C_QA + 128 * h; Kp = proj + C_KA + 128 * h; Vp = proj + C_VA + 128 * h; ldk = DINP; ldv = DINP; ycol = 128 * h; scale = 0.08838834764831845f; }
        else if (MODE == 1) { Qp = (const bf16_t*)(ws_ + WS_Q) + (size_t)q * QLD + 192 * h; Kp = (const bf16_t*)(ws_ + WS_K) + 192 * h; Vp = (const bf16_t*)(ws_ + WS_V) + 128 * h; ldk = KLD; ldv = VLD; ycol = 512 + 128 * h; scale = 0.07216878364870322f; }
        else { Qp = proj + (size_t)q * DINP + C_QC + 128 * h; Kp = proj + C_KC + 128 * (h / 3); Vp = proj + C_VC + 128 * (h / 3); ldk = DINP; ldv = DINP; ycol = 1280 + 128 * h; scale = 0.08838834764831845f; }
        float qv[NJ];
#pragma unroll
        for (int j = 0; j < NJ; ++j) qv[j] = bf2f(Qp[64 * j + lane]) * scale;
        float m = -1e30f, ls = 0.f, o0 = 0.f, o1 = 0.f; int nkeys, klo = 0, r = 0, col = 0, r0 = 0, c0 = 0; float slope = 0.f;
        if (MODE == 0) { r = q >> 6; col = q & 63; r0 = min(max(r - 4, 0), 120); c0 = min(max(col - 8, 0), 48); nkeys = 128; }
        else if (MODE == 1) nkeys = S;
        else { klo = max(0, q - 128); nkeys = min(S - 1, q + 128) - klo + 1; m = sink[l * 6 + h]; ls = 1.f; slope = exp2f(-8.0f * (float)(h + 1) / 6.0f); }
        for (int kk = 0; kk < nkeys; ++kk) {
            int key; float bias = 0.f;
            if (MODE == 0) { const int krow = r0 + (kk >> 4), kcol = c0 + (kk & 15); key = krow * 64 + kcol; bias = rpb[((l * 4 + h) * 15 + (krow - r + 7)) * 31 + (kcol - col + 15)]; }
            else if (MODE == 1) key = kk;
            else { key = klo + kk; bias = -slope * fabsf((float)(q - key)); }
            float part = 0.f;
#pragma unroll
            for (int j = 0; j < NJ; ++j) part += qv[j] * bf2f(Kp[(size_t)key * ldk + 64 * j + lane]);
            const float s = wave_sum(part) + bias;
            const float mn = fmaxf(m, s), al = __expf(m - mn), p = __expf(s - mn);
            ls = ls * al + p;
            o0 = o0 * al + p * bf2f(Vp[(size_t)key * ldv + lane]); o1 = o1 * al + p * bf2f(Vp[(size_t)key * ldv + 64 + lane]);
            m = mn;
        }
        const float inv = 1.0f / ls;
        y[(size_t)q * DM + ycol + lane] = (bf16_t)(cvt_pk_bf16(o0 * inv, 0.f) & 0xffffu);
        y[(size_t)q * DM + ycol + 64 + lane] = (bf16_t)(cvt_pk_bf16(o1 * inv, 0.f) & 0xffffu);
    }
}

#define XB_TMO      128
#define XB_XCNT(j)  (256  + 64 * (j))
#define XB_XSUB(j)  (1280 + 64 * (j))
#define XB_XGEN(j)  (2304 + 64 * (j))
#define XB_TOP      3328
#define XB_TOPGEN   3392
#define XCD_BAR_WORDS 3456
#define XB_SPIN_CAP (1u << 18)

__device__ __forceinline__ unsigned xb_ld(unsigned* p)              { return __hip_atomic_load(p, __ATOMIC_RELAXED, __HIP_MEMORY_SCOPE_AGENT); }
__device__ __forceinline__ unsigned xb_add(unsigned* p, unsigned v) { return __hip_atomic_fetch_add(p, v, __ATOMIC_RELAXED, __HIP_MEMORY_SCOPE_AGENT); }
__device__ __forceinline__ unsigned xb_xcc_id() { return (unsigned)__builtin_amdgcn_s_getreg((3 << 11) | 20) & 0xFu; }
#define XB_SPIN(cond, bar) do { unsigned _sp = 0; while (cond) { __builtin_amdgcn_s_sleep(1); \
    if ((++_sp & 255u) == 0u) { if (xb_ld(&(bar)[XB_TMO])) break; if (_sp > XB_SPIN_CAP) { atomicAdd(&(bar)[XB_TMO], 1u); break; } } } } while (0)

struct XcdBarrier {
    unsigned* bar; unsigned x;
    volatile LAS unsigned* st;
};

__device__ __forceinline__ XcdBarrier xcd_barrier_post(unsigned* bar, volatile LAS unsigned* st) {
    XcdBarrier b; b.bar = bar; b.x = xb_xcc_id(); b.st = st;
    if (threadIdx.x == 0) (void)xb_add(&bar[XB_XCNT(b.x)], 1u);
    return b;
}
__device__ __forceinline__ void xcd_barrier_complete(unsigned* bar, unsigned x, unsigned& nloc, unsigned& nx) {
    const unsigned G = gridDim.x * gridDim.y * gridDim.z;
    unsigned sum, cnt, mine, sp = 0u;
    for (;;) {
        sum = 0u; cnt = 0u; mine = 0u;
#pragma unroll
        for (unsigned j = 0; j < 16; ++j) { const unsigned c = xb_ld(&bar[XB_XCNT(j)]); sum += c; cnt += (c > 0u) ? 1u : 0u; mine = (j == x) ? c : mine; }
        if (sum == G) break;
        __builtin_amdgcn_s_sleep(1);
        if ((++sp & 255u) == 0u) { if (xb_ld(&bar[XB_TMO])) break; if (sp > XB_SPIN_CAP) { atomicAdd(&bar[XB_TMO], 1u); break; } }
    }
    nloc = mine > 0u ? mine : 1u; nx = cnt > 0u ? cnt : 1u;
}

__device__ __forceinline__ void xcd_barrier(const XcdBarrier& b) {
    asm volatile("s_waitcnt vmcnt(0)" ::: "memory");
    __syncthreads();
    if (threadIdx.x == 0) {
        unsigned* bar = b.bar;
        __builtin_amdgcn_s_waitcnt(0);
        unsigned nloc = b.st[0], nx = b.st[1];
        if (nloc == 0u) { xcd_barrier_complete(bar, b.x, nloc, nx); b.st[0] = nloc; b.st[1] = nx; }
        const unsigned old = xb_add(&bar[XB_XSUB(b.x)], 1u);
        const unsigned gen = old / nloc;
        if (old + 1u == (gen + 1u) * nloc) {
            __builtin_amdgcn_fence(__ATOMIC_RELEASE, "agent");
            asm volatile("s_waitcnt vmcnt(0)" ::: "memory");
            const unsigned og = xb_add(&bar[XB_TOP], 1u);
            const unsigned tg = og / nx;
            if (og + 1u == (tg + 1u) * nx) xb_add(&bar[XB_TOPGEN], 1u);
            else XB_SPIN(xb_ld(&bar[XB_TOPGEN]) == tg, bar);
            __builtin_amdgcn_fence(__ATOMIC_ACQUIRE, "agent");
            xb_add(&bar[XB_XGEN(b.x)], 1u);
            asm volatile("s_waitcnt vmcnt(0)" ::: "memory");
        } else {
            XB_SPIN(xb_ld(&bar[XB_XGEN(b.x)]) == gen, bar);
            __builtin_amdgcn_fence(__ATOMIC_ACQUIRE, "agent");
            asm volatile("s_waitcnt vmcnt(0)" ::: "memory");
        }
    }
    __syncthreads();
}


namespace att {
typedef short bf16x8 __attribute__((ext_vector_type(8)));
typedef short s16x4 __attribute__((ext_vector_type(4)));
typedef float f32x16 __attribute__((ext_vector_type(16)));
#define ATT_SBAR() __builtin_amdgcn_sched_barrier(0)
#define ATT_BAR() do { asm volatile("s_waitcnt lgkmcnt(0)" ::: "memory"); __builtin_amdgcn_s_barrier(); asm volatile("" ::: "memory"); } while (0)
constexpr float LOG2E = 1.4426950408889634f, NEGM = -1e30f;
constexpr int KVSPLIT = 4;
__device__ __forceinline__ int crow(int r, int hi) { return (r & 3) + 8 * (r >> 2) + 4 * hi; }
__device__ __forceinline__ unsigned cvtpk(float lo, float hi) { unsigned r; asm volatile("v_cvt_pk_bf16_f32 %0, %1, %2" : "=v"(r) : "v"(lo), "v"(hi)); return r; }
template <int DQK> __device__ __forceinline__ int kswz_x(int row) { return DQK == 128 ? (((row & 7) | (((row >> 4) & 1) << 3)) << 4) : (((row >> 1) & 7) << 4); }
template <int DQK> __device__ __forceinline__ int kswz(int row, int colB) { return row * (DQK * 2) + (colB ^ kswz_x<DQK>(row)); }
__device__ __forceinline__ int v_st(int k, int c) { const int kk = (k & ~0xC) | ((k & 4) << 1) | ((k & 8) >> 1); return ((kk >> 3) * 4 + (c >> 5)) * 512 + ((kk & 7) * 32 + (c & 31)) * 2; }
__device__ __forceinline__ int v_rd_base(int lane) { return ((lane & 3) << 3) | (((lane >> 2) & 3) << 6) | (((lane >> 4) & 1) << 5) | (((lane >> 5) & 1) << 8); }
constexpr int v_rd_off(int d0, int ks, int half) { return d0 * 512 + ks * 4096 + half * 2048; }
template <int OFF> __device__ __forceinline__ s16x4 tr_read(int vb) { s16x4 r; asm volatile("ds_read_b64_tr_b16 %0, %1 offset:%2" : "=&v"(r) : "v"(vb), "i"(OFF) : "memory"); return r; }
struct VFrag { s16x4 l0, h0, l1, h1, l2, h2, l3, h3; };
template <int D0> __device__ __forceinline__ void pv_read(VFrag& f, int vb) {
  f.l0 = tr_read<v_rd_off(D0, 0, 0)>(vb); f.h0 = tr_read<v_rd_off(D0, 0, 1)>(vb); f.l1 = tr_read<v_rd_off(D0, 1, 0)>(vb); f.h1 = tr_read<v_rd_off(D0, 1, 1)>(vb);
  f.l2 = tr_read<v_rd_off(D0, 2, 0)>(vb); f.h2 = tr_read<v_rd_off(D0, 2, 1)>(vb); f.l3 = tr_read<v_rd_off(D0, 3, 0)>(vb); f.h3 = tr_read<v_rd_off(D0, 3, 1)>(vb);
}
__device__ __forceinline__ void pv_mma(f32x16& od, const VFrag& f, bf16x8 pa0, bf16x8 pa1, bf16x8 pa2, bf16x8 pa3) {
#define ATT_PK(L, H) (bf16x8){L[0], L[1], L[2], L[3], H[0], H[1], H[2], H[3]}
  od = __builtin_amdgcn_mfma_f32_32x32x16_bf16(pa0, ATT_PK(f.l0, f.h0), od, 0, 0, 0);
  od = __builtin_amdgcn_mfma_f32_32x32x16_bf16(pa1, ATT_PK(f.l1, f.h1), od, 0, 0, 0);
  od = __builtin_amdgcn_mfma_f32_32x32x16_bf16(pa2, ATT_PK(f.l2, f.h2), od, 0, 0, 0);
  od = __builtin_amdgcn_mfma_f32_32x32x16_bf16(pa3, ATT_PK(f.l3, f.h3), od, 0, 0, 0);
#undef ATT_PK
}
__device__ __forceinline__ void pv_d0(f32x16* o, int vb, bf16x8 pa0, bf16x8 pa1, bf16x8 pa2, bf16x8 pa3) {
  VFrag fa, fb;
  pv_read<0>(fa, vb); pv_read<1>(fb, vb);
  asm volatile("s_waitcnt lgkmcnt(8)" ::: "memory"); ATT_SBAR(); pv_mma(o[0], fa, pa0, pa1, pa2, pa3); ATT_SBAR();
  pv_read<2>(fa, vb);
  asm volatile("s_waitcnt lgkmcnt(8)" ::: "memory"); ATT_SBAR(); pv_mma(o[1], fb, pa0, pa1, pa2, pa3); ATT_SBAR();
  pv_read<3>(fb, vb);
  asm volatile("s_waitcnt lgkmcnt(8)" ::: "memory"); ATT_SBAR(); pv_mma(o[2], fa, pa0, pa1, pa2, pa3); ATT_SBAR();
  asm volatile("s_waitcnt lgkmcnt(0)" ::: "memory"); ATT_SBAR(); pv_mma(o[3], fb, pa0, pa1, pa2, pa3);
}
typedef float f32x2 __attribute__((ext_vector_type(2)));
template <bool RAW>
__device__ __forceinline__ void softmax_tile(f32x16& p0, f32x16& p1, float Cs, float& m_reg, float& l_reg, float& alpha, bf16x8& pa0, bf16x8& pa1, bf16x8& pa2, bf16x8& pa3) {
  float pmax = fmaxf(fmaxf(p0[0], p0[1]), p1[0]);
#pragma unroll
  for (int r = 2; r < 16; r += 2) pmax = fmaxf(fmaxf(pmax, p0[r]), p0[r + 1]);
#pragma unroll
  for (int r = 1; r < 15; r += 2) pmax = fmaxf(fmaxf(pmax, p1[r]), p1[r + 1]);
  pmax = fmaxf(pmax, p1[15]);
  { auto rr = __builtin_amdgcn_permlane32_swap(__float_as_uint(pmax), __float_as_uint(pmax), false, false); pmax = fmaxf(__uint_as_float(rr[0]), __uint_as_float(rr[1])); }
  if (RAW) pmax *= Cs;
  const float mn = fmaxf(m_reg, pmax); alpha = __builtin_amdgcn_exp2f(m_reg - mn); m_reg = mn;
#pragma unroll
  for (int r = 0; r < 16; ++r) { p0[r] = __builtin_amdgcn_exp2f(RAW ? fmaf(p0[r], Cs, -mn) : p0[r] - mn); p1[r] = __builtin_amdgcn_exp2f(RAW ? fmaf(p1[r], Cs, -mn) : p1[r] - mn); }
  f32x2 ps2 = {0.f, 0.f};
#pragma unroll
  for (int r = 0; r < 16; r += 2) { ps2 += (f32x2){p0[r], p0[r + 1]}; ps2 += (f32x2){p1[r], p1[r + 1]}; }
  float ps = ps2[0] + ps2[1];
  { auto rr = __builtin_amdgcn_permlane32_swap(__float_as_uint(ps), __float_as_uint(ps), false, false); ps = __uint_as_float(rr[0]) + __uint_as_float(rr[1]); }
  l_reg = l_reg * alpha + ps;
#define ATT_PK4(P, BASE, OUT) do { unsigned a0 = cvtpk(P[BASE + 0], P[BASE + 1]), a1 = cvtpk(P[BASE + 2], P[BASE + 3]);   \
    unsigned b0 = cvtpk(P[BASE + 4], P[BASE + 5]), b1 = cvtpk(P[BASE + 6], P[BASE + 7]);                              \
    auto r0 = __builtin_amdgcn_permlane32_swap(a0, b0, false, false); auto r1 = __builtin_amdgcn_permlane32_swap(a1, b1, false, false); \
    u32x4 w = {r0[0], r1[0], r0[1], r1[1]}; OUT = *reinterpret_cast<bf16x8*>(&w); } while (0)
  ATT_PK4(p0, 0, pa0); ATT_PK4(p0, 8, pa1); ATT_PK4(p1, 0, pa2); ATT_PK4(p1, 8, pa3);
#undef ATT_PK4
}

template <int MODE>
__device__ __forceinline__ void attn_unit(unsigned char* ws_, const float* rpb, const float* sink, int l, int h, int qb, int kvq, unsigned char* lds_g) {
  constexpr int DQK = MODE == 1 ? 192 : 128, ND = DQK / 16, NCH = DQK / 64;
  constexpr int SHM_V = 64 * 128 * 2, SHM_K = 64 * DQK * 2, OFF_K = 3 * SHM_V, OFF_WS = OFF_K + 3 * SHM_K, OFF_RPB = OFF_WS + 8 * 64 * 4;
  const int tid = otid(), wid = tid >> 6, lane = tid & 63, r32 = lane & 31, hi = lane >> 5;
  LAS unsigned char* ldl = (LAS unsigned char*)lds_g;
  const bf16_t* proj = (const bf16_t*)(ws_ + WS_PROJ);
  const bf16_t *Qp, *Kp, *Vp; int ldq, ldk, ldv, ycol; float C;
  if (MODE == 0) { Qp = proj + C_QA + 128 * h; Kp = proj + C_KA + 128 * h; Vp = proj + C_VA + 128 * h; ldq = ldk = ldv = DINP; ycol = 128 * h; C = 0.08838834764831845f * LOG2E; }
  else if (MODE == 1) { Qp = (const bf16_t*)(ws_ + WS_Q) + 192 * h; Kp = (const bf16_t*)(ws_ + WS_K) + 192 * h; Vp = (const bf16_t*)(ws_ + WS_V) + 128 * h; ldq = QLD; ldk = KLD; ldv = VLD; ycol = 512 + 128 * h; C = 0.07216878364870322f * LOG2E; }
  else { Qp = proj + C_QC + 128 * h; Kp = proj + C_KC + 128 * (h / 3); Vp = proj + C_VC + 128 * (h / 3); ldq = ldk = ldv = DINP; ycol = 1280 + 128 * h; C = 0.08838834764831845f * LOG2E; }
  const int q0 = qb * 256, qi = q0 + wid * 32 + r32;
  int T0, T1, tw0, tw1, wrow = 0, qcol = 0, c0 = 0; float slope2 = 0.f;
  if (MODE == 1) { T0 = tw0 = kvq * (S / 64 / KVSPLIT); T1 = tw1 = T0 + S / 64 / KVSPLIT; }
  else if (MODE == 0) { const int R = qb * 4; T0 = min(max(R - 4, 0), 120); T1 = min(max(R - 1, 0), 120) + 8; wrow = R + (wid >> 1); tw0 = min(max(wrow - 4, 0), 120); tw1 = tw0 + 8;
                        qcol = (wid & 1) * 32 + r32; c0 = min(max(qcol - 8, 0), 48); }
  else { T0 = max(0, (q0 - 128) >> 6); T1 = min(S / 64, ((q0 + 255 + 128) >> 6) + 1); const int qw = q0 + wid * 32; tw0 = max(0, (qw - 128) >> 6); tw1 = min(S / 64, ((qw + 31 + 128) >> 6) + 1);
         slope2 = exp2f(-8.0f * (float)(h + 1) / 6.0f) * LOG2E; }
  LAS float* wsl = (LAS float*)(ldl + OFF_WS) + wid * 64; LAS float* li_l = wsl; LAS float* al_l = wsl + 32;
  LAS float* rpbL = (LAS float*)(ldl + OFF_RPB);
  if (MODE == 0) { for (int i = tid; i < 465; i += NTHREADS) rpbL[i] = rpb[(l * 4 + h) * 465 + i] * LOG2E; }
  float m_reg = -1e29f, l_reg = 0.f;
  if (MODE == 2) { m_reg = sink[l * 6 + h] * LOG2E; l_reg = 1.f; }
  f32x16 o[4] = {}; bf16x8 qr[ND];
  { const bf16_t* Qw = Qp + (size_t)qi * ldq + hi * 8;
#pragma unroll
    for (int d0 = 0; d0 < ND; ++d0) qr[d0] = *(const bf16x8*)(Qw + d0 * 16); }
  unsigned kg[NCH], vg[2];
#pragma unroll
  for (int i = 0; i < NCH; ++i) { const int X = (wid + 8 * i) * 1024 + lane * 16, row = X / (DQK * 2), cs = X % (DQK * 2), colB = cs ^ kswz_x<DQK>(row); kg[i] = (unsigned)(row * ldk + (colB >> 1)) * 2u; }
#pragma unroll
  for (int i = 0; i < 2; ++i) { const int X = (wid + 8 * i) * 1024 + lane * 16, st = X >> 9, w = X & 511, kk = ((st >> 2) << 3) | (w >> 6), c = ((st & 3) << 5) | ((w & 63) >> 1);
    const int k = (kk & ~0xC) | ((kk & 4) << 1) | ((kk & 8) >> 1); vg[i] = (unsigned)(k * ldv + c) * 2u; }
  const int vb0 = (int)(uintptr_t)lds_g + v_rd_base(lane);
  const int kbase0 = (int)(uintptr_t)lds_g + OFF_K;
  constexpr int NKO = DQK == 192 ? 4 : ND;
  int ko[NKO];
#pragma unroll
  for (int d0 = 0; d0 < NKO; ++d0) ko[d0] = kswz<DQK>(r32, (d0 * 16 + hi * 8) * 2);
#define ATT_KO(d0_) (DQK == 192 ? ko[(d0_) & 3] + ((d0_) >> 2) * 128 : ko[(d0_) % NKO])
  const int wslab = __builtin_amdgcn_readfirstlane(wid) * 1024;
#define ATT_DMA(t, b) do { const char* kt_ = (const char*)(Kp + (size_t)(t) * 64 * ldk); const char* vt_ = (const char*)(Vp + (size_t)(t) * 64 * ldv); \
    _Pragma("unroll") for (int i_ = 0; i_ < NCH; ++i_) __builtin_amdgcn_global_load_lds((const unsigned*)(kt_ + kg[i_]), (LAS unsigned*)(ldl + OFF_K + (b) * SHM_K + wslab + i_ * 8192), 16, 0, 0); \
    _Pragma("unroll") for (int i_ = 0; i_ < 2; ++i_) __builtin_amdgcn_global_load_lds((const unsigned*)(vt_ + vg[i_]), (LAS unsigned*)(ldl + (b) * SHM_V + wslab + i_ * 8192), 16, 0, 0); } while (0)
  __syncthreads();
  ATT_DMA(T0, 0); if (T0 + 1 < T1) { ATT_DMA(T0 + 1, 1); asm volatile("s_waitcnt vmcnt(%0)" :: "n"(NCH + 2) : "memory"); } else asm volatile("s_waitcnt vmcnt(0)" ::: "memory");
  ATT_BAR();
  int b = 0, bn = 2;
#pragma unroll 1
  for (int j = T0; j < T1; ++j) {
    const bool vis_ = (j >= tw0 && j < tw1);
    if (vis_) {
      f32x16 p0 = {}, p1 = {};
      ATT_SBAR();
      {
        const int kbase = kbase0 + b * SHM_K;
        bf16x8 fa[3], fb[3];
#define ATT_KRD(d0_) do { const int ad_ = kbase + ATT_KO(d0_); \
          asm volatile("ds_read_b128 %0, %1" : "=v"(fa[(d0_) % 3]) : "v"(ad_) : "memory"); \
          asm volatile("ds_read_b128 %0, %1 offset:%2" : "=v"(fb[(d0_) % 3]) : "v"(ad_), "i"(32 * DQK * 2) : "memory"); } while (0)
        ATT_KRD(0); ATT_KRD(1);
#pragma unroll
        for (int d0 = 0; d0 < ND; ++d0) {
          if (d0 + 2 < ND) { ATT_KRD(d0 + 2); asm volatile("s_waitcnt lgkmcnt(4)" ::: "memory"); }
          else if (d0 + 1 < ND) asm volatile("s_waitcnt lgkmcnt(2)" ::: "memory");
          else asm volatile("s_waitcnt lgkmcnt(0)" ::: "memory");
          ATT_SBAR();
          p0 = __builtin_amdgcn_mfma_f32_32x32x16_bf16(fa[d0 % 3], qr[d0], p0, 0, 0, 0);
          p1 = __builtin_amdgcn_mfma_f32_32x32x16_bf16(fb[d0 % 3], qr[d0], p1, 0, 0, 0);
          ATT_SBAR(); }
#undef ATT_KRD
      }
      ATT_SBAR();
      if (MODE == 0) {
        const int dr31 = (j - wrow + 7) * 31 + 15 - qcol;
#pragma unroll
        for (int r = 0; r < 16; ++r) { const int kc = crow(r, hi);
          { const bool v = (kc >= c0) && (kc < c0 + 16); const float bb = rpbL[v ? dr31 + kc : 0]; p0[r] = v ? fmaf(p0[r], C, bb) : NEGM; }
          { const int kc1 = kc + 32; const bool v = (kc1 >= c0) && (kc1 < c0 + 16); const float bb = rpbL[v ? dr31 + kc1 : 0]; p1[r] = v ? fmaf(p1[r], C, bb) : NEGM; } }
      } else if (MODE == 2) {
        const int kb = j * 64;
#pragma unroll
        for (int r = 0; r < 16; ++r) { const int k = kb + crow(r, hi);
          { const int d = abs(qi - k); p0[r] = d <= 128 ? fmaf(p0[r], C, -slope2 * (float)d) : NEGM; }
          { const int d = abs(qi - k - 32); p1[r] = d <= 128 ? fmaf(p1[r], C, -slope2 * (float)d) : NEGM; } }
      }
      float alpha; bf16x8 pa0, pa1, pa2, pa3;
      softmax_tile<MODE == 1>(p0, p1, C, m_reg, l_reg, alpha, pa0, pa1, pa2, pa3);
      if (__any(alpha < 1.f)) { if (hi == 0) al_l[r32] = alpha; asm volatile("s_waitcnt lgkmcnt(0)" ::: "memory");
#pragma unroll
        for (int r = 0; r < 16; ++r) { const float av = al_l[crow(r, hi)];
#pragma unroll
          for (int d = 0; d < 4; ++d) o[d][r] *= av; }
        asm volatile("s_waitcnt lgkmcnt(0)" ::: "memory"); }
      ATT_SBAR();
      pv_d0(o, vb0 + b * SHM_V, pa0, pa1, pa2, pa3);
    }
#if defined(PROBE_ATT_VALU)
    if (MODE == 1) { float dx_ = m_reg;
#pragma unroll
      for (int i_ = 0; i_ < 32; ++i_) asm volatile("v_exp_f32 %0, %0" : "+v"(dx_));
      asm volatile("" :: "v"(dx_)); }
#endif
#if defined(PROBE_ATT_LDS)
    if (MODE == 1) { bf16x8 t_; const int ad_ = (int)(uintptr_t)lds_g + OFF_K + b * SHM_K + kswz<DQK>(r32, hi * 16);
#pragma unroll
      for (int i_ = 0; i_ < 24; ++i_) asm volatile("ds_read_b128 %0, %1 offset:%2" : "=v"(t_) : "v"(ad_), "i"((i_ % 12) * 32) : "memory");
      asm volatile("s_waitcnt lgkmcnt(0)" ::: "memory"); asm volatile("" :: "v"(t_)); }
#endif
#if defined(PROBE_ATT_MFMA)
    if (MODE == 1) { f32x4 da_ = {0.f, 0.f, 0.f, 0.f};
#pragma unroll
      for (int i_ = 0; i_ < 80; ++i_) da_ = __builtin_amdgcn_mfma_f32_16x16x32_bf16(qr[0], qr[1], da_, 0, 0, 0);
      asm volatile("" :: "v"(da_)); }
#endif
    ATT_SBAR();
    if (j + 2 < T1) ATT_DMA(j + 2, bn);
    if (j + 2 < T1) asm volatile("s_waitcnt vmcnt(%0)" :: "n"(NCH + 2) : "memory"); else asm volatile("s_waitcnt vmcnt(0)" ::: "memory");
    ATT_BAR();
    b = b == 2 ? 0 : b + 1; bn = bn == 2 ? 0 : bn + 1;
  }
  if (hi == 0) li_l[r32] = l_reg; asm volatile("s_waitcnt lgkmcnt(0)" ::: "memory");
  bf16_t* Ow; int ldo;
  if (MODE == 1) { Ow = (bf16_t*)(ws_ + WS_PART) + ((size_t)kvq * S + q0 + wid * 32) * VLD + 128 * h + r32; ldo = VLD;
    if (hi == 0) { float* st = (float*)(ws_ + WS_STAT) + ((size_t)(kvq * 6 + h) * S + qi) * 2; st[0] = m_reg; st[1] = l_reg; } }
  else { Ow = (bf16_t*)(ws_ + WS_Y) + (size_t)(q0 + wid * 32) * DM + ycol + r32; ldo = DM; }
#pragma unroll
  for (int r = 0; r < 16; ++r) { const int orow = crow(r, hi); const float rl = __builtin_amdgcn_rcpf(li_l[orow]);
#pragma unroll
    for (int d0 = 0; d0 < 4; ++d0) Ow[(size_t)orow * ldo + d0 * 32] = (bf16_t)(cvtpk(o[d0][r] * rl, 0.f) & 0xffffu); }
  asm volatile("s_waitcnt lgkmcnt(0)" ::: "memory");
  __syncthreads();
#undef ATT_DMA
#undef ATT_KO
}
}

#ifndef NAIVE_ATTN
#define NAIVE_ATTN 0
#endif
#ifndef MK_MULTI
#define MK_MULTI 0
#endif
constexpr int N_PHASES = 2 + 10 * DEPTH;
__device__ __forceinline__ int opq(int v) { asm volatile("" : "+s"(v)); return v; }

__global__ void __launch_bounds__(NTHREADS) fwd_megakernel(Args a) {
    extern __shared__ __attribute__((aligned(16))) unsigned char lds[];
    cg::grid_group grid = cg::this_grid();
    const int lo = a.ph_lo, hi = a.ph_hi;
    const int G = gridDim.x;
    { LAS unsigned long long* tw = (LAS unsigned long long*)((LAS unsigned char*)lds + TAB_OFF);
#pragma unroll
      for (int i = 0; i < 19; ++i) if ((int)threadIdx.x == i) tw[i] = (unsigned long long)a.in[i];
      if (threadIdx.x == 19) tw[19] = (unsigned long long)a.out;
      if (threadIdx.x == 20) tw[20] = (unsigned long long)a.ws;
      if (threadIdx.x < 4) ((LAS unsigned*)((LAS unsigned char*)lds + TAB_OFF + 192))[threadIdx.x] = 0u;
      __syncthreads(); }
    (void)xcd_barrier_post((unsigned*)(a.ws + WS_BAR), (volatile LAS unsigned*)((LAS unsigned char*)lds + TAB_OFF + 192));
    if (a.ph_lo < 0) grid.sync();
    const Tab T{(const LAS unsigned*)((LAS unsigned char*)lds + TAB_OFF)};
#define ws (T.wsp())
#define mod ((float*)(ws + WS_MOD))
#define U ((bf16_t*)(ws + WS_U))
#define PROJ ((bf16_t*)(ws + WS_PROJ))
#define Qb ((bf16_t*)(ws + WS_Q))
#define Kb ((bf16_t*)(ws + WS_K))
#define Vb ((bf16_t*)(ws + WS_V))
#define Y ((bf16_t*)(ws + WS_Y))
#define Hb ((bf16_t*)(ws + WS_H))
#define X ((float*)(ws + WS_X))
#define rope ((float*)(ws + WS_ROPE))
#define rsq ((float*)(ws + WS_RSQ))
#define rskv ((float*)(ws + WS_RSKV))
    PG8_LAS unsigned char* ldsl = (PG8_LAS unsigned char*)lds;
#ifndef PHM
#define PHM 0xFFFFF
#endif
#ifndef ATM
#define ATM 7
#endif
#define EN(b) ((PHM >> (b)) & 1)
#ifndef PROBE_PH
#define PROBE_PH -1
#endif
#ifndef PROBE_N
#define PROBE_N 2
#endif
#define REPK(k) for (int rep_ = 0; rep_ < ((k) == PROBE_PH ? PROBE_N : 1); ++rep_)
#define IN(k) (lo <= (k) && (k) < hi)
#define GBAR() do { XcdBarrier b_; b_.bar = (unsigned*)(ws + WS_BAR); b_.x = xb_xcc_id(); b_.st = (volatile LAS unsigned*)((LAS unsigned char*)lds + TAB_OFF + 192); xcd_barrier(b_); } while (0)
#define SEAM(k) do { if (IN(k) && IN((k) + 1)) GBAR(); } while (0)

#ifdef PROBE_SYNCS
    for (int i_ = 0; i_ < PROBE_SYNCS; ++i_) GBAR();
#endif
    if (EN(0) && IN(0)) REPK(0) { phase_mod(T, lds); }
    SEAM(0);
    if (EN(1) && IN(1)) REPK(1) {
        const int fb_ = opq((int)blockIdx.x), fs_ = opq(G); const bool hide_ = (fs_ == 256);
        for (int l = 0; l < DEPTH; ++l) {
            transpose_job<3>(T.in(4) + (size_t)l * DM * DIN, (bf16_t*)(ws + WS_W + (size_t)l * SZ_WL + O_WIN), DM, DIN, DINP, nullptr, lds, fb_, fs_);
            transpose_job<1>(T.in(8) + (size_t)l * 512 * 1152, (bf16_t*)(ws + WS_W + (size_t)l * SZ_WL + O_WUQ), 512, 1152, 1280, T.in(6) + l * 512, lds, fb_, fs_);
            transpose_job<0>(T.in(9) + (size_t)l * 256 * 1536, (bf16_t*)(ws + WS_W + (size_t)l * SZ_WL + O_WUKV), 256, 1536, 1536, T.in(7) + l * 256, lds, fb_, fs_);
            if (!(hide_ && l == 1)) transpose_job<0>(T.in(12) + (size_t)l * DM * DM, (bf16_t*)(ws + WS_W + (size_t)l * SZ_WL + O_WO), DM, DM, DM, T.in(11) + l * DM, lds, fb_, fs_);
            if (!(hide_ && l == 1)) transpose_job<2>(T.in(15) + (size_t)l * DM * 2 * DFF, (bf16_t*)(ws + WS_W + (size_t)l * SZ_WL + O_WGU), DM, 2 * DFF, 2 * DFF, nullptr, lds, fb_, fs_);
            transpose_job<0>(T.in(16) + (size_t)l * DFF * DM, (bf16_t*)(ws + WS_W + (size_t)l * SZ_WL + O_WDN), DFF, DM, DM, nullptr, lds, fb_, fs_);
        }
        modulate_rows(T.in(0), mod + 1 * DM, mod + 0 * DM, U);
        rope_table(rope);
    }
    SEAM(1);
#pragma unroll 1
    for (int l = 0; l < DEPTH; ++l) {
        const int pb = 2 + 10 * l;
        if (EN(2) && IN(pb + 0)) REPK(2) {
            pg8::Gemm g{U, (const bf16_t*)(ws + WS_W + (size_t)l * SZ_WL + O_WIN), S, DINP, DM, DM}; pg8::StaticOrder So; So.init(S, DINP, opq(G), opq((int)blockIdx.x));
            pg8::EpiProj E{PROJ, DINP, (float*)(ws + WS_SSQ), rope, Kb, KLD};
            pg8::gemm_phase<pg8::EpiProj, pg8::StaticOrder, true, true>(ldsl, g, So, E);
            if (l == 0 && opq(G) == 256 && opq((int)blockIdx.x) >= 224)
                transpose_job<0>(T.in(12) + (size_t)DM * DM, (bf16_t*)(ws + WS_W + SZ_WL + O_WO), DM, DM, DM, T.in(11) + DM, lds, opq((int)blockIdx.x) - 224, 32);
        }
        SEAM(pb + 0);
        if (EN(4) && IN(pb + 2)) REPK(4) {
            { const int bq = opq((int)blockIdx.x), Gq = opq(G);
#pragma unroll 1
              for (int it = 0; ; ++it) {
                int q0 = -1, kv0 = -1, kv1 = -1, na = -1, sw0 = -1, sw1 = -1;
                if (Gq == 256) { if (it == 0) {
                    if (bq < 96) { na = bq; q0 = bq; }
                    else if (bq < 128) { na = bq; kv0 = 2 * (bq - 96); kv1 = kv0 + 1; }
                    else if (bq < 192) { sw0 = bq - 128; q0 = 96 + (bq - 128); kv0 = 64 + 2 * (bq - 128); kv1 = kv0 + 1; }
                    else { sw0 = 64 + (bq - 192); sw1 = 128 + (bq - 192); } } }
                else { const int L = bq + it * Gq; if (L < 160) q0 = L; if (L < 192) { kv0 = L; sw0 = L; } if (L < 128) na = L; }
                if ((q0 & kv0 & na & sw0) < 0 && q0 < 0 && kv0 < 0 && na < 0 && sw0 < 0) break;
                if (q0 >= 0) { pg8::Gemm g{PROJ + C_CQ, (const bf16_t*)(ws + WS_W + (size_t)l * SZ_WL + O_WUQ), S, 1280, 512, DINP}; pg8::ListOrder So{5, 1, q0, 0};
                  pg8::EpiQ E{Qb, QLD, (const float*)(ws + WS_SSQ), rope};
                  pg8::gemm_phase<pg8::EpiQ, pg8::ListOrder, true, true>(ldsl, g, So, E); }
                if (kv0 >= 0) { pg8::Gemm g{PROJ + C_CKV, (const bf16_t*)(ws + WS_W + (size_t)l * SZ_WL + O_WUKV), S, 1536, 256, DINP}; pg8::ListOrder So{6, kv1 >= 0 ? 2 : 1, kv0, kv1};
                  pg8::EpiKV E{Kb, KLD, Vb, VLD, (const float*)(ws + WS_SSQ)};
                  pg8::gemm_phase<pg8::EpiKV, pg8::ListOrder, true, true>(ldsl, g, So, E); }
                if (na >= 0) { if (ATM & 2) att::attn_unit<0>(ws, T.in(5), T.in(10), l, na >> 5, na & 31, 0, lds); }
#pragma unroll 1
                for (int i2 = 0; i2 < 2; ++i2) { const int u = i2 ? sw1 : sw0; if (u >= 0) { if (ATM & 4) att::attn_unit<2>(ws, T.in(5), T.in(10), l, u >> 5, u & 31, 0, lds); } }
              } }
        }
        SEAM(pb + 2);
        if (EN(5) && IN(pb + 3)) REPK(5) {
#if NAIVE_ATTN
            naive_attn<0>(ws, T.in(5), T.in(10), l); naive_attn<2>(ws, T.in(5), T.in(10), l); naive_attn<1>(ws, T.in(5), T.in(10), l);
#else
            const int Gq = opq(G);
            for (int su = opq((int)blockIdx.x); su < 192 * att::KVSPLIT; su += Gq) {
                int combo, qb; if (Gq == 256) { combo = (su & 7) + 8 * (su >> 8); qb = (su & 255) >> 3; } else { combo = su >> 5; qb = su & 31; }
                unsigned char* wsp_ = ws;
                if (ATM & 1) att::attn_unit<1>(wsp_, nullptr, nullptr, l, combo >> 2, qb, combo & 3, lds);
            }
#endif
        }
        SEAM(pb + 3);
        if (EN(6) && IN(pb + 4)) phase_ynorm(ws);
        SEAM(pb + 4);
        if (EN(7) && IN(pb + 5)) {
            pg8::Gemm g{Y, (const bf16_t*)(ws + WS_W + (size_t)l * SZ_WL + O_WO), S, DM, DM, DM}; pg8::StaticOrder So; So.init(S, DM, opq(G), opq((int)blockIdx.x));
            pg8::EpiRes E{l == 0 ? T.in(0) : (const float*)X, X, mod + (size_t)l * 6 * DM + 2 * DM, ALPHA, DM};
            pg8::gemm_phase<pg8::EpiRes, pg8::StaticOrder, true, true>(ldsl, g, So, E);
        }
        SEAM(pb + 5);
#ifdef PROBE_LN
        if (EN(8) && IN(pb + 6)) phase_ln(X, (float*)(ws + WS_H), T.in(13) + l * DM, T.in(14) + l * DM, mod + (size_t)l * 6 * DM + 4 * DM, mod + (size_t)l * 6 * DM + 3 * DM, (bf16_t*)(ws + WS_PART));
#endif
        if (EN(8) && IN(pb + 6)) phase_ln(X, X, T.in(13) + l * DM, T.in(14) + l * DM, mod + (size_t)l * 6 * DM + 4 * DM, mod + (size_t)l * 6 * DM + 3 * DM, U);
        SEAM(pb + 6);
        if (EN(9) && IN(pb + 7)) REPK(9) {
            pg8::Gemm g{U, (const bf16_t*)(ws + WS_W + (size_t)l * SZ_WL + O_WGU), S, 2 * DFF, DM, DM}; pg8::StaticOrder So; So.init(S, 2 * DFF, opq(G), opq((int)blockIdx.x));
            pg8::EpiSwiglu E{Hb, DFF};
            pg8::gemm_phase<pg8::EpiSwiglu, pg8::StaticOrder, true, true>(ldsl, g, So, E);
            if (l == 0 && opq(G) == 256 && opq((int)blockIdx.x) >= 128)
                transpose_job<2>(T.in(15) + (size_t)DM * 2 * DFF, (bf16_t*)(ws + WS_W + SZ_WL + O_WGU), DM, 2 * DFF, 2 * DFF, nullptr, lds, opq((int)blockIdx.x) - 128, 128);
        }
        SEAM(pb + 7);
        if (EN(10) && IN(pb + 8)) {
            pg8::Gemm g{Hb, (const bf16_t*)(ws + WS_W + (size_t)l * SZ_WL + O_WDN), S, DM, DFF, DFF}; pg8::StaticOrder So; So.init(S, DM, opq(G), opq((int)blockIdx.x));
            pg8::EpiRes E{X, X, mod + (size_t)l * 6 * DM + 5 * DM, ALPHA, DM};
            pg8::gemm_phase<pg8::EpiRes, pg8::StaticOrder, true, true>(ldsl, g, So, E);
        }
        SEAM(pb + 8);
        if (EN(11) && IN(pb + 9)) {
            const bool last = (l == DEPTH - 1);
            const float* modn = mod + (size_t)(last ? l : l + 1) * 6 * DM;
            phase_ln(X, last ? T.out() : X, T.in(17) + l * DM, T.in(18) + l * DM, last ? nullptr : modn + 1 * DM, last ? nullptr : modn + 0 * DM, last ? nullptr : U);
        }
        SEAM(pb + 9);
    }
#undef IN
#undef SEAM
#undef ws
#undef mod
#undef U
#undef PROJ
#undef Qb
#undef Kb
#undef Vb
#undef Y
#undef Hb
#undef X
#undef rope
#undef rsq
#undef rskv
}

extern "C" void kernel_launch(void* const* d_in, const int* in_sizes, int n_in, void* d_out, int out_size, void* d_ws, size_t ws_size, hipStream_t stream) {
    static int grid = 0;
    if (grid == 0) {
        if (n_in != 19 || out_size != S * DM || ws_size < WS_END) { fprintf(stderr, "kernel_launch: unexpected shapes (n_in %d out %d ws %zu need %zu)\n", n_in, out_size, ws_size, (size_t)WS_END); grid = -1; return; }
        int dev = 0, cus = 0, per_cu = 0;
        hipGetDevice(&dev); hipDeviceGetAttribute(&cus, hipDeviceAttributeMultiprocessorCount, dev);
        if (hipFuncSetAttribute((const void*)fwd_megakernel, hipFuncAttributeMaxDynamicSharedMemorySize, LDS_BYTES) != hipSuccess) { fprintf(stderr, "kernel_launch: hipFuncSetAttribute failed\n"); grid = -1; return; }
        if (hipOccupancyMaxActiveBlocksPerMultiprocessor(&per_cu, (const void*)fwd_megakernel, NTHREADS, LDS_BYTES) != hipSuccess || per_cu < 1) { fprintf(stderr, "kernel_launch: occupancy query gave %d\n", per_cu); per_cu = 1; }
        (void)hipGetLastError();
        grid = cus;
    }
    if (grid < 0) return;
    if (hipMemsetAsync((char*)d_ws + WS_BAR, 0, 16384, stream) != hipSuccess) { fprintf(stderr, "kernel_launch: memset of the barrier words failed\n"); return; }
    Args a{};
    for (int i = 0; i < 19; ++i) a.in[i] = (const float*)d_in[i];
    a.out = (float*)d_out; a.ws = (unsigned char*)d_ws;
#if MK_MULTI
    for (int p = 0; p < N_PHASES; ++p) { a.ph_lo = p; a.ph_hi = p + 1; hipLaunchKernelGGL(fwd_megakernel, dim3(grid), dim3(NTHREADS), LDS_BYTES, stream, a); }
#else
    a.ph_lo = 0; a.ph_hi = N_PHASES;
    void* args[] = {&a};
    hipError_t e = hipLaunchCooperativeKernel((const void*)fwd_megakernel, dim3(grid), dim3(NTHREADS), args, LDS_BYTES, stream);
    if (e != hipSuccess) fprintf(stderr, "kernel_launch: cooperative launch failed: %s (grid %d)\n", hipGetErrorString(e), grid);
#endif
}
```

```cpp
#include <hip/hip_runtime.h>
#include <hip/hip_cooperative_groups.h>
#include <cstdio>
#include <cstdint>
namespace cg = cooperative_groups;
namespace pg8 {
#define PG8_LAS __attribute__((address_space(3)))
typedef unsigned short bf16_t;
typedef short bf16x8 __attribute__((ext_vector_type(8)));
typedef float f32x4 __attribute__((ext_vector_type(4)));
typedef unsigned u32x4 __attribute__((ext_vector_type(4)));
constexpr int BM = 256, BK = 64, HALF = 128, HTB = HALF * BK * 2  , STAGE_BYTES = 8 * HTB, NXCD = 8, WGM = 8;

__host__ __device__ __forceinline__ int lds_byte(int r, int c) { const int st = (r >> 4) * 2 + (c >> 5), rr = r & 15, cc = c & 31, ob = rr * 64 + cc * 2; return st * 1024 + (ob ^ (((ob >> 9) & 1) << 5)); }
__host__ __device__ __forceinline__ void stage_rc(int b, int& R, int& C) { const int st = b / 1024, sb = b % 1024, swz = sb ^ (((sb >> 9) & 1) << 5); R = (st >> 1) * 16 + swz / 64; C = (st & 1) * 32 + (swz % 64) / 2; }
__host__ __device__ __forceinline__ int perm32(int rho) { const int n = rho >> 4, i = rho & 15; return 8 * (i >> 2) + 4 * n + (i & 3); }

struct Unit { int pm, pn; };
struct Gemm { const bf16_t* A; const bf16_t* Bt; int M, N, K, lda; };

struct StaticOrder {
    int nM, nN, nwg, G, c;
    __host__ __device__ void init(int M, int N, int G_, int c_) { nM = M / BM; nN = N / BM; nwg = nM * nN; G = G_; c = c_; }
    __host__ __device__ bool next(int i, Unit& u) const {
        const long L = (long)i * G + c; if (L >= nwg) return false;
        int wgid = (int)L; { const int q = nwg / NXCD, r = nwg % NXCD, xcd = wgid % NXCD, off = wgid / NXCD; wgid = (xcd < r ? xcd * (q + 1) : r * (q + 1) + (xcd - r) * q) + off; }
        const int nig = WGM * nN, gid = wgid / nig, fm = gid * WGM, gsz = (nM - fm) < WGM ? (nM - fm) : WGM;
        u.pm = fm + ((wgid % nig) % gsz); u.pn = (wgid % nig) / gsz; return true;
    }
    __device__ __forceinline__ void a_ready(const Unit&) const {}
    __device__ __forceinline__ void done(const Unit&) const {}
};

struct ListOrder {
    int nN, n, L0, L1;
    __host__ __device__ bool next(int i, Unit& u) const { if (i >= n) return false; const int L = i == 0 ? L0 : L1; u.pm = L / nN; u.pn = L % nN; return true; }
    __device__ __forceinline__ void a_ready(const Unit&) const {}
    __device__ __forceinline__ void done(const Unit&) const {}
};
__device__ __forceinline__ unsigned cvt_pk_bf16(float lo, float hi) { unsigned r; asm volatile("v_cvt_pk_bf16_f32 %0, %1, %2" : "=v"(r) : "v"(lo), "v"(hi)); return r; }
typedef float f32x2 __attribute__((ext_vector_type(2)));
__device__ __forceinline__ u32x4 pack8(const f32x4 v0, const f32x4 v1) { u32x4 w; w.x = cvt_pk_bf16(v0[0], v0[1]); w.y = cvt_pk_bf16(v0[2], v0[3]); w.z = cvt_pk_bf16(v1[0], v1[1]); w.w = cvt_pk_bf16(v1[2], v1[3]); return w; }
struct EpiStore {
    static constexpr bool PERM = true, AFTER_DRAIN = false;
    bf16_t* O; int ldc;
    __device__ __forceinline__ void operator()(const f32x4 (&acc)[2][2][4][2], const Unit& u, int wr, int wc, int fr, int fq) const {
        const int row0 = u.pm * BM + wr * 64 + fr, col0 = u.pn * BM + wc * 32 + 8 * fq;
#pragma unroll
        for (int ai = 0; ai < 2; ++ai)
#pragma unroll
            for (int m = 0; m < 4; ++m) { bf16_t* rowp = O + (size_t)(row0 + ai * HALF + m * 16) * ldc + col0;
#pragma unroll
                for (int bj = 0; bj < 2; ++bj) *(u32x4*)(rowp + bj * HALF) = pack8(acc[ai][bj][m][0], acc[ai][bj][m][1]); }
    }
};
struct EpiProj {
    static constexpr bool PERM = true, AFTER_DRAIN = false;
    bf16_t* O; int ldc; float* ssq; const float* rope; bf16_t* Kb; int ldk;
    __device__ __forceinline__ void operator()(const f32x4 (&acc)[2][2][4][2], const Unit& u, int wr, int wc, int fr, int fq) const {
        const int row0 = u.pm * BM + wr * 64 + fr, col0 = u.pn * BM + wc * 32 + 8 * fq;
#pragma unroll
        for (int ai = 0; ai < 2; ++ai)
#pragma unroll
            for (int m = 0; m < 4; ++m) { const int row = row0 + ai * HALF + m * 16; bf16_t* rowp = O + (size_t)row * ldc + col0; float sq = 0.f;
#pragma unroll
                for (int bj = 0; bj < 2; ++bj) { const u32x4 w = pack8(acc[ai][bj][m][0], acc[ai][bj][m][1]); *(u32x4*)(rowp + bj * HALF) = w;
#pragma unroll
                    for (int e = 0; e < 4; ++e) { const float lo = __uint_as_float(w[e] << 16), hi = __uint_as_float(w[e] & 0xffff0000u); sq += lo * lo + hi * hi; } }
                if (u.pn >= 6 && u.pn <= 8) { sq += __shfl_xor(sq, 16); sq += __shfl_xor(sq, 32); if (fq == 0) ssq[((size_t)row * 3 + (u.pn - 6)) * 4 + wc] = sq; }
                if (u.pn == 9 && wc < 2) { const int ib = wc * 16 + 4 * fq; const f32x4 v0 = acc[ai][0][m][0], v1 = acc[ai][0][m][1];
                    const f32x4 c = *(const f32x4*)(rope + (size_t)row * 64 + ib), sn = *(const f32x4*)(rope + (size_t)row * 64 + 32 + ib);
                    f32x4 a, b;
                    a[0] = v0[0] * c[0] - v0[1] * sn[0]; a[1] = v0[1] * c[0] + v0[0] * sn[0];
                    a[2] = v0[2] * c[1] - v0[3] * sn[1]; a[3] = v0[3] * c[1] + v0[2] * sn[1];
                    b[0] = v1[0] * c[2] - v1[1] * sn[2]; b[1] = v1[1] * c[2] + v1[0] * sn[2];
                    b[2] = v1[2] * c[3] - v1[3] * sn[3]; b[3] = v1[3] * c[3] + v1[2] * sn[3];
                    const u32x4 w = pack8(a, b);
#pragma unroll
                    for (int h = 0; h < 6; ++h) *(u32x4*)(Kb + (size_t)row * ldk + 192 * h + 128 + wc * 32 + 8 * fq) = w; }
                if (m & 1) asm volatile("" ::: "memory"); }
    }
};
struct EpiQ {
    static constexpr bool PERM = true, AFTER_DRAIN = false;
    bf16_t* O; int ldc; const float* ssq; const float* rope;
    __device__ __forceinline__ void operator()(const f32x4 (&acc)[2][2][4][2], const Unit& u, int wr, int wc, int fr, int fq) const {
        const int row0 = u.pm * BM + wr * 64 + fr;
        float sc[2][4];
        { f32x4 q0[2][4], q1[2][4];
#pragma unroll
          for (int ai = 0; ai < 2; ++ai)
#pragma unroll
            for (int m = 0; m < 4; ++m) { const float* p = ssq + (size_t)(row0 + ai * HALF + m * 16) * 12; q0[ai][m] = *(const f32x4*)p; q1[ai][m] = *(const f32x4*)(p + 4); }
#pragma unroll
          for (int ai = 0; ai < 2; ++ai)
#pragma unroll
            for (int m = 0; m < 4; ++m) { const f32x4 a = q0[ai][m], b = q1[ai][m];
                sc[ai][m] = 1.0f / sqrtf((((a[0] + a[1]) + (a[2] + a[3])) + ((b[0] + b[1]) + (b[2] + b[3]))) * (1.0f / 512.0f) + 1e-6f); } }
#pragma unroll
        for (int ai = 0; ai < 2; ++ai)
#pragma unroll
            for (int m = 0; m < 4; ++m) { const int row = row0 + ai * HALF + m * 16; const float s = sc[ai][m];
#pragma unroll
                for (int bj = 0; bj < 2; ++bj) {
                    const int cb = u.pn * BM + bj * HALF + wc * 32, hc = cb % 192;
                    f32x4 v0 = acc[ai][bj][m][0] * s, v1 = acc[ai][bj][m][1] * s;
                    if (hc >= 128) {
                        const int ib = (hc - 128) / 2 + 4 * fq;
                        const f32x4 c = *(const f32x4*)(rope + (size_t)row * 64 + ib), sn = *(const f32x4*)(rope + (size_t)row * 64 + 32 + ib);
                        f32x4 a, b;
                        a[0] = v0[0] * c[0] - v0[1] * sn[0]; a[1] = v0[1] * c[0] + v0[0] * sn[0];
                        a[2] = v0[2] * c[1] - v0[3] * sn[1]; a[3] = v0[3] * c[1] + v0[2] * sn[1];
                        b[0] = v1[0] * c[2] - v1[1] * sn[2]; b[1] = v1[1] * c[2] + v1[0] * sn[2];
                        b[2] = v1[2] * c[3] - v1[3] * sn[3]; b[3] = v1[3] * c[3] + v1[2] * sn[3];
                        v0 = a; v1 = b;
                    }
                    *(u32x4*)(O + (size_t)row * ldc + cb + 8 * fq) = pack8(v0, v1);
                }
                if (m == 3) asm volatile("" ::: "memory"); }
    }
};
struct EpiKV {
    static constexpr bool PERM = true, AFTER_DRAIN = false;
    bf16_t* Kb; int ldk; bf16_t* Vb; int ldv; const float* ssq;
    __device__ __forceinline__ void operator()(const f32x4 (&acc)[2][2][4][2], const Unit& u, int wr, int wc, int fr, int fq) const {
        const int row0 = u.pm * BM + wr * 64 + fr, cin = wc * 32 + 8 * fq;
        f32x4 q2[2][4];
#pragma unroll
        for (int ai = 0; ai < 2; ++ai)
#pragma unroll
            for (int m = 0; m < 4; ++m) q2[ai][m] = *(const f32x4*)(ssq + (size_t)(row0 + ai * HALF + m * 16) * 12 + 8);
#pragma unroll
        for (int ai = 0; ai < 2; ++ai)
#pragma unroll
            for (int m = 0; m < 4; ++m) { const int row = row0 + ai * HALF + m * 16; const f32x4 a = q2[ai][m];
                const float s = 1.0f / sqrtf(((a[0] + a[1]) + (a[2] + a[3])) * (1.0f / 256.0f) + 1e-6f);
                *(u32x4*)(Kb + (size_t)row * ldk + 192 * u.pn + cin) = pack8(acc[ai][0][m][0] * s, acc[ai][0][m][1] * s);
                *(u32x4*)(Vb + (size_t)row * ldv + 128 * u.pn + cin) = pack8(acc[ai][1][m][0] * s, acc[ai][1][m][1] * s); }
    }
};
struct EpiRes {
    static constexpr bool PERM = false, AFTER_DRAIN = false;
    const float* xres; float* z; const float* gate; float alpha; int ldc;
    __device__ __forceinline__ void operator()(const f32x4 (&acc)[2][2][4][2], const Unit& u, int wr, int wc, int fr, int fq) const {
        const int row0 = u.pm * BM + wr * 64 + fr, col0 = u.pn * BM + wc * 32 + 4 * fq;
        f32x4 gv[2][2];
#pragma unroll
        for (int bj = 0; bj < 2; ++bj)
#pragma unroll
            for (int n = 0; n < 2; ++n) gv[bj][n] = *(const f32x4*)(gate + col0 + bj * HALF + n * 16) + 1.0f;
#pragma unroll
        for (int ai = 0; ai < 2; ++ai)
#pragma unroll
            for (int m = 0; m < 4; ++m) { const size_t off = (size_t)(row0 + ai * HALF + m * 16) * ldc + col0;
#pragma unroll
                for (int bj = 0; bj < 2; ++bj)
#pragma unroll
                    for (int n = 0; n < 2; ++n) { const f32x4 xr = *(const f32x4*)(xres + off + bj * HALF + n * 16);
                        *(f32x4*)(z + off + bj * HALF + n * 16) = xr * alpha + gv[bj][n] * acc[ai][bj][m][n]; }
                if (m == 3) asm volatile("" ::: "memory"); }
    }
};
struct EpiSwiglu {
    static constexpr bool PERM = true, AFTER_DRAIN = false;
    bf16_t* H; int ldc;
    __device__ __forceinline__ void operator()(const f32x4 (&acc)[2][2][4][2], const Unit& u, int wr, int wc, int fr, int fq) const {
        const int row0 = u.pm * BM + wr * 64 + fr, col0 = u.pn * HALF + wc * 32 + 8 * fq;
#pragma unroll
        for (int ai = 0; ai < 2; ++ai)
#pragma unroll
            for (int m = 0; m < 4; ++m) { f32x4 h[2];
#pragma unroll
                for (int n = 0; n < 2; ++n) { const f32x4 g = acc[ai][0][m][n], up = acc[ai][1][m][n];
#pragma unroll
                    for (int j = 0; j < 4; ++j) h[n][j] = g[j] * __builtin_amdgcn_rcpf(1.0f + __builtin_amdgcn_exp2f(-1.4426950408889634f * g[j])) * up[j]; }
                *(u32x4*)(H + (size_t)(row0 + ai * HALF + m * 16) * ldc + col0) = pack8(h[0], h[1]); }
    }
};
template <class Epi, class Sched, bool ALIGN_EPI = false, bool SP2 = false>
__device__ __forceinline__ void gemm_phase(PG8_LAS unsigned char* lds, const Gemm g, const Sched& S, const Epi& E) {
    int tid_ = threadIdx.x; asm volatile("" : "+v"(tid_)); const int tid = tid_, wid = __builtin_amdgcn_readfirstlane(tid >> 6), lane = tid & 63, wr = wid >> 2, wc = wid & 3, fr = lane & 15, fq = lane >> 4;
    int Kv_ = g.K, lda_ = g.lda; asm volatile("" : "+s"(Kv_), "+s"(lda_)); const int K = Kv_, nt = K / BK;
    unsigned voffA[2], voffB[2];
#pragma unroll
    for (int i = 0; i < 2; ++i) { int R, C; stage_rc(tid * 16 + i * 8192, R, C); const int Rb = Epi::PERM ? ((R & ~31) + perm32(R & 31)) : R;
        voffA[i] = (unsigned)(R * lda_ + C) * 2u; voffB[i] = (unsigned)(Rb * K + C) * 2u; }
    const size_t kstep = (size_t)(BK * 2);
    const size_t hstepA = (size_t)HALF * lda_ * 2, hstepB = (size_t)HALF * K * 2;
    const size_t tstepA = 2 * hstepA, tstepB = 2 * hstepB;
    const unsigned ldsw = (unsigned)wid * 1024u;
    const int aoff = lds_byte(wr * 64 + fr, fq * 8), boff = lds_byte(wc * 32 + fr, fq * 8);
#define PG8_SA(b, h) (((b) * 2 + (h)) * HTB)
#define PG8_SB(b, h) ((4 + (b) * 2 + (h)) * HTB)
#define PG8_STAGE(bufoff, gbase, voff) do { _Pragma("unroll") for (int _i = 0; _i < 2; ++_i) \
        __builtin_amdgcn_global_load_lds((const unsigned*)((const char*)(gbase) + (voff)[_i]), (PG8_LAS unsigned*)(lds + (bufoff) + ldsw + _i * 8192), 16, 0, 0); } while (0)
#define PG8_LDA(dst, b, h) do { _Pragma("unroll") for (int m = 0; m < 4; ++m) _Pragma("unroll") for (int k = 0; k < 2; ++k) dst[m][k] = *(const PG8_LAS bf16x8*)(lds + PG8_SA(b, h) + aoff + m * 2048 + k * 1024); } while (0)
#define PG8_LDB(dst, b, h) do { _Pragma("unroll") for (int n = 0; n < 2; ++n) _Pragma("unroll") for (int k = 0; k < 2; ++k) dst[n][k] = *(const PG8_LAS bf16x8*)(lds + PG8_SB(b, h) + boff + n * 2048 + k * 1024); } while (0)
#define PG8_MMA(ai, bj, At, Bt) do { __builtin_amdgcn_s_setprio(1); _Pragma("unroll") for (int m = 0; m < 4; ++m) _Pragma("unroll") for (int n = 0; n < 2; ++n) _Pragma("unroll") for (int k = 0; k < 2; ++k) \
        acc[ai][bj][m][n] = __builtin_amdgcn_mfma_f32_16x16x32_bf16(Bt[n][k], At[m][k], acc[ai][bj][m][n], 0, 0, 0); __builtin_amdgcn_s_setprio(0); } while (0)
#define PG8_WAIT_V(n) asm volatile("s_waitcnt vmcnt(" #n ")" ::: "memory")
#define PG8_WAIT_L(n) asm volatile("s_waitcnt lgkmcnt(" #n ")" ::: "memory")
#define PG8_BAR __builtin_amdgcn_s_barrier()
#define PG8_SCHED __builtin_amdgcn_sched_barrier(0)
    Unit cur, nxt; int ui = 0;
    if (!S.next(0, cur)) return;
    f32x4 acc[2][2][4][2];
#pragma unroll
    for (int a = 0; a < 2; ++a)
#pragma unroll
        for (int b = 0; b < 2; ++b)
#pragma unroll
            for (int m = 0; m < 4; ++m)
#pragma unroll
                for (int n = 0; n < 2; ++n) acc[a][b][m][n] = (f32x4){0.f, 0.f, 0.f, 0.f};
    bf16x8 At[4][2], B0[2][2], B1[2][2];
    const char* cA = (const char*)g.A + (size_t)cur.pm * tstepA; const char* cB = (const char*)g.Bt + (size_t)cur.pn * tstepB;
    S.a_ready(cur);
    if constexpr (SP2) {
        PG8_STAGE(PG8_SB(0, 0), cB, voffB); PG8_STAGE(PG8_SB(0, 1), cB + hstepB, voffB); PG8_STAGE(PG8_SA(0, 0), cA, voffA); PG8_STAGE(PG8_SA(0, 1), cA + hstepA, voffA);
        if (wr == 1) PG8_BAR;
        PG8_WAIT_V(2); PG8_BAR;
        PG8_STAGE(PG8_SB(1, 0), cB + kstep, voffB); PG8_STAGE(PG8_SA(1, 0), cA + kstep, voffA); PG8_STAGE(PG8_SB(1, 1), cB + hstepB + kstep, voffB);
        PG8_WAIT_V(6); PG8_BAR;
    } else {
        PG8_STAGE(PG8_SB(0, 0), cB, voffB); PG8_STAGE(PG8_SA(0, 0), cA, voffA); PG8_STAGE(PG8_SB(0, 1), cB + hstepB, voffB); PG8_STAGE(PG8_SA(0, 1), cA + hstepA, voffA);
        if (wr == 1) PG8_BAR;
        PG8_WAIT_V(4); PG8_BAR;
        PG8_STAGE(PG8_SB(1, 0), cB + kstep, voffB); PG8_STAGE(PG8_SA(1, 0), cA + kstep, voffA); PG8_STAGE(PG8_SB(1, 1), cB + hstepB + kstep, voffB);
        PG8_WAIT_V(6); PG8_BAR;
    }
    for (;;) {
        const bool has_next = S.next(ui + 1, nxt);
        const char* nA = has_next ? (const char*)g.A + (size_t)nxt.pm * tstepA : cA; const char* nB = has_next ? (const char*)g.Bt + (size_t)nxt.pn * tstepB : cB;
        for (int t = 0; t < nt; t += 2) {
            const bool last = (t == nt - 2);
            const char* a1 = cA + (size_t)(t + 1) * kstep;
            const char* a2 = last ? nA : cA + (size_t)(t + 2) * kstep; const char* b2 = last ? nB : cB + (size_t)(t + 2) * kstep;
            const char* a3 = a2 + kstep; const char* b3 = b2 + kstep;
            if (last && has_next) S.a_ready(nxt);
            if constexpr (SP2) {
            PG8_LDB(B0, 0, 0); PG8_LDB(B1, 0, 1); PG8_SCHED; PG8_LDA(At, 0, 0); PG8_STAGE(PG8_SA(1, 1), a1 + hstepA, voffA);
            PG8_WAIT_V(8); PG8_WAIT_L(0); PG8_BAR; PG8_MMA(0, 0, At, B0); PG8_MMA(0, 1, At, B1); PG8_BAR; PG8_SCHED;
            PG8_LDA(At, 0, 1); PG8_STAGE(PG8_SB(0, 0), b2, voffB); PG8_STAGE(PG8_SB(0, 1), b2 + hstepB, voffB); PG8_STAGE(PG8_SA(0, 0), a2, voffA);
            PG8_WAIT_V(8); PG8_WAIT_L(0); PG8_BAR; PG8_MMA(1, 0, At, B0); PG8_MMA(1, 1, At, B1); PG8_BAR; PG8_SCHED;
            PG8_LDB(B0, 1, 0); PG8_LDB(B1, 1, 1); PG8_SCHED; PG8_LDA(At, 1, 0); PG8_STAGE(PG8_SA(0, 1), a2 + hstepA, voffA);
            PG8_WAIT_V(8); PG8_WAIT_L(0); PG8_BAR; PG8_MMA(0, 0, At, B0); PG8_MMA(0, 1, At, B1); PG8_BAR; PG8_SCHED;
            PG8_LDA(At, 1, 1); PG8_STAGE(PG8_SB(1, 0), b3, voffB); PG8_STAGE(PG8_SB(1, 1), b3 + hstepB, voffB); PG8_STAGE(PG8_SA(1, 0), a3, voffA);
            PG8_WAIT_V(8); PG8_WAIT_L(0); PG8_BAR; PG8_MMA(1, 0, At, B0); PG8_MMA(1, 1, At, B1); PG8_BAR; PG8_SCHED;
            } else {
            PG8_LDB(B0, 0, 0); PG8_SCHED; PG8_LDA(At, 0, 0); PG8_STAGE(PG8_SA(1, 1), a1 + hstepA, voffA);
            PG8_WAIT_L(8); PG8_BAR; PG8_WAIT_L(0); PG8_MMA(0, 0, At, B0); PG8_BAR; PG8_SCHED;
            PG8_LDB(B1, 0, 1); PG8_STAGE(PG8_SB(0, 0), b2, voffB);
            PG8_BAR; PG8_WAIT_L(0); PG8_MMA(0, 1, At, B1); PG8_BAR;
            PG8_LDA(At, 0, 1); PG8_STAGE(PG8_SA(0, 0), a2, voffA);
            PG8_BAR; PG8_WAIT_L(0); PG8_MMA(1, 0, At, B0); PG8_BAR; PG8_SCHED;
            PG8_STAGE(PG8_SB(0, 1), b2 + hstepB, voffB);
            PG8_WAIT_V(6); PG8_BAR; PG8_MMA(1, 1, At, B1); PG8_BAR;
            PG8_LDB(B0, 1, 0); PG8_SCHED; PG8_LDA(At, 1, 0); PG8_STAGE(PG8_SA(0, 1), a2 + hstepA, voffA);
            PG8_WAIT_L(8); PG8_BAR; PG8_WAIT_L(0); PG8_MMA(0, 0, At, B0); PG8_BAR; PG8_SCHED;
            PG8_LDB(B1, 1, 1); PG8_STAGE(PG8_SB(1, 0), b3, voffB);
            PG8_BAR; PG8_WAIT_L(0); PG8_MMA(0, 1, At, B1); PG8_BAR;
            PG8_LDA(At, 1, 1); PG8_STAGE(PG8_SA(1, 0), a3, voffA);
            PG8_BAR; PG8_WAIT_L(0); PG8_MMA(1, 0, At, B0); PG8_BAR; PG8_SCHED;
            PG8_STAGE(PG8_SB(1, 1), b3 + hstepB, voffB);
            PG8_WAIT_V(6); PG8_BAR; PG8_MMA(1, 1, At, B1); PG8_BAR;
            }
        }
        if constexpr (ALIGN_EPI) { if (wr == 0) PG8_BAR; }
        if constexpr (!Epi::AFTER_DRAIN) { E(acc, cur, wr, wc, fr, fq); S.done(cur); }
        if (!has_next) break;
#pragma unroll
        for (int a = 0; a < 2; ++a)
#pragma unroll
            for (int b = 0; b < 2; ++b)
#pragma unroll
                for (int m = 0; m < 4; ++m)
#pragma unroll
                    for (int n = 0; n < 2; ++n) acc[a][b][m][n] = (f32x4){0.f, 0.f, 0.f, 0.f};
        cur = nxt; cA = nA; cB = nB; ++ui;
        if constexpr (ALIGN_EPI) { if (wr == 1) PG8_BAR; }
    }
    PG8_WAIT_V(0);
    if constexpr (!ALIGN_EPI) { if (wr == 0) PG8_BAR; }
    PG8_BAR;
    if constexpr (Epi::AFTER_DRAIN) { E.fused(acc, cur, wr, wc, fr, fq, lds, wid, lane); S.done(cur); }
#undef PG8_SA
#undef PG8_SB
#undef PG8_STAGE
#undef PG8_LDA
#undef PG8_LDB
#undef PG8_MMA
#undef PG8_WAIT_V
#undef PG8_WAIT_L
#undef PG8_BAR
#undef PG8_SCHED
}
}

#define LAS __attribute__((address_space(3)))
typedef unsigned short bf16_t;
typedef float f32x4 __attribute__((ext_vector_type(4)));
typedef unsigned u32x4 __attribute__((ext_vector_type(4)));
typedef unsigned u32x2 __attribute__((ext_vector_type(2)));
constexpr int S = 8192, DM = 2048, DEPTH = 2, DIN = 3648, DINP = 3840, DFF = 5632;
constexpr int QLD = 1280, KLD = 1152, VLD = 768;
constexpr int C_QA = 0, C_KA = 512, C_VA = 1024, C_CQ = 1536, C_CKV = 2048, C_KR = 2304, C_QC = 2368, C_KC = 3136, C_VC = 3392;
constexpr float ALPHA = 1.4142135623730951f;
constexpr size_t al256(size_t x) { return (x + 255) / 256 * 256; }
constexpr size_t SZ_WIN = (size_t)DINP * DM * 2, SZ_WUQ = (size_t)1280 * 512 * 2, SZ_WUKV = (size_t)1536 * 256 * 2, SZ_WO = (size_t)DM * DM * 2, SZ_WGU = (size_t)2 * DFF * DM * 2, SZ_WDN = (size_t)DM * DFF * 2;
constexpr size_t O_WIN = 0, O_WUQ = O_WIN + SZ_WIN, O_WUKV = O_WUQ + SZ_WUQ, O_WO = O_WUKV + SZ_WUKV, O_WGU = O_WO + SZ_WO, O_WDN = O_WGU + SZ_WGU, SZ_WL = O_WDN + SZ_WDN;
constexpr size_t WS_W = 0;
constexpr size_t WS_MOD = al256(WS_W + DEPTH * SZ_WL);
constexpr size_t WS_ROPE = al256(WS_MOD + (size_t)DEPTH * 6 * DM * 4);
constexpr size_t WS_RSQ = al256(WS_ROPE + (size_t)S * 64 * 4);
constexpr size_t WS_RSKV = al256(WS_RSQ + (size_t)S * 4);
constexpr size_t WS_X = al256(WS_RSKV + (size_t)S * 4);
constexpr size_t WS_U = al256(WS_X + (size_t)S * DM * 4);
constexpr size_t WS_PROJ = al256(WS_U + (size_t)S * DM * 2);
constexpr size_t WS_Q = al256(WS_PROJ + (size_t)S * DINP * 2);
constexpr size_t WS_K = al256(WS_Q + (size_t)S * QLD * 2);
constexpr size_t WS_V = al256(WS_K + (size_t)S * KLD * 2);
constexpr size_t WS_Y = al256(WS_V + (size_t)S * VLD * 2);
constexpr size_t WS_H = al256(WS_Y + (size_t)S * DM * 2);
constexpr size_t WS_PART = al256(WS_H + (size_t)S * DFF * 2);
constexpr size_t WS_STAT = al256(WS_PART + (size_t)4 * S * VLD * 2);
constexpr size_t WS_SSQ = al256(WS_STAT + (size_t)4 * 6 * S * 2 * 4);
constexpr size_t WS_BAR0_ = WS_SSQ + (size_t)S * 12 * 4;
constexpr size_t WS_BAR = al256(WS_BAR0_);
constexpr size_t WS_END = al256(WS_BAR + 16384);
constexpr int TAB_OFF = pg8::STAGE_BYTES, LDS_BYTES = pg8::STAGE_BYTES + 256;
constexpr int NTHREADS = 512;

struct Args { const float* in[19]; float* out; unsigned char* ws; int ph_lo, ph_hi; };
struct Tab {
    const LAS unsigned* t;
    __device__ __forceinline__ unsigned long long ld(int i) const { const unsigned lo = __builtin_amdgcn_readfirstlane(t[2 * i]), hi = __builtin_amdgcn_readfirstlane(t[2 * i + 1]); return ((unsigned long long)hi << 32) | lo; }
    __device__ __forceinline__ const float* in(int i) const { return (const float*)ld(i); }
    __device__ __forceinline__ float* out() const { return (float*)ld(19); }
    __device__ __forceinline__ unsigned char* wsp() const { return (unsigned char*)ld(20); }
};

__device__ __forceinline__ float bf2f(unsigned short b) { return __uint_as_float((unsigned)b << 16); }
__device__ __forceinline__ float wave_sum(float v) {
#pragma unroll
    for (int o = 32; o; o >>= 1) v += __shfl_xor(v, o);
    return v; }
using pg8::cvt_pk_bf16;
__device__ __forceinline__ int otid() { int t = threadIdx.x; asm volatile("" : "+v"(t)); return t; }

__device__ __forceinline__ void phase_mod(const Tab tb, unsigned char* lds_g) {
    unsigned char* ws_ = tb.wsp(); const float* in1 = tb.in(1); const float* in2 = tb.in(2); const float* in3 = tb.in(3);
    float* condL = (float*)lds_g; f32x4* red = (f32x4*)(lds_g + 8192);
    const int tid = otid();
    const float* c = in1;
    for (int i = tid; i < DM; i += NTHREADS) { const float v = c[i]; condL[i] = v / (1.0f + __expf(-v)); }
    __syncthreads();
    float* mod = (float*)(ws_ + WS_MOD);
    const int cl = tid & 31, kg = tid >> 5;
    for (int item = blockIdx.x; item < DEPTH * 96; item += gridDim.x) {
        const int l = item / 96, cgp = item % 96;
        const float* W = in2 + (size_t)l * DM * 6 * DM + (size_t)(kg * 128) * (6 * DM) + cgp * 128 + 4 * cl;
        f32x4 acc = {0.f, 0.f, 0.f, 0.f};
#pragma unroll 8
        for (int kk = 0; kk < 128; ++kk) { const f32x4 w = __builtin_nontemporal_load((const f32x4*)(W + (size_t)kk * (6 * DM))); acc += w * condL[kg * 128 + kk]; }
        red[kg * 32 + cl] = acc;
        __syncthreads();
        if (tid < 128) { float s = 0.f; const float* rf = (const float*)red;
            for (int g = 0; g < 16; ++g) s += rf[g * 128 + tid];
            mod[l * 6 * DM + cgp * 128 + tid] = s + in3[l * 6 * DM + cgp * 128 + tid]; }
        __syncthreads();
    }
}

template <int PERMT>
__device__ __forceinline__ int dst_row(int n) {
    if (PERMT == 1) { const int h = n / 192, d = n % 192; if (d < 128) return n; const int j = d - 128; return h * 192 + 128 + 2 * (j & 31) + (j >> 5); }
    if (PERMT == 3) { if (n < C_KR || n >= C_KR + 64) return n; const int j = n - C_KR; return C_KR + 2 * (j & 31) + (j >> 5); }
    if (PERMT == 2) { if (n < DFF) return 256 * (n >> 7) + (n & 127); const int m = n - DFF; return 256 * (m >> 7) + 128 + (m & 127); }
    return n;
}
template <int PERMT>
__device__ __forceinline__ void transpose_job(const float* __restrict__ src, bf16_t* __restrict__ dst, int K, int N, int Npad, const float* __restrict__ kscale, unsigned char* lds_g, int first, int stride) {
    float* T = (float*)lds_g;
    const int tid = otid(), nkt = K / 64, nnt = (N + 255) / 256, ntiles = nkt * nnt;
    for (int t = first; t < ntiles; t += stride) {
        const int k0 = (t % nkt) * 64, n0 = (t / nkt) * 256;
        { const int kk = tid >> 6, n4 = tid & 63; const bool ok = n0 + 4 * n4 < N; f32x4 v[8];
#pragma unroll
          for (int i = 0; i < 8; ++i) { const int k = k0 + kk + 8 * i; v[i] = ok ? __builtin_nontemporal_load((const f32x4*)(src + (size_t)k * N + n0 + 4 * n4)) : (f32x4){0.f, 0.f, 0.f, 0.f}; }
#pragma unroll
          for (int i = 0; i < 8; ++i) { const int k = k0 + kk + 8 * i; if (kscale) v[i] = v[i] * kscale[k];
              float* tp = T + (kk + 8 * i) * 257 + 4 * n4; tp[0] = v[i][0]; tp[1] = v[i][1]; tp[2] = v[i][2]; tp[3] = v[i][3]; } }
        __syncthreads();
        { const int n = tid >> 1, ks = tid & 1;
          if (n0 + n < N) { bf16_t* dp = dst + (size_t)dst_row<PERMT>(n0 + n) * K + k0 + 32 * ks;
#pragma unroll
            for (int eb = 0; eb < 4; ++eb) { float v[8];
#pragma unroll
              for (int e = 0; e < 8; ++e) v[e] = T[(32 * ks + 8 * eb + e) * 257 + n];
              u32x4 w; w.x = cvt_pk_bf16(v[0], v[1]); w.y = cvt_pk_bf16(v[2], v[3]); w.z = cvt_pk_bf16(v[4], v[5]); w.w = cvt_pk_bf16(v[6], v[7]);
              *(u32x4*)(dp + 8 * eb) = w; } } }
        __syncthreads();
    }
    const size_t nz = (size_t)(Npad - N) * K / 8;
    for (size_t i = (size_t)blockIdx.x * NTHREADS + tid; i < nz; i += (size_t)gridDim.x * NTHREADS) *(u32x4*)(dst + (size_t)N * K + i * 8) = (u32x4){0u, 0u, 0u, 0u};
}

__device__ __forceinline__ void modulate_rows(const float* __restrict__ x, const float* __restrict__ sc, const float* __restrict__ sh, bf16_t* __restrict__ u) {
    const size_t n8 = (size_t)S * DM / 8;
    for (size_t i = (size_t)blockIdx.x * NTHREADS + otid(); i < n8; i += (size_t)gridDim.x * NTHREADS) {
        const int col = (int)((i * 8) % DM);
        const f32x4 x0 = *(const f32x4*)(x + i * 8), x1 = *(const f32x4*)(x + i * 8 + 4);
        const f32x4 s0 = *(const f32x4*)(sc + col) + 1.0f, s1 = *(const f32x4*)(sc + col + 4) + 1.0f;
        const f32x4 h0 = *(const f32x4*)(sh + col), h1 = *(const f32x4*)(sh + col + 4);
        *(u32x4*)(u + i * 8) = pg8::pack8(x0 * s0 + h0, x1 * s1 + h1);
    }
}

__device__ __forceinline__ void rope_table(float* __restrict__ rope) {
    for (int i = blockIdx.x * NTHREADS + otid(); i < S * 32; i += gridDim.x * NTHREADS) {
        const int pos = i >> 5, j = i & 31;
        const float inv = exp2f(-(float)j * (13.287712379549449f / 32.0f));
        const float ang = (float)pos * inv;
        const double rev = (double)ang * 0.15915494309189535;
        const double fr = rev - floor(rev);
        const float ar = (float)(fr * 6.283185307179586);
        rope[(size_t)pos * 64 + j] = cosf(ar); rope[(size_t)pos * 64 + 32 + j] = sinf(ar);
    }
}

__device__ __forceinline__ void phase_prep(unsigned char* ws_) {
    const bf16_t* proj = (const bf16_t*)(ws_ + WS_PROJ); const float* rope = (const float*)(ws_ + WS_ROPE);
    float* rsq = (float*)(ws_ + WS_RSQ); float* rskv = (float*)(ws_ + WS_RSKV); bf16_t* Kb = (bf16_t*)(ws_ + WS_K);
    const int tid_o = otid(), lane = tid_o & 63, wave = tid_o >> 6;
    for (int r = blockIdx.x * 8 + wave; r < S; r += gridDim.x * 8) {
        const bf16_t* pr = proj + (size_t)r * DINP;
        { const u32x4 w = *(const u32x4*)(pr + C_CQ + 8 * lane); float ss = 0.f;
#pragma unroll
          for (int e = 0; e < 4; ++e) { const float lo = __uint_as_float(w[e] << 16), hi = __uint_as_float(w[e] & 0xffff0000u); ss += lo * lo + hi * hi; }
          ss = wave_sum(ss); if (lane == 0) rsq[r] = 1.0f / sqrtf(ss * (1.0f / 512.0f) + 1e-6f); }
        { const u32x2 w = *(const u32x2*)(pr + C_CKV + 4 * lane); float ss = 0.f;
#pragma unroll
          for (int e = 0; e < 2; ++e) { const float lo = __uint_as_float(w[e] << 16), hi = __uint_as_float(w[e] & 0xffff0000u); ss += lo * lo + hi * hi; }
          ss = wave_sum(ss); if (lane == 0) rskv[r] = 1.0f / sqrtf(ss * (1.0f / 256.0f) + 1e-6f); }
        { const int i = lane & 31; const float x1 = bf2f(pr[C_KR + i]), x2 = bf2f(pr[C_KR + 32 + i]);
          const float c = rope[(size_t)r * 64 + i], sn = rope[(size_t)r * 64 + 32 + i];
          const unsigned w = cvt_pk_bf16(x1 * c - x2 * sn, x2 * c + x1 * sn);
          const int hb = (lane >> 5) * 3;
#pragma unroll
          for (int h = 0; h < 3; ++h) *(unsigned*)(Kb + (size_t)r * KLD + (hb + h) * 192 + 128 + 2 * i) = w; }
    }
}

__device__ __forceinline__ void phase_ynorm(unsigned char* ws_) {
    bf16_t* y = (bf16_t*)(ws_ + WS_Y); const bf16_t* part = (const bf16_t*)(ws_ + WS_PART); const float* stat = (const float*)(ws_ + WS_STAT);
    const int tid_o = otid(), lane = tid_o & 63, wave = tid_o >> 6;
    const bool lowhalf = lane < 32;
    for (int r = blockIdx.x * 8 + wave; r < S; r += gridDim.x * 8) {
        bf16_t* yr = y + (size_t)r * DM;
        float v[4][8]; float ss[4];
#pragma unroll
        for (int j = 0; j < 4; ++j) {
            const bool fromPart = (j == 1) || (j == 2 && lowhalf);
            if (!fromPart) { const u32x4 w = *(const u32x4*)(yr + j * 512 + 8 * lane);
#pragma unroll
                for (int e = 0; e < 4; ++e) { v[j][2 * e] = __uint_as_float(w[e] << 16); v[j][2 * e + 1] = __uint_as_float(w[e] & 0xffff0000u); } }
            else { const int yb = j * 512 + 8 * lane - 512, h = yb >> 7; float m[4], lw[4];
#pragma unroll
                for (int i = 0; i < 4; ++i) { const float* st = stat + ((size_t)(i * 6 + h) * S + r) * 2; m[i] = st[0]; lw[i] = st[1]; }
                const float M = fmaxf(fmaxf(m[0], m[1]), fmaxf(m[2], m[3])); float W = 0.f;
#pragma unroll
                for (int i = 0; i < 4; ++i) { lw[i] *= __builtin_amdgcn_exp2f(m[i] - M); W += lw[i]; }
                const float rW = 1.0f / W;
#pragma unroll
                for (int e = 0; e < 8; ++e) v[j][e] = 0.f;
#pragma unroll
                for (int i = 0; i < 4; ++i) { const u32x4 w = *(const u32x4*)(part + ((size_t)i * S + r) * VLD + yb); const float wi = lw[i] * rW;
#pragma unroll
                    for (int e = 0; e < 4; ++e) { v[j][2 * e] += wi * __uint_as_float(w[e] << 16); v[j][2 * e + 1] += wi * __uint_as_float(w[e] & 0xffff0000u); } } }
            float sq = 0.f;
#pragma unroll
            for (int e = 0; e < 8; ++e) sq += v[j][e] * v[j][e];
            ss[j] = sq;
        }
        const float sA = wave_sum(ss[0]);
        const float sB = wave_sum(ss[1] + (lowhalf ? ss[2] : 0.f));
        const float sC = wave_sum(ss[3] + (lowhalf ? 0.f : ss[2]));
        const float rA = 1.0f / sqrtf(sA * (1.0f / 512.0f) + 1e-6f), rB = 1.0f / sqrtf(sB * (1.0f / 768.0f) + 1e-6f), rC = 1.0f / sqrtf(sC * (1.0f / 768.0f) + 1e-6f);
#pragma unroll
        for (int j = 0; j < 4; ++j) { const float sc = j == 0 ? rA : (j == 1 ? rB : (j == 2 ? (lowhalf ? rB : rC) : rC)); u32x4 o;
#pragma unroll
            for (int e = 0; e < 4; ++e) o[e] = cvt_pk_bf16(v[j][2 * e] * sc, v[j][2 * e + 1] * sc);
            *(u32x4*)(yr + j * 512 + 8 * lane) = o; }
    }
}

__device__ __forceinline__ void phase_ln(const float* z, float* xo, const float* __restrict__ g, const float* __restrict__ b, const float* __restrict__ sc, const float* __restrict__ sh, bf16_t* __restrict__ u) {
    const int tid_o = otid(), lane = tid_o & 63, wave = tid_o >> 6;
    const int stride = gridDim.x * 8;
    for (int r = blockIdx.x * 8 + wave; r < S; r += 2 * stride) {
        const bool hasB = r + stride < S; const int rr[2] = {r, hasB ? r + stride : r};
        f32x4 v[2][8]; float s[2] = {0.f, 0.f};
#pragma unroll
        for (int k = 0; k < 2; ++k) { const float* zr = z + (size_t)rr[k] * DM;
#pragma unroll
            for (int j = 0; j < 8; ++j) v[k][j] = *(const f32x4*)(zr + j * 256 + 4 * lane); }
#pragma unroll
        for (int k = 0; k < 2; ++k)
#pragma unroll
            for (int j = 0; j < 8; ++j) s[k] += (v[k][j][0] + v[k][j][1]) + (v[k][j][2] + v[k][j][3]);
        float mean[2], rstd[2];
#pragma unroll
        for (int k = 0; k < 2; ++k) { mean[k] = wave_sum(s[k]) * (1.0f / DM); float q = 0.f;
#pragma unroll
            for (int j = 0; j < 8; ++j) { const f32x4 d = v[k][j] - mean[k]; q += (d[0] * d[0] + d[1] * d[1]) + (d[2] * d[2] + d[3] * d[3]); }
            rstd[k] = 1.0f / sqrtf(wave_sum(q) * (1.0f / DM) + 1e-5f); }
#pragma unroll
        for (int j = 0; j < 8; ++j) { const int col = j * 256 + 4 * lane;
            const f32x4 gg = *(const f32x4*)(g + col), bb = *(const f32x4*)(b + col);
            f32x4 s1 = {0.f, 0.f, 0.f, 0.f}, h1 = {0.f, 0.f, 0.f, 0.f};
            if (u) { s1 = *(const f32x4*)(sc + col) + 1.0f; h1 = *(const f32x4*)(sh + col); }
#pragma unroll
            for (int k = 0; k < 2; ++k) { if (k == 1 && !hasB) continue;
                const f32x4 o = (v[k][j] - mean[k]) * rstd[k] * gg + bb;
                *(f32x4*)(xo + (size_t)rr[k] * DM + col) = o;
                if (u) { const f32x4 m = o * s1 + h1; u32x2 w; w.x = cvt_pk_bf16(m[0], m[1]); w.y = cvt_pk_bf16(m[2], m[3]); *(u32x2*)(u + (size_t)rr[k] * DM + col) = w; } } }
    }
}

template <int MODE>
__device__ __forceinline__ void naive_attn(unsigned char* ws_, const float* rpb, const float* sink, int l) {
    constexpr int DQK = MODE == 1 ? 192 : 128, NJ = DQK / 64, H = MODE == 0 ? 4 : 6;
    const bf16_t* proj = (const bf16_t*)(ws_ + WS_PROJ); bf16_t* y = (bf16_t*)(ws_ + WS_Y);
    const int tid_o = otid(), lane = tid_o & 63, wave = tid_o >> 6;
    for (int it = blockIdx.x * 8 + wave; it < S * H; it += gridDim.x * 8) {
        const int h = it / S, q = it % S;
        const bf16_t *Qp, *Kp, *Vp; int ldk, ldv, ycol; float scale;
        if (MODE == 0) { Qp = proj + (size_t)q * DINP + C_QA + 128 * h; Kp = proj + C_KA + 128 * h; Vp = proj + C_VA + 128 * h; ldk = DINP; ldv = DINP; ycol = 128 * h; scale = 0.08838834764831845f; }
        else if (MODE == 1) { Qp = (const bf16_t*)(ws_ + WS_Q) + (size_t)q * QLD + 192 * h; Kp = (const bf16_t*)(ws_ + WS_K) + 192 * h; Vp = (const bf16_t*)(ws_ + WS_V) + 128 * h; ldk = KLD; ldv = VLD; ycol = 512 + 128 * h; scale = 0.07216878364870322f; }
        else { Qp = proj + (size_t)q * DINP + C_QC + 128 * h; Kp = proj + C_KC + 128 * (h / 3); Vp = proj + C_VC + 128 * (h / 3); ldk = DINP; ldv = DINP; ycol = 1280 + 128 * h; scale = 0.08838834764831845f; }
        float qv[NJ];
#pragma unroll
        for (int j = 0; j < NJ; ++j) qv[j] = bf2f(Qp[64 * j + lane]) * scale;
        float m = -1e30f, ls = 0.f, o0 = 0.f, o1 = 0.f; int nkeys, klo = 0, r = 0, col = 0, r0 = 0, c0 = 0; float slope = 0.f;
        if (MODE == 0) { r = q >> 6; col = q & 63; r0 = min(max(r - 4, 0), 120); c0 = min(max(col - 8, 0), 48); nkeys = 128; }
        else if (MODE == 1) nkeys = S;
        else { klo = max(0, q - 128); nkeys = min(S - 1, q + 128) - klo + 1; m = sink[l * 6 + h]; ls = 1.f; slope = exp2f(-8.0f * (float)(h + 1) / 6.0f); }
        for (int kk = 0; kk < nkeys; ++kk) {
            int key; float bias = 0.f;
            if (MODE == 0) { const int krow = r0 + (kk >> 4), kcol = c0 + (kk & 15); key = krow * 64 + kcol; bias = rpb[((l * 4 + h) * 15 + (krow - r + 7)) * 31 + (kcol - col + 15)]; }
            else if (MODE == 1) key = kk;
            else { key = klo + kk; bias = -slope * fabsf((float)(q - key)); }
            float part = 0.f;
#pragma unroll
            for (int j = 0; j < NJ; ++j) part += qv[j] * bf2f(Kp[(size_t)key * ldk + 64 * j + lane]);
            const float s = wave_sum(part) + bias;
            const float mn = fmaxf(m, s), al = __expf(m - mn), p = __expf(s - mn);
            ls = ls * al + p;
            o0 = o0 * al + p * bf2f(Vp[(size_t)key * ldv + lane]); o1 = o1 * al + p * bf2f(Vp[(size_t)key * ldv + 64 + lane]);
            m = mn;
        }
        const float inv = 1.0f / ls;
        y[(size_t)q * DM + ycol + lane] = (bf16_t)(cvt_pk_bf16(o0 * inv, 0.f) & 0xffffu);
        y[(size_t)q * DM + ycol + 64 + lane] = (bf16_t)(cvt_pk_bf16(o1 * inv, 0.f) & 0xffffu);
    }
}

#define XB_TMO      128
#define XB_XCNT(j)  (256  + 64 * (j))
#define XB_XSUB(j)  (1280 + 64 * (j))
#define XB_XGEN(j)  (2304 + 64 * (j))
#define XB_TOP      3328
#define XB_TOPGEN   3392
#define XCD_BAR_WORDS 3456
#define XB_SPIN_CAP (1u << 18)

__device__ __forceinline__ unsigned xb_ld(unsigned* p)              { return __hip_atomic_load(p, __ATOMIC_RELAXED, __HIP_MEMORY_SCOPE_AGENT); }
__device__ __forceinline__ unsigned xb_add(unsigned* p, unsigned v) { return __hip_atomic_fetch_add(p, v, __ATOMIC_RELAXED, __HIP_MEMORY_SCOPE_AGENT); }
__device__ __forceinline__ unsigned xb_xcc_id() { return (unsigned)__builtin_amdgcn_s_getreg((3 << 11) | 20) & 0xFu; }
#define XB_SPIN(cond, bar) do { unsigned _sp = 0; while (cond) { __builtin_amdgcn_s_sleep(1); \
    if ((++_sp & 255u) == 0u) { if (xb_ld(&(bar)[XB_TMO])) break; if (_sp > XB_SPIN_CAP) { atomicAdd(&(bar)[XB_TMO], 1u); break; } } } } while (0)

struct XcdBarrier {
    unsigned* bar; unsigned x;
    volatile LAS unsigned* st;
};

__device__ __forceinline__ XcdBarrier xcd_barrier_post(unsigned* bar, volatile LAS unsigned* st) {
    XcdBarrier b; b.bar = bar; b.x = xb_xcc_id(); b.st = st;
    if (threadIdx.x == 0) (void)xb_add(&bar[XB_XCNT(b.x)], 1u);
    return b;
}
__device__ __forceinline__ void xcd_barrier_complete(unsigned* bar, unsigned x, unsigned& nloc, unsigned& nx) {
    const unsigned G = gridDim.x * gridDim.y * gridDim.z;
    unsigned sum, cnt, mine, sp = 0u;
    for (;;) {
        sum = 0u; cnt = 0u; mine = 0u;
#pragma unroll
        for (unsigned j = 0; j < 16; ++j) { const unsigned c = xb_ld(&bar[XB_XCNT(j)]); sum += c; cnt += (c > 0u) ? 1u : 0u; mine = (j == x) ? c : mine; }
        if (sum == G) break;
        __builtin_amdgcn_s_sleep(1);
        if ((++sp & 255u) == 0u) { if (xb_ld(&bar[XB_TMO])) break; if (sp > XB_SPIN_CAP) { atomicAdd(&bar[XB_TMO], 1u); break; } }
    }
    nloc = mine > 0u ? mine : 1u; nx = cnt > 0u ? cnt : 1u;
}

__device__ __forceinline__ void xcd_barrier(const XcdBarrier& b) {
    asm volatile("s_waitcnt vmcnt(0)" ::: "memory");
    __syncthreads();
    if (threadIdx.x == 0) {
        unsigned* bar = b.bar;
        __builtin_amdgcn_s_waitcnt(0);
        unsigned nloc = b.st[0], nx = b.st[1];
        if (nloc == 0u) { xcd_barrier_complete(bar, b.x, nloc, nx); b.st[0] = nloc; b.st[1] = nx; }
        const unsigned old = xb_add(&bar[XB_XSUB(b.x)], 1u);
        const unsigned gen = old / nloc;
        if (old + 1u == (gen + 1u) * nloc) {
            __builtin_amdgcn_fence(__ATOMIC_RELEASE, "agent");
            asm volatile("s_waitcnt vmcnt(0)" ::: "memory");
            const unsigned og = xb_add(&bar[XB_TOP], 1u);
            const unsigned tg = og / nx;
            if (og + 1u == (tg + 1u) * nx) xb_add(&bar[XB_TOPGEN], 1u);
            else XB_SPIN(xb_ld(&bar[XB_TOPGEN]) == tg, bar);
            __builtin_amdgcn_fence(__ATOMIC_ACQUIRE, "agent");
            xb_add(&bar[XB_XGEN(b.x)], 1u);
            asm volatile("s_waitcnt vmcnt(0)" ::: "memory");
        } else {
            XB_SPIN(xb_ld(&bar[XB_XGEN(b.x)]) == gen, bar);
            __builtin_amdgcn_fence(__ATOMIC_ACQUIRE, "agent");
            asm volatile("s_waitcnt vmcnt(0)" ::: "memory");
        }
    }
    __syncthreads();
}


namespace att {
typedef short bf16x8 __attribute__((ext_vector_type(8)));
typedef short s16x4 __attribute__((ext_vector_type(4)));
typedef float f32x16 __attribute__((ext_vector_type(16)));
#define ATT_SBAR() __builtin_amdgcn_sched_barrier(0)
#define ATT_BAR() do { asm volatile("s_waitcnt lgkmcnt(0)" ::: "memory"); __builtin_amdgcn_s_barrier(); asm volatile("" ::: "memory"); } while (0)
constexpr float LOG2E = 1.4426950408889634f, NEGM = -1e30f;
constexpr int KVSPLIT = 4;
__device__ __forceinline__ int crow(int r, int hi) { return (r & 3) + 8 * (r >> 2) + 4 * hi; }
__device__ __forceinline__ unsigned cvtpk(float lo, float hi) { unsigned r; asm volatile("v_cvt_pk_bf16_f32 %0, %1, %2" : "=v"(r) : "v"(lo), "v"(hi)); return r; }
template <int DQK> __device__ __forceinline__ int kswz_x(int row) { return DQK == 128 ? (((row & 7) | (((row >> 4) & 1) << 3)) << 4) : (((row >> 1) & 7) << 4); }
template <int DQK> __device__ __forceinline__ int kswz(int row, int colB) { return row * (DQK * 2) + (colB ^ kswz_x<DQK>(row)); }
__device__ __forceinline__ int v_st(int k, int c) { const int kk = (k & ~0xC) | ((k & 4) << 1) | ((k & 8) >> 1); return ((kk >> 3) * 4 + (c >> 5)) * 512 + ((kk & 7) * 32 + (c & 31)) * 2; }
__device__ __forceinline__ int v_rd_base(int lane) { return ((lane & 3) << 3) | (((lane >> 2) & 3) << 6) | (((lane >> 4) & 1) << 5) | (((lane >> 5) & 1) << 8); }
constexpr int v_rd_off(int d0, int ks, int half) { return d0 * 512 + ks * 4096 + half * 2048; }
template <int OFF> __device__ __forceinline__ s16x4 tr_read(int vb) { s16x4 r; asm volatile("ds_read_b64_tr_b16 %0, %1 offset:%2" : "=&v"(r) : "v"(vb), "i"(OFF) : "memory"); return r; }
struct VFrag { s16x4 l0, h0, l1, h1, l2, h2, l3, h3; };
template <int D0> __device__ __forceinline__ void pv_read(VFrag& f, int vb) {
  f.l0 = tr_read<v_rd_off(D0, 0, 0)>(vb); f.h0 = tr_read<v_rd_off(D0, 0, 1)>(vb); f.l1 = tr_read<v_rd_off(D0, 1, 0)>(vb); f.h1 = tr_read<v_rd_off(D0, 1, 1)>(vb);
  f.l2 = tr_read<v_rd_off(D0, 2, 0)>(vb); f.h2 = tr_read<v_rd_off(D0, 2, 1)>(vb); f.l3 = tr_read<v_rd_off(D0, 3, 0)>(vb); f.h3 = tr_read<v_rd_off(D0, 3, 1)>(vb);
}
__device__ __forceinline__ void pv_mma(f32x16& od, const VFrag& f, bf16x8 pa0, bf16x8 pa1, bf16x8 pa2, bf16x8 pa3) {
#define ATT_PK(L, H) (bf16x8){L[0], L[1], L[2], L[3], H[0], H[1], H[2], H[3]}
  od = __builtin_amdgcn_mfma_f32_32x32x16_bf16(pa0, ATT_PK(f.l0, f.h0), od, 0, 0, 0);
  od = __builtin_amdgcn_mfma_f32_32x32x16_bf16(pa1, ATT_PK(f.l1, f.h1), od, 0, 0, 0);
  od = __builtin_amdgcn_mfma_f32_32x32x16_bf16(pa2, ATT_PK(f.l2, f.h2), od, 0, 0, 0);
  od = __builtin_amdgcn_mfma_f32_32x32x16_bf16(pa3, ATT_PK(f.l3, f.h3), od, 0, 0, 0);
#undef ATT_PK
}
__device__ __forceinline__ void pv_d0(f32x16* o, int vb, bf16x8 pa0, bf16x8 pa1, bf16x8 pa2, bf16x8 pa3) {
  VFrag fa, fb;
  pv_read<0>(fa, vb); pv_read<1>(fb, vb);
  asm volatile("s_waitcnt lgkmcnt(8)" ::: "memory"); ATT_SBAR(); pv_mma(o[0], fa, pa0, pa1, pa2, pa3); ATT_SBAR();
  pv_read<2>(fa, vb);
  asm volatile("s_waitcnt lgkmcnt(8)" ::: "memory"); ATT_SBAR(); pv_mma(o[1], fb, pa0, pa1, pa2, pa3); ATT_SBAR();
  pv_read<3>(fb, vb);
  asm volatile("s_waitcnt lgkmcnt(8)" ::: "memory"); ATT_SBAR(); pv_mma(o[2], fa, pa0, pa1, pa2, pa3); ATT_SBAR();
  asm volatile("s_waitcnt lgkmcnt(0)" ::: "memory"); ATT_SBAR(); pv_mma(o[3], fb, pa0, pa1, pa2, pa3);
}
typedef float f32x2 __attribute__((ext_vector_type(2)));
template <bool RAW>
__device__ __forceinline__ void softmax_tile(f32x16& p0, f32x16& p1, float Cs, float& m_reg, float& l_reg, float& alpha, bf16x8& pa0, bf16x8& pa1, bf16x8& pa2, bf16x8& pa3) {
  float pmax = fmaxf(fmaxf(p0[0], p0[1]), p1[0]);
#pragma unroll
  for (int r = 2; r < 16; r += 2) pmax = fmaxf(fmaxf(pmax, p0[r]), p0[r + 1]);
#pragma unroll
  for (int r = 1; r < 15; r += 2) pmax = fmaxf(fmaxf(pmax, p1[r]), p1[r + 1]);
  pmax = fmaxf(pmax, p1[15]);
  { auto rr = __builtin_amdgcn_permlane32_swap(__float_as_uint(pmax), __float_as_uint(pmax), false, false); pmax = fmaxf(__uint_as_float(rr[0]), __uint_as_float(rr[1])); }
  if (RAW) pmax *= Cs;
  const float mn = fmaxf(m_reg, pmax); alpha = __builtin_amdgcn_exp2f(m_reg - mn); m_reg = mn;
#pragma unroll
  for (int r = 0; r < 16; ++r) { p0[r] = __builtin_amdgcn_exp2f(RAW ? fmaf(p0[r], Cs, -mn) : p0[r] - mn); p1[r] = __builtin_amdgcn_exp2f(RAW ? fmaf(p1[r], Cs, -mn) : p1[r] - mn); }
  f32x2 ps2 = {0.f, 0.f};
#pragma unroll
  for (int r = 0; r < 16; r += 2) { ps2 += (f32x2){p0[r], p0[r + 1]}; ps2 += (f32x2){p1[r], p1[r + 1]}; }
  float ps = ps2[0] + ps2[1];
  { auto rr = __builtin_amdgcn_permlane32_swap(__float_as_uint(ps), __float_as_uint(ps), false, false); ps = __uint_as_float(rr[0]) + __uint_as_float(rr[1]); }
  l_reg = l_reg * alpha + ps;
#define ATT_PK4(P, BASE, OUT) do { unsigned a0 = cvtpk(P[BASE + 0], P[BASE + 1]), a1 = cvtpk(P[BASE + 2], P[BASE + 3]);   \
    unsigned b0 = cvtpk(P[BASE + 4], P[BASE + 5]), b1 = cvtpk(P[BASE + 6], P[BASE + 7]);                              \
    auto r0 = __builtin_amdgcn_permlane32_swap(a0, b0, false, false); auto r1 = __builtin_amdgcn_permlane32_swap(a1, b1, false, false); \
    u32x4 w = {r0[0], r1[0], r0[1], r1[1]}; OUT = *reinterpret_cast<bf16x8*>(&w); } while (0)
  ATT_PK4(p0, 0, pa0); ATT_PK4(p0, 8, pa1); ATT_PK4(p1, 0, pa2); ATT_PK4(p1, 8, pa3);
#undef ATT_PK4
}

template <int MODE>
__device__ __forceinline__ void attn_unit(unsigned char* ws_, const float* rpb, const float* sink, int l, int h, int qb, int kvq, unsigned char* lds_g) {
  constexpr int DQK = MODE == 1 ? 192 : 128, ND = DQK / 16, NCH = DQK / 64;
  constexpr int SHM_V = 64 * 128 * 2, SHM_K = 64 * DQK * 2, OFF_K = 3 * SHM_V, OFF_WS = OFF_K + 3 * SHM_K, OFF_RPB = OFF_WS + 8 * 64 * 4;
  const int tid = otid(), wid = tid >> 6, lane = tid & 63, r32 = lane & 31, hi = lane >> 5;
  LAS unsigned char* ldl = (LAS unsigned char*)lds_g;
  const bf16_t* proj = (const bf16_t*)(ws_ + WS_PROJ);
  const bf16_t *Qp, *Kp, *Vp; int ldq, ldk, ldv, ycol; float C;
  if (MODE == 0) { Qp = proj + C_QA + 128 * h; Kp = proj + C_KA + 128 * h; Vp = proj + C_VA + 128 * h; ldq = ldk = ldv = DINP; ycol = 128 * h; C = 0.08838834764831845f * LOG2E; }
  else if (MODE == 1) { Qp = (const bf16_t*)(ws_ + WS_Q) + 192 * h; Kp = (const bf16_t*)(ws_ + WS_K) + 192 * h; Vp = (const bf16_t*)(ws_ + WS_V) + 128 * h; ldq = QLD; ldk = KLD; ldv = VLD; ycol = 512 + 128 * h; C = 0.07216878364870322f * LOG2E; }
  else { Qp = proj + C_QC + 128 * h; Kp = proj + C_KC + 128 * (h / 3); Vp = proj + C_VC + 128 * (h / 3); ldq = ldk = ldv = DINP; ycol = 1280 + 128 * h; C = 0.08838834764831845f * LOG2E; }
  const int q0 = qb * 256, qi = q0 + wid * 32 + r32;
  int T0, T1, tw0, tw1, wrow = 0, qcol = 0, c0 = 0; float slope2 = 0.f;
  if (MODE == 1) { T0 = tw0 = kvq * (S / 64 / KVSPLIT); T1 = tw1 = T0 + S / 64 / KVSPLIT; }
  else if (MODE == 0) { const int R = qb * 4; T0 = min(max(R - 4, 0), 120); T1 = min(max(R - 1, 0), 120) + 8; wrow = R + (wid >> 1); tw0 = min(max(wrow - 4, 0), 120); tw1 = tw0 + 8;
                        qcol = (wid & 1) * 32 + r32; c0 = min(max(qcol - 8, 0), 48); }
  else { T0 = max(0, (q0 - 128) >> 6); T1 = min(S / 64, ((q0 + 255 + 128) >> 6) + 1); const int qw = q0 + wid * 32; tw0 = max(0, (qw - 128) >> 6); tw1 = min(S / 64, ((qw + 31 + 128) >> 6) + 1);
         slope2 = exp2f(-8.0f * (float)(h + 1) / 6.0f) * LOG2E; }
  LAS float* wsl = (LAS float*)(ldl + OFF_WS) + wid * 64; LAS float* li_l = wsl; LAS float* al_l = wsl + 32;
  LAS float* rpbL = (LAS float*)(ldl + OFF_RPB);
  if (MODE == 0) { for (int i = tid; i < 465; i += NTHREADS) rpbL[i] = rpb[(l * 4 + h) * 465 + i] * LOG2E; }
  float m_reg = -1e29f, l_reg = 0.f;
  if (MODE == 2) { m_reg = sink[l * 6 + h] * LOG2E; l_reg = 1.f; }
  f32x16 o[4] = {}; bf16x8 qr[ND];
  { const bf16_t* Qw = Qp + (size_t)qi * ldq + hi * 8;
#pragma unroll
    for (int d0 = 0; d0 < ND; ++d0) qr[d0] = *(const bf16x8*)(Qw + d0 * 16); }
  unsigned kg[NCH], vg[2];
#pragma unroll
  for (int i = 0; i < NCH; ++i) { const int X = (wid + 8 * i) * 1024 + lane * 16, row = X / (DQK * 2), cs = X % (DQK * 2), colB = cs ^ kswz_x<DQK>(row); kg[i] = (unsigned)(row * ldk + (colB >> 1)) * 2u; }
#pragma unroll
  for (int i = 0; i < 2; ++i) { const int X = (wid + 8 * i) * 1024 + lane * 16, st = X >> 9, w = X & 511, kk = ((st >> 2) << 3) | (w >> 6), c = ((st & 3) << 5) | ((w & 63) >> 1);
    const int k = (kk & ~0xC) | ((kk & 4) << 1) | ((kk & 8) >> 1); vg[i] = (unsigned)(k * ldv + c) * 2u; }
  const int vb0 = (int)(uintptr_t)lds_g + v_rd_base(lane);
  const int kbase0 = (int)(uintptr_t)lds_g + OFF_K;
  constexpr int NKO = DQK == 192 ? 4 : ND;
  int ko[NKO];
#pragma unroll
  for (int d0 = 0; d0 < NKO; ++d0) ko[d0] = kswz<DQK>(r32, (d0 * 16 + hi * 8) * 2);
#define ATT_KO(d0_) (DQK == 192 ? ko[(d0_) & 3] + ((d0_) >> 2) * 128 : ko[(d0_) % NKO])
  const int wslab = __builtin_amdgcn_readfirstlane(wid) * 1024;
#define ATT_DMA(t, b) do { const char* kt_ = (const char*)(Kp + (size_t)(t) * 64 * ldk); const char* vt_ = (const char*)(Vp + (size_t)(t) * 64 * ldv); \
    _Pragma("unroll") for (int i_ = 0; i_ < NCH; ++i_) __builtin_amdgcn_global_load_lds((const unsigned*)(kt_ + kg[i_]), (LAS unsigned*)(ldl + OFF_K + (b) * SHM_K + wslab + i_ * 8192), 16, 0, 0); \
    _Pragma("unroll") for (int i_ = 0; i_ < 2; ++i_) __builtin_amdgcn_global_load_lds((const unsigned*)(vt_ + vg[i_]), (LAS unsigned*)(ldl + (b) * SHM_V + wslab + i_ * 8192), 16, 0, 0); } while (0)
  __syncthreads();
  ATT_DMA(T0, 0); if (T0 + 1 < T1) { ATT_DMA(T0 + 1, 1); asm volatile("s_waitcnt vmcnt(%0)" :: "n"(NCH + 2) : "memory"); } else asm volatile("s_waitcnt vmcnt(0)" ::: "memory");
  ATT_BAR();
  int b = 0, bn = 2;
#pragma unroll 1
  for (int j = T0; j < T1; ++j) {
    const bool vis_ = (j >= tw0 && j < tw1);
    if (vis_) {
      f32x16 p0 = {}, p1 = {};
      ATT_SBAR();
      {
        const int kbase = kbase0 + b * SHM_K;
        bf16x8 fa[3], fb[3];
#define ATT_KRD(d0_) do { const int ad_ = kbase + ATT_KO(d0_); \
          asm volatile("ds_read_b128 %0, %1" : "=v"(fa[(d0_) % 3]) : "v"(ad_) : "memory"); \
          asm volatile("ds_read_b128 %0, %1 offset:%2" : "=v"(fb[(d0_) % 3]) : "v"(ad_), "i"(32 * DQK * 2) : "memory"); } while (0)
        ATT_KRD(0); ATT_KRD(1);
#pragma unroll
        for (int d0 = 0; d0 < ND; ++d0) {
          if (d0 + 2 < ND) { ATT_KRD(d0 + 2); asm volatile("s_waitcnt lgkmcnt(4)" ::: "memory"); }
          else if (d0 + 1 < ND) asm volatile("s_waitcnt lgkmcnt(2)" ::: "memory");
          else asm volatile("s_waitcnt lgkmcnt(0)" ::: "memory");
          ATT_SBAR();
          p0 = __builtin_amdgcn_mfma_f32_32x32x16_bf16(fa[d0 % 3], qr[d0], p0, 0, 0, 0);
          p1 = __builtin_amdgcn_mfma_f32_32x32x16_bf16(fb[d0 % 3], qr[d0], p1, 0, 0, 0);
          ATT_SBAR(); }
#undef ATT_KRD
      }
      ATT_SBAR();
      if (MODE == 0) {
        const int dr31 = (j - wrow + 7) * 31 + 15 - qcol;
#pragma unroll
        for (int r = 0; r < 16; ++r) { const int kc = crow(r, hi);
          { const bool v = (kc >= c0) && (kc < c0 + 16); const float bb = rpbL[v ? dr31 + kc : 0]; p0[r] = v ? fmaf(p0[r], C, bb) : NEGM; }
          { const int kc1 = kc + 32; const bool v = (kc1 >= c0) && (kc1 < c0 + 16); const float bb = rpbL[v ? dr31 + kc1 : 0]; p1[r] = v ? fmaf(p1[r], C, bb) : NEGM; } }
      } else if (MODE == 2) {
        const int kb = j * 64;
#pragma unroll
        for (int r = 0; r < 16; ++r) { const int k = kb + crow(r, hi);
          { const int d = abs(qi - k); p0[r] = d <= 128 ? fmaf(p0[r], C, -slope2 * (float)d) : NEGM; }
          { const int d = abs(qi - k - 32); p1[r] = d <= 128 ? fmaf(p1[r], C, -slope2 * (float)d) : NEGM; } }
      }
      float alpha; bf16x8 pa0, pa1, pa2, pa3;
      softmax_tile<MODE == 1>(p0, p1, C, m_reg, l_reg, alpha, pa0, pa1, pa2, pa3);
      if (__any(alpha < 1.f)) { if (hi == 0) al_l[r32] = alpha; asm volatile("s_waitcnt lgkmcnt(0)" ::: "memory");
#pragma unroll
        for (int r = 0; r < 16; ++r) { const float av = al_l[crow(r, hi)];
#pragma unroll
          for (int d = 0; d < 4; ++d) o[d][r] *= av; }
        asm volatile("s_waitcnt lgkmcnt(0)" ::: "memory"); }
      ATT_SBAR();
      pv_d0(o, vb0 + b * SHM_V, pa0, pa1, pa2, pa3);
    }
#if defined(PROBE_ATT_VALU)
    if (MODE == 1) { float dx_ = m_reg;
#pragma unroll
      for (int i_ = 0; i_ < 32; ++i_) asm volatile("v_exp_f32 %0, %0" : "+v"(dx_));
      asm volatile("" :: "v"(dx_)); }
#endif
#if defined(PROBE_ATT_LDS)
    if (MODE == 1) { bf16x8 t_; const int ad_ = (int)(uintptr_t)lds_g + OFF_K + b * SHM_K + kswz<DQK>(r32, hi * 16);
#pragma unroll
      for (int i_ = 0; i_ < 24; ++i_) asm volatile("ds_read_b128 %0, %1 offset:%2" : "=v"(t_) : "v"(ad_), "i"((i_ % 12) * 32) : "memory");
      asm volatile("s_waitcnt lgkmcnt(0)" ::: "memory"); asm volatile("" :: "v"(t_)); }
#endif
#if defined(PROBE_ATT_MFMA)
    if (MODE == 1) { f32x4 da_ = {0.f, 0.f, 0.f, 0.f};
#pragma unroll
      for (int i_ = 0; i_ < 80; ++i_) da_ = __builtin_amdgcn_mfma_f32_16x16x32_bf16(qr[0], qr[1], da_, 0, 0, 0);
      asm volatile("" :: "v"(da_)); }
#endif
    ATT_SBAR();
    if (j + 2 < T1) ATT_DMA(j + 2, bn);
    if (j + 2 < T1) asm volatile("s_waitcnt vmcnt(%0)" :: "n"(NCH + 2) : "memory"); else asm volatile("s_waitcnt vmcnt(0)" ::: "memory");
    ATT_BAR();
    b = b == 2 ? 0 : b + 1; bn = bn == 2 ? 0 : bn + 1;
  }
  if (hi == 0) li_l[r32] = l_reg; asm volatile("s_waitcnt lgkmcnt(0)" ::: "memory");
  bf16_t* Ow; int ldo;
  if (MODE == 1) { Ow = (bf16_t*)(ws_ + WS_PART) + ((size_t)kvq * S + q0 + wid * 32) * VLD + 128 * h + r32; ldo = VLD;
    if (hi == 0) { float* st = (float*)(ws_ + WS_STAT) + ((size_t)(kvq * 6 + h) * S + qi) * 2; st[0] = m_reg; st[1] = l_reg; } }
  else { Ow = (bf16_t*)(ws_ + WS_Y) + (size_t)(q0 + wid * 32) * DM + ycol + r32; ldo = DM; }
#pragma unroll
  for (int r = 0; r < 16; ++r) { const int orow = crow(r, hi); const float rl = __builtin_amdgcn_rcpf(li_l[orow]);
#pragma unroll
    for (int d0 = 0; d0 < 4; ++d0) Ow[(size_t)orow * ldo + d0 * 32] = (bf16_t)(cvtpk(o[d0][r] * rl, 0.f) & 0xffffu); }
  asm volatile("s_waitcnt lgkmcnt(0)" ::: "memory");
  __syncthreads();
#undef ATT_DMA
#undef ATT_KO
}
}

#ifndef NAIVE_ATTN
#define NAIVE_ATTN 0
#endif
#ifndef MK_MULTI
#define MK_MULTI 0
#endif
constexpr int N_PHASES = 2 + 10 * DEPTH;
__device__ __forceinline__ int opq(int v) { asm volatile("" : "+s"(v)); return v; }

__global__ void __launch_bounds__(NTHREADS) fwd_megakernel(Args a) {
    extern __shared__ __attribute__((aligned(16))) unsigned char lds[];
    cg::grid_group grid = cg::this_grid();
    const int lo = a.ph_lo, hi = a.ph_hi;
    const int G = gridDim.x;
    { LAS unsigned long long* tw = (LAS unsigned long long*)((LAS unsigned char*)lds + TAB_OFF);
#pragma unroll
      for (int i = 0; i < 19; ++i) if ((int)threadIdx.x == i) tw[i] = (unsigned long long)a.in[i];
      if (threadIdx.x == 19) tw[19] = (unsigned long long)a.out;
      if (threadIdx.x == 20) tw[20] = (unsigned long long)a.ws;
      if (threadIdx.x < 4) ((LAS unsigned*)((LAS unsigned char*)lds + TAB_OFF + 192))[threadIdx.x] = 0u;
      __syncthreads(); }
    (void)xcd_barrier_post((unsigned*)(a.ws + WS_BAR), (volatile LAS unsigned*)((LAS unsigned char*)lds + TAB_OFF + 192));
    if (a.ph_lo < 0) grid.sync();
    const Tab T{(const LAS unsigned*)((LAS unsigned char*)lds + TAB_OFF)};
#define ws (T.wsp())
#define mod ((float*)(ws + WS_MOD))
#define U ((bf16_t*)(ws + WS_U))
#define PROJ ((bf16_t*)(ws + WS_PROJ))
#define Qb ((bf16_t*)(ws + WS_Q))
#define Kb ((bf16_t*)(ws + WS_K))
#define Vb ((bf16_t*)(ws + WS_V))
#define Y ((bf16_t*)(ws + WS_Y))
#define Hb ((bf16_t*)(ws + WS_H))
#define X ((float*)(ws + WS_X))
#define rope ((float*)(ws + WS_ROPE))
#define rsq ((float*)(ws + WS_RSQ))
#define rskv ((float*)(ws + WS_RSKV))
    PG8_LAS unsigned char* ldsl = (PG8_LAS unsigned char*)lds;
#ifndef PHM
#define PHM 0xFFFFF
#endif
#ifndef ATM
#define ATM 7
#endif
#define EN(b) ((PHM >> (b)) & 1)
#ifndef PROBE_PH
#define PROBE_PH -1
#endif
#ifndef PROBE_N
#define PROBE_N 2
#endif
#define REPK(k) for (int rep_ = 0; rep_ < ((k) == PROBE_PH ? PROBE_N : 1); ++rep_)
#define IN(k) (lo <= (k) && (k) < hi)
#define GBAR() do { XcdBarrier b_; b_.bar = (unsigned*)(ws + WS_BAR); b_.x = xb_xcc_id(); b_.st = (volatile LAS unsigned*)((LAS unsigned char*)lds + TAB_OFF + 192); xcd_barrier(b_); } while (0)
#define SEAM(k) do { if (IN(k) && IN((k) + 1)) GBAR(); } while (0)

#ifdef PROBE_SYNCS
    for (int i_ = 0; i_ < PROBE_SYNCS; ++i_) GBAR();
#endif
    if (EN(0) && IN(0)) REPK(0) { phase_mod(T, lds); }
    SEAM(0);
    if (EN(1) && IN(1)) REPK(1) {
        const int fb_ = opq((int)blockIdx.x), fs_ = opq(G); const bool hide_ = (fs_ == 256);
        for (int l = 0; l < DEPTH; ++l) {
            transpose_job<3>(T.in(4) + (size_t)l * DM * DIN, (bf16_t*)(ws + WS_W + (size_t)l * SZ_WL + O_WIN), DM, DIN, DINP, nullptr, lds, fb_, fs_);
            const int fh_ = (hide_ && l == 1) ? (1 << 30) : fb_, fh0_ = hide_ ? (1 << 30) : fb_;
            transpose_job<1>(T.in(8) + (size_t)l * 512 * 1152, (bf16_t*)(ws + WS_W + (size_t)l * SZ_WL + O_WUQ), 512, 1152, 1280, T.in(6) + l * 512, lds, fh0_, fs_);
            transpose_job<0>(T.in(9) + (size_t)l * 256 * 1536, (bf16_t*)(ws + WS_W + (size_t)l * SZ_WL + O_WUKV), 256, 1536, 1536, T.in(7) + l * 256, lds, fh0_, fs_);
            if (!hide_) transpose_job<0>(T.in(12) + (size_t)l * DM * DM, (bf16_t*)(ws + WS_W + (size_t)l * SZ_WL + O_WO), DM, DM, DM, T.in(11) + l * DM, lds, fb_, fs_);
            if (!(hide_ && l == 1)) transpose_job<2>(T.in(15) + (size_t)l * DM * 2 * DFF, (bf16_t*)(ws + WS_W + (size_t)l * SZ_WL + O_WGU), DM, 2 * DFF, 2 * DFF, nullptr, lds, fb_, fs_);
            transpose_job<0>(T.in(16) + (size_t)l * DFF * DM, (bf16_t*)(ws + WS_W + (size_t)l * SZ_WL + O_WDN), DFF, DM, DM, nullptr, lds, fh_, fs_);
        }
        modulate_rows(T.in(0), mod + 1 * DM, mod + 0 * DM, U);
        rope_table(rope);
    }
    SEAM(1);
#pragma unroll 1
    for (int l = 0; l < DEPTH; ++l) {
        const int pb = 2 + 10 * l;
        if (EN(2) && IN(pb + 0)) REPK(2) {
            pg8::Gemm g{U, (const bf16_t*)(ws + WS_W + (size_t)l * SZ_WL + O_WIN), S, DINP, DM, DM}; pg8::StaticOrder So; So.init(S, DINP, opq(G), opq((int)blockIdx.x));
            pg8::EpiProj E{PROJ, DINP, (float*)(ws + WS_SSQ), rope, Kb, KLD};
            pg8::gemm_phase<pg8::EpiProj, pg8::StaticOrder, true, true>(ldsl, g, So, E);
            if (opq(G) == 256 && opq((int)blockIdx.x) >= 224) {
                const int sb_ = opq((int)blockIdx.x) - 224; const size_t lo_ = (size_t)l;
                transpose_job<1>(T.in(8) + lo_ * 512 * 1152, (bf16_t*)(ws + WS_W + lo_ * SZ_WL + O_WUQ), 512, 1152, 1280, T.in(6) + lo_ * 512, lds, sb_, 32);
                transpose_job<0>(T.in(9) + lo_ * 256 * 1536, (bf16_t*)(ws + WS_W + lo_ * SZ_WL + O_WUKV), 256, 1536, 1536, T.in(7) + lo_ * 256, lds, (sb_ + 8) & 31, 32);
                transpose_job<0>(T.in(12) + lo_ * DM * DM, (bf16_t*)(ws + WS_W + lo_ * SZ_WL + O_WO), DM, DM, DM, T.in(11) + lo_ * DM, lds, sb_, 32); }
        }
        SEAM(pb + 0);
        if (EN(4) && IN(pb + 2)) REPK(4) {
            { const int bq = opq((int)blockIdx.x), Gq = opq(G);
#pragma unroll 1
              for (int it = 0; ; ++it) {
                int q0 = -1, kv0 = -1, kv1 = -1, na = -1, sw0 = -1, sw1 = -1;
                if (Gq == 256) { if (it == 0) {
                    if (bq < 96) { na = bq; q0 = bq; }
                    else if (bq < 128) { na = bq; kv0 = 2 * (bq - 96); kv1 = kv0 + 1; }
                    else if (bq < 192) { sw0 = bq - 128; q0 = 96 + (bq - 128); kv0 = 64 + 2 * (bq - 128); kv1 = kv0 + 1; }
                    else { sw0 = 64 + (bq - 192); sw1 = 128 + (bq - 192); } } }
                else { const int L = bq + it * Gq; if (L < 160) q0 = L; if (L < 192) { kv0 = L; sw0 = L; } if (L < 128) na = L; }
                if ((q0 & kv0 & na & sw0) < 0 && q0 < 0 && kv0 < 0 && na < 0 && sw0 < 0) break;
                if (q0 >= 0) { pg8::Gemm g{PROJ + C_CQ, (const bf16_t*)(ws + WS_W + (size_t)l * SZ_WL + O_WUQ), S, 1280, 512, DINP}; pg8::ListOrder So{5, 1, q0, 0};
                  pg8::EpiQ E{Qb, QLD, (const float*)(ws + WS_SSQ), rope};
                  pg8::gemm_phase<pg8::EpiQ, pg8::ListOrder, true, true>(ldsl, g, So, E); }
                if (kv0 >= 0) { pg8::Gemm g{PROJ + C_CKV, (const bf16_t*)(ws + WS_W + (size_t)l * SZ_WL + O_WUKV), S, 1536, 256, DINP}; pg8::ListOrder So{6, kv1 >= 0 ? 2 : 1, kv0, kv1};
                  pg8::EpiKV E{Kb, KLD, Vb, VLD, (const float*)(ws + WS_SSQ)};
                  pg8::gemm_phase<pg8::EpiKV, pg8::ListOrder, true, true>(ldsl, g, So, E); }
                if (na >= 0) { if (ATM & 2) att::attn_unit<0>(ws, T.in(5), T.in(10), l, na >> 5, na & 31, 0, lds); }
#pragma unroll 1
                for (int i2 = 0; i2 < 2; ++i2) { const int u = i2 ? sw1 : sw0; if (u >= 0) { if (ATM & 4) att::attn_unit<2>(ws, T.in(5), T.in(10), l, u >> 5, u & 31, 0, lds); } }
              } }
        }
        SEAM(pb + 2);
        if (EN(5) && IN(pb + 3)) REPK(5) {
#if NAIVE_ATTN
            naive_attn<0>(ws, T.in(5), T.in(10), l); naive_attn<2>(ws, T.in(5), T.in(10), l); naive_attn<1>(ws, T.in(5), T.in(10), l);
#else
            const int Gq = opq(G);
            for (int su = opq((int)blockIdx.x); su < 192 * att::KVSPLIT; su += Gq) {
                int combo, qb; if (Gq == 256) { combo = (su & 7) + 8 * (su >> 8); qb = (su & 255) >> 3; } else { combo = su >> 5; qb = su & 31; }
                unsigned char* wsp_ = ws;
                if (ATM & 1) att::attn_unit<1>(wsp_, nullptr, nullptr, l, combo >> 2, qb, combo & 3, lds);
            }
#endif
        }
        SEAM(pb + 3);
        if (EN(6) && IN(pb + 4)) phase_ynorm(ws);
        SEAM(pb + 4);
        if (EN(7) && IN(pb + 5)) {
            pg8::Gemm g{Y, (const bf16_t*)(ws + WS_W + (size_t)l * SZ_WL + O_WO), S, DM, DM, DM}; pg8::StaticOrder So; So.init(S, DM, opq(G), opq((int)blockIdx.x));
            pg8::EpiRes E{l == 0 ? T.in(0) : (const float*)X, X, mod + (size_t)l * 6 * DM + 2 * DM, ALPHA, DM};
            pg8::gemm_phase<pg8::EpiRes, pg8::StaticOrder, true, true>(ldsl, g, So, E);
        }
        SEAM(pb + 5);
#ifdef PROBE_LN
        if (EN(8) && IN(pb + 6)) phase_ln(X, (float*)(ws + WS_H), T.in(13) + l * DM, T.in(14) + l * DM, mod + (size_t)l * 6 * DM + 4 * DM, mod + (size_t)l * 6 * DM + 3 * DM, (bf16_t*)(ws + WS_PART));
#endif
        if (EN(8) && IN(pb + 6)) phase_ln(X, X, T.in(13) + l * DM, T.in(14) + l * DM, mod + (size_t)l * 6 * DM + 4 * DM, mod + (size_t)l * 6 * DM + 3 * DM, U);
        SEAM(pb + 6);
        if (EN(9) && IN(pb + 7)) REPK(9) {
            pg8::Gemm g{U, (const bf16_t*)(ws + WS_W + (size_t)l * SZ_WL + O_WGU), S, 2 * DFF, DM, DM}; pg8::StaticOrder So; So.init(S, 2 * DFF, opq(G), opq((int)blockIdx.x));
            pg8::EpiSwiglu E{Hb, DFF};
            pg8::gemm_phase<pg8::EpiSwiglu, pg8::StaticOrder, true, true>(ldsl, g, So, E);
            if (l == 0 && opq(G) == 256 && opq((int)blockIdx.x) >= 128)
                transpose_job<2>(T.in(15) + (size_t)DM * 2 * DFF, (bf16_t*)(ws + WS_W + SZ_WL + O_WGU), DM, 2 * DFF, 2 * DFF, nullptr, lds, opq((int)blockIdx.x) - 128, 128);
            if (l == 1 && opq(G) == 256 && opq((int)blockIdx.x) >= 128)
                transpose_job<0>(T.in(16) + (size_t)DFF * DM, (bf16_t*)(ws + WS_W + SZ_WL + O_WDN), DFF, DM, DM, nullptr, lds, opq((int)blockIdx.x) - 128, 128);
        }
        SEAM(pb + 7);
        if (EN(10) && IN(pb + 8)) {
            pg8::Gemm g{Hb, (const bf16_t*)(ws + WS_W + (size_t)l * SZ_WL + O_WDN), S, DM, DFF, DFF}; pg8::StaticOrder So; So.init(S, DM, opq(G), opq((int)blockIdx.x));
            pg8::EpiRes E{X, X, mod + (size_t)l * 6 * DM + 5 * DM, ALPHA, DM};
            pg8::gemm_phase<pg8::EpiRes, pg8::StaticOrder, true, true>(ldsl, g, So, E);
        }
        SEAM(pb + 8);
        if (EN(11) && IN(pb + 9)) {
            const bool last = (l == DEPTH - 1);
            const float* modn = mod + (size_t)(last ? l : l + 1) * 6 * DM;
            phase_ln(X, last ? T.out() : X, T.in(17) + l * DM, T.in(18) + l * DM, last ? nullptr : modn + 1 * DM, last ? nullptr : modn + 0 * DM, last ? nullptr : U);
        }
        SEAM(pb + 9);
    }
#undef IN
#undef SEAM
#undef ws
#undef mod
#undef U
#undef PROJ
#undef Qb
#undef Kb
#undef Vb
#undef Y
#undef Hb
#undef X
#undef rope
#undef rsq
#undef rskv
}

extern "C" void kernel_launch(void* const* d_in, const int* in_sizes, int n_in, void* d_out, int out_size, void* d_ws, size_t ws_size, hipStream_t stream) {
    static int grid = 0;
    if (grid == 0) {
        if (n_in != 19 || out_size != S * DM || ws_size < WS_END) { fprintf(stderr, "kernel_launch: unexpected shapes (n_in %d out %d ws %zu need %zu)\n", n_in, out_size, ws_size, (size_t)WS_END); grid = -1; return; }
        int dev = 0, cus = 0, per_cu = 0;
        hipGetDevice(&dev); hipDeviceGetAttribute(&cus, hipDeviceAttributeMultiprocessorCount, dev);
        if (hipFuncSetAttribute((const void*)fwd_megakernel, hipFuncAttributeMaxDynamicSharedMemorySize, LDS_BYTES) != hipSuccess) { fprintf(stderr, "kernel_launch: hipFuncSetAttribute failed\n"); grid = -1; return; }
        if (hipOccupancyMaxActiveBlocksPerMultiprocessor(&per_cu, (const void*)fwd_megakernel, NTHREADS, LDS_BYTES) != hipSuccess || per_cu < 1) { fprintf(stderr, "kernel_launch: occupancy query gave %d\n", per_cu); per_cu = 1; }
        (void)hipGetLastError();
        grid = cus;
    }
    if (grid < 0) return;
    if (hipMemsetAsync((char*)d_ws + WS_BAR, 0, 16384, stream) != hipSuccess) { fprintf(stderr, "kernel_launch: memset of the barrier words failed\n"); return; }
    Args a{};
    for (int i = 0; i < 19; ++i) a.in[i] = (const float*)d_in[i];
    a.out = (float*)d_out; a.ws = (unsigned char*)d_ws;
#if MK_MULTI
    for (int p = 0; p < N_PHASES; ++p) { a.ph_lo = p; a.ph_hi = p + 1; hipLaunchKernelGGL(fwd_megakernel, dim3(grid), dim3(NTHREADS), LDS_BYTES, stream, a); }
#else
    a.ph_lo = 0; a.ph_hi = N_PHASES;
    void* args[] = {&a};
    hipError_t e = hipLaunchCooperativeKernel((const void*)fwd_megakernel, dim3(grid), dim3(NTHREADS), args, LDS_BYTES, stream);
    if (e != hipSuccess) fprintf(stderr, "kernel_launch: cooperative launch failed: %s (grid %d)\n", hipGetErrorString(e), grid);
#endif
}
```

```cpp
#include <hip/hip_runtime.h>
#include <hip/hip_cooperative_groups.h>
#include <cstdio>
#include <cstdint>
namespace cg = cooperative_groups;
namespace pg8 {
#define PG8_LAS __attribute__((address_space(3)))
typedef unsigned short bf16_t;
typedef short bf16x8 __attribute__((ext_vector_type(8)));
typedef float f32x4 __attribute__((ext_vector_type(4)));
typedef unsigned u32x4 __attribute__((ext_vector_type(4)));
constexpr int BM = 256, BK = 64, HALF = 128, HTB = HALF * BK * 2  , STAGE_BYTES = 8 * HTB, NXCD = 8, WGM = 8;

__host__ __device__ __forceinline__ int lds_byte(int r, int c) { const int st = (r >> 4) * 2 + (c >> 5), rr = r & 15, cc = c & 31, ob = rr * 64 + cc * 2; return st * 1024 + (ob ^ (((ob >> 9) & 1) << 5)); }
__host__ __device__ __forceinline__ void stage_rc(int b, int& R, int& C) { const int st = b / 1024, sb = b % 1024, swz = sb ^ (((sb >> 9) & 1) << 5); R = (st >> 1) * 16 + swz / 64; C = (st & 1) * 32 + (swz % 64) / 2; }
__host__ __device__ __forceinline__ int perm32(int rho) { const int n = rho >> 4, i = rho & 15; return 8 * (i >> 2) + 4 * n + (i & 3); }

struct Unit { int pm, pn; };
struct Gemm { const bf16_t* A; const bf16_t* Bt; int M, N, K, lda; };

struct StaticOrder {
    int nM, nN, nwg, G, c;
    __host__ __device__ void init(int M, int N, int G_, int c_) { nM = M / BM; nN = N / BM; nwg = nM * nN; G = G_; c = c_; }
    __host__ __device__ bool next(int i, Unit& u) const {
        const long L = (long)i * G + c; if (L >= nwg) return false;
        int wgid = (int)L; { const int q = nwg / NXCD, r = nwg % NXCD, xcd = wgid % NXCD, off = wgid / NXCD; wgid = (xcd < r ? xcd * (q + 1) : r * (q + 1) + (xcd - r) * q) + off; }
        const int nig = WGM * nN, gid = wgid / nig, fm = gid * WGM, gsz = (nM - fm) < WGM ? (nM - fm) : WGM;
        u.pm = fm + ((wgid % nig) % gsz); u.pn = (wgid % nig) / gsz; return true;
    }
    __device__ __forceinline__ void a_ready(const Unit&) const {}
    __device__ __forceinline__ void done(const Unit&) const {}
};

struct ListOrder {
    int nN, n, L0, L1;
    __host__ __device__ bool next(int i, Unit& u) const { if (i >= n) return false; const int L = i == 0 ? L0 : L1; u.pm = L / nN; u.pn = L % nN; return true; }
    __device__ __forceinline__ void a_ready(const Unit&) const {}
    __device__ __forceinline__ void done(const Unit&) const {}
};
__device__ __forceinline__ unsigned cvt_pk_bf16(float lo, float hi) { unsigned r; asm volatile("v_cvt_pk_bf16_f32 %0, %1, %2" : "=v"(r) : "v"(lo), "v"(hi)); return r; }
typedef float f32x2 __attribute__((ext_vector_type(2)));
__device__ __forceinline__ u32x4 pack8(const f32x4 v0, const f32x4 v1) { u32x4 w; w.x = cvt_pk_bf16(v0[0], v0[1]); w.y = cvt_pk_bf16(v0[2], v0[3]); w.z = cvt_pk_bf16(v1[0], v1[1]); w.w = cvt_pk_bf16(v1[2], v1[3]); return w; }
struct EpiStore {
    static constexpr bool PERM = true, AFTER_DRAIN = false;
    bf16_t* O; int ldc;
    __device__ __forceinline__ void operator()(const f32x4 (&acc)[2][2][4][2], const Unit& u, int wr, int wc, int fr, int fq) const {
        const int row0 = u.pm * BM + wr * 64 + fr, col0 = u.pn * BM + wc * 32 + 8 * fq;
#pragma unroll
        for (int ai = 0; ai < 2; ++ai)
#pragma unroll
            for (int m = 0; m < 4; ++m) { bf16_t* rowp = O + (size_t)(row0 + ai * HALF + m * 16) * ldc + col0;
#pragma unroll
                for (int bj = 0; bj < 2; ++bj) *(u32x4*)(rowp + bj * HALF) = pack8(acc[ai][bj][m][0], acc[ai][bj][m][1]); }
    }
};
struct EpiProj {
    static constexpr bool PERM = true, AFTER_DRAIN = false;
    bf16_t* O; int ldc; float* ssq; const float* rope; bf16_t* Kb; int ldk;
    __device__ __forceinline__ void operator()(const f32x4 (&acc)[2][2][4][2], const Unit& u, int wr, int wc, int fr, int fq) const {
        const int row0 = u.pm * BM + wr * 64 + fr, col0 = u.pn * BM + wc * 32 + 8 * fq;
#pragma unroll
        for (int ai = 0; ai < 2; ++ai)
#pragma unroll
            for (int m = 0; m < 4; ++m) { const int row = row0 + ai * HALF + m * 16; bf16_t* rowp = O + (size_t)row * ldc + col0; float sq = 0.f;
#pragma unroll
                for (int bj = 0; bj < 2; ++bj) { const u32x4 w = pack8(acc[ai][bj][m][0], acc[ai][bj][m][1]); *(u32x4*)(rowp + bj * HALF) = w;
#pragma unroll
                    for (int e = 0; e < 4; ++e) { const float lo = __uint_as_float(w[e] << 16), hi = __uint_as_float(w[e] & 0xffff0000u); sq += lo * lo + hi * hi; } }
                if (u.pn >= 6 && u.pn <= 8) { sq += __shfl_xor(sq, 16); sq += __shfl_xor(sq, 32); if (fq == 0) ssq[((size_t)row * 3 + (u.pn - 6)) * 4 + wc] = sq; }
                if (u.pn == 9 && wc < 2) { const int ib = wc * 16 + 4 * fq; const f32x4 v0 = acc[ai][0][m][0], v1 = acc[ai][0][m][1];
                    const f32x4 c = *(const f32x4*)(rope + (size_t)row * 64 + ib), sn = *(const f32x4*)(rope + (size_t)row * 64 + 32 + ib);
                    f32x4 a, b;
                    a[0] = v0[0] * c[0] - v0[1] * sn[0]; a[1] = v0[1] * c[0] + v0[0] * sn[0];
                    a[2] = v0[2] * c[1] - v0[3] * sn[1]; a[3] = v0[3] * c[1] + v0[2] * sn[1];
                    b[0] = v1[0] * c[2] - v1[1] * sn[2]; b[1] = v1[1] * c[2] + v1[0] * sn[2];
                    b[2] = v1[2] * c[3] - v1[3] * sn[3]; b[3] = v1[3] * c[3] + v1[2] * sn[3];
                    const u32x4 w = pack8(a, b);
#pragma unroll
                    for (int h = 0; h < 6; ++h) *(u32x4*)(Kb + (size_t)row * ldk + 192 * h + 128 + wc * 32 + 8 * fq) = w; }
                if (m & 1) asm volatile("" ::: "memory"); }
    }
};
struct EpiQ {
    static constexpr bool PERM = true, AFTER_DRAIN = false;
    bf16_t* O; int ldc; const float* ssq; const float* rope;
    __device__ __forceinline__ void operator()(const f32x4 (&acc)[2][2][4][2], const Unit& u, int wr, int wc, int fr, int fq) const {
        const int row0 = u.pm * BM + wr * 64 + fr;
        float sc[2][4];
        { f32x4 q0[2][4], q1[2][4];
#pragma unroll
          for (int ai = 0; ai < 2; ++ai)
#pragma unroll
            for (int m = 0; m < 4; ++m) { const float* p = ssq + (size_t)(row0 + ai * HALF + m * 16) * 12; q0[ai][m] = *(const f32x4*)p; q1[ai][m] = *(const f32x4*)(p + 4); }
#pragma unroll
          for (int ai = 0; ai < 2; ++ai)
#pragma unroll
            for (int m = 0; m < 4; ++m) { const f32x4 a = q0[ai][m], b = q1[ai][m];
                sc[ai][m] = 1.0f / sqrtf((((a[0] + a[1]) + (a[2] + a[3])) + ((b[0] + b[1]) + (b[2] + b[3]))) * (1.0f / 512.0f) + 1e-6f); } }
#pragma unroll
        for (int ai = 0; ai < 2; ++ai)
#pragma unroll
            for (int m = 0; m < 4; ++m) { const int row = row0 + ai * HALF + m * 16; const float s = sc[ai][m];
#pragma unroll
                for (int bj = 0; bj < 2; ++bj) {
                    const int cb = u.pn * BM + bj * HALF + wc * 32, hc = cb % 192;
                    f32x4 v0 = acc[ai][bj][m][0] * s, v1 = acc[ai][bj][m][1] * s;
                    if (hc >= 128) {
                        const int ib = (hc - 128) / 2 + 4 * fq;
                        const f32x4 c = *(const f32x4*)(rope + (size_t)row * 64 + ib), sn = *(const f32x4*)(rope + (size_t)row * 64 + 32 + ib);
                        f32x4 a, b;
                        a[0] = v0[0] * c[0] - v0[1] * sn[0]; a[1] = v0[1] * c[0] + v0[0] * sn[0];
                        a[2] = v0[2] * c[1] - v0[3] * sn[1]; a[3] = v0[3] * c[1] + v0[2] * sn[1];
                        b[0] = v1[0] * c[2] - v1[1] * sn[2]; b[1] = v1[1] * c[2] + v1[0] * sn[2];
                        b[2] = v1[2] * c[3] - v1[3] * sn[3]; b[3] = v1[3] * c[3] + v1[2] * sn[3];
                        v0 = a; v1 = b;
                    }
                    *(u32x4*)(O + (size_t)row * ldc + cb + 8 * fq) = pack8(v0, v1);
                }
                if (m == 3) asm volatile("" ::: "memory"); }
    }
};
struct EpiKV {
    static constexpr bool PERM = true, AFTER_DRAIN = false;
    bf16_t* Kb; int ldk; bf16_t* Vb; int ldv; const float* ssq;
    __device__ __forceinline__ void operator()(const f32x4 (&acc)[2][2][4][2], const Unit& u, int wr, int wc, int fr, int fq) const {
        const int row0 = u.pm * BM + wr * 64 + fr, cin = wc * 32 + 8 * fq;
        f32x4 q2[2][4];
#pragma unroll
        for (int ai = 0; ai < 2; ++ai)
#pragma unroll
            for (int m = 0; m < 4; ++m) q2[ai][m] = *(const f32x4*)(ssq + (size_t)(row0 + ai * HALF + m * 16) * 12 + 8);
#pragma unroll
        for (int ai = 0; ai < 2; ++ai)
#pragma unroll
            for (int m = 0; m < 4; ++m) { const int row = row0 + ai * HALF + m * 16; const f32x4 a = q2[ai][m];
                const float s = 1.0f / sqrtf(((a[0] + a[1]) + (a[2] + a[3])) * (1.0f / 256.0f) + 1e-6f);
                *(u32x4*)(Kb + (size_t)row * ldk + 192 * u.pn + cin) = pack8(acc[ai][0][m][0] * s, acc[ai][0][m][1] * s);
                *(u32x4*)(Vb + (size_t)row * ldv + 128 * u.pn + cin) = pack8(acc[ai][1][m][0] * s, acc[ai][1][m][1] * s); }
    }
};
struct EpiRes {
    static constexpr bool PERM = false, AFTER_DRAIN = false;
    const float* xres; float* z; const float* gate; float alpha; int ldc;
    __device__ __forceinline__ void operator()(const f32x4 (&acc)[2][2][4][2], const Unit& u, int wr, int wc, int fr, int fq) const {
        const int row0 = u.pm * BM + wr * 64 + fr, col0 = u.pn * BM + wc * 32 + 4 * fq;
        f32x4 gv[2][2];
#pragma unroll
        for (int bj = 0; bj < 2; ++bj)
#pragma unroll
            for (int n = 0; n < 2; ++n) gv[bj][n] = *(const f32x4*)(gate + col0 + bj * HALF + n * 16) + 1.0f;
#pragma unroll
        for (int ai = 0; ai < 2; ++ai)
#pragma unroll
            for (int m = 0; m < 4; ++m) { const size_t off = (size_t)(row0 + ai * HALF + m * 16) * ldc + col0;
#pragma unroll
                for (int bj = 0; bj < 2; ++bj)
#pragma unroll
                    for (int n = 0; n < 2; ++n) { const f32x4 xr = *(const f32x4*)(xres + off + bj * HALF + n * 16);
                        *(f32x4*)(z + off + bj * HALF + n * 16) = xr * alpha + gv[bj][n] * acc[ai][bj][m][n]; }
                if (m == 3) asm volatile("" ::: "memory"); }
    }
};
struct EpiSwiglu {
    static constexpr bool PERM = true, AFTER_DRAIN = false;
    bf16_t* H; int ldc;
    __device__ __forceinline__ void operator()(const f32x4 (&acc)[2][2][4][2], const Unit& u, int wr, int wc, int fr, int fq) const {
        const int row0 = u.pm * BM + wr * 64 + fr, col0 = u.pn * HALF + wc * 32 + 8 * fq;
#pragma unroll
        for (int ai = 0; ai < 2; ++ai)
#pragma unroll
            for (int m = 0; m < 4; ++m) { f32x4 h[2];
#pragma unroll
                for (int n = 0; n < 2; ++n) { const f32x4 g = acc[ai][0][m][n], up = acc[ai][1][m][n];
#pragma unroll
                    for (int j = 0; j < 4; ++j) h[n][j] = g[j] * __builtin_amdgcn_rcpf(1.0f + __builtin_amdgcn_exp2f(-1.4426950408889634f * g[j])) * up[j]; }
                *(u32x4*)(H + (size_t)(row0 + ai * HALF + m * 16) * ldc + col0) = pack8(h[0], h[1]); }
    }
};
template <class Epi, class Sched, bool ALIGN_EPI = false, bool SP2 = false>
__device__ __forceinline__ void gemm_phase(PG8_LAS unsigned char* lds, const Gemm g, const Sched& S, const Epi& E) {
    int tid_ = threadIdx.x; asm volatile("" : "+v"(tid_)); const int tid = tid_, wid = __builtin_amdgcn_readfirstlane(tid >> 6), lane = tid & 63, wr = wid >> 2, wc = wid & 3, fr = lane & 15, fq = lane >> 4;
    int Kv_ = g.K, lda_ = g.lda; asm volatile("" : "+s"(Kv_), "+s"(lda_)); const int K = Kv_, nt = K / BK;
    unsigned voffA[2], voffB[2];
#pragma unroll
    for (int i = 0; i < 2; ++i) { int R, C; stage_rc(tid * 16 + i * 8192, R, C); const int Rb = Epi::PERM ? ((R & ~31) + perm32(R & 31)) : R;
        voffA[i] = (unsigned)(R * lda_ + C) * 2u; voffB[i] = (unsigned)(Rb * K + C) * 2u; }
    const size_t kstep = (size_t)(BK * 2);
    const size_t hstepA = (size_t)HALF * lda_ * 2, hstepB = (size_t)HALF * K * 2;
    const size_t tstepA = 2 * hstepA, tstepB = 2 * hstepB;
    const unsigned ldsw = (unsigned)wid * 1024u;
    const int aoff = lds_byte(wr * 64 + fr, fq * 8), boff = lds_byte(wc * 32 + fr, fq * 8);
#define PG8_SA(b, h) (((b) * 2 + (h)) * HTB)
#define PG8_SB(b, h) ((4 + (b) * 2 + (h)) * HTB)
#define PG8_STAGE(bufoff, gbase, voff) do { _Pragma("unroll") for (int _i = 0; _i < 2; ++_i) \
        __builtin_amdgcn_global_load_lds((const unsigned*)((const char*)(gbase) + (voff)[_i]), (PG8_LAS unsigned*)(lds + (bufoff) + ldsw + _i * 8192), 16, 0, 0); } while (0)
#define PG8_LDA(dst, b, h) do { _Pragma("unroll") for (int m = 0; m < 4; ++m) _Pragma("unroll") for (int k = 0; k < 2; ++k) dst[m][k] = *(const PG8_LAS bf16x8*)(lds + PG8_SA(b, h) + aoff + m * 2048 + k * 1024); } while (0)
#define PG8_LDB(dst, b, h) do { _Pragma("unroll") for (int n = 0; n < 2; ++n) _Pragma("unroll") for (int k = 0; k < 2; ++k) dst[n][k] = *(const PG8_LAS bf16x8*)(lds + PG8_SB(b, h) + boff + n * 2048 + k * 1024); } while (0)
#define PG8_MMA(ai, bj, At, Bt) do { __builtin_amdgcn_s_setprio(1); _Pragma("unroll") for (int m = 0; m < 4; ++m) _Pragma("unroll") for (int n = 0; n < 2; ++n) _Pragma("unroll") for (int k = 0; k < 2; ++k) \
        acc[ai][bj][m][n] = __builtin_amdgcn_mfma_f32_16x16x32_bf16(Bt[n][k], At[m][k], acc[ai][bj][m][n], 0, 0, 0); __builtin_amdgcn_s_setprio(0); } while (0)
#define PG8_WAIT_V(n) asm volatile("s_waitcnt vmcnt(" #n ")" ::: "memory")
#define PG8_WAIT_L(n) asm volatile("s_waitcnt lgkmcnt(" #n ")" ::: "memory")
#define PG8_BAR __builtin_amdgcn_s_barrier()
#define PG8_SCHED __builtin_amdgcn_sched_barrier(0)
    Unit cur, nxt; int ui = 0;
    if (!S.next(0, cur)) return;
    f32x4 acc[2][2][4][2];
#pragma unroll
    for (int a = 0; a < 2; ++a)
#pragma unroll
        for (int b = 0; b < 2; ++b)
#pragma unroll
            for (int m = 0; m < 4; ++m)
#pragma unroll
                for (int n = 0; n < 2; ++n) acc[a][b][m][n] = (f32x4){0.f, 0.f, 0.f, 0.f};
    bf16x8 At[4][2], B0[2][2], B1[2][2];
    const char* cA = (const char*)g.A + (size_t)cur.pm * tstepA; const char* cB = (const char*)g.Bt + (size_t)cur.pn * tstepB;
    S.a_ready(cur);
    if constexpr (SP2) {
        PG8_STAGE(PG8_SB(0, 0), cB, voffB); PG8_STAGE(PG8_SB(0, 1), cB + hstepB, voffB); PG8_STAGE(PG8_SA(0, 0), cA, voffA); PG8_STAGE(PG8_SA(0, 1), cA + hstepA, voffA);
        if (wr == 1) PG8_BAR;
        PG8_WAIT_V(2); PG8_BAR;
        PG8_STAGE(PG8_SB(1, 0), cB + kstep, voffB); PG8_STAGE(PG8_SA(1, 0), cA + kstep, voffA); PG8_STAGE(PG8_SB(1, 1), cB + hstepB + kstep, voffB);
        PG8_WAIT_V(6); PG8_BAR;
    } else {
        PG8_STAGE(PG8_SB(0, 0), cB, voffB); PG8_STAGE(PG8_SA(0, 0), cA, voffA); PG8_STAGE(PG8_SB(0, 1), cB + hstepB, voffB); PG8_STAGE(PG8_SA(0, 1), cA + hstepA, voffA);
        if (wr == 1) PG8_BAR;
        PG8_WAIT_V(4); PG8_BAR;
        PG8_STAGE(PG8_SB(1, 0), cB + kstep, voffB); PG8_STAGE(PG8_SA(1, 0), cA + kstep, voffA); PG8_STAGE(PG8_SB(1, 1), cB + hstepB + kstep, voffB);
        PG8_WAIT_V(6); PG8_BAR;
    }
    for (;;) {
        const bool has_next = S.next(ui + 1, nxt);
        const char* nA = has_next ? (const char*)g.A + (size_t)nxt.pm * tstepA : cA; const char* nB = has_next ? (const char*)g.Bt + (size_t)nxt.pn * tstepB : cB;
        for (int t = 0; t < nt; t += 2) {
            const bool last = (t == nt - 2);
            const char* a1 = cA + (size_t)(t + 1) * kstep;
            const char* a2 = last ? nA : cA + (size_t)(t + 2) * kstep; const char* b2 = last ? nB : cB + (size_t)(t + 2) * kstep;
            const char* a3 = a2 + kstep; const char* b3 = b2 + kstep;
            if (last && has_next) S.a_ready(nxt);
            if constexpr (SP2) {
            PG8_LDB(B0, 0, 0); PG8_LDB(B1, 0, 1); PG8_SCHED; PG8_LDA(At, 0, 0); PG8_STAGE(PG8_SA(1, 1), a1 + hstepA, voffA);
            PG8_WAIT_V(8); PG8_WAIT_L(0); PG8_BAR; PG8_MMA(0, 0, At, B0); PG8_MMA(0, 1, At, B1); PG8_BAR; PG8_SCHED;
            PG8_LDA(At, 0, 1); PG8_STAGE(PG8_SB(0, 0), b2, voffB); PG8_STAGE(PG8_SB(0, 1), b2 + hstepB, voffB); PG8_STAGE(PG8_SA(0, 0), a2, voffA);
            PG8_WAIT_V(8); PG8_WAIT_L(0); PG8_BAR; PG8_MMA(1, 0, At, B0); PG8_MMA(1, 1, At, B1); PG8_BAR; PG8_SCHED;
            PG8_LDB(B0, 1, 0); PG8_LDB(B1, 1, 1); PG8_SCHED; PG8_LDA(At, 1, 0); PG8_STAGE(PG8_SA(0, 1), a2 + hstepA, voffA);
            PG8_WAIT_V(8); PG8_WAIT_L(0); PG8_BAR; PG8_MMA(0, 0, At, B0); PG8_MMA(0, 1, At, B1); PG8_BAR; PG8_SCHED;
            PG8_LDA(At, 1, 1); PG8_STAGE(PG8_SB(1, 0), b3, voffB); PG8_STAGE(PG8_SB(1, 1), b3 + hstepB, voffB); PG8_STAGE(PG8_SA(1, 0), a3, voffA);
            PG8_WAIT_V(8); PG8_WAIT_L(0); PG8_BAR; PG8_MMA(1, 0, At, B0); PG8_MMA(1, 1, At, B1); PG8_BAR; PG8_SCHED;
            } else {
            PG8_LDB(B0, 0, 0); PG8_SCHED; PG8_LDA(At, 0, 0); PG8_STAGE(PG8_SA(1, 1), a1 + hstepA, voffA);
            PG8_WAIT_L(8); PG8_BAR; PG8_WAIT_L(0); PG8_MMA(0, 0, At, B0); PG8_BAR; PG8_SCHED;
            PG8_LDB(B1, 0, 1); PG8_STAGE(PG8_SB(0, 0), b2, voffB);
            PG8_BAR; PG8_WAIT_L(0); PG8_MMA(0, 1, At, B1); PG8_BAR;
            PG8_LDA(At, 0, 1); PG8_STAGE(PG8_SA(0, 0), a2, voffA);
            PG8_BAR; PG8_WAIT_L(0); PG8_MMA(1, 0, At, B0); PG8_BAR; PG8_SCHED;
            PG8_STAGE(PG8_SB(0, 1), b2 + hstepB, voffB);
            PG8_WAIT_V(6); PG8_BAR; PG8_MMA(1, 1, At, B1); PG8_BAR;
            PG8_LDB(B0, 1, 0); PG8_SCHED; PG8_LDA(At, 1, 0); PG8_STAGE(PG8_SA(0, 1), a2 + hstepA, voffA);
            PG8_WAIT_L(8); PG8_BAR; PG8_WAIT_L(0); PG8_MMA(0, 0, At, B0); PG8_BAR; PG8_SCHED;
            PG8_LDB(B1, 1, 1); PG8_STAGE(PG8_SB(1, 0), b3, voffB);
            PG8_BAR; PG8_WAIT_L(0); PG8_MMA(0, 1, At, B1); PG8_BAR;
            PG8_LDA(At, 1, 1); PG8_STAGE(PG8_SA(1, 0), a3, voffA);
            PG8_BAR; PG8_WAIT_L(0); PG8_MMA(1, 0, At, B0); PG8_BAR; PG8_SCHED;
            PG8_STAGE(PG8_SB(1, 1), b3 + hstepB, voffB);
            PG8_WAIT_V(6); PG8_BAR; PG8_MMA(1, 1, At, B1); PG8_BAR;
            }
        }
        if constexpr (ALIGN_EPI) { if (wr == 0) PG8_BAR; }
        if constexpr (!Epi::AFTER_DRAIN) { E(acc, cur, wr, wc, fr, fq); S.done(cur); }
        if (!has_next) break;
#pragma unroll
        for (int a = 0; a < 2; ++a)
#pragma unroll
            for (int b = 0; b < 2; ++b)
#pragma unroll
                for (int m = 0; m < 4; ++m)
#pragma unroll
                    for (int n = 0; n < 2; ++n) acc[a][b][m][n] = (f32x4){0.f, 0.f, 0.f, 0.f};
        cur = nxt; cA = nA; cB = nB; ++ui;
        if constexpr (ALIGN_EPI) { if (wr == 1) PG8_BAR; }
    }
    PG8_WAIT_V(0);
    if constexpr (!ALIGN_EPI) { if (wr == 0) PG8_BAR; }
    PG8_BAR;
    if constexpr (Epi::AFTER_DRAIN) { E.fused(acc, cur, wr, wc, fr, fq, lds, wid, lane); S.done(cur); }
#undef PG8_SA
#undef PG8_SB
#undef PG8_STAGE
#undef PG8_LDA
#undef PG8_LDB
#undef PG8_MMA
#undef PG8_WAIT_V
#undef PG8_WAIT_L
#undef PG8_BAR
#undef PG8_SCHED
}
}

#define LAS __attribute__((address_space(3)))
typedef unsigned short bf16_t;
typedef float f32x4 __attribute__((ext_vector_type(4)));
typedef unsigned u32x4 __attribute__((ext_vector_type(4)));
typedef unsigned u32x2 __attribute__((ext_vector_type(2)));
constexpr int S = 8192, DM = 2048, DEPTH = 2, DIN = 3648, DINP = 3840, DFF = 5632;
constexpr int QLD = 1280, KLD = 1152, VLD = 768;
constexpr int C_QA = 0, C_KA = 512, C_VA = 1024, C_CQ = 1536, C_CKV = 2048, C_KR = 2304, C_QC = 2368, C_KC = 3136, C_VC = 3392;
constexpr float ALPHA = 1.4142135623730951f;
constexpr size_t al256(size_t x) { return (x + 255) / 256 * 256; }
constexpr size_t SZ_WIN = (size_t)DINP * DM * 2, SZ_WUQ = (size_t)1280 * 512 * 2, SZ_WUKV = (size_t)1536 * 256 * 2, SZ_WO = (size_t)DM * DM * 2, SZ_WGU = (size_t)2 * DFF * DM * 2, SZ_WDN = (size_t)DM * DFF * 2;
constexpr size_t O_WIN = 0, O_WUQ = O_WIN + SZ_WIN, O_WUKV = O_WUQ + SZ_WUQ, O_WO = O_WUKV + SZ_WUKV, O_WGU = O_WO + SZ_WO, O_WDN = O_WGU + SZ_WGU, SZ_WL = O_WDN + SZ_WDN;
constexpr size_t WS_W = 0;
constexpr size_t WS_MOD = al256(WS_W + DEPTH * SZ_WL);
constexpr size_t WS_ROPE = al256(WS_MOD + (size_t)DEPTH * 6 * DM * 4);
constexpr size_t WS_RSQ = al256(WS_ROPE + (size_t)S * 64 * 4);
constexpr size_t WS_RSKV = al256(WS_RSQ + (size_t)S * 4);
constexpr size_t WS_X = al256(WS_RSKV + (size_t)S * 4);
constexpr size_t WS_U = al256(WS_X + (size_t)S * DM * 4);
constexpr size_t WS_PROJ = al256(WS_U + (size_t)S * DM * 2);
constexpr size_t WS_Q = al256(WS_PROJ + (size_t)S * DINP * 2);
constexpr size_t WS_K = al256(WS_Q + (size_t)S * QLD * 2);
constexpr size_t WS_V = al256(WS_K + (size_t)S * KLD * 2);
constexpr size_t WS_Y = al256(WS_V + (size_t)S * VLD * 2);
constexpr size_t WS_H = al256(WS_Y + (size_t)S * DM * 2);
constexpr size_t WS_PART = al256(WS_H + (size_t)S * DFF * 2);
constexpr size_t WS_STAT = al256(WS_PART + (size_t)4 * S * VLD * 2);
constexpr size_t WS_SSQ = al256(WS_STAT + (size_t)4 * 6 * S * 2 * 4);
constexpr size_t WS_BAR0_ = WS_SSQ + (size_t)S * 12 * 4;
constexpr size_t WS_BAR = al256(WS_BAR0_);
constexpr size_t WS_END = al256(WS_BAR + 16384);
constexpr int TAB_OFF = pg8::STAGE_BYTES, LDS_BYTES = pg8::STAGE_BYTES + 256;
constexpr int NTHREADS = 512;

struct Args { const float* in[19]; float* out; unsigned char* ws; int ph_lo, ph_hi; };
struct Tab {
    const LAS unsigned* t;
    __device__ __forceinline__ unsigned long long ld(int i) const { const unsigned lo = __builtin_amdgcn_readfirstlane(t[2 * i]), hi = __builtin_amdgcn_readfirstlane(t[2 * i + 1]); return ((unsigned long long)hi << 32) | lo; }
    __device__ __forceinline__ const float* in(int i) const { return (const float*)ld(i); }
    __device__ __forceinline__ float* out() const { return (float*)ld(19); }
    __device__ __forceinline__ unsigned char* wsp() const { return (unsigned char*)ld(20); }
};

__device__ __forceinline__ float bf2f(unsigned short b) { return __uint_as_float((unsigned)b << 16); }
__device__ __forceinline__ float wave_sum(float v) {
#pragma unroll
    for (int o = 32; o; o >>= 1) v += __shfl_xor(v, o);
    return v; }
using pg8::cvt_pk_bf16;
__device__ __forceinline__ int otid() { int t = threadIdx.x; asm volatile("" : "+v"(t)); return t; }

__device__ __forceinline__ void phase_mod(const Tab tb, unsigned char* lds_g) {
    unsigned char* ws_ = tb.wsp(); const float* in1 = tb.in(1); const float* in2 = tb.in(2); const float* in3 = tb.in(3);
    float* condL = (float*)lds_g; f32x4* red = (f32x4*)(lds_g + 8192);
    const int tid = otid();
    const float* c = in1;
    for (int i = tid; i < DM; i += NTHREADS) { const float v = c[i]; condL[i] = v / (1.0f + __expf(-v)); }
    __syncthreads();
    float* mod = (float*)(ws_ + WS_MOD);
    const int cl = tid & 31, kg = tid >> 5;
    for (int item = blockIdx.x; item < DEPTH * 96; item += gridDim.x) {
        const int l = item / 96, cgp = item % 96;
        const float* W = in2 + (size_t)l * DM * 6 * DM + (size_t)(kg * 128) * (6 * DM) + cgp * 128 + 4 * cl;
        f32x4 acc = {0.f, 0.f, 0.f, 0.f};
#pragma unroll 8
        for (int kk = 0; kk < 128; ++kk) { const f32x4 w = __builtin_nontemporal_load((const f32x4*)(W + (size_t)kk * (6 * DM))); acc += w * condL[kg * 128 + kk]; }
        red[kg * 32 + cl] = acc;
        __syncthreads();
        if (tid < 128) { float s = 0.f; const float* rf = (const float*)red;
            for (int g = 0; g < 16; ++g) s += rf[g * 128 + tid];
            mod[l * 6 * DM + cgp * 128 + tid] = s + in3[l * 6 * DM + cgp * 128 + tid]; }
        __syncthreads();
    }
}

template <int PERMT>
__device__ __forceinline__ int dst_row(int n) {
    if (PERMT == 1) { const int h = n / 192, d = n % 192; if (d < 128) return n; const int j = d - 128; return h * 192 + 128 + 2 * (j & 31) + (j >> 5); }
    if (PERMT == 3) { if (n < C_KR || n >= C_KR + 64) return n; const int j = n - C_KR; return C_KR + 2 * (j & 31) + (j >> 5); }
    if (PERMT == 2) { if (n < DFF) return 256 * (n >> 7) + (n & 127); const int m = n - DFF; return 256 * (m >> 7) + 128 + (m & 127); }
    return n;
}
template <int PERMT>
__device__ __forceinline__ void transpose_job(const float* __restrict__ src, bf16_t* __restrict__ dst, int K, int N, int Npad, const float* __restrict__ kscale, unsigned char* lds_g, int first, int stride) {
    float* T = (float*)lds_g;
    const int tid = otid(), nkt = K / 64, nnt = (N + 255) / 256, ntiles = nkt * nnt;
    for (int t = first; t < ntiles; t += stride) {
        const int k0 = (t % nkt) * 64, n0 = (t / nkt) * 256;
        { const int kk = tid >> 6, n4 = tid & 63; const bool ok = n0 + 4 * n4 < N; f32x4 v[8];
#pragma unroll
          for (int i = 0; i < 8; ++i) { const int k = k0 + kk + 8 * i; v[i] = ok ? __builtin_nontemporal_load((const f32x4*)(src + (size_t)k * N + n0 + 4 * n4)) : (f32x4){0.f, 0.f, 0.f, 0.f}; }
#pragma unroll
          for (int i = 0; i < 8; ++i) { const int k = k0 + kk + 8 * i; if (kscale) v[i] = v[i] * kscale[k];
              float* tp = T + (kk + 8 * i) * 257 + 4 * n4; tp[0] = v[i][0]; tp[1] = v[i][1]; tp[2] = v[i][2]; tp[3] = v[i][3]; } }
        __syncthreads();
        { const int n = tid >> 1, ks = tid & 1;
          if (n0 + n < N) { bf16_t* dp = dst + (size_t)dst_row<PERMT>(n0 + n) * K + k0 + 32 * ks;
#pragma unroll
            for (int eb = 0; eb < 4; ++eb) { float v[8];
#pragma unroll
              for (int e = 0; e < 8; ++e) v[e] = T[(32 * ks + 8 * eb + e) * 257 + n];
              u32x4 w; w.x = cvt_pk_bf16(v[0], v[1]); w.y = cvt_pk_bf16(v[2], v[3]); w.z = cvt_pk_bf16(v[4], v[5]); w.w = cvt_pk_bf16(v[6], v[7]);
              *(u32x4*)(dp + 8 * eb) = w; } } }
        __syncthreads();
    }
    const size_t nz = (size_t)(Npad - N) * K / 8;
    for (size_t i = (size_t)blockIdx.x * NTHREADS + tid; i < nz; i += (size_t)gridDim.x * NTHREADS) *(u32x4*)(dst + (size_t)N * K + i * 8) = (u32x4){0u, 0u, 0u, 0u};
}

__device__ __forceinline__ void modulate_rows(const float* __restrict__ x, const float* __restrict__ sc, const float* __restrict__ sh, bf16_t* __restrict__ u) {
    const size_t n8 = (size_t)S * DM / 8;
    for (size_t i = (size_t)blockIdx.x * NTHREADS + otid(); i < n8; i += (size_t)gridDim.x * NTHREADS) {
        const int col = (int)((i * 8) % DM);
        const f32x4 x0 = *(const f32x4*)(x + i * 8), x1 = *(const f32x4*)(x + i * 8 + 4);
        const f32x4 s0 = *(const f32x4*)(sc + col) + 1.0f, s1 = *(const f32x4*)(sc + col + 4) + 1.0f;
        const f32x4 h0 = *(const f32x4*)(sh + col), h1 = *(const f32x4*)(sh + col + 4);
        *(u32x4*)(u + i * 8) = pg8::pack8(x0 * s0 + h0, x1 * s1 + h1);
    }
}

__device__ __forceinline__ void rope_table(float* __restrict__ rope) {
    for (int i = blockIdx.x * NTHREADS + otid(); i < S * 32; i += gridDim.x * NTHREADS) {
        const int pos = i >> 5, j = i & 31;
        const float inv = exp2f(-(float)j * (13.287712379549449f / 32.0f));
        const float ang = (float)pos * inv;
        const double rev = (double)ang * 0.15915494309189535;
        const double fr = rev - floor(rev);
        const float ar = (float)(fr * 6.283185307179586);
        rope[(size_t)pos * 64 + j] = cosf(ar); rope[(size_t)pos * 64 + 32 + j] = sinf(ar);
    }
}

__device__ __forceinline__ void phase_prep(unsigned char* ws_) {
    const bf16_t* proj = (const bf16_t*)(ws_ + WS_PROJ); const float* rope = (const float*)(ws_ + WS_ROPE);
    float* rsq = (float*)(ws_ + WS_RSQ); float* rskv = (float*)(ws_ + WS_RSKV); bf16_t* Kb = (bf16_t*)(ws_ + WS_K);
    const int tid_o = otid(), lane = tid_o & 63, wave = tid_o >> 6;
    for (int r = blockIdx.x * 8 + wave; r < S; r += gridDim.x * 8) {
        const bf16_t* pr = proj + (size_t)r * DINP;
        { const u32x4 w = *(const u32x4*)(pr + C_CQ + 8 * lane); float ss = 0.f;
#pragma unroll
          for (int e = 0; e < 4; ++e) { const float lo = __uint_as_float(w[e] << 16), hi = __uint_as_float(w[e] & 0xffff0000u); ss += lo * lo + hi * hi; }
          ss = wave_sum(ss); if (lane == 0) rsq[r] = 1.0f / sqrtf(ss * (1.0f / 512.0f) + 1e-6f); }
        { const u32x2 w = *(const u32x2*)(pr + C_CKV + 4 * lane); float ss = 0.f;
#pragma unroll
          for (int e = 0; e < 2; ++e) { const float lo = __uint_as_float(w[e] << 16), hi = __uint_as_float(w[e] & 0xffff0000u); ss += lo * lo + hi * hi; }
          ss = wave_sum(ss); if (lane == 0) rskv[r] = 1.0f / sqrtf(ss * (1.0f / 256.0f) + 1e-6f); }
        { const int i = lane & 31; const float x1 = bf2f(pr[C_KR + i]), x2 = bf2f(pr[C_KR + 32 + i]);
          const float c = rope[(size_t)r * 64 + i], sn = rope[(size_t)r * 64 + 32 + i];
          const unsigned w = cvt_pk_bf16(x1 * c - x2 * sn, x2 * c + x1 * sn);
          const int hb = (lane >> 5) * 3;
#pragma unroll
          for (int h = 0; h < 3; ++h) *(unsigned*)(Kb + (size_t)r * KLD + (hb + h) * 192 + 128 + 2 * i) = w; }
    }
}

__device__ __forceinline__ void phase_ynorm(unsigned char* ws_) {
    bf16_t* y = (bf16_t*)(ws_ + WS_Y); const bf16_t* part = (const bf16_t*)(ws_ + WS_PART); const float* stat = (const float*)(ws_ + WS_STAT);
    const int tid_o = otid(), lane = tid_o & 63, wave = tid_o >> 6;
    const bool lowhalf = lane < 32;
    for (int r = blockIdx.x * 8 + wave; r < S; r += gridDim.x * 8) {
        bf16_t* yr = y + (size_t)r * DM;
        float v[4][8]; float ss[4];
#pragma unroll
        for (int j = 0; j < 4; ++j) {
            const bool fromPart = (j == 1) || (j == 2 && lowhalf);
            if (!fromPart) { const u32x4 w = *(const u32x4*)(yr + j * 512 + 8 * lane);
#pragma unroll
                for (int e = 0; e < 4; ++e) { v[j][2 * e] = __uint_as_float(w[e] << 16); v[j][2 * e + 1] = __uint_as_float(w[e] & 0xffff0000u); } }
            else { const int yb = j * 512 + 8 * lane - 512, h = yb >> 7; float m[4], lw[4];
#pragma unroll
                for (int i = 0; i < 4; ++i) { const float* st = stat + ((size_t)(i * 6 + h) * S + r) * 2; m[i] = st[0]; lw[i] = st[1]; }
                const float M = fmaxf(fmaxf(m[0], m[1]), fmaxf(m[2], m[3])); float W = 0.f;
#pragma unroll
                for (int i = 0; i < 4; ++i) { lw[i] *= __builtin_amdgcn_exp2f(m[i] - M); W += lw[i]; }
                const float rW = 1.0f / W;
#pragma unroll
                for (int e = 0; e < 8; ++e) v[j][e] = 0.f;
#pragma unroll
                for (int i = 0; i < 4; ++i) { const u32x4 w = *(const u32x4*)(part + ((size_t)i * S + r) * VLD + yb); const float wi = lw[i] * rW;
#pragma unroll
                    for (int e = 0; e < 4; ++e) { v[j][2 * e] += wi * __uint_as_float(w[e] << 16); v[j][2 * e + 1] += wi * __uint_as_float(w[e] & 0xffff0000u); } } }
            float sq = 0.f;
#pragma unroll
            for (int e = 0; e < 8; ++e) sq += v[j][e] * v[j][e];
            ss[j] = sq;
        }
        const float sA = wave_sum(ss[0]);
        const float sB = wave_sum(ss[1] + (lowhalf ? ss[2] : 0.f));
        const float sC = wave_sum(ss[3] + (lowhalf ? 0.f : ss[2]));
        const float rA = 1.0f / sqrtf(sA * (1.0f / 512.0f) + 1e-6f), rB = 1.0f / sqrtf(sB * (1.0f / 768.0f) + 1e-6f), rC = 1.0f / sqrtf(sC * (1.0f / 768.0f) + 1e-6f);
#pragma unroll
        for (int j = 0; j < 4; ++j) { const float sc = j == 0 ? rA : (j == 1 ? rB : (j == 2 ? (lowhalf ? rB : rC) : rC)); u32x4 o;
#pragma unroll
            for (int e = 0; e < 4; ++e) o[e] = cvt_pk_bf16(v[j][2 * e] * sc, v[j][2 * e + 1] * sc);
            *(u32x4*)(yr + j * 512 + 8 * lane) = o; }
    }
}

__device__ __forceinline__ void phase_ln(const float* z, float* xo, const float* __restrict__ g, const float* __restrict__ b, const float* __restrict__ sc, const float* __restrict__ sh, bf16_t* __restrict__ u) {
    const int tid_o = otid(), lane = tid_o & 63, wave = tid_o >> 6;
    const int stride = gridDim.x * 8;
    for (int r = blockIdx.x * 8 + wave; r < S; r += 2 * stride) {
        const bool hasB = r + stride < S; const int rr[2] = {r, hasB ? r + stride : r};
        f32x4 v[2][8]; float s[2] = {0.f, 0.f};
#pragma unroll
        for (int k = 0; k < 2; ++k) { const float* zr = z + (size_t)rr[k] * DM;
#pragma unroll
            for (int j = 0; j < 8; ++j) v[k][j] = *(const f32x4*)(zr + j * 256 + 4 * lane); }
#pragma unroll
        for (int k = 0; k < 2; ++k)
#pragma unroll
            for (int j = 0; j < 8; ++j) s[k] += (v[k][j][0] + v[k][j][1]) + (v[k][j][2] + v[k][j][3]);
        float mean[2], rstd[2];
#pragma unroll
        for (int k = 0; k < 2; ++k) { mean[k] = wave_sum(s[k]) * (1.0f / DM); float q = 0.f;
#pragma unroll
            for (int j = 0; j < 8; ++j) { const f32x4 d = v[k][j] - mean[k]; q += (d[0] * d[0] + d[1] * d[1]) + (d[2] * d[2] + d[3] * d[3]); }
            rstd[k] = 1.0f / sqrtf(wave_sum(q) * (1.0f / DM) + 1e-5f); }
#pragma unroll
        for (int j = 0; j < 8; ++j) { const int col = j * 256 + 4 * lane;
            const f32x4 gg = *(const f32x4*)(g + col), bb = *(const f32x4*)(b + col);
            f32x4 s1 = {0.f, 0.f, 0.f, 0.f}, h1 = {0.f, 0.f, 0.f, 0.f};
            if (u) { s1 = *(const f32x4*)(sc + col) + 1.0f; h1 = *(const f32x4*)(sh + col); }
#pragma unroll
            for (int k = 0; k < 2; ++k) { if (k == 1 && !hasB) continue;
                const f32x4 o = (v[k][j] - mean[k]) * rstd[k] * gg + bb;
                *(f32x4*)(xo + (size_t)rr[k] * DM + col) = o;
                if (u) { const f32x4 m = o * s1 + h1; u32x2 w; w.x = cvt_pk_bf16(m[0], m[1]); w.y = cvt_pk_bf16(m[2], m[3]); *(u32x2*)(u + (size_t)rr[k] * DM + col) = w; } } }
    }
}

template <int MODE>
__device__ __forceinline__ void naive_attn(unsigned char* ws_, const float* rpb, const float* sink, int l) {
    constexpr int DQK = MODE == 1 ? 192 : 128, NJ = DQK / 64, H = MODE == 0 ? 4 : 6;
    const bf16_t* proj = (const bf16_t*)(ws_ + WS_PROJ); bf16_t* y = (bf16_t*)(ws_ + WS_Y);
    const int tid_o = otid(), lane = tid_o & 63, wave = tid_o >> 6;
    for (int it = blockIdx.x * 8 + wave; it < S * H; it += gridDim.x * 8) {
        const int h = it / S, q = it % S;
        const bf16_t *Qp, *Kp, *Vp; int ldk, ldv, ycol; float scale;
        if (MODE == 0) { Qp = proj + (size_t)q * DINP + C_QA + 128 * h; Kp = proj + C_KA + 128 * h; Vp = proj + C_VA + 128 * h; ldk = DINP; ldv = DINP; ycol = 128 * h; scale = 0.08838834764831845f; }
        else if (MODE == 1) { Qp = (const bf16_t*)(ws_ + WS_Q) + (size_t)q * QLD + 192 * h; Kp = (const bf16_t*)(ws_ + WS_K) + 192 * h; Vp = (const bf16_t*)(ws_ + WS_V) + 128 * h; ldk = KLD; ldv = VLD; ycol = 512 + 128 * h; scale = 0.07216878364870322f; }
        else { Qp = proj + (size_t)q * DINP + C_QC + 128 * h; Kp = proj + C_KC + 128 * (h / 3); Vp = proj + C_VC + 128 * (h / 3); ldk = DINP; ldv = DINP; ycol = 1280 + 128 * h; scale = 0.08838834764831845f; }
        float qv[NJ];
#pragma unroll
        for (int j = 0; j < NJ; ++j) qv[j] = bf2f(Qp[64 * j + lane]) * scale;
        float m = -1e30f, ls = 0.f, o0 = 0.f, o1 = 0.f; int nkeys, klo = 0, r = 0, col = 0, r0 = 0, c0 = 0; float slope = 0.f;
        if (MODE == 0) { r = q >> 6; col = q & 63; r0 = min(max(r - 4, 0), 120); c0 = min(max(col - 8, 0), 48); nkeys = 128; }
        else if (MODE == 1) nkeys = S;
        else { klo = max(0, q - 128); nkeys = min(S - 1, q + 128) - klo + 1; m = sink[l * 6 + h]; ls = 1.f; slope = exp2f(-8.0f * (float)(h + 1) / 6.0f); }
        for (int kk = 0; kk < nkeys; ++kk) {
            int key; float bias = 0.f;
            if (MODE == 0) { const int krow = r0 + (kk >> 4), kcol = c0 + (kk & 15); key = krow * 64 + kcol; bias = rpb[((l * 4 + h) * 15 + (krow - r + 7)) * 31 + (kcol - col + 15)]; }
            else if (MODE == 1) key = kk;
            else { key = klo + kk; bias = -slope * fabsf((float)(q - key)); }
            float part = 0.f;
#pragma unroll
            for (int j = 0; j < NJ; ++j) part += qv[j] * bf2f(Kp[(size_t)key * ldk + 64 * j + lane]);
            const float s = wave_sum(part) + bias;
            const float mn = fmaxf(m, s), al = __expf(m - mn), p = __expf(s - mn);
            ls = ls * al + p;
            o0 = o0 * al + p * bf2f(Vp[(size_t)key * ldv + lane]); o1 = o1 * al + p * bf2f(Vp[(size_t)key * ldv + 64 + lane]);
            m = mn;
        }
        const float inv = 1.0f / ls;
        y[(size_t)q * DM + ycol + lane] = (bf16_t)(cvt_pk_bf16(o0 * inv, 0.f) & 0xffffu);
        y[(size_t)q * DM + ycol + 64 + lane] = (bf16_t)(cvt_pk_bf16(o1 * inv, 0.f) & 0xffffu);
    }
}

#define XB_TMO      128
#define XB_XCNT(j)  (256  + 64 * (j))
#define XB_XSUB(j)  (1280 + 64 * (j))
#define XB_XGEN(j)  (2304 + 64 * (j))
#define XB_TOP      3328
#define XB_TOPGEN   3392
#define XCD_BAR_WORDS 3456
#define XB_SPIN_CAP (1u << 18)

__device__ __forceinline__ unsigned xb_ld(unsigned* p)              { return __hip_atomic_load(p, __ATOMIC_RELAXED, __HIP_MEMORY_SCOPE_AGENT); }
__device__ __forceinline__ unsigned xb_add(unsigned* p, unsigned v) { return __hip_atomic_fetch_add(p, v, __ATOMIC_RELAXED, __HIP_MEMORY_SCOPE_AGENT); }
__device__ __forceinline__ unsigned xb_xcc_id() { return (unsigned)__builtin_amdgcn_s_getreg((3 << 11) | 20) & 0xFu; }
#define XB_SPIN(cond, bar) do { unsigned _sp = 0; while (cond) { __builtin_amdgcn_s_sleep(1); \
    if ((++_sp & 255u) == 0u) { if (xb_ld(&(bar)[XB_TMO])) break; if (_sp > XB_SPIN_CAP) { atomicAdd(&(bar)[XB_TMO], 1u); break; } } } } while (0)

struct XcdBarrier {
    unsigned* bar; unsigned x;
    volatile LAS unsigned* st;
};

__device__ __forceinline__ XcdBarrier xcd_barrier_post(unsigned* bar, volatile LAS unsigned* st) {
    XcdBarrier b; b.bar = bar; b.x = xb_xcc_id(); b.st = st;
    if (threadIdx.x == 0) (void)xb_add(&bar[XB_XCNT(b.x)], 1u);
    return b;
}
__device__ __forceinline__ void xcd_barrier_complete(unsigned* bar, unsigned x, unsigned& nloc, unsigned& nx) {
    const unsigned G = gridDim.x * gridDim.y * gridDim.z;
    unsigned sum, cnt, mine, sp = 0u;
    for (;;) {
        sum = 0u; cnt = 0u; mine = 0u;
#pragma unroll
        for (unsigned j = 0; j < 16; ++j) { const unsigned c = xb_ld(&bar[XB_XCNT(j)]); sum += c; cnt += (c > 0u) ? 1u : 0u; mine = (j == x) ? c : mine; }
        if (sum == G) break;
        __builtin_amdgcn_s_sleep(1);
        if ((++sp & 255u) == 0u) { if (xb_ld(&bar[XB_TMO])) break; if (sp > XB_SPIN_CAP) { atomicAdd(&bar[XB_TMO], 1u); break; } }
    }
    nloc = mine > 0u ? mine : 1u; nx = cnt > 0u ? cnt : 1u;
}

__device__ __forceinline__ void xcd_barrier(const XcdBarrier& b) {
    asm volatile("s_waitcnt vmcnt(0)" ::: "memory");
    __syncthreads();
    if (threadIdx.x == 0) {
        unsigned* bar = b.bar;
        __builtin_amdgcn_s_waitcnt(0);
        unsigned nloc = b.st[0], nx = b.st[1];
        if (nloc == 0u) { xcd_barrier_complete(bar, b.x, nloc, nx); b.st[0] = nloc; b.st[1] = nx; }
        const unsigned old = xb_add(&bar[XB_XSUB(b.x)], 1u);
        const unsigned gen = old / nloc;
        if (old + 1u == (gen + 1u) * nloc) {
            __builtin_amdgcn_fence(__ATOMIC_RELEASE, "agent");
            asm volatile("s_waitcnt vmcnt(0)" ::: "memory");
            const unsigned og = xb_add(&bar[XB_TOP], 1u);
            const unsigned tg = og / nx;
            if (og + 1u == (tg + 1u) * nx) xb_add(&bar[XB_TOPGEN], 1u);
            else XB_SPIN(xb_ld(&bar[XB_TOPGEN]) == tg, bar);
            __builtin_amdgcn_fence(__ATOMIC_ACQUIRE, "agent");
            xb_add(&bar[XB_XGEN(b.x)], 1u);
            asm volatile("s_waitcnt vmcnt(0)" ::: "memory");
        } else {
            XB_SPIN(xb_ld(&bar[XB_XGEN(b.x)]) == gen, bar);
            __builtin_amdgcn_fence(__ATOMIC_ACQUIRE, "agent");
            asm volatile("s_waitcnt vmcnt(0)" ::: "memory");
        }
    }
    __syncthreads();
}


namespace att {
typedef short bf16x8 __attribute__((ext_vector_type(8)));
typedef short s16x4 __attribute__((ext_vector_type(4)));
typedef float f32x16 __attribute__((ext_vector_type(16)));
#define ATT_SBAR() __builtin_amdgcn_sched_barrier(0)
#define ATT_BAR() do { asm volatile("s_waitcnt lgkmcnt(0)" ::: "memory"); __builtin_amdgcn_s_barrier(); asm volatile("" ::: "memory"); } while (0)
constexpr float LOG2E = 1.4426950408889634f, NEGM = -1e30f;
constexpr float DEFER_THR = 8.f;
constexpr int KVSPLIT = 4;
__device__ __forceinline__ int crow(int r, int hi) { return (r & 3) + 8 * (r >> 2) + 4 * hi; }
__device__ __forceinline__ unsigned cvtpk(float lo, float hi) { unsigned r; asm volatile("v_cvt_pk_bf16_f32 %0, %1, %2" : "=v"(r) : "v"(lo), "v"(hi)); return r; }
template <int DQK> __device__ __forceinline__ int kswz_x(int row) { return DQK == 128 ? (((row & 7) | (((row >> 4) & 1) << 3)) << 4) : (((row >> 1) & 7) << 4); }
template <int DQK> __device__ __forceinline__ int kswz(int row, int colB) { return row * (DQK * 2) + (colB ^ kswz_x<DQK>(row)); }
__device__ __forceinline__ int v_st(int k, int c) { const int kk = (k & ~0xC) | ((k & 4) << 1) | ((k & 8) >> 1); return ((kk >> 3) * 4 + (c >> 5)) * 512 + ((kk & 7) * 32 + (c & 31)) * 2; }
__device__ __forceinline__ int v_rd_base(int lane) { return ((lane & 3) << 3) | (((lane >> 2) & 3) << 6) | (((lane >> 4) & 1) << 5) | (((lane >> 5) & 1) << 8); }
constexpr int v_rd_off(int d0, int ks, int half) { return d0 * 512 + ks * 4096 + half * 2048; }
template <int OFF> __device__ __forceinline__ s16x4 tr_read(int vb) { s16x4 r; asm volatile("ds_read_b64_tr_b16 %0, %1 offset:%2" : "=&v"(r) : "v"(vb), "i"(OFF) : "memory"); return r; }
struct VFrag { s16x4 l0, h0, l1, h1, l2, h2, l3, h3; };
template <int D0> __device__ __forceinline__ void pv_read(VFrag& f, int vb) {
  f.l0 = tr_read<v_rd_off(D0, 0, 0)>(vb); f.h0 = tr_read<v_rd_off(D0, 0, 1)>(vb); f.l1 = tr_read<v_rd_off(D0, 1, 0)>(vb); f.h1 = tr_read<v_rd_off(D0, 1, 1)>(vb);
  f.l2 = tr_read<v_rd_off(D0, 2, 0)>(vb); f.h2 = tr_read<v_rd_off(D0, 2, 1)>(vb); f.l3 = tr_read<v_rd_off(D0, 3, 0)>(vb); f.h3 = tr_read<v_rd_off(D0, 3, 1)>(vb);
}
__device__ __forceinline__ void pv_mma(f32x16& od, const VFrag& f, bf16x8 pa0, bf16x8 pa1, bf16x8 pa2, bf16x8 pa3) {
#define ATT_PK(L, H) (bf16x8){L[0], L[1], L[2], L[3], H[0], H[1], H[2], H[3]}
  od = __builtin_amdgcn_mfma_f32_32x32x16_bf16(pa0, ATT_PK(f.l0, f.h0), od, 0, 0, 0);
  od = __builtin_amdgcn_mfma_f32_32x32x16_bf16(pa1, ATT_PK(f.l1, f.h1), od, 0, 0, 0);
  od = __builtin_amdgcn_mfma_f32_32x32x16_bf16(pa2, ATT_PK(f.l2, f.h2), od, 0, 0, 0);
  od = __builtin_amdgcn_mfma_f32_32x32x16_bf16(pa3, ATT_PK(f.l3, f.h3), od, 0, 0, 0);
#undef ATT_PK
}
__device__ __forceinline__ void pv_d0(f32x16* o, int vb, bf16x8 pa0, bf16x8 pa1, bf16x8 pa2, bf16x8 pa3) {
  VFrag fa, fb;
  pv_read<0>(fa, vb); pv_read<1>(fb, vb);
  asm volatile("s_waitcnt lgkmcnt(8)" ::: "memory"); ATT_SBAR(); pv_mma(o[0], fa, pa0, pa1, pa2, pa3); ATT_SBAR();
  pv_read<2>(fa, vb);
  asm volatile("s_waitcnt lgkmcnt(8)" ::: "memory"); ATT_SBAR(); pv_mma(o[1], fb, pa0, pa1, pa2, pa3); ATT_SBAR();
  pv_read<3>(fb, vb);
  asm volatile("s_waitcnt lgkmcnt(8)" ::: "memory"); ATT_SBAR(); pv_mma(o[2], fa, pa0, pa1, pa2, pa3); ATT_SBAR();
  asm volatile("s_waitcnt lgkmcnt(0)" ::: "memory"); ATT_SBAR(); pv_mma(o[3], fb, pa0, pa1, pa2, pa3);
}
typedef float f32x2 __attribute__((ext_vector_type(2)));
template <bool RAW>
__device__ __forceinline__ void softmax_tile(f32x16& p0, f32x16& p1, float Cs, float& m_reg, float& l_reg, float& alpha, bf16x8& pa0, bf16x8& pa1, bf16x8& pa2, bf16x8& pa3) {
  float pmax = fmaxf(fmaxf(p0[0], p0[1]), p1[0]);
#pragma unroll
  for (int r = 2; r < 16; r += 2) pmax = fmaxf(fmaxf(pmax, p0[r]), p0[r + 1]);
#pragma unroll
  for (int r = 1; r < 15; r += 2) pmax = fmaxf(fmaxf(pmax, p1[r]), p1[r + 1]);
  pmax = fmaxf(pmax, p1[15]);
  { auto rr = __builtin_amdgcn_permlane32_swap(__float_as_uint(pmax), __float_as_uint(pmax), false, false); pmax = fmaxf(__uint_as_float(rr[0]), __uint_as_float(rr[1])); }
  if (RAW) pmax *= Cs;
  float mn;
  if (__builtin_expect(__all(pmax - m_reg <= DEFER_THR * LOG2E), 1)) { mn = m_reg; alpha = 1.f; }
  else { mn = fmaxf(m_reg, pmax); alpha = __builtin_amdgcn_exp2f(m_reg - mn); m_reg = mn; }
#pragma unroll
  for (int r = 0; r < 16; ++r) { p0[r] = __builtin_amdgcn_exp2f(RAW ? fmaf(p0[r], Cs, -mn) : p0[r] - mn); p1[r] = __builtin_amdgcn_exp2f(RAW ? fmaf(p1[r], Cs, -mn) : p1[r] - mn); }
  f32x2 ps2 = {0.f, 0.f};
#pragma unroll
  for (int r = 0; r < 16; r += 2) { ps2 += (f32x2){p0[r], p0[r + 1]}; ps2 += (f32x2){p1[r], p1[r + 1]}; }
  float ps = ps2[0] + ps2[1];
  { auto rr = __builtin_amdgcn_permlane32_swap(__float_as_uint(ps), __float_as_uint(ps), false, false); ps = __uint_as_float(rr[0]) + __uint_as_float(rr[1]); }
  l_reg = l_reg * alpha + ps;
#define ATT_PK4(P, BASE, OUT) do { unsigned a0 = cvtpk(P[BASE + 0], P[BASE + 1]), a1 = cvtpk(P[BASE + 2], P[BASE + 3]);   \
    unsigned b0 = cvtpk(P[BASE + 4], P[BASE + 5]), b1 = cvtpk(P[BASE + 6], P[BASE + 7]);                              \
    auto r0 = __builtin_amdgcn_permlane32_swap(a0, b0, false, false); auto r1 = __builtin_amdgcn_permlane32_swap(a1, b1, false, false); \
    u32x4 w = {r0[0], r1[0], r0[1], r1[1]}; OUT = *reinterpret_cast<bf16x8*>(&w); } while (0)
  ATT_PK4(p0, 0, pa0); ATT_PK4(p0, 8, pa1); ATT_PK4(p1, 0, pa2); ATT_PK4(p1, 8, pa3);
#undef ATT_PK4
}

template <int MODE>
__device__ __forceinline__ void attn_unit(unsigned char* ws_, const float* rpb, const float* sink, int l, int h, int qb, int kvq, unsigned char* lds_g) {
  constexpr int DQK = MODE == 1 ? 192 : 128, ND = DQK / 16, NCH = DQK / 64;
  constexpr int SHM_V = 64 * 128 * 2, SHM_K = 64 * DQK * 2, OFF_K = 3 * SHM_V, OFF_WS = OFF_K + 3 * SHM_K, OFF_RPB = OFF_WS + 8 * 64 * 4;
  const int tid = otid(), wid = tid >> 6, lane = tid & 63, r32 = lane & 31, hi = lane >> 5;
  LAS unsigned char* ldl = (LAS unsigned char*)lds_g;
  const bf16_t* proj = (const bf16_t*)(ws_ + WS_PROJ);
  const bf16_t *Qp, *Kp, *Vp; int ldq, ldk, ldv, ycol; float C;
  if (MODE == 0) { Qp = proj + C_QA + 128 * h; Kp = proj + C_KA + 128 * h; Vp = proj + C_VA + 128 * h; ldq = ldk = ldv = DINP; ycol = 128 * h; C = 0.08838834764831845f * LOG2E; }
  else if (MODE == 1) { Qp = (const bf16_t*)(ws_ + WS_Q) + 192 * h; Kp = (const bf16_t*)(ws_ + WS_K) + 192 * h; Vp = (const bf16_t*)(ws_ + WS_V) + 128 * h; ldq = QLD; ldk = KLD; ldv = VLD; ycol = 512 + 128 * h; C = 0.07216878364870322f * LOG2E; }
  else { Qp = proj + C_QC + 128 * h; Kp = proj + C_KC + 128 * (h / 3); Vp = proj + C_VC + 128 * (h / 3); ldq = ldk = ldv = DINP; ycol = 1280 + 128 * h; C = 0.08838834764831845f * LOG2E; }
  const int q0 = qb * 256, qi = q0 + wid * 32 + r32;
  int T0, T1, tw0, tw1, wrow = 0, qcol = 0, c0 = 0; float slope2 = 0.f;
  if (MODE == 1) { T0 = tw0 = kvq * (S / 64 / KVSPLIT); T1 = tw1 = T0 + S / 64 / KVSPLIT; }
  else if (MODE == 0) { const int R = qb * 4; T0 = min(max(R - 4, 0), 120); T1 = min(max(R - 1, 0), 120) + 8; wrow = R + (wid >> 1); tw0 = min(max(wrow - 4, 0), 120); tw1 = tw0 + 8;
                        qcol = (wid & 1) * 32 + r32; c0 = min(max(qcol - 8, 0), 48); }
  else { T0 = max(0, (q0 - 128) >> 6); T1 = min(S / 64, ((q0 + 255 + 128) >> 6) + 1); const int qw = q0 + wid * 32; tw0 = max(0, (qw - 128) >> 6); tw1 = min(S / 64, ((qw + 31 + 128) >> 6) + 1);
         slope2 = exp2f(-8.0f * (float)(h + 1) / 6.0f) * LOG2E; }
  LAS float* wsl = (LAS float*)(ldl + OFF_WS) + wid * 64; LAS float* li_l = wsl; LAS float* al_l = wsl + 32;
  LAS float* rpbL = (LAS float*)(ldl + OFF_RPB);
  if (MODE == 0) { for (int i = tid; i < 465; i += NTHREADS) rpbL[i] = rpb[(l * 4 + h) * 465 + i] * LOG2E; }
  float m_reg = -1e29f, l_reg = 0.f;
  if (MODE == 2) { m_reg = sink[l * 6 + h] * LOG2E; l_reg = 1.f; }
  f32x16 o[4] = {}; bf16x8 qr[ND];
  { const bf16_t* Qw = Qp + (size_t)qi * ldq + hi * 8;
#pragma unroll
    for (int d0 = 0; d0 < ND; ++d0) qr[d0] = *(const bf16x8*)(Qw + d0 * 16); }
  unsigned kg[NCH], vg[2];
#pragma unroll
  for (int i = 0; i < NCH; ++i) { const int X = (wid + 8 * i) * 1024 + lane * 16, row = X / (DQK * 2), cs = X % (DQK * 2), colB = cs ^ kswz_x<DQK>(row); kg[i] = (unsigned)(row * ldk + (colB >> 1)) * 2u; }
#pragma unroll
  for (int i = 0; i < 2; ++i) { const int X = (wid + 8 * i) * 1024 + lane * 16, st = X >> 9, w = X & 511, kk = ((st >> 2) << 3) | (w >> 6), c = ((st & 3) << 5) | ((w & 63) >> 1);
    const int k = (kk & ~0xC) | ((kk & 4) << 1) | ((kk & 8) >> 1); vg[i] = (unsigned)(k * ldv + c) * 2u; }
  const int vb0 = (int)(uintptr_t)lds_g + v_rd_base(lane);
  const int kbase0 = (int)(uintptr_t)lds_g + OFF_K;
  constexpr int NKO = DQK == 192 ? 4 : ND;
  int ko[NKO];
#pragma unroll
  for (int d0 = 0; d0 < NKO; ++d0) ko[d0] = kswz<DQK>(r32, (d0 * 16 + hi * 8) * 2);
#define ATT_KO(d0_) (DQK == 192 ? ko[(d0_) & 3] + ((d0_) >> 2) * 128 : ko[(d0_) % NKO])
  const int wslab = __builtin_amdgcn_readfirstlane(wid) * 1024;
#define ATT_DMA(t, b) do { const char* kt_ = (const char*)(Kp + (size_t)(t) * 64 * ldk); const char* vt_ = (const char*)(Vp + (size_t)(t) * 64 * ldv); \
    _Pragma("unroll") for (int i_ = 0; i_ < NCH; ++i_) __builtin_amdgcn_global_load_lds((const unsigned*)(kt_ + kg[i_]), (LAS unsigned*)(ldl + OFF_K + (b) * SHM_K + wslab + i_ * 8192), 16, 0, 0); \
    _Pragma("unroll") for (int i_ = 0; i_ < 2; ++i_) __builtin_amdgcn_global_load_lds((const unsigned*)(vt_ + vg[i_]), (LAS unsigned*)(ldl + (b) * SHM_V + wslab + i_ * 8192), 16, 0, 0); } while (0)
  __syncthreads();
  ATT_DMA(T0, 0); if (T0 + 1 < T1) { ATT_DMA(T0 + 1, 1); asm volatile("s_waitcnt vmcnt(%0)" :: "n"(NCH + 2) : "memory"); } else asm volatile("s_waitcnt vmcnt(0)" ::: "memory");
  ATT_BAR();
  int b = 0, bn = 2;
#pragma unroll 1
  for (int j = T0; j < T1; ++j) {
    const bool vis_ = (j >= tw0 && j < tw1);
    if (vis_) {
      f32x16 p0 = {}, p1 = {};
      ATT_SBAR();
      {
        const int kbase = kbase0 + b * SHM_K;
        bf16x8 fa[3], fb[3];
#define ATT_KRD(d0_) do { const int ad_ = kbase + ATT_KO(d0_); \
          asm volatile("ds_read_b128 %0, %1" : "=v"(fa[(d0_) % 3]) : "v"(ad_) : "memory"); \
          asm volatile("ds_read_b128 %0, %1 offset:%2" : "=v"(fb[(d0_) % 3]) : "v"(ad_), "i"(32 * DQK * 2) : "memory"); } while (0)
        ATT_KRD(0); ATT_KRD(1);
#pragma unroll
        for (int d0 = 0; d0 < ND; ++d0) {
          if (d0 + 2 < ND) { ATT_KRD(d0 + 2); asm volatile("s_waitcnt lgkmcnt(4)" ::: "memory"); }
          else if (d0 + 1 < ND) asm volatile("s_waitcnt lgkmcnt(2)" ::: "memory");
          else asm volatile("s_waitcnt lgkmcnt(0)" ::: "memory");
          ATT_SBAR();
          p0 = __builtin_amdgcn_mfma_f32_32x32x16_bf16(fa[d0 % 3], qr[d0], p0, 0, 0, 0);
          p1 = __builtin_amdgcn_mfma_f32_32x32x16_bf16(fb[d0 % 3], qr[d0], p1, 0, 0, 0);
          ATT_SBAR(); }
#undef ATT_KRD
      }
      ATT_SBAR();
      if (MODE == 0) {
        const int dr31 = (j - wrow + 7) * 31 + 15 - qcol;
#pragma unroll
        for (int r = 0; r < 16; ++r) { const int kc = crow(r, hi);
          { const bool v = (kc >= c0) && (kc < c0 + 16); const float bb = rpbL[v ? dr31 + kc : 0]; p0[r] = v ? fmaf(p0[r], C, bb) : NEGM; }
          { const int kc1 = kc + 32; const bool v = (kc1 >= c0) && (kc1 < c0 + 16); const float bb = rpbL[v ? dr31 + kc1 : 0]; p1[r] = v ? fmaf(p1[r], C, bb) : NEGM; } }
      } else if (MODE == 2) {
        const int kb = j * 64;
#pragma unroll
        for (int r = 0; r < 16; ++r) { const int k = kb + crow(r, hi);
          { const int d = abs(qi - k); p0[r] = d <= 128 ? fmaf(p0[r], C, -slope2 * (float)d) : NEGM; }
          { const int d = abs(qi - k - 32); p1[r] = d <= 128 ? fmaf(p1[r], C, -slope2 * (float)d) : NEGM; } }
      }
      float alpha; bf16x8 pa0, pa1, pa2, pa3;
      softmax_tile<MODE == 1>(p0, p1, C, m_reg, l_reg, alpha, pa0, pa1, pa2, pa3);
      if (__any(alpha < 1.f)) { if (hi == 0) al_l[r32] = alpha; asm volatile("s_waitcnt lgkmcnt(0)" ::: "memory");
#pragma unroll
        for (int r = 0; r < 16; ++r) { const float av = al_l[crow(r, hi)];
#pragma unroll
          for (int d = 0; d < 4; ++d) o[d][r] *= av; }
        asm volatile("s_waitcnt lgkmcnt(0)" ::: "memory"); }
      ATT_SBAR();
      pv_d0(o, vb0 + b * SHM_V, pa0, pa1, pa2, pa3);
    }
#if defined(PROBE_ATT_VALU)
    if (MODE == 1) { float dx_ = m_reg;
#pragma unroll
      for (int i_ = 0; i_ < 32; ++i_) asm volatile("v_exp_f32 %0, %0" : "+v"(dx_));
      asm volatile("" :: "v"(dx_)); }
#endif
#if defined(PROBE_ATT_LDS)
    if (MODE == 1) { bf16x8 t_; const int ad_ = (int)(uintptr_t)lds_g + OFF_K + b * SHM_K + kswz<DQK>(r32, hi * 16);
#pragma unroll
      for (int i_ = 0; i_ < 24; ++i_) asm volatile("ds_read_b128 %0, %1 offset:%2" : "=v"(t_) : "v"(ad_), "i"((i_ % 12) * 32) : "memory");
      asm volatile("s_waitcnt lgkmcnt(0)" ::: "memory"); asm volatile("" :: "v"(t_)); }
#endif
#if defined(PROBE_ATT_MFMA)
    if (MODE == 1) { f32x4 da_ = {0.f, 0.f, 0.f, 0.f};
#pragma unroll
      for (int i_ = 0; i_ < 80; ++i_) da_ = __builtin_amdgcn_mfma_f32_16x16x32_bf16(qr[0], qr[1], da_, 0, 0, 0);
      asm volatile("" :: "v"(da_)); }
#endif
    ATT_SBAR();
    if (j + 2 < T1) ATT_DMA(j + 2, bn);
    if (j + 2 < T1) asm volatile("s_waitcnt vmcnt(%0)" :: "n"(NCH + 2) : "memory"); else asm volatile("s_waitcnt vmcnt(0)" ::: "memory");
    ATT_BAR();
    b = b == 2 ? 0 : b + 1; bn = bn == 2 ? 0 : bn + 1;
  }
  if (hi == 0) li_l[r32] = l_reg; asm volatile("s_waitcnt lgkmcnt(0)" ::: "memory");
  bf16_t* Ow; int ldo;
  if (MODE == 1) { Ow = (bf16_t*)(ws_ + WS_PART) + ((size_t)kvq * S + q0 + wid * 32) * VLD + 128 * h + r32; ldo = VLD;
    if (hi == 0) { float* st = (float*)(ws_ + WS_STAT) + ((size_t)(kvq * 6 + h) * S + qi) * 2; st[0] = m_reg; st[1] = l_reg; } }
  else { Ow = (bf16_t*)(ws_ + WS_Y) + (size_t)(q0 + wid * 32) * DM + ycol + r32; ldo = DM; }
#pragma unroll
  for (int r = 0; r < 16; ++r) { const int orow = crow(r, hi); const float rl = __builtin_amdgcn_rcpf(li_l[orow]);
#pragma unroll
    for (int d0 = 0; d0 < 4; ++d0) Ow[(size_t)orow * ldo + d0 * 32] = (bf16_t)(cvtpk(o[d0][r] * rl, 0.f) & 0xffffu); }
  asm volatile("s_waitcnt lgkmcnt(0)" ::: "memory");
  __syncthreads();
#undef ATT_DMA
#undef ATT_KO
}
}

#ifndef NAIVE_ATTN
#define NAIVE_ATTN 0
#endif
#ifndef MK_MULTI
#define MK_MULTI 0
#endif
constexpr int N_PHASES = 2 + 10 * DEPTH;
__device__ __forceinline__ int opq(int v) { asm volatile("" : "+s"(v)); return v; }

__global__ void __launch_bounds__(NTHREADS) fwd_megakernel(Args a) {
    extern __shared__ __attribute__((aligned(16))) unsigned char lds[];
    cg::grid_group grid = cg::this_grid();
    const int lo = a.ph_lo, hi = a.ph_hi;
    const int G = gridDim.x;
    { LAS unsigned long long* tw = (LAS unsigned long long*)((LAS unsigned char*)lds + TAB_OFF);
#pragma unroll
      for (int i = 0; i < 19; ++i) if ((int)threadIdx.x == i) tw[i] = (unsigned long long)a.in[i];
      if (threadIdx.x == 19) tw[19] = (unsigned long long)a.out;
      if (threadIdx.x == 20) tw[20] = (unsigned long long)a.ws;
      if (threadIdx.x < 4) ((LAS unsigned*)((LAS unsigned char*)lds + TAB_OFF + 192))[threadIdx.x] = 0u;
      __syncthreads(); }
    (void)xcd_barrier_post((unsigned*)(a.ws + WS_BAR), (volatile LAS unsigned*)((LAS unsigned char*)lds + TAB_OFF + 192));
    if (a.ph_lo < 0) grid.sync();
    const Tab T{(const LAS unsigned*)((LAS unsigned char*)lds + TAB_OFF)};
#define ws (T.wsp())
#define mod ((float*)(ws + WS_MOD))
#define U ((bf16_t*)(ws + WS_U))
#define PROJ ((bf16_t*)(ws + WS_PROJ))
#define Qb ((bf16_t*)(ws + WS_Q))
#define Kb ((bf16_t*)(ws + WS_K))
#define Vb ((bf16_t*)(ws + WS_V))
#define Y ((bf16_t*)(ws + WS_Y))
#define Hb ((bf16_t*)(ws + WS_H))
#define X ((float*)(ws + WS_X))
#define rope ((float*)(ws + WS_ROPE))
#define rsq ((float*)(ws + WS_RSQ))
#define rskv ((float*)(ws + WS_RSKV))
    PG8_LAS unsigned char* ldsl = (PG8_LAS unsigned char*)lds;
#ifndef PHM
#define PHM 0xFFFFF
#endif
#ifndef ATM
#define ATM 7
#endif
#define EN(b) ((PHM >> (b)) & 1)
#ifndef PROBE_PH
#define PROBE_PH -1
#endif
#ifndef PROBE_N
#define PROBE_N 2
#endif
#define REPK(k) for (int rep_ = 0; rep_ < ((k) == PROBE_PH ? PROBE_N : 1); ++rep_)
#define IN(k) (lo <= (k) && (k) < hi)
#define GBAR() do { XcdBarrier b_; b_.bar = (unsigned*)(ws + WS_BAR); b_.x = xb_xcc_id(); b_.st = (volatile LAS unsigned*)((LAS unsigned char*)lds + TAB_OFF + 192); xcd_barrier(b_); } while (0)
#define SEAM(k) do { if (IN(k) && IN((k) + 1)) GBAR(); } while (0)

#ifdef PROBE_SYNCS
    for (int i_ = 0; i_ < PROBE_SYNCS; ++i_) GBAR();
#endif
    if (EN(0) && IN(0)) REPK(0) { phase_mod(T, lds); }
    SEAM(0);
    if (EN(1) && IN(1)) REPK(1) {
        const int fb_ = opq((int)blockIdx.x), fs_ = opq(G); const bool hide_ = (fs_ == 256);
        for (int l = 0; l < DEPTH; ++l) {
            transpose_job<3>(T.in(4) + (size_t)l * DM * DIN, (bf16_t*)(ws + WS_W + (size_t)l * SZ_WL + O_WIN), DM, DIN, DINP, nullptr, lds, fb_, fs_);
            const int fh_ = (hide_ && l == 1) ? (1 << 30) : fb_, fh0_ = hide_ ? (1 << 30) : fb_;
            transpose_job<1>(T.in(8) + (size_t)l * 512 * 1152, (bf16_t*)(ws + WS_W + (size_t)l * SZ_WL + O_WUQ), 512, 1152, 1280, T.in(6) + l * 512, lds, fh0_, fs_);
            transpose_job<0>(T.in(9) + (size_t)l * 256 * 1536, (bf16_t*)(ws + WS_W + (size_t)l * SZ_WL + O_WUKV), 256, 1536, 1536, T.in(7) + l * 256, lds, fh0_, fs_);
            if (!hide_) transpose_job<0>(T.in(12) + (size_t)l * DM * DM, (bf16_t*)(ws + WS_W + (size_t)l * SZ_WL + O_WO), DM, DM, DM, T.in(11) + l * DM, lds, fb_, fs_);
            if (!(hide_ && l == 1)) transpose_job<2>(T.in(15) + (size_t)l * DM * 2 * DFF, (bf16_t*)(ws + WS_W + (size_t)l * SZ_WL + O_WGU), DM, 2 * DFF, 2 * DFF, nullptr, lds, fb_, fs_);
            transpose_job<0>(T.in(16) + (size_t)l * DFF * DM, (bf16_t*)(ws + WS_W + (size_t)l * SZ_WL + O_WDN), DFF, DM, DM, nullptr, lds, fh_, fs_);
        }
        modulate_rows(T.in(0), mod + 1 * DM, mod + 0 * DM, U);
        rope_table(rope);
    }
    SEAM(1);
#pragma unroll 1
    for (int l = 0; l < DEPTH; ++l) {
        const int pb = 2 + 10 * l;
        if (EN(2) && IN(pb + 0)) REPK(2) {
            pg8::Gemm g{U, (const bf16_t*)(ws + WS_W + (size_t)l * SZ_WL + O_WIN), S, DINP, DM, DM}; pg8::StaticOrder So; So.init(S, DINP, opq(G), opq((int)blockIdx.x));
            pg8::EpiProj E{PROJ, DINP, (float*)(ws + WS_SSQ), rope, Kb, KLD};
            pg8::gemm_phase<pg8::EpiProj, pg8::StaticOrder, true, true>(ldsl, g, So, E);
            if (opq(G) == 256 && opq((int)blockIdx.x) >= 224) {
                const int sb_ = opq((int)blockIdx.x) - 224; const size_t lo_ = (size_t)l;
                transpose_job<1>(T.in(8) + lo_ * 512 * 1152, (bf16_t*)(ws + WS_W + lo_ * SZ_WL + O_WUQ), 512, 1152, 1280, T.in(6) + lo_ * 512, lds, sb_, 32);
                transpose_job<0>(T.in(9) + lo_ * 256 * 1536, (bf16_t*)(ws + WS_W + lo_ * SZ_WL + O_WUKV), 256, 1536, 1536, T.in(7) + lo_ * 256, lds, (sb_ + 8) & 31, 32);
                transpose_job<0>(T.in(12) + lo_ * DM * DM, (bf16_t*)(ws + WS_W + lo_ * SZ_WL + O_WO), DM, DM, DM, T.in(11) + lo_ * DM, lds, sb_, 32); }
        }
        SEAM(pb + 0);
        if (EN(4) && IN(pb + 2)) REPK(4) {
            { const int bq = opq((int)blockIdx.x), Gq = opq(G);
#pragma unroll 1
              for (int it = 0; ; ++it) {
                int q0 = -1, kv0 = -1, kv1 = -1, na = -1, sw0 = -1, sw1 = -1;
                if (Gq == 256) { if (it == 0) {
                    if (bq < 96) { na = bq; q0 = bq; }
                    else if (bq < 128) { na = bq; kv0 = 2 * (bq - 96); kv1 = kv0 + 1; }
                    else if (bq < 192) { sw0 = bq - 128; q0 = 96 + (bq - 128); kv0 = 64 + 2 * (bq - 128); kv1 = kv0 + 1; }
                    else { sw0 = 64 + (bq - 192); sw1 = 128 + (bq - 192); } } }
                else { const int L = bq + it * Gq; if (L < 160) q0 = L; if (L < 192) { kv0 = L; sw0 = L; } if (L < 128) na = L; }
                if ((q0 & kv0 & na & sw0) < 0 && q0 < 0 && kv0 < 0 && na < 0 && sw0 < 0) break;
                if (q0 >= 0) { pg8::Gemm g{PROJ + C_CQ, (const bf16_t*)(ws + WS_W + (size_t)l * SZ_WL + O_WUQ), S, 1280, 512, DINP}; pg8::ListOrder So{5, 1, q0, 0};
                  pg8::EpiQ E{Qb, QLD, (const float*)(ws + WS_SSQ), rope};
                  pg8::gemm_phase<pg8::EpiQ, pg8::ListOrder, true, true>(ldsl, g, So, E); }
                if (kv0 >= 0) { pg8::Gemm g{PROJ + C_CKV, (const bf16_t*)(ws + WS_W + (size_t)l * SZ_WL + O_WUKV), S, 1536, 256, DINP}; pg8::ListOrder So{6, kv1 >= 0 ? 2 : 1, kv0, kv1};
                  pg8::EpiKV E{Kb, KLD, Vb, VLD, (const float*)(ws + WS_SSQ)};
                  pg8::gemm_phase<pg8::EpiKV, pg8::ListOrder, true, true>(ldsl, g, So, E); }
                if (na >= 0) { if (ATM & 2) att::attn_unit<0>(ws, T.in(5), T.in(10), l, na >> 5, na & 31, 0, lds); }
#pragma unroll 1
                for (int i2 = 0; i2 < 2; ++i2) { const int u = i2 ? sw1 : sw0; if (u >= 0) { if (ATM & 4) att::attn_unit<2>(ws, T.in(5), T.in(10), l, u >> 5, u & 31, 0, lds); } }
              } }
        }
        SEAM(pb + 2);
        if (EN(5) && IN(pb + 3)) REPK(5) {
#if NAIVE_ATTN
            naive_attn<0>(ws, T.in(5), T.in(10), l); naive_attn<2>(ws, T.in(5), T.in(10), l); naive_attn<1>(ws, T.in(5), T.in(10), l);
#else
            const int Gq = opq(G);
            for (int su = opq((int)blockIdx.x); su < 192 * att::KVSPLIT; su += Gq) {
                int combo, qb; if (Gq == 256) { combo = (su & 7) + 8 * (su >> 8); qb = (su & 255) >> 3; } else { combo = su >> 5; qb = su & 31; }
                unsigned char* wsp_ = ws;
                if (ATM & 1) att::attn_unit<1>(wsp_, nullptr, nullptr, l, combo >> 2, qb, combo & 3, lds);
            }
#endif
        }
        SEAM(pb + 3);
        if (EN(6) && IN(pb + 4)) phase_ynorm(ws);
        SEAM(pb + 4);
        if (EN(7) && IN(pb + 5)) {
            pg8::Gemm g{Y, (const bf16_t*)(ws + WS_W + (size_t)l * SZ_WL + O_WO), S, DM, DM, DM}; pg8::StaticOrder So; So.init(S, DM, opq(G), opq((int)blockIdx.x));
            pg8::EpiRes E{l == 0 ? T.in(0) : (const float*)X, X, mod + (size_t)l * 6 * DM + 2 * DM, ALPHA, DM};
            pg8::gemm_phase<pg8::EpiRes, pg8::StaticOrder, true, true>(ldsl, g, So, E);
        }
        SEAM(pb + 5);
#ifdef PROBE_LN
        if (EN(8) && IN(pb + 6)) phase_ln(X, (float*)(ws + WS_H), T.in(13) + l * DM, T.in(14) + l * DM, mod + (size_t)l * 6 * DM + 4 * DM, mod + (size_t)l * 6 * DM + 3 * DM, (bf16_t*)(ws + WS_PART));
#endif
        if (EN(8) && IN(pb + 6)) phase_ln(X, X, T.in(13) + l * DM, T.in(14) + l * DM, mod + (size_t)l * 6 * DM + 4 * DM, mod + (size_t)l * 6 * DM + 3 * DM, U);
        SEAM(pb + 6);
        if (EN(9) && IN(pb + 7)) REPK(9) {
            pg8::Gemm g{U, (const bf16_t*)(ws + WS_W + (size_t)l * SZ_WL + O_WGU), S, 2 * DFF, DM, DM}; pg8::StaticOrder So; So.init(S, 2 * DFF, opq(G), opq((int)blockIdx.x));
            pg8::EpiSwiglu E{Hb, DFF};
            pg8::gemm_phase<pg8::EpiSwiglu, pg8::StaticOrder, true, true>(ldsl, g, So, E);
            if (l == 0 && opq(G) == 256 && opq((int)blockIdx.x) >= 128)
                transpose_job<2>(T.in(15) + (size_t)DM * 2 * DFF, (bf16_t*)(ws + WS_W + SZ_WL + O_WGU), DM, 2 * DFF, 2 * DFF, nullptr, lds, opq((int)blockIdx.x) - 128, 128);
            if (l == 1 && opq(G) == 256 && opq((int)blockIdx.x) >= 128)
                transpose_job<0>(T.in(16) + (size_t)DFF * DM, (bf16_t*)(ws + WS_W + SZ_WL + O_WDN), DFF, DM, DM, nullptr, lds, opq((int)blockIdx.x) - 128, 128);
        }
        SEAM(pb + 7);
        if (EN(10) && IN(pb + 8)) {
            pg8::Gemm g{Hb, (const bf16_t*)(ws + WS_W + (size_t)l * SZ_WL + O_WDN), S, DM, DFF, DFF}; pg8::StaticOrder So; So.init(S, DM, opq(G), opq((int)blockIdx.x));
            pg8::EpiRes E{X, X, mod + (size_t)l * 6 * DM + 5 * DM, ALPHA, DM};
            pg8::gemm_phase<pg8::EpiRes, pg8::StaticOrder, true, true>(ldsl, g, So, E);
        }
        SEAM(pb + 8);
        if (EN(11) && IN(pb + 9)) {
            const bool last = (l == DEPTH - 1);
            const float* modn = mod + (size_t)(last ? l : l + 1) * 6 * DM;
            phase_ln(X, last ? T.out() : X, T.in(17) + l * DM, T.in(18) + l * DM, last ? nullptr : modn + 1 * DM, last ? nullptr : modn + 0 * DM, last ? nullptr : U);
        }
        SEAM(pb + 9);
    }
#undef IN
#undef SEAM
#undef ws
#undef mod
#undef U
#undef PROJ
#undef Qb
#undef Kb
#undef Vb
#undef Y
#undef Hb
#undef X
#undef rope
#undef rsq
#undef rskv
}

extern "C" void kernel_launch(void* const* d_in, const int* in_sizes, int n_in, void* d_out, int out_size, void* d_ws, size_t ws_size, hipStream_t stream) {
    static int grid = 0;
    if (grid == 0) {
        if (n_in != 19 || out_size != S * DM || ws_size < WS_END) { fprintf(stderr, "kernel_launch: unexpected shapes (n_in %d out %d ws %zu need %zu)\n", n_in, out_size, ws_size, (size_t)WS_END); grid = -1; return; }
        int dev = 0, cus = 0, per_cu = 0;
        hipGetDevice(&dev); hipDeviceGetAttribute(&cus, hipDeviceAttributeMultiprocessorCount, dev);
        if (hipFuncSetAttribute((const void*)fwd_megakernel, hipFuncAttributeMaxDynamicSharedMemorySize, LDS_BYTES) != hipSuccess) { fprintf(stderr, "kernel_launch: hipFuncSetAttribute failed\n"); grid = -1; return; }
        if (hipOccupancyMaxActiveBlocksPerMultiprocessor(&per_cu, (const void*)fwd_megakernel, NTHREADS, LDS_BYTES) != hipSuccess || per_cu < 1) { fprintf(stderr, "kernel_launch: occupancy query gave %d\n", per_cu); per_cu = 1; }
        (void)hipGetLastError();
        grid = cus;
    }
    if (grid < 0) return;
    if (hipMemsetAsync((char*)d_ws + WS_BAR, 0, 16384, stream) != hipSuccess) { fprintf(stderr, "kernel_launch: memset of the barrier words failed\n"); return; }
    Args a{};
    for (int i = 0; i < 19; ++i) a.in[i] = (const float*)d_in[i];
    a.out = (float*)d_out; a.ws = (unsigned char*)d_ws;
#if MK_MULTI
    for (int p = 0; p < N_PHASES; ++p) { a.ph_lo = p; a.ph_hi = p + 1; hipLaunchKernelGGL(fwd_megakernel, dim3(grid), dim3(NTHREADS), LDS_BYTES, stream, a); }
#else
    a.ph_lo = 0; a.ph_hi = N_PHASES;
    void* args[] = {&a};
    hipError_t e = hipLaunchCooperativeKernel((const void*)fwd_megakernel, dim3(grid), dim3(NTHREADS), args, LDS_BYTES, stream);
    if (e != hipSuccess) fprintf(stderr, "kernel_launch: cooperative launch failed: %s (grid %d)\n", hipGetErrorString(e), grid);
#endif
}
```

```cpp
#include <hip/hip_runtime.h>
#include <hip/hip_cooperative_groups.h>
#include <cstdio>
#include <cstdint>
namespace cg = cooperative_groups;
namespace pg8 {
#define PG8_LAS __attribute__((address_space(3)))
typedef unsigned short bf16_t;
typedef short bf16x8 __attribute__((ext_vector_type(8)));
typedef float f32x4 __attribute__((ext_vector_type(4)));
typedef unsigned u32x4 __attribute__((ext_vector_type(4)));
constexpr int BM = 256, BK = 64, HALF = 128, HTB = HALF * BK * 2  , STAGE_BYTES = 8 * HTB, NXCD = 8, WGM = 8;

__host__ __device__ __forceinline__ int lds_byte(int r, int c) { const int st = (r >> 4) * 2 + (c >> 5), rr = r & 15, cc = c & 31, ob = rr * 64 + cc * 2; return st * 1024 + (ob ^ (((ob >> 9) & 1) << 5)); }
__host__ __device__ __forceinline__ void stage_rc(int b, int& R, int& C) { const int st = b / 1024, sb = b % 1024, swz = sb ^ (((sb >> 9) & 1) << 5); R = (st >> 1) * 16 + swz / 64; C = (st & 1) * 32 + (swz % 64) / 2; }
__host__ __device__ __forceinline__ int perm32(int rho) { const int n = rho >> 4, i = rho & 15; return 8 * (i >> 2) + 4 * n + (i & 3); }

struct Unit { int pm, pn; };
struct Gemm { const bf16_t* A; const bf16_t* Bt; int M, N, K, lda; };

struct StaticOrder {
    int nM, nN, nwg, G, c;
    __host__ __device__ void init(int M, int N, int G_, int c_) { nM = M / BM; nN = N / BM; nwg = nM * nN; G = G_; c = c_; }
    __host__ __device__ bool next(int i, Unit& u) const {
        const long L = (long)i * G + c; if (L >= nwg) return false;
        int wgid = (int)L; { const int q = nwg / NXCD, r = nwg % NXCD, xcd = wgid % NXCD, off = wgid / NXCD; wgid = (xcd < r ? xcd * (q + 1) : r * (q + 1) + (xcd - r) * q) + off; }
        const int nig = WGM * nN, gid = wgid / nig, fm = gid * WGM, gsz = (nM - fm) < WGM ? (nM - fm) : WGM;
        u.pm = fm + ((wgid % nig) % gsz); u.pn = (wgid % nig) / gsz; return true;
    }
    __device__ __forceinline__ void a_ready(const Unit&) const {}
    __device__ __forceinline__ void done(const Unit&) const {}
};

struct ListOrder {
    int nN, n, L0, L1;
    __host__ __device__ bool next(int i, Unit& u) const { if (i >= n) return false; const int L = i == 0 ? L0 : L1; u.pm = L / nN; u.pn = L % nN; return true; }
    __device__ __forceinline__ void a_ready(const Unit&) const {}
    __device__ __forceinline__ void done(const Unit&) const {}
};
__device__ __forceinline__ unsigned cvt_pk_bf16(float lo, float hi) { unsigned r; asm volatile("v_cvt_pk_bf16_f32 %0, %1, %2" : "=v"(r) : "v"(lo), "v"(hi)); return r; }
typedef float f32x2 __attribute__((ext_vector_type(2)));
__device__ __forceinline__ u32x4 pack8(const f32x4 v0, const f32x4 v1) { u32x4 w; w.x = cvt_pk_bf16(v0[0], v0[1]); w.y = cvt_pk_bf16(v0[2], v0[3]); w.z = cvt_pk_bf16(v1[0], v1[1]); w.w = cvt_pk_bf16(v1[2], v1[3]); return w; }
struct EpiStore {
    static constexpr bool PERM = true, AFTER_DRAIN = false;
    bf16_t* O; int ldc;
    __device__ __forceinline__ void operator()(const f32x4 (&acc)[2][2][4][2], const Unit& u, int wr, int wc, int fr, int fq) const {
        const int row0 = u.pm * BM + wr * 64 + fr, col0 = u.pn * BM + wc * 32 + 8 * fq;
#pragma unroll
        for (int ai = 0; ai < 2; ++ai)
#pragma unroll
            for (int m = 0; m < 4; ++m) { bf16_t* rowp = O + (size_t)(row0 + ai * HALF + m * 16) * ldc + col0;
#pragma unroll
                for (int bj = 0; bj < 2; ++bj) *(u32x4*)(rowp + bj * HALF) = pack8(acc[ai][bj][m][0], acc[ai][bj][m][1]); }
    }
};
struct EpiProj {
    static constexpr bool PERM = true, AFTER_DRAIN = false;
    bf16_t* O; int ldc; float* ssq; const float* rope; bf16_t* Kb; int ldk;
    __device__ __forceinline__ void operator()(const f32x4 (&acc)[2][2][4][2], const Unit& u, int wr, int wc, int fr, int fq) const {
        const int row0 = u.pm * BM + wr * 64 + fr, col0 = u.pn * BM + wc * 32 + 8 * fq;
#pragma unroll
        for (int ai = 0; ai < 2; ++ai)
#pragma unroll
            for (int m = 0; m < 4; ++m) { const int row = row0 + ai * HALF + m * 16; bf16_t* rowp = O + (size_t)row * ldc + col0; float sq = 0.f;
#pragma unroll
                for (int bj = 0; bj < 2; ++bj) { const u32x4 w = pack8(acc[ai][bj][m][0], acc[ai][bj][m][1]); *(u32x4*)(rowp + bj * HALF) = w;
#pragma unroll
                    for (int e = 0; e < 4; ++e) { const float lo = __uint_as_float(w[e] << 16), hi = __uint_as_float(w[e] & 0xffff0000u); sq += lo * lo + hi * hi; } }
                if (u.pn >= 6 && u.pn <= 8) { sq += __shfl_xor(sq, 16); sq += __shfl_xor(sq, 32); if (fq == 0) ssq[((size_t)row * 3 + (u.pn - 6)) * 4 + wc] = sq; }
                if (u.pn == 9 && wc < 2) { const int ib = wc * 16 + 4 * fq; const f32x4 v0 = acc[ai][0][m][0], v1 = acc[ai][0][m][1];
                    const f32x4 c = *(const f32x4*)(rope + (size_t)row * 64 + ib), sn = *(const f32x4*)(rope + (size_t)row * 64 + 32 + ib);
                    f32x4 a, b;
                    a[0] = v0[0] * c[0] - v0[1] * sn[0]; a[1] = v0[1] * c[0] + v0[0] * sn[0];
                    a[2] = v0[2] * c[1] - v0[3] * sn[1]; a[3] = v0[3] * c[1] + v0[2] * sn[1];
                    b[0] = v1[0] * c[2] - v1[1] * sn[2]; b[1] = v1[1] * c[2] + v1[0] * sn[2];
                    b[2] = v1[2] * c[3] - v1[3] * sn[3]; b[3] = v1[3] * c[3] + v1[2] * sn[3];
                    const u32x4 w = pack8(a, b);
#pragma unroll
                    for (int h = 0; h < 6; ++h) *(u32x4*)(Kb + (size_t)row * ldk + 192 * h + 128 + wc * 32 + 8 * fq) = w; }
                if (m & 1) asm volatile("" ::: "memory"); }
    }
};
struct EpiQ {
    static constexpr bool PERM = true, AFTER_DRAIN = false;
    bf16_t* O; int ldc; const float* ssq; const float* rope;
    __device__ __forceinline__ void operator()(const f32x4 (&acc)[2][2][4][2], const Unit& u, int wr, int wc, int fr, int fq) const {
        const int row0 = u.pm * BM + wr * 64 + fr;
        float sc[2][4];
        { f32x4 q0[2][4], q1[2][4];
#pragma unroll
          for (int ai = 0; ai < 2; ++ai)
#pragma unroll
            for (int m = 0; m < 4; ++m) { const float* p = ssq + (size_t)(row0 + ai * HALF + m * 16) * 12; q0[ai][m] = *(const f32x4*)p; q1[ai][m] = *(const f32x4*)(p + 4); }
#pragma unroll
          for (int ai = 0; ai < 2; ++ai)
#pragma unroll
            for (int m = 0; m < 4; ++m) { const f32x4 a = q0[ai][m], b = q1[ai][m];
                sc[ai][m] = 1.0f / sqrtf((((a[0] + a[1]) + (a[2] + a[3])) + ((b[0] + b[1]) + (b[2] + b[3]))) * (1.0f / 512.0f) + 1e-6f); } }
#pragma unroll
        for (int ai = 0; ai < 2; ++ai)
#pragma unroll
            for (int m = 0; m < 4; ++m) { const int row = row0 + ai * HALF + m * 16; const float s = sc[ai][m];
#pragma unroll
                for (int bj = 0; bj < 2; ++bj) {
                    const int cb = u.pn * BM + bj * HALF + wc * 32, hc = cb % 192;
                    f32x4 v0 = acc[ai][bj][m][0] * s, v1 = acc[ai][bj][m][1] * s;
                    if (hc >= 128) {
                        const int ib = (hc - 128) / 2 + 4 * fq;
                        const f32x4 c = *(const f32x4*)(rope + (size_t)row * 64 + ib), sn = *(const f32x4*)(rope + (size_t)row * 64 + 32 + ib);
                        f32x4 a, b;
                        a[0] = v0[0] * c[0] - v0[1] * sn[0]; a[1] = v0[1] * c[0] + v0[0] * sn[0];
                        a[2] = v0[2] * c[1] - v0[3] * sn[1]; a[3] = v0[3] * c[1] + v0[2] * sn[1];
                        b[0] = v1[0] * c[2] - v1[1] * sn[2]; b[1] = v1[1] * c[2] + v1[0] * sn[2];
                        b[2] = v1[2] * c[3] - v1[3] * sn[3]; b[3] = v1[3] * c[3] + v1[2] * sn[3];
                        v0 = a; v1 = b;
                    }
                    *(u32x4*)(O + (size_t)row * ldc + cb + 8 * fq) = pack8(v0, v1);
                }
                if (m == 3) asm volatile("" ::: "memory"); }
    }
};
struct EpiKV {
    static constexpr bool PERM = true, AFTER_DRAIN = false;
    bf16_t* Kb; int ldk; bf16_t* Vb; int ldv; const float* ssq;
    __device__ __forceinline__ void operator()(const f32x4 (&acc)[2][2][4][2], const Unit& u, int wr, int wc, int fr, int fq) const {
        const int row0 = u.pm * BM + wr * 64 + fr, cin = wc * 32 + 8 * fq;
        f32x4 q2[2][4];
#pragma unroll
        for (int ai = 0; ai < 2; ++ai)
#pragma unroll
            for (int m = 0; m < 4; ++m) q2[ai][m] = *(const f32x4*)(ssq + (size_t)(row0 + ai * HALF + m * 16) * 12 + 8);
#pragma unroll
        for (int ai = 0; ai < 2; ++ai)
#pragma unroll
            for (int m = 0; m < 4; ++m) { const int row = row0 + ai * HALF + m * 16; const f32x4 a = q2[ai][m];
                const float s = 1.0f / sqrtf(((a[0] + a[1]) + (a[2] + a[3])) * (1.0f / 256.0f) + 1e-6f);
                *(u32x4*)(Kb + (size_t)row * ldk + 192 * u.pn + cin) = pack8(acc[ai][0][m][0] * s, acc[ai][0][m][1] * s);
                *(u32x4*)(Vb + (size_t)row * ldv + 128 * u.pn + cin) = pack8(acc[ai][1][m][0] * s, acc[ai][1][m][1] * s); }
    }
};
struct EpiRes {
    static constexpr bool PERM = false, AFTER_DRAIN = false;
    const float* xres; float* z; const float* gate; float alpha; int ldc;
    __device__ __forceinline__ void operator()(const f32x4 (&acc)[2][2][4][2], const Unit& u, int wr, int wc, int fr, int fq) const {
        const int row0 = u.pm * BM + wr * 64 + fr, col0 = u.pn * BM + wc * 32 + 4 * fq;
        f32x4 gv[2][2];
#pragma unroll
        for (int bj = 0; bj < 2; ++bj)
#pragma unroll
            for (int n = 0; n < 2; ++n) gv[bj][n] = *(const f32x4*)(gate + col0 + bj * HALF + n * 16) + 1.0f;
#pragma unroll
        for (int ai = 0; ai < 2; ++ai)
#pragma unroll
            for (int m = 0; m < 4; ++m) { const size_t off = (size_t)(row0 + ai * HALF + m * 16) * ldc + col0;
#pragma unroll
                for (int bj = 0; bj < 2; ++bj)
#pragma unroll
                    for (int n = 0; n < 2; ++n) { const f32x4 xr = *(const f32x4*)(xres + off + bj * HALF + n * 16);
                        *(f32x4*)(z + off + bj * HALF + n * 16) = xr * alpha + gv[bj][n] * acc[ai][bj][m][n]; }
                if (m == 3) asm volatile("" ::: "memory"); }
    }
};
struct EpiSwiglu {
    static constexpr bool PERM = true, AFTER_DRAIN = false;
    bf16_t* H; int ldc;
    __device__ __forceinline__ void operator()(const f32x4 (&acc)[2][2][4][2], const Unit& u, int wr, int wc, int fr, int fq) const {
        const int row0 = u.pm * BM + wr * 64 + fr, col0 = u.pn * HALF + wc * 32 + 8 * fq;
#pragma unroll
        for (int ai = 0; ai < 2; ++ai)
#pragma unroll
            for (int m = 0; m < 4; ++m) { f32x4 h[2];
#pragma unroll
                for (int n = 0; n < 2; ++n) { const f32x4 g = acc[ai][0][m][n], up = acc[ai][1][m][n];
#pragma unroll
                    for (int j = 0; j < 4; ++j) h[n][j] = g[j] * __builtin_amdgcn_rcpf(1.0f + __builtin_amdgcn_exp2f(-1.4426950408889634f * g[j])) * up[j]; }
                *(u32x4*)(H + (size_t)(row0 + ai * HALF + m * 16) * ldc + col0) = pack8(h[0], h[1]); }
    }
};
template <class Epi, class Sched, bool ALIGN_EPI = false, bool SP2 = false>
__device__ __forceinline__ void gemm_phase(PG8_LAS unsigned char* lds, const Gemm g, const Sched& S, const Epi& E) {
    int tid_ = threadIdx.x; asm volatile("" : "+v"(tid_)); const int tid = tid_, wid = __builtin_amdgcn_readfirstlane(tid >> 6), lane = tid & 63, wr = wid >> 2, wc = wid & 3, fr = lane & 15, fq = lane >> 4;
    int Kv_ = g.K, lda_ = g.lda; asm volatile("" : "+s"(Kv_), "+s"(lda_)); const int K = Kv_, nt = K / BK;
    unsigned voffA[2], voffB[2];
#pragma unroll
    for (int i = 0; i < 2; ++i) { int R, C; stage_rc(tid * 16 + i * 8192, R, C); const int Rb = Epi::PERM ? ((R & ~31) + perm32(R & 31)) : R;
        voffA[i] = (unsigned)(R * lda_ + C) * 2u; voffB[i] = (unsigned)(Rb * K + C) * 2u; }
    const size_t kstep = (size_t)(BK * 2);
    const size_t hstepA = (size_t)HALF * lda_ * 2, hstepB = (size_t)HALF * K * 2;
    const size_t tstepA = 2 * hstepA, tstepB = 2 * hstepB;
    const unsigned ldsw = (unsigned)wid * 1024u;
    const int aoff = lds_byte(wr * 64 + fr, fq * 8), boff = lds_byte(wc * 32 + fr, fq * 8);
#define PG8_SA(b, h) (((b) * 2 + (h)) * HTB)
#define PG8_SB(b, h) ((4 + (b) * 2 + (h)) * HTB)
#define PG8_STAGE(bufoff, gbase, voff) do { _Pragma("unroll") for (int _i = 0; _i < 2; ++_i) \
        __builtin_amdgcn_global_load_lds((const unsigned*)((const char*)(gbase) + (voff)[_i]), (PG8_LAS unsigned*)(lds + (bufoff) + ldsw + _i * 8192), 16, 0, 0); } while (0)
#define PG8_LDA(dst, b, h) do { _Pragma("unroll") for (int m = 0; m < 4; ++m) _Pragma("unroll") for (int k = 0; k < 2; ++k) dst[m][k] = *(const PG8_LAS bf16x8*)(lds + PG8_SA(b, h) + aoff + m * 2048 + k * 1024); } while (0)
#define PG8_LDB(dst, b, h) do { _Pragma("unroll") for (int n = 0; n < 2; ++n) _Pragma("unroll") for (int k = 0; k < 2; ++k) dst[n][k] = *(const PG8_LAS bf16x8*)(lds + PG8_SB(b, h) + boff + n * 2048 + k * 1024); } while (0)
#define PG8_MMA(ai, bj, At, Bt) do { __builtin_amdgcn_s_setprio(1); _Pragma("unroll") for (int m = 0; m < 4; ++m) _Pragma("unroll") for (int n = 0; n < 2; ++n) _Pragma("unroll") for (int k = 0; k < 2; ++k) \
        acc[ai][bj][m][n] = __builtin_amdgcn_mfma_f32_16x16x32_bf16(Bt[n][k], At[m][k], acc[ai][bj][m][n], 0, 0, 0); __builtin_amdgcn_s_setprio(0); } while (0)
#define PG8_WAIT_V(n) asm volatile("s_waitcnt vmcnt(" #n ")" ::: "memory")
#define PG8_WAIT_L(n) asm volatile("s_waitcnt lgkmcnt(" #n ")" ::: "memory")
#define PG8_BAR __builtin_amdgcn_s_barrier()
#define PG8_SCHED __builtin_amdgcn_sched_barrier(0)
    Unit cur, nxt; int ui = 0;
    if (!S.next(0, cur)) return;
    f32x4 acc[2][2][4][2];
#pragma unroll
    for (int a = 0; a < 2; ++a)
#pragma unroll
        for (int b = 0; b < 2; ++b)
#pragma unroll
            for (int m = 0; m < 4; ++m)
#pragma unroll
                for (int n = 0; n < 2; ++n) acc[a][b][m][n] = (f32x4){0.f, 0.f, 0.f, 0.f};
    bf16x8 At[4][2], B0[2][2], B1[2][2];
    const char* cA = (const char*)g.A + (size_t)cur.pm * tstepA; const char* cB = (const char*)g.Bt + (size_t)cur.pn * tstepB;
    S.a_ready(cur);
    if constexpr (SP2) {
        PG8_STAGE(PG8_SB(0, 0), cB, voffB); PG8_STAGE(PG8_SB(0, 1), cB + hstepB, voffB); PG8_STAGE(PG8_SA(0, 0), cA, voffA); PG8_STAGE(PG8_SA(0, 1), cA + hstepA, voffA);
        if (wr == 1) PG8_BAR;
        PG8_WAIT_V(2); PG8_BAR;
        PG8_STAGE(PG8_SB(1, 0), cB + kstep, voffB); PG8_STAGE(PG8_SA(1, 0), cA + kstep, voffA); PG8_STAGE(PG8_SB(1, 1), cB + hstepB + kstep, voffB);
        PG8_WAIT_V(6); PG8_BAR;
    } else {
        PG8_STAGE(PG8_SB(0, 0), cB, voffB); PG8_STAGE(PG8_SA(0, 0), cA, voffA); PG8_STAGE(PG8_SB(0, 1), cB + hstepB, voffB); PG8_STAGE(PG8_SA(0, 1), cA + hstepA, voffA);
        if (wr == 1) PG8_BAR;
        PG8_WAIT_V(4); PG8_BAR;
        PG8_STAGE(PG8_SB(1, 0), cB + kstep, voffB); PG8_STAGE(PG8_SA(1, 0), cA + kstep, voffA); PG8_STAGE(PG8_SB(1, 1), cB + hstepB + kstep, voffB);
        PG8_WAIT_V(6); PG8_BAR;
    }
    for (;;) {
        const bool has_next = S.next(ui + 1, nxt);
        const char* nA = has_next ? (const char*)g.A + (size_t)nxt.pm * tstepA : cA; const char* nB = has_next ? (const char*)g.Bt + (size_t)nxt.pn * tstepB : cB;
        for (int t = 0; t < nt; t += 2) {
            const bool last = (t == nt - 2);
            const char* a1 = cA + (size_t)(t + 1) * kstep;
            const char* a2 = last ? nA : cA + (size_t)(t + 2) * kstep; const char* b2 = last ? nB : cB + (size_t)(t + 2) * kstep;
            const char* a3 = a2 + kstep; const char* b3 = b2 + kstep;
            if (last && has_next) S.a_ready(nxt);
            if constexpr (SP2) {
            PG8_LDB(B0, 0, 0); PG8_LDB(B1, 0, 1); PG8_SCHED; PG8_LDA(At, 0, 0); PG8_STAGE(PG8_SA(1, 1), a1 + hstepA, voffA);
            PG8_WAIT_V(8); PG8_WAIT_L(0); PG8_BAR; PG8_MMA(0, 0, At, B0); PG8_MMA(0, 1, At, B1); PG8_BAR; PG8_SCHED;
            PG8_LDA(At, 0, 1); PG8_STAGE(PG8_SB(0, 0), b2, voffB); PG8_STAGE(PG8_SB(0, 1), b2 + hstepB, voffB); PG8_STAGE(PG8_SA(0, 0), a2, voffA);
            PG8_WAIT_V(8); PG8_WAIT_L(0); PG8_BAR; PG8_MMA(1, 0, At, B0); PG8_MMA(1, 1, At, B1); PG8_BAR; PG8_SCHED;
            PG8_LDB(B0, 1, 0); PG8_LDB(B1, 1, 1); PG8_SCHED; PG8_LDA(At, 1, 0); PG8_STAGE(PG8_SA(0, 1), a2 + hstepA, voffA);
            PG8_WAIT_V(8); PG8_WAIT_L(0); PG8_BAR; PG8_MMA(0, 0, At, B0); PG8_MMA(0, 1, At, B1); PG8_BAR; PG8_SCHED;
            PG8_LDA(At, 1, 1); PG8_STAGE(PG8_SB(1, 0), b3, voffB); PG8_STAGE(PG8_SB(1, 1), b3 + hstepB, voffB); PG8_STAGE(PG8_SA(1, 0), a3, voffA);
            PG8_WAIT_V(8); PG8_WAIT_L(0); PG8_BAR; PG8_MMA(1, 0, At, B0); PG8_MMA(1, 1, At, B1); PG8_BAR; PG8_SCHED;
            } else {
            PG8_LDB(B0, 0, 0); PG8_SCHED; PG8_LDA(At, 0, 0); PG8_STAGE(PG8_SA(1, 1), a1 + hstepA, voffA);
            PG8_WAIT_L(8); PG8_BAR; PG8_WAIT_L(0); PG8_MMA(0, 0, At, B0); PG8_BAR; PG8_SCHED;
            PG8_LDB(B1, 0, 1); PG8_STAGE(PG8_SB(0, 0), b2, voffB);
            PG8_BAR; PG8_WAIT_L(0); PG8_MMA(0, 1, At, B1); PG8_BAR;
            PG8_LDA(At, 0, 1); PG8_STAGE(PG8_SA(0, 0), a2, voffA);
            PG8_BAR; PG8_WAIT_L(0); PG8_MMA(1, 0, At, B0); PG8_BAR; PG8_SCHED;
            PG8_STAGE(PG8_SB(0, 1), b2 + hstepB, voffB);
            PG8_WAIT_V(6); PG8_BAR; PG8_MMA(1, 1, At, B1); PG8_BAR;
            PG8_LDB(B0, 1, 0); PG8_SCHED; PG8_LDA(At, 1, 0); PG8_STAGE(PG8_SA(0, 1), a2 + hstepA, voffA);
            PG8_WAIT_L(8); PG8_BAR; PG8_WAIT_L(0); PG8_MMA(0, 0, At, B0); PG8_BAR; PG8_SCHED;
            PG8_LDB(B1, 1, 1); PG8_STAGE(PG8_SB(1, 0), b3, voffB);
            PG8_BAR; PG8_WAIT_L(0); PG8_MMA(0, 1, At, B1); PG8_BAR;
            PG8_LDA(At, 1, 1); PG8_STAGE(PG8_SA(1, 0), a3, voffA);
            PG8_BAR; PG8_WAIT_L(0); PG8_MMA(1, 0, At, B0); PG8_BAR; PG8_SCHED;
            PG8_STAGE(PG8_SB(1, 1), b3 + hstepB, voffB);
            PG8_WAIT_V(6); PG8_BAR; PG8_MMA(1, 1, At, B1); PG8_BAR;
            }
        }
        if constexpr (ALIGN_EPI) { if (wr == 0) PG8_BAR; }
        if constexpr (!Epi::AFTER_DRAIN) { E(acc, cur, wr, wc, fr, fq); S.done(cur); }
        if (!has_next) break;
#pragma unroll
        for (int a = 0; a < 2; ++a)
#pragma unroll
            for (int b = 0; b < 2; ++b)
#pragma unroll
                for (int m = 0; m < 4; ++m)
#pragma unroll
                    for (int n = 0; n < 2; ++n) acc[a][b][m][n] = (f32x4){0.f, 0.f, 0.f, 0.f};
        cur = nxt; cA = nA; cB = nB; ++ui;
        if constexpr (ALIGN_EPI) { if (wr == 1) PG8_BAR; }
    }
    PG8_WAIT_V(0);
    if constexpr (!ALIGN_EPI) { if (wr == 0) PG8_BAR; }
    PG8_BAR;
    if constexpr (Epi::AFTER_DRAIN) { E.fused(acc, cur, wr, wc, fr, fq, lds, wid, lane); S.done(cur); }
#undef PG8_SA
#undef PG8_SB
#undef PG8_STAGE
#undef PG8_LDA
#undef PG8_LDB
#undef PG8_MMA
#undef PG8_WAIT_V
#undef PG8_WAIT_L
#undef PG8_BAR
#undef PG8_SCHED
}
}

#define LAS __attribute__((address_space(3)))
typedef unsigned short bf16_t;
typedef float f32x4 __attribute__((ext_vector_type(4)));
typedef unsigned u32x4 __attribute__((ext_vector_type(4)));
typedef unsigned u32x2 __attribute__((ext_vector_type(2)));
constexpr int S = 8192, DM = 2048, DEPTH = 2, DIN = 3648, DINP = 3840, DFF = 5632;
constexpr int QLD = 1280, KLD = 1152, VLD = 768;
constexpr int C_QA = 0, C_KA = 512, C_VA = 1024, C_CQ = 1536, C_CKV = 2048, C_KR = 2304, C_QC = 2368, C_KC = 3136, C_VC = 3392;
constexpr float ALPHA = 1.4142135623730951f;
constexpr size_t al256(size_t x) { return (x + 255) / 256 * 256; }
constexpr size_t SZ_WIN = (size_t)DINP * DM * 2, SZ_WUQ = (size_t)1280 * 512 * 2, SZ_WUKV = (size_t)1536 * 256 * 2, SZ_WO = (size_t)DM * DM * 2, SZ_WGU = (size_t)2 * DFF * DM * 2, SZ_WDN = (size_t)DM * DFF * 2;
constexpr size_t O_WIN = 0, O_WUQ = O_WIN + SZ_WIN, O_WUKV = O_WUQ + SZ_WUQ, O_WO = O_WUKV + SZ_WUKV, O_WGU = O_WO + SZ_WO, O_WDN = O_WGU + SZ_WGU, SZ_WL = O_WDN + SZ_WDN;
constexpr size_t WS_W = 0;
constexpr size_t WS_MOD = al256(WS_W + DEPTH * SZ_WL);
constexpr size_t WS_ROPE = al256(WS_MOD + (size_t)DEPTH * 6 * DM * 4);
constexpr size_t WS_RSQ = al256(WS_ROPE + (size_t)S * 64 * 4);
constexpr size_t WS_RSKV = al256(WS_RSQ + (size_t)S * 4);
constexpr size_t WS_X = al256(WS_RSKV + (size_t)S * 4);
constexpr size_t WS_U = al256(WS_X + (size_t)S * DM * 4);
constexpr size_t WS_PROJ = al256(WS_U + (size_t)S * DM * 2);
constexpr size_t WS_Q = al256(WS_PROJ + (size_t)S * DINP * 2);
constexpr size_t WS_K = al256(WS_Q + (size_t)S * QLD * 2);
constexpr size_t WS_V = al256(WS_K + (size_t)S * KLD * 2);
constexpr size_t WS_Y = al256(WS_V + (size_t)S * VLD * 2);
constexpr size_t WS_H = al256(WS_Y + (size_t)S * DM * 2);
constexpr size_t WS_PART = al256(WS_H + (size_t)S * DFF * 2);
constexpr size_t WS_STAT = al256(WS_PART + (size_t)4 * S * VLD * 2);
constexpr size_t WS_SSQ = al256(WS_STAT + (size_t)4 * 6 * S * 2 * 4);
constexpr size_t WS_BAR0_ = WS_SSQ + (size_t)S * 12 * 4;
constexpr size_t WS_BAR = al256(WS_BAR0_);
constexpr size_t WS_END = al256(WS_BAR + 16384);
constexpr int TAB_OFF = pg8::STAGE_BYTES, LDS_BYTES = pg8::STAGE_BYTES + 256;
constexpr int NTHREADS = 512;

struct Args { const float* in[19]; float* out; unsigned char* ws; int ph_lo, ph_hi; };
struct Tab {
    const LAS unsigned* t;
    __device__ __forceinline__ unsigned long long ld(int i) const { const unsigned lo = __builtin_amdgcn_readfirstlane(t[2 * i]), hi = __builtin_amdgcn_readfirstlane(t[2 * i + 1]); return ((unsigned long long)hi << 32) | lo; }
    __device__ __forceinline__ const float* in(int i) const { return (const float*)ld(i); }
    __device__ __forceinline__ float* out() const { return (float*)ld(19); }
    __device__ __forceinline__ unsigned char* wsp() const { return (unsigned char*)ld(20); }
};

__device__ __forceinline__ float bf2f(unsigned short b) { return __uint_as_float((unsigned)b << 16); }
template <int CTRL> __device__ __forceinline__ float dpp_mov(float v) { return __builtin_bit_cast(float, __builtin_amdgcn_update_dpp(0, __builtin_bit_cast(int, v), CTRL, 0xf, 0xf, true)); }
__device__ __forceinline__ float wave_sum(float v) {
    v += dpp_mov<0xB1>(v);
    v += dpp_mov<0x4E>(v);
    v += dpp_mov<0x141>(v);
    v += dpp_mov<0x140>(v);
    { auto rr = __builtin_amdgcn_permlane16_swap(__float_as_uint(v), __float_as_uint(v), false, false); v = __uint_as_float(rr[0]) + __uint_as_float(rr[1]); }
    { auto rr = __builtin_amdgcn_permlane32_swap(__float_as_uint(v), __float_as_uint(v), false, false); v = __uint_as_float(rr[0]) + __uint_as_float(rr[1]); }
    return v; }
using pg8::cvt_pk_bf16;
__device__ __forceinline__ int otid() { int t = threadIdx.x; asm volatile("" : "+v"(t)); return t; }

__device__ __forceinline__ void phase_mod(const Tab tb, unsigned char* lds_g) {
    unsigned char* ws_ = tb.wsp(); const float* in1 = tb.in(1); const float* in2 = tb.in(2); const float* in3 = tb.in(3);
    float* condL = (float*)lds_g; f32x4* red = (f32x4*)(lds_g + 8192);
    const int tid = otid();
    const float* c = in1;
    for (int i = tid; i < DM; i += NTHREADS) { const float v = c[i]; condL[i] = v / (1.0f + __expf(-v)); }
    __syncthreads();
    float* mod = (float*)(ws_ + WS_MOD);
    const int cl = tid & 31, kg = tid >> 5;
    for (int item = blockIdx.x; item < DEPTH * 96; item += gridDim.x) {
        const int l = item / 96, cgp = item % 96;
        const float* W = in2 + (size_t)l * DM * 6 * DM + (size_t)(kg * 128) * (6 * DM) + cgp * 128 + 4 * cl;
        f32x4 acc = {0.f, 0.f, 0.f, 0.f};
#pragma unroll 8
        for (int kk = 0; kk < 128; ++kk) { const f32x4 w = __builtin_nontemporal_load((const f32x4*)(W + (size_t)kk * (6 * DM))); acc += w * condL[kg * 128 + kk]; }
        red[kg * 32 + cl] = acc;
        __syncthreads();
        if (tid < 128) { float s = 0.f; const float* rf = (const float*)red;
            for (int g = 0; g < 16; ++g) s += rf[g * 128 + tid];
            mod[l * 6 * DM + cgp * 128 + tid] = s + in3[l * 6 * DM + cgp * 128 + tid]; }
        __syncthreads();
    }
}

template <int PERMT>
__device__ __forceinline__ int dst_row(int n) {
    if (PERMT == 1) { const int h = n / 192, d = n % 192; if (d < 128) return n; const int j = d - 128; return h * 192 + 128 + 2 * (j & 31) + (j >> 5); }
    if (PERMT == 3) { if (n < C_KR || n >= C_KR + 64) return n; const int j = n - C_KR; return C_KR + 2 * (j & 31) + (j >> 5); }
    if (PERMT == 2) { if (n < DFF) return 256 * (n >> 7) + (n & 127); const int m = n - DFF; return 256 * (m >> 7) + 128 + (m & 127); }
    return n;
}
template <int PERMT>
__device__ __forceinline__ void transpose_job(const float* __restrict__ src, bf16_t* __restrict__ dst, int K, int N, int Npad, const float* __restrict__ kscale, unsigned char* lds_g, int first, int stride) {
    float* T = (float*)lds_g;
    const int tid = otid(), nkt = K / 64, nnt = (N + 255) / 256, ntiles = nkt * nnt;
    for (int t = first; t < ntiles; t += stride) {
        const int k0 = (t % nkt) * 64, n0 = (t / nkt) * 256;
        { const int kk = tid >> 6, n4 = tid & 63; const bool ok = n0 + 4 * n4 < N; f32x4 v[8];
#pragma unroll
          for (int i = 0; i < 8; ++i) { const int k = k0 + kk + 8 * i; v[i] = ok ? __builtin_nontemporal_load((const f32x4*)(src + (size_t)k * N + n0 + 4 * n4)) : (f32x4){0.f, 0.f, 0.f, 0.f}; }
#pragma unroll
          for (int i = 0; i < 8; ++i) { const int k = k0 + kk + 8 * i; if (kscale) v[i] = v[i] * kscale[k];
              float* tp = T + (kk + 8 * i) * 257 + 4 * n4; tp[0] = v[i][0]; tp[1] = v[i][1]; tp[2] = v[i][2]; tp[3] = v[i][3]; } }
        __syncthreads();
        { const int n = tid >> 1, ks = tid & 1;
          if (n0 + n < N) { bf16_t* dp = dst + (size_t)dst_row<PERMT>(n0 + n) * K + k0 + 32 * ks;
#pragma unroll
            for (int eb = 0; eb < 4; ++eb) { float v[8];
#pragma unroll
              for (int e = 0; e < 8; ++e) v[e] = T[(32 * ks + 8 * eb + e) * 257 + n];
              u32x4 w; w.x = cvt_pk_bf16(v[0], v[1]); w.y = cvt_pk_bf16(v[2], v[3]); w.z = cvt_pk_bf16(v[4], v[5]); w.w = cvt_pk_bf16(v[6], v[7]);
              *(u32x4*)(dp + 8 * eb) = w; } } }
        __syncthreads();
    }
    const size_t nz = (size_t)(Npad - N) * K / 8;
    for (size_t i = (size_t)blockIdx.x * NTHREADS + tid; i < nz; i += (size_t)gridDim.x * NTHREADS) *(u32x4*)(dst + (size_t)N * K + i * 8) = (u32x4){0u, 0u, 0u, 0u};
}

__device__ __forceinline__ void modulate_rows(const float* __restrict__ x, const float* __restrict__ sc, const float* __restrict__ sh, bf16_t* __restrict__ u) {
    const size_t n8 = (size_t)S * DM / 8;
    for (size_t i = (size_t)blockIdx.x * NTHREADS + otid(); i < n8; i += (size_t)gridDim.x * NTHREADS) {
        const int col = (int)((i * 8) % DM);
        const f32x4 x0 = *(const f32x4*)(x + i * 8), x1 = *(const f32x4*)(x + i * 8 + 4);
        const f32x4 s0 = *(const f32x4*)(sc + col) + 1.0f, s1 = *(const f32x4*)(sc + col + 4) + 1.0f;
        const f32x4 h0 = *(const f32x4*)(sh + col), h1 = *(const f32x4*)(sh + col + 4);
        *(u32x4*)(u + i * 8) = pg8::pack8(x0 * s0 + h0, x1 * s1 + h1);
    }
}

__device__ __forceinline__ void rope_table(float* __restrict__ rope) {
    for (int i = blockIdx.x * NTHREADS + otid(); i < S * 32; i += gridDim.x * NTHREADS) {
        const int pos = i >> 5, j = i & 31;
        const float inv = exp2f(-(float)j * (13.287712379549449f / 32.0f));
        const float ang = (float)pos * inv;
        const double rev = (double)ang * 0.15915494309189535;
        const double fr = rev - floor(rev);
        const float ar = (float)(fr * 6.283185307179586);
        rope[(size_t)pos * 64 + j] = cosf(ar); rope[(size_t)pos * 64 + 32 + j] = sinf(ar);
    }
}

__device__ __forceinline__ void phase_prep(unsigned char* ws_) {
    const bf16_t* proj = (const bf16_t*)(ws_ + WS_PROJ); const float* rope = (const float*)(ws_ + WS_ROPE);
    float* rsq = (float*)(ws_ + WS_RSQ); float* rskv = (float*)(ws_ + WS_RSKV); bf16_t* Kb = (bf16_t*)(ws_ + WS_K);
    const int tid_o = otid(), lane = tid_o & 63, wave = tid_o >> 6;
    for (int r = blockIdx.x * 8 + wave; r < S; r += gridDim.x * 8) {
        const bf16_t* pr = proj + (size_t)r * DINP;
        { const u32x4 w = *(const u32x4*)(pr + C_CQ + 8 * lane); float ss = 0.f;
#pragma unroll
          for (int e = 0; e < 4; ++e) { const float lo = __uint_as_float(w[e] << 16), hi = __uint_as_float(w[e] & 0xffff0000u); ss += lo * lo + hi * hi; }
          ss = wave_sum(ss); if (lane == 0) rsq[r] = 1.0f / sqrtf(ss * (1.0f / 512.0f) + 1e-6f); }
        { const u32x2 w = *(const u32x2*)(pr + C_CKV + 4 * lane); float ss = 0.f;
#pragma unroll
          for (int e = 0; e < 2; ++e) { const float lo = __uint_as_float(w[e] << 16), hi = __uint_as_float(w[e] & 0xffff0000u); ss += lo * lo + hi * hi; }
          ss = wave_sum(ss); if (lane == 0) rskv[r] = 1.0f / sqrtf(ss * (1.0f / 256.0f) + 1e-6f); }
        { const int i = lane & 31; const float x1 = bf2f(pr[C_KR + i]), x2 = bf2f(pr[C_KR + 32 + i]);
          const float c = rope[(size_t)r * 64 + i], sn = rope[(size_t)r * 64 + 32 + i];
          const unsigned w = cvt_pk_bf16(x1 * c - x2 * sn, x2 * c + x1 * sn);
          const int hb = (lane >> 5) * 3;
#pragma unroll
          for (int h = 0; h < 3; ++h) *(unsigned*)(Kb + (size_t)r * KLD + (hb + h) * 192 + 128 + 2 * i) = w; }
    }
}

__device__ __forceinline__ void phase_ynorm(unsigned char* ws_) {
    bf16_t* y = (bf16_t*)(ws_ + WS_Y); const bf16_t* part = (const bf16_t*)(ws_ + WS_PART); const float* stat = (const float*)(ws_ + WS_STAT);
    const int tid_o = otid(), lane = tid_o & 63, wave = tid_o >> 6;
    const bool lowhalf = lane < 32;
    for (int r = blockIdx.x * 8 + wave; r < S; r += gridDim.x * 8) {
        bf16_t* yr = y + (size_t)r * DM;
        float v[4][8]; float ss[4];
#pragma unroll
        for (int j = 0; j < 4; ++j) {
            const bool fromPart = (j == 1) || (j == 2 && lowhalf);
            if (!fromPart) { const u32x4 w = *(const u32x4*)(yr + j * 512 + 8 * lane);
#pragma unroll
                for (int e = 0; e < 4; ++e) { v[j][2 * e] = __uint_as_float(w[e] << 16); v[j][2 * e + 1] = __uint_as_float(w[e] & 0xffff0000u); } }
            else { const int yb = j * 512 + 8 * lane - 512, h = yb >> 7; float m[4], lw[4];
#pragma unroll
                for (int i = 0; i < 4; ++i) { const float* st = stat + ((size_t)(i * 6 + h) * S + r) * 2; m[i] = st[0]; lw[i] = st[1]; }
                const float M = fmaxf(fmaxf(m[0], m[1]), fmaxf(m[2], m[3])); float W = 0.f;
#pragma unroll
                for (int i = 0; i < 4; ++i) { lw[i] *= __builtin_amdgcn_exp2f(m[i] - M); W += lw[i]; }
                const float rW = 1.0f / W;
#pragma unroll
                for (int e = 0; e < 8; ++e) v[j][e] = 0.f;
#pragma unroll
                for (int i = 0; i < 4; ++i) { const u32x4 w = *(const u32x4*)(part + ((size_t)i * S + r) * VLD + yb); const float wi = lw[i] * rW;
#pragma unroll
                    for (int e = 0; e < 4; ++e) { v[j][2 * e] += wi * __uint_as_float(w[e] << 16); v[j][2 * e + 1] += wi * __uint_as_float(w[e] & 0xffff0000u); } } }
            float sq = 0.f;
#pragma unroll
            for (int e = 0; e < 8; ++e) sq += v[j][e] * v[j][e];
            ss[j] = sq;
        }
        const float sA = wave_sum(ss[0]);
        const float sB = wave_sum(ss[1] + (lowhalf ? ss[2] : 0.f));
        const float sC = wave_sum(ss[3] + (lowhalf ? 0.f : ss[2]));
        const float rA = 1.0f / sqrtf(sA * (1.0f / 512.0f) + 1e-6f), rB = 1.0f / sqrtf(sB * (1.0f / 768.0f) + 1e-6f), rC = 1.0f / sqrtf(sC * (1.0f / 768.0f) + 1e-6f);
#pragma unroll
        for (int j = 0; j < 4; ++j) { const float sc = j == 0 ? rA : (j == 1 ? rB : (j == 2 ? (lowhalf ? rB : rC) : rC)); u32x4 o;
#pragma unroll
            for (int e = 0; e < 4; ++e) o[e] = cvt_pk_bf16(v[j][2 * e] * sc, v[j][2 * e + 1] * sc);
            *(u32x4*)(yr + j * 512 + 8 * lane) = o; }
    }
}

__device__ __forceinline__ void phase_ln(const float* z, float* xo, const float* __restrict__ g, const float* __restrict__ b, const float* __restrict__ sc, const float* __restrict__ sh, bf16_t* __restrict__ u) {
    const int tid_o = otid(), lane = tid_o & 63, wave = tid_o >> 6;
    const int stride = gridDim.x * 8;
    for (int r = blockIdx.x * 8 + wave; r < S; r += 2 * stride) {
        const bool hasB = r + stride < S; const int rr[2] = {r, hasB ? r + stride : r};
        f32x4 v[2][8]; float s[2] = {0.f, 0.f};
#pragma unroll
        for (int k = 0; k < 2; ++k) { const float* zr = z + (size_t)rr[k] * DM;
#pragma unroll
            for (int j = 0; j < 8; ++j) v[k][j] = *(const f32x4*)(zr + j * 256 + 4 * lane); }
#pragma unroll
        for (int k = 0; k < 2; ++k)
#pragma unroll
            for (int j = 0; j < 8; ++j) s[k] += (v[k][j][0] + v[k][j][1]) + (v[k][j][2] + v[k][j][3]);
        float mean[2], rstd[2];
#pragma unroll
        for (int k = 0; k < 2; ++k) { mean[k] = wave_sum(s[k]) * (1.0f / DM); float q = 0.f;
#pragma unroll
            for (int j = 0; j < 8; ++j) { const f32x4 d = v[k][j] - mean[k]; q += (d[0] * d[0] + d[1] * d[1]) + (d[2] * d[2] + d[3] * d[3]); }
            rstd[k] = 1.0f / sqrtf(wave_sum(q) * (1.0f / DM) + 1e-5f); }
#pragma unroll
        for (int j = 0; j < 8; ++j) { const int col = j * 256 + 4 * lane;
            const f32x4 gg = *(const f32x4*)(g + col), bb = *(const f32x4*)(b + col);
            f32x4 s1 = {0.f, 0.f, 0.f, 0.f}, h1 = {0.f, 0.f, 0.f, 0.f};
            if (u) { s1 = *(const f32x4*)(sc + col) + 1.0f; h1 = *(const f32x4*)(sh + col); }
#pragma unroll
            for (int k = 0; k < 2; ++k) { if (k == 1 && !hasB) continue;
                const f32x4 o = (v[k][j] - mean[k]) * rstd[k] * gg + bb;
                *(f32x4*)(xo + (size_t)rr[k] * DM + col) = o;
                if (u) { const f32x4 m = o * s1 + h1; u32x2 w; w.x = cvt_pk_bf16(m[0], m[1]); w.y = cvt_pk_bf16(m[2], m[3]); *(u32x2*)(u + (size_t)rr[k] * DM + col) = w; } } }
    }
}

template <int MODE>
__device__ __forceinline__ void naive_attn(unsigned char* ws_, const float* rpb, const float* sink, int l) {
    constexpr int DQK = MODE == 1 ? 192 : 128, NJ = DQK / 64, H = MODE == 0 ? 4 : 6;
    const bf16_t* proj = (const bf16_t*)(ws_ + WS_PROJ); bf16_t* y = (bf16_t*)(ws_ + WS_Y);
    const int tid_o = otid(), lane = tid_o & 63, wave = tid_o >> 6;
    for (int it = blockIdx.x * 8 + wave; it < S * H; it += gridDim.x * 8) {
        const int h = it / S, q = it % S;
        const bf16_t *Qp, *Kp, *Vp; int ldk, ldv, ycol; float scale;
        if (MODE == 0) { Qp = proj + (size_t)q * DINP + C_QA + 128 * h; Kp = proj + C_KA + 128 * h; Vp = proj + C_VA + 128 * h; ldk = DINP; ldv = DINP; ycol = 128 * h; scale = 0.08838834764831845f; }
        else if (MODE == 1) { Qp = (const bf16_t*)(ws_ + WS_Q) + (size_t)q * QLD + 192 * h; Kp = (const bf16_t*)(ws_ + WS_K) + 192 * h; Vp = (const bf16_t*)(ws_ + WS_V) + 128 * h; ldk = KLD; ldv = VLD; ycol = 512 + 128 * h; scale = 0.07216878364870322f; }
        else { Qp = proj + (size_t)q * DINP + C_QC + 128 * h; Kp = proj + C_KC + 128 * (h / 3); Vp = proj + C_VC + 128 * (h / 3); ldk = DINP; ldv = DINP; ycol = 1280 + 128 * h; scale = 0.08838834764831845f; }
        float qv[NJ];
#pragma unroll
        for (int j = 0; j < NJ; ++j) qv[j] = bf2f(Qp[64 * j + lane]) * scale;
        float m = -1e30f, ls = 0.f, o0 = 0.f, o1 = 0.f; int nkeys, klo = 0, r = 0, col = 0, r0 = 0, c0 = 0; float slope = 0.f;
        if (MODE == 0) { r = q >> 6; col = q & 63; r0 = min(max(r - 4, 0), 120); c0 = min(max(col - 8, 0), 48); nkeys = 128; }
        else if (MODE == 1) nkeys = S;
        else { klo = max(0, q - 128); nkeys = min(S - 1, q + 128) - klo + 1; m = sink[l * 6 + h]; ls = 1.f; slope = exp2f(-8.0f * (float)(h + 1) / 6.0f); }
        for (int kk = 0; kk < nkeys; ++kk) {
            int key; float bias = 0.f;
            if (MODE == 0) { const int krow = r0 + (kk >> 4), kcol = c0 + (kk & 15); key = krow * 64 + kcol; bias = rpb[((l * 4 + h) * 15 + (krow - r + 7)) * 31 + (kcol - col + 15)]; }
            else if (MODE == 1) key = kk;
            else { key = klo + kk; bias = -slope * fabsf((float)(q - key)); }
            float part = 0.f;
#pragma unroll
            for (int j = 0; j < NJ; ++j) part += qv[j] * bf2f(Kp[(size_t)key * ldk + 64 * j + lane]);
            const float s = wave_sum(part) + bias;
            const float mn = fmaxf(m, s), al = __expf(m - mn), p = __expf(s - mn);
            ls = ls * al + p;
            o0 = o0 * al + p * bf2f(Vp[(size_t)key * ldv + lane]); o1 = o1 * al + p * bf2f(Vp[(size_t)key * ldv + 64 + lane]);
            m = mn;
        }
        const float inv = 1.0f / ls;
        y[(size_t)q * DM + ycol + lane] = (bf16_t)(cvt_pk_bf16(o0 * inv, 0.f) & 0xffffu);
        y[(size_t)q * DM + ycol + 64 + lane] = (bf16_t)(cvt_pk_bf16(o1 * inv, 0.f) & 0xffffu);
    }
}

#define XB_TMO      128
#define XB_XCNT(j)  (256  + 64 * (j))
#define XB_XSUB(j)  (1280 + 64 * (j))
#define XB_XGEN(j)  (2304 + 64 * (j))
#define XB_TOP      3328
#define XB_TOPGEN   3392
#define XCD_BAR_WORDS 3456
#define XB_SPIN_CAP (1u << 18)

__device__ __forceinline__ unsigned xb_ld(unsigned* p)              { return __hip_atomic_load(p, __ATOMIC_RELAXED, __HIP_MEMORY_SCOPE_AGENT); }
__device__ __forceinline__ unsigned xb_add(unsigned* p, unsigned v) { return __hip_atomic_fetch_add(p, v, __ATOMIC_RELAXED, __HIP_MEMORY_SCOPE_AGENT); }
__device__ __forceinline__ unsigned xb_xcc_id() { return (unsigned)__builtin_amdgcn_s_getreg((3 << 11) | 20) & 0xFu; }
#define XB_SPIN(cond, bar) do { unsigned _sp = 0; while (cond) { __builtin_amdgcn_s_sleep(1); \
    if ((++_sp & 255u) == 0u) { if (xb_ld(&(bar)[XB_TMO])) break; if (_sp > XB_SPIN_CAP) { atomicAdd(&(bar)[XB_TMO], 1u); break; } } } } while (0)

struct XcdBarrier {
    unsigned* bar; unsigned x;
    volatile LAS unsigned* st;
};

__device__ __forceinline__ XcdBarrier xcd_barrier_post(unsigned* bar, volatile LAS unsigned* st) {
    XcdBarrier b; b.bar = bar; b.x = xb_xcc_id(); b.st = st;
    if (threadIdx.x == 0) (void)xb_add(&bar[XB_XCNT(b.x)], 1u);
    return b;
}
__device__ __forceinline__ void xcd_barrier_complete(unsigned* bar, unsigned x, unsigned& nloc, unsigned& nx) {
    const unsigned G = gridDim.x * gridDim.y * gridDim.z;
    unsigned sum, cnt, mine, sp = 0u;
    for (;;) {
        sum = 0u; cnt = 0u; mine = 0u;
#pragma unroll
        for (unsigned j = 0; j < 16; ++j) { const unsigned c = xb_ld(&bar[XB_XCNT(j)]); sum += c; cnt += (c > 0u) ? 1u : 0u; mine = (j == x) ? c : mine; }
        if (sum == G) break;
        __builtin_amdgcn_s_sleep(1);
        if ((++sp & 255u) == 0u) { if (xb_ld(&bar[XB_TMO])) break; if (sp > XB_SPIN_CAP) { atomicAdd(&bar[XB_TMO], 1u); break; } }
    }
    nloc = mine > 0u ? mine : 1u; nx = cnt > 0u ? cnt : 1u;
}

__device__ __forceinline__ void xcd_barrier(const XcdBarrier& b) {
    asm volatile("s_waitcnt vmcnt(0)" ::: "memory");
    __syncthreads();
    if (threadIdx.x == 0) {
        unsigned* bar = b.bar;
        __builtin_amdgcn_s_waitcnt(0);
        unsigned nloc = b.st[0], nx = b.st[1];
        if (nloc == 0u) { xcd_barrier_complete(bar, b.x, nloc, nx); b.st[0] = nloc; b.st[1] = nx; }
        const unsigned old = xb_add(&bar[XB_XSUB(b.x)], 1u);
        const unsigned gen = old / nloc;
        if (old + 1u == (gen + 1u) * nloc) {
            __builtin_amdgcn_fence(__ATOMIC_RELEASE, "agent");
            asm volatile("s_waitcnt vmcnt(0)" ::: "memory");
            const unsigned og = xb_add(&bar[XB_TOP], 1u);
            const unsigned tg = og / nx;
            if (og + 1u == (tg + 1u) * nx) xb_add(&bar[XB_TOPGEN], 1u);
            else XB_SPIN(xb_ld(&bar[XB_TOPGEN]) == tg, bar);
            __builtin_amdgcn_fence(__ATOMIC_ACQUIRE, "agent");
            xb_add(&bar[XB_XGEN(b.x)], 1u);
            asm volatile("s_waitcnt vmcnt(0)" ::: "memory");
        } else {
            XB_SPIN(xb_ld(&bar[XB_XGEN(b.x)]) == gen, bar);
            __builtin_amdgcn_fence(__ATOMIC_ACQUIRE, "agent");
            asm volatile("s_waitcnt vmcnt(0)" ::: "memory");
        }
    }
    __syncthreads();
}


namespace att {
typedef short bf16x8 __attribute__((ext_vector_type(8)));
typedef short s16x4 __attribute__((ext_vector_type(4)));
typedef float f32x16 __attribute__((ext_vector_type(16)));
#define ATT_SBAR() __builtin_amdgcn_sched_barrier(0)
#define ATT_BAR() do { asm volatile("s_waitcnt lgkmcnt(0)" ::: "memory"); __builtin_amdgcn_s_barrier(); asm volatile("" ::: "memory"); } while (0)
constexpr float LOG2E = 1.4426950408889634f, NEGM = -1e30f;
constexpr float DEFER_THR = 8.f;
constexpr int KVSPLIT = 4;
__device__ __forceinline__ int crow(int r, int hi) { return (r & 3) + 8 * (r >> 2) + 4 * hi; }
__device__ __forceinline__ unsigned cvtpk(float lo, float hi) { unsigned r; asm volatile("v_cvt_pk_bf16_f32 %0, %1, %2" : "=v"(r) : "v"(lo), "v"(hi)); return r; }
template <int DQK> __device__ __forceinline__ int kswz_x(int row) { return DQK == 128 ? (((row & 7) | (((row >> 4) & 1) << 3)) << 4) : (((row >> 1) & 7) << 4); }
template <int DQK> __device__ __forceinline__ int kswz(int row, int colB) { return row * (DQK * 2) + (colB ^ kswz_x<DQK>(row)); }
__device__ __forceinline__ int v_st(int k, int c) { const int kk = (k & ~0xC) | ((k & 4) << 1) | ((k & 8) >> 1); return ((kk >> 3) * 4 + (c >> 5)) * 512 + ((kk & 7) * 32 + (c & 31)) * 2; }
__device__ __forceinline__ int v_rd_base(int lane) { return ((lane & 3) << 3) | (((lane >> 2) & 3) << 6) | (((lane >> 4) & 1) << 5) | (((lane >> 5) & 1) << 8); }
constexpr int v_rd_off(int d0, int ks, int half) { return d0 * 512 + ks * 4096 + half * 2048; }
template <int OFF> __device__ __forceinline__ s16x4 tr_read(int vb) { s16x4 r; asm volatile("ds_read_b64_tr_b16 %0, %1 offset:%2" : "=&v"(r) : "v"(vb), "i"(OFF) : "memory"); return r; }
struct VFrag { s16x4 l0, h0, l1, h1, l2, h2, l3, h3; };
template <int D0> __device__ __forceinline__ void pv_read(VFrag& f, int vb) {
  f.l0 = tr_read<v_rd_off(D0, 0, 0)>(vb); f.h0 = tr_read<v_rd_off(D0, 0, 1)>(vb); f.l1 = tr_read<v_rd_off(D0, 1, 0)>(vb); f.h1 = tr_read<v_rd_off(D0, 1, 1)>(vb);
  f.l2 = tr_read<v_rd_off(D0, 2, 0)>(vb); f.h2 = tr_read<v_rd_off(D0, 2, 1)>(vb); f.l3 = tr_read<v_rd_off(D0, 3, 0)>(vb); f.h3 = tr_read<v_rd_off(D0, 3, 1)>(vb);
}
__device__ __forceinline__ void pv_mma(f32x16& od, const VFrag& f, bf16x8 pa0, bf16x8 pa1, bf16x8 pa2, bf16x8 pa3) {
#define ATT_PK(L, H) (bf16x8){L[0], L[1], L[2], L[3], H[0], H[1], H[2], H[3]}
  od = __builtin_amdgcn_mfma_f32_32x32x16_bf16(pa0, ATT_PK(f.l0, f.h0), od, 0, 0, 0);
  od = __builtin_amdgcn_mfma_f32_32x32x16_bf16(pa1, ATT_PK(f.l1, f.h1), od, 0, 0, 0);
  od = __builtin_amdgcn_mfma_f32_32x32x16_bf16(pa2, ATT_PK(f.l2, f.h2), od, 0, 0, 0);
  od = __builtin_amdgcn_mfma_f32_32x32x16_bf16(pa3, ATT_PK(f.l3, f.h3), od, 0, 0, 0);
#undef ATT_PK
}
__device__ __forceinline__ void pv_d0(f32x16* o, int vb, bf16x8 pa0, bf16x8 pa1, bf16x8 pa2, bf16x8 pa3) {
  VFrag fa, fb;
  pv_read<0>(fa, vb); pv_read<1>(fb, vb);
  asm volatile("s_waitcnt lgkmcnt(8)" ::: "memory"); ATT_SBAR(); pv_mma(o[0], fa, pa0, pa1, pa2, pa3); ATT_SBAR();
  pv_read<2>(fa, vb);
  asm volatile("s_waitcnt lgkmcnt(8)" ::: "memory"); ATT_SBAR(); pv_mma(o[1], fb, pa0, pa1, pa2, pa3); ATT_SBAR();
  pv_read<3>(fb, vb);
  asm volatile("s_waitcnt lgkmcnt(8)" ::: "memory"); ATT_SBAR(); pv_mma(o[2], fa, pa0, pa1, pa2, pa3); ATT_SBAR();
  asm volatile("s_waitcnt lgkmcnt(0)" ::: "memory"); ATT_SBAR(); pv_mma(o[3], fb, pa0, pa1, pa2, pa3);
}
typedef float f32x2 __attribute__((ext_vector_type(2)));
template <bool RAW>
__device__ __forceinline__ void softmax_tile(f32x16& p0, f32x16& p1, float Cs, float& m_reg, float& l_reg, float& alpha, bf16x8& pa0, bf16x8& pa1, bf16x8& pa2, bf16x8& pa3) {
  float pmax = fmaxf(fmaxf(p0[0], p0[1]), p1[0]);
#pragma unroll
  for (int r = 2; r < 16; r += 2) pmax = fmaxf(fmaxf(pmax, p0[r]), p0[r + 1]);
#pragma unroll
  for (int r = 1; r < 15; r += 2) pmax = fmaxf(fmaxf(pmax, p1[r]), p1[r + 1]);
  pmax = fmaxf(pmax, p1[15]);
  { auto rr = __builtin_amdgcn_permlane32_swap(__float_as_uint(pmax), __float_as_uint(pmax), false, false); pmax = fmaxf(__uint_as_float(rr[0]), __uint_as_float(rr[1])); }
  if (RAW) pmax *= Cs;
  float mn;
  if (__builtin_expect(__all(pmax - m_reg <= DEFER_THR * LOG2E), 1)) { mn = m_reg; alpha = 1.f; }
  else { mn = fmaxf(m_reg, pmax); alpha = __builtin_amdgcn_exp2f(m_reg - mn); m_reg = mn; }
#pragma unroll
  for (int r = 0; r < 16; ++r) { p0[r] = __builtin_amdgcn_exp2f(RAW ? fmaf(p0[r], Cs, -mn) : p0[r] - mn); p1[r] = __builtin_amdgcn_exp2f(RAW ? fmaf(p1[r], Cs, -mn) : p1[r] - mn); }
  f32x2 ps2 = {0.f, 0.f};
#pragma unroll
  for (int r = 0; r < 16; r += 2) { ps2 += (f32x2){p0[r], p0[r + 1]}; ps2 += (f32x2){p1[r], p1[r + 1]}; }
  float ps = ps2[0] + ps2[1];
  { auto rr = __builtin_amdgcn_permlane32_swap(__float_as_uint(ps), __float_as_uint(ps), false, false); ps = __uint_as_float(rr[0]) + __uint_as_float(rr[1]); }
  l_reg = l_reg * alpha + ps;
#define ATT_PK4(P, BASE, OUT) do { unsigned a0 = cvtpk(P[BASE + 0], P[BASE + 1]), a1 = cvtpk(P[BASE + 2], P[BASE + 3]);   \
    unsigned b0 = cvtpk(P[BASE + 4], P[BASE + 5]), b1 = cvtpk(P[BASE + 6], P[BASE + 7]);                              \
    auto r0 = __builtin_amdgcn_permlane32_swap(a0, b0, false, false); auto r1 = __builtin_amdgcn_permlane32_swap(a1, b1, false, false); \
    u32x4 w = {r0[0], r1[0], r0[1], r1[1]}; OUT = *reinterpret_cast<bf16x8*>(&w); } while (0)
  ATT_PK4(p0, 0, pa0); ATT_PK4(p0, 8, pa1); ATT_PK4(p1, 0, pa2); ATT_PK4(p1, 8, pa3);
#undef ATT_PK4
}

template <int MODE>
__device__ __forceinline__ void attn_unit(unsigned char* ws_, const float* rpb, const float* sink, int l, int h, int qb, int kvq, unsigned char* lds_g) {
  constexpr int DQK = MODE == 1 ? 192 : 128, ND = DQK / 16, NCH = DQK / 64;
  constexpr int SHM_V = 64 * 128 * 2, SHM_K = 64 * DQK * 2, OFF_K = 3 * SHM_V, OFF_WS = OFF_K + 3 * SHM_K, OFF_RPB = OFF_WS + 8 * 64 * 4;
  const int tid = otid(), wid = tid >> 6, lane = tid & 63, r32 = lane & 31, hi = lane >> 5;
  LAS unsigned char* ldl = (LAS unsigned char*)lds_g;
  const bf16_t* proj = (const bf16_t*)(ws_ + WS_PROJ);
  const bf16_t *Qp, *Kp, *Vp; int ldq, ldk, ldv, ycol; float C;
  if (MODE == 0) { Qp = proj + C_QA + 128 * h; Kp = proj + C_KA + 128 * h; Vp = proj + C_VA + 128 * h; ldq = ldk = ldv = DINP; ycol = 128 * h; C = 0.08838834764831845f * LOG2E; }
  else if (MODE == 1) { Qp = (const bf16_t*)(ws_ + WS_Q) + 192 * h; Kp = (const bf16_t*)(ws_ + WS_K) + 192 * h; Vp = (const bf16_t*)(ws_ + WS_V) + 128 * h; ldq = QLD; ldk = KLD; ldv = VLD; ycol = 512 + 128 * h; C = 0.07216878364870322f * LOG2E; }
  else { Qp = proj + C_QC + 128 * h; Kp = proj + C_KC + 128 * (h / 3); Vp = proj + C_VC + 128 * (h / 3); ldq = ldk = ldv = DINP; ycol = 1280 + 128 * h; C = 0.08838834764831845f * LOG2E; }
  const int q0 = qb * 256, qi = q0 + wid * 32 + r32;
  int T0, T1, tw0, tw1, wrow = 0, qcol = 0, c0 = 0; float slope2 = 0.f;
  if (MODE == 1) { T0 = tw0 = kvq * (S / 64 / KVSPLIT); T1 = tw1 = T0 + S / 64 / KVSPLIT; }
  else if (MODE == 0) { const int R = qb * 4; T0 = min(max(R - 4, 0), 120); T1 = min(max(R - 1, 0), 120) + 8; wrow = R + (wid >> 1); tw0 = min(max(wrow - 4, 0), 120); tw1 = tw0 + 8;
                        qcol = (wid & 1) * 32 + r32; c0 = min(max(qcol - 8, 0), 48); }
  else { T0 = max(0, (q0 - 128) >> 6); T1 = min(S / 64, ((q0 + 255 + 128) >> 6) + 1); const int qw = q0 + wid * 32; tw0 = max(0, (qw - 128) >> 6); tw1 = min(S / 64, ((qw + 31 + 128) >> 6) + 1);
         slope2 = exp2f(-8.0f * (float)(h + 1) / 6.0f) * LOG2E; }
  LAS float* wsl = (LAS float*)(ldl + OFF_WS) + wid * 64; LAS float* li_l = wsl; LAS float* al_l = wsl + 32;
  LAS float* rpbL = (LAS float*)(ldl + OFF_RPB);
  if (MODE == 0) { for (int i = tid; i < 465; i += NTHREADS) rpbL[i] = rpb[(l * 4 + h) * 465 + i] * LOG2E; }
  float m_reg = -1e29f, l_reg = 0.f;
  if (MODE == 2) { m_reg = sink[l * 6 + h] * LOG2E; l_reg = 1.f; }
  f32x16 o[4] = {}; bf16x8 qr[ND];
  { const bf16_t* Qw = Qp + (size_t)qi * ldq + hi * 8;
#pragma unroll
    for (int d0 = 0; d0 < ND; ++d0) qr[d0] = *(const bf16x8*)(Qw + d0 * 16); }
  unsigned kg[NCH], vg[2];
#pragma unroll
  for (int i = 0; i < NCH; ++i) { const int X = (wid + 8 * i) * 1024 + lane * 16, row = X / (DQK * 2), cs = X % (DQK * 2), colB = cs ^ kswz_x<DQK>(row); kg[i] = (unsigned)(row * ldk + (colB >> 1)) * 2u; }
#pragma unroll
  for (int i = 0; i < 2; ++i) { const int X = (wid + 8 * i) * 1024 + lane * 16, st = X >> 9, w = X & 511, kk = ((st >> 2) << 3) | (w >> 6), c = ((st & 3) << 5) | ((w & 63) >> 1);
    const int k = (kk & ~0xC) | ((kk & 4) << 1) | ((kk & 8) >> 1); vg[i] = (unsigned)(k * ldv + c) * 2u; }
  const int vb0 = (int)(uintptr_t)lds_g + v_rd_base(lane);
  const int kbase0 = (int)(uintptr_t)lds_g + OFF_K;
  constexpr int NKO = DQK == 192 ? 4 : ND;
  int ko[NKO];
#pragma unroll
  for (int d0 = 0; d0 < NKO; ++d0) ko[d0] = kswz<DQK>(r32, (d0 * 16 + hi * 8) * 2);
#define ATT_KO(d0_) (DQK == 192 ? ko[(d0_) & 3] + ((d0_) >> 2) * 128 : ko[(d0_) % NKO])
  const int wslab = __builtin_amdgcn_readfirstlane(wid) * 1024;
#define ATT_DMA(t, b) do { const char* kt_ = (const char*)(Kp + (size_t)(t) * 64 * ldk); const char* vt_ = (const char*)(Vp + (size_t)(t) * 64 * ldv); \
    _Pragma("unroll") for (int i_ = 0; i_ < NCH; ++i_) __builtin_amdgcn_global_load_lds((const unsigned*)(kt_ + kg[i_]), (LAS unsigned*)(ldl + OFF_K + (b) * SHM_K + wslab + i_ * 8192), 16, 0, 0); \
    _Pragma("unroll") for (int i_ = 0; i_ < 2; ++i_) __builtin_amdgcn_global_load_lds((const unsigned*)(vt_ + vg[i_]), (LAS unsigned*)(ldl + (b) * SHM_V + wslab + i_ * 8192), 16, 0, 0); } while (0)
  __syncthreads();
  ATT_DMA(T0, 0); if (T0 + 1 < T1) { ATT_DMA(T0 + 1, 1); asm volatile("s_waitcnt vmcnt(%0)" :: "n"(NCH + 2) : "memory"); } else asm volatile("s_waitcnt vmcnt(0)" ::: "memory");
  ATT_BAR();
  int b = 0, bn = 2;
#pragma unroll 1
  for (int j = T0; j < T1; ++j) {
    const bool vis_ = (j >= tw0 && j < tw1);
    if (vis_) {
      f32x16 p0 = {}, p1 = {};
      ATT_SBAR();
      {
        const int kbase = kbase0 + b * SHM_K;
        bf16x8 fa[3], fb[3];
#define ATT_KRD(d0_) do { const int ad_ = kbase + ATT_KO(d0_); \
          asm volatile("ds_read_b128 %0, %1" : "=v"(fa[(d0_) % 3]) : "v"(ad_) : "memory"); \
          asm volatile("ds_read_b128 %0, %1 offset:%2" : "=v"(fb[(d0_) % 3]) : "v"(ad_), "i"(32 * DQK * 2) : "memory"); } while (0)
        ATT_KRD(0); ATT_KRD(1);
#pragma unroll
        for (int d0 = 0; d0 < ND; ++d0) {
          if (d0 + 2 < ND) { ATT_KRD(d0 + 2); asm volatile("s_waitcnt lgkmcnt(4)" ::: "memory"); }
          else if (d0 + 1 < ND) asm volatile("s_waitcnt lgkmcnt(2)" ::: "memory");
          else asm volatile("s_waitcnt lgkmcnt(0)" ::: "memory");
          ATT_SBAR();
          p0 = __builtin_amdgcn_mfma_f32_32x32x16_bf16(fa[d0 % 3], qr[d0], p0, 0, 0, 0);
          p1 = __builtin_amdgcn_mfma_f32_32x32x16_bf16(fb[d0 % 3], qr[d0], p1, 0, 0, 0);
          ATT_SBAR(); }
#undef ATT_KRD
      }
      ATT_SBAR();
      if (MODE == 0) {
        const int dr31 = (j - wrow + 7) * 31 + 15 - qcol;
#pragma unroll
        for (int r = 0; r < 16; ++r) { const int kc = crow(r, hi);
          { const bool v = (kc >= c0) && (kc < c0 + 16); const float bb = rpbL[v ? dr31 + kc : 0]; p0[r] = v ? fmaf(p0[r], C, bb) : NEGM; }
          { const int kc1 = kc + 32; const bool v = (kc1 >= c0) && (kc1 < c0 + 16); const float bb = rpbL[v ? dr31 + kc1 : 0]; p1[r] = v ? fmaf(p1[r], C, bb) : NEGM; } }
      } else if (MODE == 2) {
        const int kb = j * 64;
#pragma unroll
        for (int r = 0; r < 16; ++r) { const int k = kb + crow(r, hi);
          { const int d = abs(qi - k); p0[r] = d <= 128 ? fmaf(p0[r], C, -slope2 * (float)d) : NEGM; }
          { const int d = abs(qi - k - 32); p1[r] = d <= 128 ? fmaf(p1[r], C, -slope2 * (float)d) : NEGM; } }
      }
      float alpha; bf16x8 pa0, pa1, pa2, pa3;
      softmax_tile<MODE == 1>(p0, p1, C, m_reg, l_reg, alpha, pa0, pa1, pa2, pa3);
      if (__any(alpha < 1.f)) { if (hi == 0) al_l[r32] = alpha; asm volatile("s_waitcnt lgkmcnt(0)" ::: "memory");
#pragma unroll
        for (int r = 0; r < 16; ++r) { const float av = al_l[crow(r, hi)];
#pragma unroll
          for (int d = 0; d < 4; ++d) o[d][r] *= av; }
        asm volatile("s_waitcnt lgkmcnt(0)" ::: "memory"); }
      ATT_SBAR();
      pv_d0(o, vb0 + b * SHM_V, pa0, pa1, pa2, pa3);
    }
#if defined(PROBE_ATT_VALU)
    if (MODE == 1) { float dx_ = m_reg;
#pragma unroll
      for (int i_ = 0; i_ < 32; ++i_) asm volatile("v_exp_f32 %0, %0" : "+v"(dx_));
      asm volatile("" :: "v"(dx_)); }
#endif
#if defined(PROBE_ATT_LDS)
    if (MODE == 1) { bf16x8 t_; const int ad_ = (int)(uintptr_t)lds_g + OFF_K + b * SHM_K + kswz<DQK>(r32, hi * 16);
#pragma unroll
      for (int i_ = 0; i_ < 24; ++i_) asm volatile("ds_read_b128 %0, %1 offset:%2" : "=v"(t_) : "v"(ad_), "i"((i_ % 12) * 32) : "memory");
      asm volatile("s_waitcnt lgkmcnt(0)" ::: "memory"); asm volatile("" :: "v"(t_)); }
#endif
#if defined(PROBE_ATT_MFMA)
    if (MODE == 1) { f32x4 da_ = {0.f, 0.f, 0.f, 0.f};
#pragma unroll
      for (int i_ = 0; i_ < 80; ++i_) da_ = __builtin_amdgcn_mfma_f32_16x16x32_bf16(qr[0], qr[1], da_, 0, 0, 0);
      asm volatile("" :: "v"(da_)); }
#endif
    ATT_SBAR();
    if (j + 2 < T1) ATT_DMA(j + 2, bn);
    if (j + 2 < T1) asm volatile("s_waitcnt vmcnt(%0)" :: "n"(NCH + 2) : "memory"); else asm volatile("s_waitcnt vmcnt(0)" ::: "memory");
    ATT_BAR();
    b = b == 2 ? 0 : b + 1; bn = bn == 2 ? 0 : bn + 1;
  }
  if (hi == 0) li_l[r32] = l_reg; asm volatile("s_waitcnt lgkmcnt(0)" ::: "memory");
  bf16_t* Ow; int ldo;
  if (MODE == 1) { Ow = (bf16_t*)(ws_ + WS_PART) + ((size_t)kvq * S + q0 + wid * 32) * VLD + 128 * h + r32; ldo = VLD;
    if (hi == 0) { float* st = (float*)(ws_ + WS_STAT) + ((size_t)(kvq * 6 + h) * S + qi) * 2; st[0] = m_reg; st[1] = l_reg; } }
  else { Ow = (bf16_t*)(ws_ + WS_Y) + (size_t)(q0 + wid * 32) * DM + ycol + r32; ldo = DM; }
#pragma unroll
  for (int r = 0; r < 16; ++r) { const int orow = crow(r, hi); const float rl = __builtin_amdgcn_rcpf(li_l[orow]);
#pragma unroll
    for (int d0 = 0; d0 < 4; ++d0) Ow[(size_t)orow * ldo + d0 * 32] = (bf16_t)(cvtpk(o[d0][r] * rl, 0.f) & 0xffffu); }
  asm volatile("s_waitcnt lgkmcnt(0)" ::: "memory");
  __syncthreads();
#undef ATT_DMA
#undef ATT_KO
}
}

#ifndef NAIVE_ATTN
#define NAIVE_ATTN 0
#endif
#ifndef MK_MULTI
#define MK_MULTI 0
#endif
constexpr int N_PHASES = 2 + 10 * DEPTH;
__device__ __forceinline__ int opq(int v) { asm volatile("" : "+s"(v)); return v; }

__global__ void __launch_bounds__(NTHREADS) fwd_megakernel(Args a) {
    extern __shared__ __attribute__((aligned(16))) unsigned char lds[];
    cg::grid_group grid = cg::this_grid();
    const int lo = a.ph_lo, hi = a.ph_hi;
    const int G = gridDim.x;
    { LAS unsigned long long* tw = (LAS unsigned long long*)((LAS unsigned char*)lds + TAB_OFF);
#pragma unroll
      for (int i = 0; i < 19; ++i) if ((int)threadIdx.x == i) tw[i] = (unsigned long long)a.in[i];
      if (threadIdx.x == 19) tw[19] = (unsigned long long)a.out;
      if (threadIdx.x == 20) tw[20] = (unsigned long long)a.ws;
      if (threadIdx.x < 4) ((LAS unsigned*)((LAS unsigned char*)lds + TAB_OFF + 192))[threadIdx.x] = 0u;
      __syncthreads(); }
    (void)xcd_barrier_post((unsigned*)(a.ws + WS_BAR), (volatile LAS unsigned*)((LAS unsigned char*)lds + TAB_OFF + 192));
    if (a.ph_lo < 0) grid.sync();
    const Tab T{(const LAS unsigned*)((LAS unsigned char*)lds + TAB_OFF)};
#define ws (T.wsp())
#define mod ((float*)(ws + WS_MOD))
#define U ((bf16_t*)(ws + WS_U))
#define PROJ ((bf16_t*)(ws + WS_PROJ))
#define Qb ((bf16_t*)(ws + WS_Q))
#define Kb ((bf16_t*)(ws + WS_K))
#define Vb ((bf16_t*)(ws + WS_V))
#define Y ((bf16_t*)(ws + WS_Y))
#define Hb ((bf16_t*)(ws + WS_H))
#define X ((float*)(ws + WS_X))
#define rope ((float*)(ws + WS_ROPE))
#define rsq ((float*)(ws + WS_RSQ))
#define rskv ((float*)(ws + WS_RSKV))
    PG8_LAS unsigned char* ldsl = (PG8_LAS unsigned char*)lds;
#ifndef PHM
#define PHM 0xFFFFF
#endif
#ifndef ATM
#define ATM 7
#endif
#define EN(b) ((PHM >> (b)) & 1)
#ifndef PROBE_PH
#define PROBE_PH -1
#endif
#ifndef PROBE_N
#define PROBE_N 2
#endif
#define REPK(k) for (int rep_ = 0; rep_ < ((k) == PROBE_PH ? PROBE_N : 1); ++rep_)
#define IN(k) (lo <= (k) && (k) < hi)
#define GBAR() do { XcdBarrier b_; b_.bar = (unsigned*)(ws + WS_BAR); b_.x = xb_xcc_id(); b_.st = (volatile LAS unsigned*)((LAS unsigned char*)lds + TAB_OFF + 192); xcd_barrier(b_); } while (0)
#define SEAM(k) do { if (IN(k) && IN((k) + 1)) GBAR(); } while (0)

#ifdef PROBE_SYNCS
    for (int i_ = 0; i_ < PROBE_SYNCS; ++i_) GBAR();
#endif
    if (EN(0) && IN(0)) REPK(0) { phase_mod(T, lds); }
    SEAM(0);
    if (EN(1) && IN(1)) REPK(1) {
        const int fb_ = opq((int)blockIdx.x), fs_ = opq(G); const bool hide_ = (fs_ == 256);
        for (int l = 0; l < DEPTH; ++l) {
            transpose_job<3>(T.in(4) + (size_t)l * DM * DIN, (bf16_t*)(ws + WS_W + (size_t)l * SZ_WL + O_WIN), DM, DIN, DINP, nullptr, lds, fb_, fs_);
            const int fh_ = (hide_ && l == 1) ? (1 << 30) : fb_, fh0_ = hide_ ? (1 << 30) : fb_;
            transpose_job<1>(T.in(8) + (size_t)l * 512 * 1152, (bf16_t*)(ws + WS_W + (size_t)l * SZ_WL + O_WUQ), 512, 1152, 1280, T.in(6) + l * 512, lds, fh0_, fs_);
            transpose_job<0>(T.in(9) + (size_t)l * 256 * 1536, (bf16_t*)(ws + WS_W + (size_t)l * SZ_WL + O_WUKV), 256, 1536, 1536, T.in(7) + l * 256, lds, fh0_, fs_);
            if (!hide_) transpose_job<0>(T.in(12) + (size_t)l * DM * DM, (bf16_t*)(ws + WS_W + (size_t)l * SZ_WL + O_WO), DM, DM, DM, T.in(11) + l * DM, lds, fb_, fs_);
            if (!(hide_ && l == 1)) transpose_job<2>(T.in(15) + (size_t)l * DM * 2 * DFF, (bf16_t*)(ws + WS_W + (size_t)l * SZ_WL + O_WGU), DM, 2 * DFF, 2 * DFF, nullptr, lds, fb_, fs_);
            transpose_job<0>(T.in(16) + (size_t)l * DFF * DM, (bf16_t*)(ws + WS_W + (size_t)l * SZ_WL + O_WDN), DFF, DM, DM, nullptr, lds, fh_, fs_);
        }
        modulate_rows(T.in(0), mod + 1 * DM, mod + 0 * DM, U);
        rope_table(rope);
    }
    SEAM(1);
#pragma unroll 1
    for (int l = 0; l < DEPTH; ++l) {
        const int pb = 2 + 10 * l;
        if (EN(2) && IN(pb + 0)) REPK(2) {
            pg8::Gemm g{U, (const bf16_t*)(ws + WS_W + (size_t)l * SZ_WL + O_WIN), S, DINP, DM, DM}; pg8::StaticOrder So; So.init(S, DINP, opq(G), opq((int)blockIdx.x));
            pg8::EpiProj E{PROJ, DINP, (float*)(ws + WS_SSQ), rope, Kb, KLD};
            pg8::gemm_phase<pg8::EpiProj, pg8::StaticOrder, true, true>(ldsl, g, So, E);
            if (opq(G) == 256 && opq((int)blockIdx.x) >= 224) {
                const int sb_ = opq((int)blockIdx.x) - 224; const size_t lo_ = (size_t)l;
                transpose_job<1>(T.in(8) + lo_ * 512 * 1152, (bf16_t*)(ws + WS_W + lo_ * SZ_WL + O_WUQ), 512, 1152, 1280, T.in(6) + lo_ * 512, lds, sb_, 32);
                transpose_job<0>(T.in(9) + lo_ * 256 * 1536, (bf16_t*)(ws + WS_W + lo_ * SZ_WL + O_WUKV), 256, 1536, 1536, T.in(7) + lo_ * 256, lds, (sb_ + 8) & 31, 32);
                transpose_job<0>(T.in(12) + lo_ * DM * DM, (bf16_t*)(ws + WS_W + lo_ * SZ_WL + O_WO), DM, DM, DM, T.in(11) + lo_ * DM, lds, sb_, 32); }
        }
        SEAM(pb + 0);
        if (EN(4) && IN(pb + 2)) REPK(4) {
            { const int bq = opq((int)blockIdx.x), Gq = opq(G);
#pragma unroll 1
              for (int it = 0; ; ++it) {
                int q0 = -1, kv0 = -1, kv1 = -1, na = -1, sw0 = -1, sw1 = -1;
                if (Gq == 256) { if (it == 0) {
                    if (bq < 96) { na = bq; q0 = bq; }
                    else if (bq < 128) { na = bq; kv0 = 2 * (bq - 96); kv1 = kv0 + 1; }
                    else if (bq < 192) { sw0 = bq - 128; q0 = 96 + (bq - 128); kv0 = 64 + 2 * (bq - 128); kv1 = kv0 + 1; }
                    else { sw0 = 64 + (bq - 192); sw1 = 128 + (bq - 192); } } }
                else { const int L = bq + it * Gq; if (L < 160) q0 = L; if (L < 192) { kv0 = L; sw0 = L; } if (L < 128) na = L; }
                if ((q0 & kv0 & na & sw0) < 0 && q0 < 0 && kv0 < 0 && na < 0 && sw0 < 0) break;
                if (q0 >= 0) { pg8::Gemm g{PROJ + C_CQ, (const bf16_t*)(ws + WS_W + (size_t)l * SZ_WL + O_WUQ), S, 1280, 512, DINP}; pg8::ListOrder So{5, 1, q0, 0};
                  pg8::EpiQ E{Qb, QLD, (const float*)(ws + WS_SSQ), rope};
                  pg8::gemm_phase<pg8::EpiQ, pg8::ListOrder, true, true>(ldsl, g, So, E); }
                if (kv0 >= 0) { pg8::Gemm g{PROJ + C_CKV, (const bf16_t*)(ws + WS_W + (size_t)l * SZ_WL + O_WUKV), S, 1536, 256, DINP}; pg8::ListOrder So{6, kv1 >= 0 ? 2 : 1, kv0, kv1};
                  pg8::EpiKV E{Kb, KLD, Vb, VLD, (const float*)(ws + WS_SSQ)};
                  pg8::gemm_phase<pg8::EpiKV, pg8::ListOrder, true, true>(ldsl, g, So, E); }
                if (na >= 0) { if (ATM & 2) att::attn_unit<0>(ws, T.in(5), T.in(10), l, na >> 5, na & 31, 0, lds); }
#pragma unroll 1
                for (int i2 = 0; i2 < 2; ++i2) { const int u = i2 ? sw1 : sw0; if (u >= 0) { if (ATM & 4) att::attn_unit<2>(ws, T.in(5), T.in(10), l, u >> 5, u & 31, 0, lds); } }
              } }
        }
        SEAM(pb + 2);
        if (EN(5) && IN(pb + 3)) REPK(5) {
#if NAIVE_ATTN
            naive_attn<0>(ws, T.in(5), T.in(10), l); naive_attn<2>(ws, T.in(5), T.in(10), l); naive_attn<1>(ws, T.in(5), T.in(10), l);
#else
            const int Gq = opq(G);
            for (int su = opq((int)blockIdx.x); su < 192 * att::KVSPLIT; su += Gq) {
                int combo, qb; if (Gq == 256) { combo = (su & 7) + 8 * (su >> 8); qb = (su & 255) >> 3; } else { combo = su >> 5; qb = su & 31; }
                unsigned char* wsp_ = ws;
                if (ATM & 1) att::attn_unit<1>(wsp_, nullptr, nullptr, l, combo >> 2, qb, combo & 3, lds);
            }
#endif
        }
        SEAM(pb + 3);
        if (EN(6) && IN(pb + 4)) phase_ynorm(ws);
        SEAM(pb + 4);
        if (EN(7) && IN(pb + 5)) {
            pg8::Gemm g{Y, (const bf16_t*)(ws + WS_W + (size_t)l * SZ_WL + O_WO), S, DM, DM, DM}; pg8::StaticOrder So; So.init(S, DM, opq(G), opq((int)blockIdx.x));
            pg8::EpiRes E{l == 0 ? T.in(0) : (const float*)X, X, mod + (size_t)l * 6 * DM + 2 * DM, ALPHA, DM};
            pg8::gemm_phase<pg8::EpiRes, pg8::StaticOrder, true, true>(ldsl, g, So, E);
        }
        SEAM(pb + 5);
#ifdef PROBE_LN
        if (EN(8) && IN(pb + 6)) phase_ln(X, (float*)(ws + WS_H), T.in(13) + l * DM, T.in(14) + l * DM, mod + (size_t)l * 6 * DM + 4 * DM, mod + (size_t)l * 6 * DM + 3 * DM, (bf16_t*)(ws + WS_PART));
#endif
        if (EN(8) && IN(pb + 6)) phase_ln(X, X, T.in(13) + l * DM, T.in(14) + l * DM, mod + (size_t)l * 6 * DM + 4 * DM, mod + (size_t)l * 6 * DM + 3 * DM, U);
        SEAM(pb + 6);
        if (EN(9) && IN(pb + 7)) REPK(9) {
            pg8::Gemm g{U, (const bf16_t*)(ws + WS_W + (size_t)l * SZ_WL + O_WGU), S, 2 * DFF, DM, DM}; pg8::StaticOrder So; So.init(S, 2 * DFF, opq(G), opq((int)blockIdx.x));
            pg8::EpiSwiglu E{Hb, DFF};
            pg8::gemm_phase<pg8::EpiSwiglu, pg8::StaticOrder, true, true>(ldsl, g, So, E);
            if (l == 0 && opq(G) == 256 && opq((int)blockIdx.x) >= 128)
                transpose_job<2>(T.in(15) + (size_t)DM * 2 * DFF, (bf16_t*)(ws + WS_W + SZ_WL + O_WGU), DM, 2 * DFF, 2 * DFF, nullptr, lds, opq((int)blockIdx.x) - 128, 128);
            if (l == 1 && opq(G) == 256 && opq((int)blockIdx.x) >= 128)
                transpose_job<0>(T.in(16) + (size_t)DFF * DM, (bf16_t*)(ws + WS_W + SZ_WL + O_WDN), DFF, DM, DM, nullptr, lds, opq((int)blockIdx.x) - 128, 128);
        }
        SEAM(pb + 7);
        if (EN(10) && IN(pb + 8)) {
            pg8::Gemm g{Hb, (const bf16_t*)(ws + WS_W + (size_t)l * SZ_WL + O_WDN), S, DM, DFF, DFF}; pg8::StaticOrder So; So.init(S, DM, opq(G), opq((int)blockIdx.x));
            pg8::EpiRes E{X, X, mod + (size_t)l * 6 * DM + 5 * DM, ALPHA, DM};
            pg8::gemm_phase<pg8::EpiRes, pg8::StaticOrder, true, true>(ldsl, g, So, E);
        }
        SEAM(pb + 8);
        if (EN(11) && IN(pb + 9)) {
            const bool last = (l == DEPTH - 1);
            const float* modn = mod + (size_t)(last ? l : l + 1) * 6 * DM;
            phase_ln(X, last ? T.out() : X, T.in(17) + l * DM, T.in(18) + l * DM, last ? nullptr : modn + 1 * DM, last ? nullptr : modn + 0 * DM, last ? nullptr : U);
        }
        SEAM(pb + 9);
    }
#undef IN
#undef SEAM
#undef ws
#undef mod
#undef U
#undef PROJ
#undef Qb
#undef Kb
#undef Vb
#undef Y
#undef Hb
#undef X
#undef rope
#undef rsq
#undef rskv
}

extern "C" void kernel_launch(void* const* d_in, const int* in_sizes, int n_in, void* d_out, int out_size, void* d_ws, size_t ws_size, hipStream_t stream) {
    static int grid = 0;
    if (grid == 0) {
        if (n_in != 19 || out_size != S * DM || ws_size < WS_END) { fprintf(stderr, "kernel_launch: unexpected shapes (n_in %d out %d ws %zu need %zu)\n", n_in, out_size, ws_size, (size_t)WS_END); grid = -1; return; }
        int dev = 0, cus = 0, per_cu = 0;
        hipGetDevice(&dev); hipDeviceGetAttribute(&cus, hipDeviceAttributeMultiprocessorCount, dev);
        if (hipFuncSetAttribute((const void*)fwd_megakernel, hipFuncAttributeMaxDynamicSharedMemorySize, LDS_BYTES) != hipSuccess) { fprintf(stderr, "kernel_launch: hipFuncSetAttribute failed\n"); grid = -1; return; }
        if (hipOccupancyMaxActiveBlocksPerMultiprocessor(&per_cu, (const void*)fwd_megakernel, NTHREADS, LDS_BYTES) != hipSuccess || per_cu < 1) { fprintf(stderr, "kernel_launch: occupancy query gave %d\n", per_cu); per_cu = 1; }
        (void)hipGetLastError();
        grid = cus;
    }
    if (grid < 0) return;
    if (hipMemsetAsync((char*)d_ws + WS_BAR, 0, 16384, stream) != hipSuccess) { fprintf(stderr, "kernel_launch: memset of the barrier words failed\n"); return; }
    Args a{};
    for (int i = 0; i < 19; ++i) a.in[i] = (const float*)d_in[i];
    a.out = (float*)d_out; a.ws = (unsigned char*)d_ws;
#if MK_MULTI
    for (int p = 0; p < N_PHASES; ++p) { a.ph_lo = p; a.ph_hi = p + 1; hipLaunchKernelGGL(fwd_megakernel, dim3(grid), dim3(NTHREADS), LDS_BYTES, stream, a); }
#else
    a.ph_lo = 0; a.ph_hi = N_PHASES;
    void* args[] = {&a};
    hipError_t e = hipLaunchCooperativeKernel((const void*)fwd_megakernel, dim3(grid), dim3(NTHREADS), args, LDS_BYTES, stream);
    if (e != hipSuccess) fprintf(stderr, "kernel_launch: cooperative launch failed: %s (grid %d)\n", hipGetErrorString(e), grid);
#endif
}
```

```cpp
#include <hip/hip_runtime.h>
#include <hip/hip_cooperative_groups.h>
#include <cstdio>
#include <cstdint>
namespace cg = cooperative_groups;
namespace pg8 {
#define PG8_LAS __attribute__((address_space(3)))
typedef unsigned short bf16_t;
typedef short bf16x8 __attribute__((ext_vector_type(8)));
typedef float f32x4 __attribute__((ext_vector_type(4)));
typedef unsigned u32x4 __attribute__((ext_vector_type(4)));
constexpr int BM = 256, BK = 64, HALF = 128, HTB = HALF * BK * 2  , STAGE_BYTES = 8 * HTB, NXCD = 8, WGM = 8;

__host__ __device__ __forceinline__ int lds_byte(int r, int c) { const int st = (r >> 4) * 2 + (c >> 5), rr = r & 15, cc = c & 31, ob = rr * 64 + cc * 2; return st * 1024 + (ob ^ (((ob >> 9) & 1) << 5)); }
__host__ __device__ __forceinline__ void stage_rc(int b, int& R, int& C) { const int st = b / 1024, sb = b % 1024, swz = sb ^ (((sb >> 9) & 1) << 5); R = (st >> 1) * 16 + swz / 64; C = (st & 1) * 32 + (swz % 64) / 2; }
__host__ __device__ __forceinline__ int perm32(int rho) { const int n = rho >> 4, i = rho & 15; return 8 * (i >> 2) + 4 * n + (i & 3); }

struct Unit { int pm, pn; };
struct Gemm { const bf16_t* A; const bf16_t* Bt; int M, N, K, lda; };

struct StaticOrder {
    int nM, nN, nwg, G, c;
    __host__ __device__ void init(int M, int N, int G_, int c_) { nM = M / BM; nN = N / BM; nwg = nM * nN; G = G_; c = c_; }
    __host__ __device__ bool next(int i, Unit& u) const {
        const long L = (long)i * G + c; if (L >= nwg) return false;
        int wgid = (int)L; { const int q = nwg / NXCD, r = nwg % NXCD, xcd = wgid % NXCD, off = wgid / NXCD; wgid = (xcd < r ? xcd * (q + 1) : r * (q + 1) + (xcd - r) * q) + off; }
        const int nig = WGM * nN, gid = wgid / nig, fm = gid * WGM, gsz = (nM - fm) < WGM ? (nM - fm) : WGM;
        u.pm = fm + ((wgid % nig) % gsz); u.pn = (wgid % nig) / gsz; return true;
    }
    __device__ __forceinline__ void a_ready(const Unit&) const {}
    __device__ __forceinline__ void done(const Unit&) const {}
};

struct ListOrder {
    int nN, n, L0, L1;
    __host__ __device__ bool next(int i, Unit& u) const { if (i >= n) return false; const int L = i == 0 ? L0 : L1; u.pm = L / nN; u.pn = L % nN; return true; }
    __device__ __forceinline__ void a_ready(const Unit&) const {}
    __device__ __forceinline__ void done(const Unit&) const {}
};
__device__ __forceinline__ unsigned cvt_pk_bf16(float lo, float hi) { unsigned r; asm volatile("v_cvt_pk_bf16_f32 %0, %1, %2" : "=v"(r) : "v"(lo), "v"(hi)); return r; }
typedef float f32x2 __attribute__((ext_vector_type(2)));
__device__ __forceinline__ u32x4 pack8(const f32x4 v0, const f32x4 v1) { u32x4 w; w.x = cvt_pk_bf16(v0[0], v0[1]); w.y = cvt_pk_bf16(v0[2], v0[3]); w.z = cvt_pk_bf16(v1[0], v1[1]); w.w = cvt_pk_bf16(v1[2], v1[3]); return w; }
struct EpiStore {
    static constexpr bool PERM = true, AFTER_DRAIN = false;
    bf16_t* O; int ldc;
    __device__ __forceinline__ void operator()(const f32x4 (&acc)[2][2][4][2], const Unit& u, int wr, int wc, int fr, int fq) const {
        const int row0 = u.pm * BM + wr * 64 + fr, col0 = u.pn * BM + wc * 32 + 8 * fq;
#pragma unroll
        for (int ai = 0; ai < 2; ++ai)
#pragma unroll
            for (int m = 0; m < 4; ++m) { bf16_t* rowp = O + (size_t)(row0 + ai * HALF + m * 16) * ldc + col0;
#pragma unroll
                for (int bj = 0; bj < 2; ++bj) *(u32x4*)(rowp + bj * HALF) = pack8(acc[ai][bj][m][0], acc[ai][bj][m][1]); }
    }
};
struct EpiProj {
    static constexpr bool PERM = true, AFTER_DRAIN = false;
    bf16_t* O; int ldc; float* ssq; const float* rope; bf16_t* Kb; int ldk;
    __device__ __forceinline__ void operator()(const f32x4 (&acc)[2][2][4][2], const Unit& u, int wr, int wc, int fr, int fq) const {
        const int row0 = u.pm * BM + wr * 64 + fr, col0 = u.pn * BM + wc * 32 + 8 * fq;
#pragma unroll
        for (int ai = 0; ai < 2; ++ai)
#pragma unroll
            for (int m = 0; m < 4; ++m) { const int row = row0 + ai * HALF + m * 16; bf16_t* rowp = O + (size_t)row * ldc + col0; float sq = 0.f;
#pragma unroll
                for (int bj = 0; bj < 2; ++bj) { const u32x4 w = pack8(acc[ai][bj][m][0], acc[ai][bj][m][1]); *(u32x4*)(rowp + bj * HALF) = w;
#pragma unroll
                    for (int e = 0; e < 4; ++e) { const float lo = __uint_as_float(w[e] << 16), hi = __uint_as_float(w[e] & 0xffff0000u); sq += lo * lo + hi * hi; } }
                if (u.pn >= 6 && u.pn <= 8) { sq += __shfl_xor(sq, 16); sq += __shfl_xor(sq, 32); if (fq == 0) ssq[((size_t)row * 3 + (u.pn - 6)) * 4 + wc] = sq; }
                if (u.pn == 9 && wc < 2) { const int ib = wc * 16 + 4 * fq; const f32x4 v0 = acc[ai][0][m][0], v1 = acc[ai][0][m][1];
                    const f32x4 c = *(const f32x4*)(rope + (size_t)row * 64 + ib), sn = *(const f32x4*)(rope + (size_t)row * 64 + 32 + ib);
                    f32x4 a, b;
                    a[0] = v0[0] * c[0] - v0[1] * sn[0]; a[1] = v0[1] * c[0] + v0[0] * sn[0];
                    a[2] = v0[2] * c[1] - v0[3] * sn[1]; a[3] = v0[3] * c[1] + v0[2] * sn[1];
                    b[0] = v1[0] * c[2] - v1[1] * sn[2]; b[1] = v1[1] * c[2] + v1[0] * sn[2];
                    b[2] = v1[2] * c[3] - v1[3] * sn[3]; b[3] = v1[3] * c[3] + v1[2] * sn[3];
                    const u32x4 w = pack8(a, b);
#pragma unroll
                    for (int h = 0; h < 6; ++h) *(u32x4*)(Kb + (size_t)row * ldk + 192 * h + 128 + wc * 32 + 8 * fq) = w; }
                if (m & 1) asm volatile("" ::: "memory"); }
    }
};
struct EpiQ {
    static constexpr bool PERM = true, AFTER_DRAIN = false;
    bf16_t* O; int ldc; const float* ssq; const float* rope;
    __device__ __forceinline__ void operator()(const f32x4 (&acc)[2][2][4][2], const Unit& u, int wr, int wc, int fr, int fq) const {
        const int row0 = u.pm * BM + wr * 64 + fr;
        float sc[2][4];
        { f32x4 q0[2][4], q1[2][4];
#pragma unroll
          for (int ai = 0; ai < 2; ++ai)
#pragma unroll
            for (int m = 0; m < 4; ++m) { const float* p = ssq + (size_t)(row0 + ai * HALF + m * 16) * 12; q0[ai][m] = *(const f32x4*)p; q1[ai][m] = *(const f32x4*)(p + 4); }
#pragma unroll
          for (int ai = 0; ai < 2; ++ai)
#pragma unroll
            for (int m = 0; m < 4; ++m) { const f32x4 a = q0[ai][m], b = q1[ai][m];
                sc[ai][m] = 1.0f / sqrtf((((a[0] + a[1]) + (a[2] + a[3])) + ((b[0] + b[1]) + (b[2] + b[3]))) * (1.0f / 512.0f) + 1e-6f); } }
#pragma unroll
        for (int ai = 0; ai < 2; ++ai)
#pragma unroll
            for (int m = 0; m < 4; ++m) { const int row = row0 + ai * HALF + m * 16; const float s = sc[ai][m];
#pragma unroll
                for (int bj = 0; bj < 2; ++bj) {
                    const int cb = u.pn * BM + bj * HALF + wc * 32, hc = cb % 192;
                    f32x4 v0 = acc[ai][bj][m][0] * s, v1 = acc[ai][bj][m][1] * s;
                    if (hc >= 128) {
                        const int ib = (hc - 128) / 2 + 4 * fq;
                        const f32x4 c = *(const f32x4*)(rope + (size_t)row * 64 + ib), sn = *(const f32x4*)(rope + (size_t)row * 64 + 32 + ib);
                        f32x4 a, b;
                        a[0] = v0[0] * c[0] - v0[1] * sn[0]; a[1] = v0[1] * c[0] + v0[0] * sn[0];
                        a[2] = v0[2] * c[1] - v0[3] * sn[1]; a[3] = v0[3] * c[1] + v0[2] * sn[1];
                        b[0] = v1[0] * c[2] - v1[1] * sn[2]; b[1] = v1[1] * c[2] + v1[0] * sn[2];
                        b[2] = v1[2] * c[3] - v1[3] * sn[3]; b[3] = v1[3] * c[3] + v1[2] * sn[3];
                        v0 = a; v1 = b;
                    }
                    *(u32x4*)(O + (size_t)row * ldc + cb + 8 * fq) = pack8(v0, v1);
                }
                if (m == 3) asm volatile("" ::: "memory"); }
    }
};
struct EpiKV {
    static constexpr bool PERM = true, AFTER_DRAIN = false;
    bf16_t* Kb; int ldk; bf16_t* Vb; int ldv; const float* ssq;
    __device__ __forceinline__ void operator()(const f32x4 (&acc)[2][2][4][2], const Unit& u, int wr, int wc, int fr, int fq) const {
        const int row0 = u.pm * BM + wr * 64 + fr, cin = wc * 32 + 8 * fq;
        f32x4 q2[2][4];
#pragma unroll
        for (int ai = 0; ai < 2; ++ai)
#pragma unroll
            for (int m = 0; m < 4; ++m) q2[ai][m] = *(const f32x4*)(ssq + (size_t)(row0 + ai * HALF + m * 16) * 12 + 8);
#pragma unroll
        for (int ai = 0; ai < 2; ++ai)
#pragma unroll
            for (int m = 0; m < 4; ++m) { const int row = row0 + ai * HALF + m * 16; const f32x4 a = q2[ai][m];
                const float s = 1.0f / sqrtf(((a[0] + a[1]) + (a[2] + a[3])) * (1.0f / 256.0f) + 1e-6f);
                *(u32x4*)(Kb + (size_t)row * ldk + 192 * u.pn + cin) = pack8(acc[ai][0][m][0] * s, acc[ai][0][m][1] * s);
                *(u32x4*)(Vb + (size_t)row * ldv + 128 * u.pn + cin) = pack8(acc[ai][1][m][0] * s, acc[ai][1][m][1] * s); }
    }
};
struct EpiRes {
    static constexpr bool PERM = false, AFTER_DRAIN = false;
    const float* xres; float* z; const float* gate; float alpha; int ldc;
    __device__ __forceinline__ void operator()(const f32x4 (&acc)[2][2][4][2], const Unit& u, int wr, int wc, int fr, int fq) const {
        const int row0 = u.pm * BM + wr * 64 + fr, col0 = u.pn * BM + wc * 32 + 4 * fq;
        f32x4 gv[2][2];
#pragma unroll
        for (int bj = 0; bj < 2; ++bj)
#pragma unroll
            for (int n = 0; n < 2; ++n) gv[bj][n] = *(const f32x4*)(gate + col0 + bj * HALF + n * 16) + 1.0f;
#pragma unroll
        for (int ai = 0; ai < 2; ++ai)
#pragma unroll
            for (int m = 0; m < 4; ++m) { const size_t off = (size_t)(row0 + ai * HALF + m * 16) * ldc + col0;
#pragma unroll
                for (int bj = 0; bj < 2; ++bj)
#pragma unroll
                    for (int n = 0; n < 2; ++n) { const f32x4 xr = *(const f32x4*)(xres + off + bj * HALF + n * 16);
                        *(f32x4*)(z + off + bj * HALF + n * 16) = xr * alpha + gv[bj][n] * acc[ai][bj][m][n]; }
                if (m == 3) asm volatile("" ::: "memory"); }
    }
};
struct EpiSwiglu {
    static constexpr bool PERM = true, AFTER_DRAIN = false;
    bf16_t* H; int ldc;
    __device__ __forceinline__ void operator()(const f32x4 (&acc)[2][2][4][2], const Unit& u, int wr, int wc, int fr, int fq) const {
        const int row0 = u.pm * BM + wr * 64 + fr, col0 = u.pn * HALF + wc * 32 + 8 * fq;
#pragma unroll
        for (int ai = 0; ai < 2; ++ai)
#pragma unroll
            for (int m = 0; m < 4; ++m) { f32x4 h[2];
#pragma unroll
                for (int n = 0; n < 2; ++n) { const f32x4 g = acc[ai][0][m][n], up = acc[ai][1][m][n];
#pragma unroll
                    for (int j = 0; j < 4; ++j) h[n][j] = g[j] * __builtin_amdgcn_rcpf(1.0f + __builtin_amdgcn_exp2f(-1.4426950408889634f * g[j])) * up[j]; }
                *(u32x4*)(H + (size_t)(row0 + ai * HALF + m * 16) * ldc + col0) = pack8(h[0], h[1]); }
    }
};
template <class Epi, class Sched, bool ALIGN_EPI = false, bool SP2 = false>
__device__ __forceinline__ void gemm_phase(PG8_LAS unsigned char* lds, const Gemm g, const Sched& S, const Epi& E) {
    int tid_ = threadIdx.x; asm volatile("" : "+v"(tid_)); const int tid = tid_, wid = __builtin_amdgcn_readfirstlane(tid >> 6), lane = tid & 63, wr = wid >> 2, wc = wid & 3, fr = lane & 15, fq = lane >> 4;
    int Kv_ = g.K, lda_ = g.lda; asm volatile("" : "+s"(Kv_), "+s"(lda_)); const int K = Kv_, nt = K / BK;
    unsigned voffA[2], voffB[2];
#pragma unroll
    for (int i = 0; i < 2; ++i) { int R, C; stage_rc(tid * 16 + i * 8192, R, C); const int Rb = Epi::PERM ? ((R & ~31) + perm32(R & 31)) : R;
        voffA[i] = (unsigned)(R * lda_ + C) * 2u; voffB[i] = (unsigned)(Rb * K + C) * 2u; }
    const size_t kstep = (size_t)(BK * 2);
    const size_t hstepA = (size_t)HALF * lda_ * 2, hstepB = (size_t)HALF * K * 2;
    const size_t tstepA = 2 * hstepA, tstepB = 2 * hstepB;
    const unsigned ldsw = (unsigned)wid * 1024u;
    const int aoff = lds_byte(wr * 64 + fr, fq * 8), boff = lds_byte(wc * 32 + fr, fq * 8);
#define PG8_SA(b, h) (((b) * 2 + (h)) * HTB)
#define PG8_SB(b, h) ((4 + (b) * 2 + (h)) * HTB)
#define PG8_STAGE(bufoff, gbase, voff) do { _Pragma("unroll") for (int _i = 0; _i < 2; ++_i) \
        __builtin_amdgcn_global_load_lds((const unsigned*)((const char*)(gbase) + (voff)[_i]), (PG8_LAS unsigned*)(lds + (bufoff) + ldsw + _i * 8192), 16, 0, 0); } while (0)
#define PG8_LDA(dst, b, h) do { _Pragma("unroll") for (int m = 0; m < 4; ++m) _Pragma("unroll") for (int k = 0; k < 2; ++k) dst[m][k] = *(const PG8_LAS bf16x8*)(lds + PG8_SA(b, h) + aoff + m * 2048 + k * 1024); } while (0)
#define PG8_LDB(dst, b, h) do { _Pragma("unroll") for (int n = 0; n < 2; ++n) _Pragma("unroll") for (int k = 0; k < 2; ++k) dst[n][k] = *(const PG8_LAS bf16x8*)(lds + PG8_SB(b, h) + boff + n * 2048 + k * 1024); } while (0)
#define PG8_MMA(ai, bj, At, Bt) do { __builtin_amdgcn_s_setprio(1); _Pragma("unroll") for (int m = 0; m < 4; ++m) _Pragma("unroll") for (int n = 0; n < 2; ++n) _Pragma("unroll") for (int k = 0; k < 2; ++k) \
        acc[ai][bj][m][n] = __builtin_amdgcn_mfma_f32_16x16x32_bf16(Bt[n][k], At[m][k], acc[ai][bj][m][n], 0, 0, 0); __builtin_amdgcn_s_setprio(0); } while (0)
#define PG8_WAIT_V(n) asm volatile("s_waitcnt vmcnt(" #n ")" ::: "memory")
#define PG8_WAIT_L(n) asm volatile("s_waitcnt lgkmcnt(" #n ")" ::: "memory")
#define PG8_BAR __builtin_amdgcn_s_barrier()
#define PG8_SCHED __builtin_amdgcn_sched_barrier(0)
    Unit cur, nxt; int ui = 0;
    if (!S.next(0, cur)) return;
    f32x4 acc[2][2][4][2];
#pragma unroll
    for (int a = 0; a < 2; ++a)
#pragma unroll
        for (int b = 0; b < 2; ++b)
#pragma unroll
            for (int m = 0; m < 4; ++m)
#pragma unroll
                for (int n = 0; n < 2; ++n) acc[a][b][m][n] = (f32x4){0.f, 0.f, 0.f, 0.f};
    bf16x8 At[4][2], B0[2][2], B1[2][2];
    const char* cA = (const char*)g.A + (size_t)cur.pm * tstepA; const char* cB = (const char*)g.Bt + (size_t)cur.pn * tstepB;
    S.a_ready(cur);
    if constexpr (SP2) {
        PG8_STAGE(PG8_SB(0, 0), cB, voffB); PG8_STAGE(PG8_SB(0, 1), cB + hstepB, voffB); PG8_STAGE(PG8_SA(0, 0), cA, voffA); PG8_STAGE(PG8_SA(0, 1), cA + hstepA, voffA);
        if (wr == 1) PG8_BAR;
        PG8_WAIT_V(2); PG8_BAR;
        PG8_STAGE(PG8_SB(1, 0), cB + kstep, voffB); PG8_STAGE(PG8_SA(1, 0), cA + kstep, voffA); PG8_STAGE(PG8_SB(1, 1), cB + hstepB + kstep, voffB);
        PG8_WAIT_V(6); PG8_BAR;
    } else {
        PG8_STAGE(PG8_SB(0, 0), cB, voffB); PG8_STAGE(PG8_SA(0, 0), cA, voffA); PG8_STAGE(PG8_SB(0, 1), cB + hstepB, voffB); PG8_STAGE(PG8_SA(0, 1), cA + hstepA, voffA);
        if (wr == 1) PG8_BAR;
        PG8_WAIT_V(4); PG8_BAR;
        PG8_STAGE(PG8_SB(1, 0), cB + kstep, voffB); PG8_STAGE(PG8_SA(1, 0), cA + kstep, voffA); PG8_STAGE(PG8_SB(1, 1), cB + hstepB + kstep, voffB);
        PG8_WAIT_V(6); PG8_BAR;
    }
    for (;;) {
        const bool has_next = S.next(ui + 1, nxt);
        const char* nA = has_next ? (const char*)g.A + (size_t)nxt.pm * tstepA : cA; const char* nB = has_next ? (const char*)g.Bt + (size_t)nxt.pn * tstepB : cB;
        for (int t = 0; t < nt; t += 2) {
            const bool last = (t == nt - 2);
            const char* a1 = cA + (size_t)(t + 1) * kstep;
            const char* a2 = last ? nA : cA + (size_t)(t + 2) * kstep; const char* b2 = last ? nB : cB + (size_t)(t + 2) * kstep;
            const char* a3 = a2 + kstep; const char* b3 = b2 + kstep;
            if (last && has_next) S.a_ready(nxt);
            if constexpr (SP2) {
            PG8_LDB(B0, 0, 0); PG8_LDB(B1, 0, 1); PG8_SCHED; PG8_LDA(At, 0, 0); PG8_STAGE(PG8_SA(1, 1), a1 + hstepA, voffA);
            PG8_WAIT_V(8); PG8_WAIT_L(0); PG8_BAR; PG8_MMA(0, 0, At, B0); PG8_MMA(0, 1, At, B1); PG8_BAR; PG8_SCHED;
            PG8_LDA(At, 0, 1); PG8_STAGE(PG8_SB(0, 0), b2, voffB); PG8_STAGE(PG8_SB(0, 1), b2 + hstepB, voffB); PG8_STAGE(PG8_SA(0, 0), a2, voffA);
            PG8_WAIT_V(8); PG8_WAIT_L(0); PG8_BAR; PG8_MMA(1, 0, At, B0); PG8_MMA(1, 1, At, B1); PG8_BAR; PG8_SCHED;
            PG8_LDB(B0, 1, 0); PG8_LDB(B1, 1, 1); PG8_SCHED; PG8_LDA(At, 1, 0); PG8_STAGE(PG8_SA(0, 1), a2 + hstepA, voffA);
            PG8_WAIT_V(8); PG8_WAIT_L(0); PG8_BAR; PG8_MMA(0, 0, At, B0); PG8_MMA(0, 1, At, B1); PG8_BAR; PG8_SCHED;
            PG8_LDA(At, 1, 1); PG8_STAGE(PG8_SB(1, 0), b3, voffB); PG8_STAGE(PG8_SB(1, 1), b3 + hstepB, voffB); PG8_STAGE(PG8_SA(1, 0), a3, voffA);
            PG8_WAIT_V(8); PG8_WAIT_L(0); PG8_BAR; PG8_MMA(1, 0, At, B0); PG8_MMA(1, 1, At, B1); PG8_BAR; PG8_SCHED;
            } else {
            PG8_LDB(B0, 0, 0); PG8_SCHED; PG8_LDA(At, 0, 0); PG8_STAGE(PG8_SA(1, 1), a1 + hstepA, voffA);
            PG8_WAIT_L(8); PG8_BAR; PG8_WAIT_L(0); PG8_MMA(0, 0, At, B0); PG8_BAR; PG8_SCHED;
            PG8_LDB(B1, 0, 1); PG8_STAGE(PG8_SB(0, 0), b2, voffB);
            PG8_BAR; PG8_WAIT_L(0); PG8_MMA(0, 1, At, B1); PG8_BAR;
            PG8_LDA(At, 0, 1); PG8_STAGE(PG8_SA(0, 0), a2, voffA);
            PG8_BAR; PG8_WAIT_L(0); PG8_MMA(1, 0, At, B0); PG8_BAR; PG8_SCHED;
            PG8_STAGE(PG8_SB(0, 1), b2 + hstepB, voffB);
            PG8_WAIT_V(6); PG8_BAR; PG8_MMA(1, 1, At, B1); PG8_BAR;
            PG8_LDB(B0, 1, 0); PG8_SCHED; PG8_LDA(At, 1, 0); PG8_STAGE(PG8_SA(0, 1), a2 + hstepA, voffA);
            PG8_WAIT_L(8); PG8_BAR; PG8_WAIT_L(0); PG8_MMA(0, 0, At, B0); PG8_BAR; PG8_SCHED;
            PG8_LDB(B1, 1, 1); PG8_STAGE(PG8_SB(1, 0), b3, voffB);
            PG8_BAR; PG8_WAIT_L(0); PG8_MMA(0, 1, At, B1); PG8_BAR;
            PG8_LDA(At, 1, 1); PG8_STAGE(PG8_SA(1, 0), a3, voffA);
            PG8_BAR; PG8_WAIT_L(0); PG8_MMA(1, 0, At, B0); PG8_BAR; PG8_SCHED;
            PG8_STAGE(PG8_SB(1, 1), b3 + hstepB, voffB);
            PG8_WAIT_V(6); PG8_BAR; PG8_MMA(1, 1, At, B1); PG8_BAR;
            }
        }
        if constexpr (ALIGN_EPI) { if (wr == 0) PG8_BAR; }
        if constexpr (!Epi::AFTER_DRAIN) { E(acc, cur, wr, wc, fr, fq); S.done(cur); }
        if (!has_next) break;
#pragma unroll
        for (int a = 0; a < 2; ++a)
#pragma unroll
            for (int b = 0; b < 2; ++b)
#pragma unroll
                for (int m = 0; m < 4; ++m)
#pragma unroll
                    for (int n = 0; n < 2; ++n) acc[a][b][m][n] = (f32x4){0.f, 0.f, 0.f, 0.f};
        cur = nxt; cA = nA; cB = nB; ++ui;
        if constexpr (ALIGN_EPI) { if (wr == 1) PG8_BAR; }
    }
    PG8_WAIT_V(0);
    if constexpr (!ALIGN_EPI) { if (wr == 0) PG8_BAR; }
    PG8_BAR;
    if constexpr (Epi::AFTER_DRAIN) { E.fused(acc, cur, wr, wc, fr, fq, lds, wid, lane); S.done(cur); }
#undef PG8_SA
#undef PG8_SB
#undef PG8_STAGE
#undef PG8_LDA
#undef PG8_LDB
#undef PG8_MMA
#undef PG8_WAIT_V
#undef PG8_WAIT_L
#undef PG8_BAR
#undef PG8_SCHED
}
}

#define LAS __attribute__((address_space(3)))
typedef unsigned short bf16_t;
typedef float f32x4 __attribute__((ext_vector_type(4)));
typedef unsigned u32x4 __attribute__((ext_vector_type(4)));
typedef unsigned u32x2 __attribute__((ext_vector_type(2)));
constexpr int S = 8192, DM = 2048, DEPTH = 2, DIN = 3648, DINP = 3840, DFF = 5632;
constexpr int QLD = 1280, KLD = 1152, VLD = 768;
constexpr int C_QA = 0, C_KA = 512, C_VA = 1024, C_CQ = 1536, C_CKV = 2048, C_KR = 2304, C_QC = 2368, C_KC = 3136, C_VC = 3392;
constexpr float ALPHA = 1.4142135623730951f;
constexpr size_t al256(size_t x) { return (x + 255) / 256 * 256; }
constexpr size_t SZ_WIN = (size_t)DINP * DM * 2, SZ_WUQ = (size_t)1280 * 512 * 2, SZ_WUKV = (size_t)1536 * 256 * 2, SZ_WO = (size_t)DM * DM * 2, SZ_WGU = (size_t)2 * DFF * DM * 2, SZ_WDN = (size_t)DM * DFF * 2;
constexpr size_t O_WIN = 0, O_WUQ = O_WIN + SZ_WIN, O_WUKV = O_WUQ + SZ_WUQ, O_WO = O_WUKV + SZ_WUKV, O_WGU = O_WO + SZ_WO, O_WDN = O_WGU + SZ_WGU, SZ_WL = O_WDN + SZ_WDN;
constexpr size_t WS_W = 0;
constexpr size_t WS_MOD = al256(WS_W + DEPTH * SZ_WL);
constexpr size_t WS_ROPE = al256(WS_MOD + (size_t)DEPTH * 6 * DM * 4);
constexpr size_t WS_RSQ = al256(WS_ROPE + (size_t)S * 64 * 4);
constexpr size_t WS_RSKV = al256(WS_RSQ + (size_t)S * 4);
constexpr size_t WS_X = al256(WS_RSKV + (size_t)S * 4);
constexpr size_t WS_U = al256(WS_X + (size_t)S * DM * 4);
constexpr size_t WS_PROJ = al256(WS_U + (size_t)S * DM * 2);
constexpr size_t WS_Q = al256(WS_PROJ + (size_t)S * DINP * 2);
constexpr size_t WS_K = al256(WS_Q + (size_t)S * QLD * 2);
constexpr size_t WS_V = al256(WS_K + (size_t)S * KLD * 2);
constexpr size_t WS_Y = al256(WS_V + (size_t)S * VLD * 2);
constexpr size_t WS_H = al256(WS_Y + (size_t)S * DM * 2);
constexpr size_t WS_PART = al256(WS_H + (size_t)S * DFF * 2);
constexpr size_t WS_STAT = al256(WS_PART + (size_t)4 * S * VLD * 2);
constexpr size_t WS_SSQ = al256(WS_STAT + (size_t)4 * 6 * S * 2 * 4);
constexpr size_t WS_BAR0_ = WS_SSQ + (size_t)S * 12 * 4;
constexpr size_t WS_BAR = al256(WS_BAR0_);
constexpr size_t WS_END = al256(WS_BAR + 16384);
constexpr int TAB_OFF = pg8::STAGE_BYTES, LDS_BYTES = pg8::STAGE_BYTES + 256;
constexpr int NTHREADS = 512;

struct Args { const float* in[19]; float* out; unsigned char* ws; int ph_lo, ph_hi; };
struct Tab {
    const LAS unsigned* t;
    __device__ __forceinline__ unsigned long long ld(int i) const { const unsigned lo = __builtin_amdgcn_readfirstlane(t[2 * i]), hi = __builtin_amdgcn_readfirstlane(t[2 * i + 1]); return ((unsigned long long)hi << 32) | lo; }
    __device__ __forceinline__ const float* in(int i) const { return (const float*)ld(i); }
    __device__ __forceinline__ float* out() const { return (float*)ld(19); }
    __device__ __forceinline__ unsigned char* wsp() const { return (unsigned char*)ld(20); }
};

__device__ __forceinline__ float bf2f(unsigned short b) { return __uint_as_float((unsigned)b << 16); }
template <int CTRL> __device__ __forceinline__ float dpp_mov(float v) { return __builtin_bit_cast(float, __builtin_amdgcn_update_dpp(0, __builtin_bit_cast(int, v), CTRL, 0xf, 0xf, true)); }
__device__ __forceinline__ float wave_sum(float v) {
    v += dpp_mov<0xB1>(v);
    v += dpp_mov<0x4E>(v);
    v += dpp_mov<0x141>(v);
    v += dpp_mov<0x140>(v);
    { auto rr = __builtin_amdgcn_permlane16_swap(__float_as_uint(v), __float_as_uint(v), false, false); v = __uint_as_float(rr[0]) + __uint_as_float(rr[1]); }
    { auto rr = __builtin_amdgcn_permlane32_swap(__float_as_uint(v), __float_as_uint(v), false, false); v = __uint_as_float(rr[0]) + __uint_as_float(rr[1]); }
    return v; }
using pg8::cvt_pk_bf16;
__device__ __forceinline__ int otid() { int t = threadIdx.x; asm volatile("" : "+v"(t)); return t; }

__device__ __forceinline__ void phase_mod(const Tab tb, unsigned char* lds_g) {
    unsigned char* ws_ = tb.wsp(); const float* in1 = tb.in(1); const float* in2 = tb.in(2); const float* in3 = tb.in(3);
    float* condL = (float*)lds_g; f32x4* red = (f32x4*)(lds_g + 8192);
    const int tid = otid();
    const float* c = in1;
    for (int i = tid; i < DM; i += NTHREADS) { const float v = c[i]; condL[i] = v / (1.0f + __expf(-v)); }
    __syncthreads();
    float* mod = (float*)(ws_ + WS_MOD);
    const int cl = tid & 31, kg = tid >> 5;
    for (int item = blockIdx.x; item < DEPTH * 96; item += gridDim.x) {
        const int l = item / 96, cgp = item % 96;
        const float* W = in2 + (size_t)l * DM * 6 * DM + (size_t)(kg * 128) * (6 * DM) + cgp * 128 + 4 * cl;
        f32x4 acc = {0.f, 0.f, 0.f, 0.f};
#pragma unroll 8
        for (int kk = 0; kk < 128; ++kk) { const f32x4 w = __builtin_nontemporal_load((const f32x4*)(W + (size_t)kk * (6 * DM))); acc += w * condL[kg * 128 + kk]; }
        red[kg * 32 + cl] = acc;
        __syncthreads();
        if (tid < 128) { float s = 0.f; const float* rf = (const float*)red;
            for (int g = 0; g < 16; ++g) s += rf[g * 128 + tid];
            mod[l * 6 * DM + cgp * 128 + tid] = s + in3[l * 6 * DM + cgp * 128 + tid]; }
        __syncthreads();
    }
}

template <int PERMT>
__device__ __forceinline__ int dst_row(int n) {
    if (PERMT == 1) { const int h = n / 192, d = n % 192; if (d < 128) return n; const int j = d - 128; return h * 192 + 128 + 2 * (j & 31) + (j >> 5); }
    if (PERMT == 3) { if (n < C_KR || n >= C_KR + 64) return n; const int j = n - C_KR; return C_KR + 2 * (j & 31) + (j >> 5); }
    if (PERMT == 2) { if (n < DFF) return 256 * (n >> 7) + (n & 127); const int m = n - DFF; return 256 * (m >> 7) + 128 + (m & 127); }
    return n;
}
template <int PERMT>
__device__ __forceinline__ void transpose_job(const float* __restrict__ src, bf16_t* __restrict__ dst, int K, int N, int Npad, const float* __restrict__ kscale, unsigned char* lds_g, int first, int stride) {
    float* T = (float*)lds_g;
    const int tid = otid(), nkt = K / 64, nnt = (N + 255) / 256, ntiles = nkt * nnt;
    for (int t = first; t < ntiles; t += stride) {
        const int k0 = (t % nkt) * 64, n0 = (t / nkt) * 256;
        { const int kk = tid >> 6, n4 = tid & 63; const bool ok = n0 + 4 * n4 < N; f32x4 v[8];
#pragma unroll
          for (int i = 0; i < 8; ++i) { const int k = k0 + kk + 8 * i; v[i] = ok ? __builtin_nontemporal_load((const f32x4*)(src + (size_t)k * N + n0 + 4 * n4)) : (f32x4){0.f, 0.f, 0.f, 0.f}; }
#pragma unroll
          for (int i = 0; i < 8; ++i) { const int k = k0 + kk + 8 * i; if (kscale) v[i] = v[i] * kscale[k];
              float* tp = T + (kk + 8 * i) * 257 + 4 * n4; tp[0] = v[i][0]; tp[1] = v[i][1]; tp[2] = v[i][2]; tp[3] = v[i][3]; } }
        __syncthreads();
        { const int n = tid >> 1, ks = tid & 1;
          if (n0 + n < N) { bf16_t* dp = dst + (size_t)dst_row<PERMT>(n0 + n) * K + k0 + 32 * ks;
#pragma unroll
            for (int eb = 0; eb < 4; ++eb) { float v[8];
#pragma unroll
              for (int e = 0; e < 8; ++e) v[e] = T[(32 * ks + 8 * eb + e) * 257 + n];
              u32x4 w; w.x = cvt_pk_bf16(v[0], v[1]); w.y = cvt_pk_bf16(v[2], v[3]); w.z = cvt_pk_bf16(v[4], v[5]); w.w = cvt_pk_bf16(v[6], v[7]);
              *(u32x4*)(dp + 8 * eb) = w; } } }
        __syncthreads();
    }
    const size_t nz = (size_t)(Npad - N) * K / 8;
    for (size_t i = (size_t)blockIdx.x * NTHREADS + tid; i < nz; i += (size_t)gridDim.x * NTHREADS) *(u32x4*)(dst + (size_t)N * K + i * 8) = (u32x4){0u, 0u, 0u, 0u};
}

__device__ __forceinline__ void modulate_rows(const float* __restrict__ x, const float* __restrict__ sc, const float* __restrict__ sh, bf16_t* __restrict__ u) {
    const size_t n8 = (size_t)S * DM / 8;
    for (size_t i = (size_t)blockIdx.x * NTHREADS + otid(); i < n8; i += (size_t)gridDim.x * NTHREADS) {
        const int col = (int)((i * 8) % DM);
        const f32x4 x0 = *(const f32x4*)(x + i * 8), x1 = *(const f32x4*)(x + i * 8 + 4);
        const f32x4 s0 = *(const f32x4*)(sc + col) + 1.0f, s1 = *(const f32x4*)(sc + col + 4) + 1.0f;
        const f32x4 h0 = *(const f32x4*)(sh + col), h1 = *(const f32x4*)(sh + col + 4);
        *(u32x4*)(u + i * 8) = pg8::pack8(x0 * s0 + h0, x1 * s1 + h1);
    }
}

__device__ __forceinline__ void rope_table(float* __restrict__ rope) {
    for (int i = blockIdx.x * NTHREADS + otid(); i < S * 32; i += gridDim.x * NTHREADS) {
        const int pos = i >> 5, j = i & 31;
        const float inv = exp2f(-(float)j * (13.287712379549449f / 32.0f));
        const float ang = (float)pos * inv;
        const double rev = (double)ang * 0.15915494309189535;
        const double fr = rev - floor(rev);
        const float ar = (float)(fr * 6.283185307179586);
        rope[(size_t)pos * 64 + j] = cosf(ar); rope[(size_t)pos * 64 + 32 + j] = sinf(ar);
    }
}

__device__ __forceinline__ void phase_prep(unsigned char* ws_) {
    const bf16_t* proj = (const bf16_t*)(ws_ + WS_PROJ); const float* rope = (const float*)(ws_ + WS_ROPE);
    float* rsq = (float*)(ws_ + WS_RSQ); float* rskv = (float*)(ws_ + WS_RSKV); bf16_t* Kb = (bf16_t*)(ws_ + WS_K);
    const int tid_o = otid(), lane = tid_o & 63, wave = tid_o >> 6;
    for (int r = blockIdx.x * 8 + wave; r < S; r += gridDim.x * 8) {
        const bf16_t* pr = proj + (size_t)r * DINP;
        { const u32x4 w = *(const u32x4*)(pr + C_CQ + 8 * lane); float ss = 0.f;
#pragma unroll
          for (int e = 0; e < 4; ++e) { const float lo = __uint_as_float(w[e] << 16), hi = __uint_as_float(w[e] & 0xffff0000u); ss += lo * lo + hi * hi; }
          ss = wave_sum(ss); if (lane == 0) rsq[r] = 1.0f / sqrtf(ss * (1.0f / 512.0f) + 1e-6f); }
        { const u32x2 w = *(const u32x2*)(pr + C_CKV + 4 * lane); float ss = 0.f;
#pragma unroll
          for (int e = 0; e < 2; ++e) { const float lo = __uint_as_float(w[e] << 16), hi = __uint_as_float(w[e] & 0xffff0000u); ss += lo * lo + hi * hi; }
          ss = wave_sum(ss); if (lane == 0) rskv[r] = 1.0f / sqrtf(ss * (1.0f / 256.0f) + 1e-6f); }
        { const int i = lane & 31; const float x1 = bf2f(pr[C_KR + i]), x2 = bf2f(pr[C_KR + 32 + i]);
          const float c = rope[(size_t)r * 64 + i], sn = rope[(size_t)r * 64 + 32 + i];
          const unsigned w = cvt_pk_bf16(x1 * c - x2 * sn, x2 * c + x1 * sn);
          const int hb = (lane >> 5) * 3;
#pragma unroll
          for (int h = 0; h < 3; ++h) *(unsigned*)(Kb + (size_t)r * KLD + (hb + h) * 192 + 128 + 2 * i) = w; }
    }
}

__device__ __forceinline__ void phase_ynorm(unsigned char* ws_) {
    bf16_t* y = (bf16_t*)(ws_ + WS_Y); const bf16_t* part = (const bf16_t*)(ws_ + WS_PART); const float* stat = (const float*)(ws_ + WS_STAT);
    const int tid_o = otid(), lane = tid_o & 63, wave = tid_o >> 6;
    const bool lowhalf = lane < 32;
    for (int r = blockIdx.x * 8 + wave; r < S; r += gridDim.x * 8) {
        bf16_t* yr = y + (size_t)r * DM;
        float v[4][8]; float ss[4];
#pragma unroll
        for (int j = 0; j < 4; ++j) {
            const bool fromPart = (j == 1) || (j == 2 && lowhalf);
            if (!fromPart) { const u32x4 w = *(const u32x4*)(yr + j * 512 + 8 * lane);
#pragma unroll
                for (int e = 0; e < 4; ++e) { v[j][2 * e] = __uint_as_float(w[e] << 16); v[j][2 * e + 1] = __uint_as_float(w[e] & 0xffff0000u); } }
            else { const int yb = j * 512 + 8 * lane - 512, h = yb >> 7; float m[4], lw[4];
#pragma unroll
                for (int i = 0; i < 4; ++i) { const float* st = stat + ((size_t)(i * 6 + h) * S + r) * 2; m[i] = st[0]; lw[i] = st[1]; }
                const float M = fmaxf(fmaxf(m[0], m[1]), fmaxf(m[2], m[3])); float W = 0.f;
#pragma unroll
                for (int i = 0; i < 4; ++i) { lw[i] *= __builtin_amdgcn_exp2f(m[i] - M); W += lw[i]; }
                const float rW = 1.0f / W;
#pragma unroll
                for (int e = 0; e < 8; ++e) v[j][e] = 0.f;
#pragma unroll
                for (int i = 0; i < 4; ++i) { const u32x4 w = *(const u32x4*)(part + ((size_t)i * S + r) * VLD + yb); const float wi = lw[i] * rW;
#pragma unroll
                    for (int e = 0; e < 4; ++e) { v[j][2 * e] += wi * __uint_as_float(w[e] << 16); v[j][2 * e + 1] += wi * __uint_as_float(w[e] & 0xffff0000u); } } }
            float sq = 0.f;
#pragma unroll
            for (int e = 0; e < 8; ++e) sq += v[j][e] * v[j][e];
            ss[j] = sq;
        }
        const float sA = wave_sum(ss[0]);
        const float sB = wave_sum(ss[1] + (lowhalf ? ss[2] : 0.f));
        const float sC = wave_sum(ss[3] + (lowhalf ? 0.f : ss[2]));
        const float rA = 1.0f / sqrtf(sA * (1.0f / 512.0f) + 1e-6f), rB = 1.0f / sqrtf(sB * (1.0f / 768.0f) + 1e-6f), rC = 1.0f / sqrtf(sC * (1.0f / 768.0f) + 1e-6f);
#pragma unroll
        for (int j = 0; j < 4; ++j) { const float sc = j == 0 ? rA : (j == 1 ? rB : (j == 2 ? (lowhalf ? rB : rC) : rC)); u32x4 o;
#pragma unroll
            for (int e = 0; e < 4; ++e) o[e] = cvt_pk_bf16(v[j][2 * e] * sc, v[j][2 * e + 1] * sc);
            *(u32x4*)(yr + j * 512 + 8 * lane) = o; }
    }
}

__device__ __forceinline__ void phase_ln(const float* z, float* xo, const float* __restrict__ g, const float* __restrict__ b, const float* __restrict__ sc, const float* __restrict__ sh, bf16_t* __restrict__ u) {
    const int tid_o = otid(), lane = tid_o & 63, wave = tid_o >> 6;
    const int stride = gridDim.x * 8;
    for (int r = blockIdx.x * 8 + wave; r < S; r += 2 * stride) {
        const bool hasB = r + stride < S; const int rr[2] = {r, hasB ? r + stride : r};
        f32x4 v[2][8]; float s[2] = {0.f, 0.f};
#pragma unroll
        for (int k = 0; k < 2; ++k) { const float* zr = z + (size_t)rr[k] * DM;
#pragma unroll
            for (int j = 0; j < 8; ++j) v[k][j] = *(const f32x4*)(zr + j * 256 + 4 * lane); }
#pragma unroll
        for (int k = 0; k < 2; ++k)
#pragma unroll
            for (int j = 0; j < 8; ++j) s[k] += (v[k][j][0] + v[k][j][1]) + (v[k][j][2] + v[k][j][3]);
        float mean[2], rstd[2];
#pragma unroll
        for (int k = 0; k < 2; ++k) { mean[k] = wave_sum(s[k]) * (1.0f / DM); float q = 0.f;
#pragma unroll
            for (int j = 0; j < 8; ++j) { const f32x4 d = v[k][j] - mean[k]; q += (d[0] * d[0] + d[1] * d[1]) + (d[2] * d[2] + d[3] * d[3]); }
            rstd[k] = 1.0f / sqrtf(wave_sum(q) * (1.0f / DM) + 1e-5f); }
#pragma unroll
        for (int j = 0; j < 8; ++j) { const int col = j * 256 + 4 * lane;
            const f32x4 gg = *(const f32x4*)(g + col), bb = *(const f32x4*)(b + col);
            f32x4 s1 = {0.f, 0.f, 0.f, 0.f}, h1 = {0.f, 0.f, 0.f, 0.f};
            if (u) { s1 = *(const f32x4*)(sc + col) + 1.0f; h1 = *(const f32x4*)(sh + col); }
#pragma unroll
            for (int k = 0; k < 2; ++k) { if (k == 1 && !hasB) continue;
                const f32x4 o = (v[k][j] - mean[k]) * rstd[k] * gg + bb;
                *(f32x4*)(xo + (size_t)rr[k] * DM + col) = o;
                if (u) { const f32x4 m = o * s1 + h1; u32x2 w; w.x = cvt_pk_bf16(m[0], m[1]); w.y = cvt_pk_bf16(m[2], m[3]); *(u32x2*)(u + (size_t)rr[k] * DM + col) = w; } } }
    }
}

template <int MODE>
__device__ __forceinline__ void naive_attn(unsigned char* ws_, const float* rpb, const float* sink, int l) {
    constexpr int DQK = MODE == 1 ? 192 : 128, NJ = DQK / 64, H = MODE == 0 ? 4 : 6;
    const bf16_t* proj = (const bf16_t*)(ws_ + WS_PROJ); bf16_t* y = (bf16_t*)(ws_ + WS_Y);
    const int tid_o = otid(), lane = tid_o & 63, wave = tid_o >> 6;
    for (int it = blockIdx.x * 8 + wave; it < S * H; it += gridDim.x * 8) {
        const int h = it / S, q = it % S;
        const bf16_t *Qp, *Kp, *Vp; int ldk, ldv, ycol; float scale;
        if (MODE == 0) { Qp = proj + (size_t)q * DINP + C_QA + 128 * h; Kp = proj + C_KA + 128 * h; Vp = proj + C_VA + 128 * h; ldk = DINP; ldv = DINP; ycol = 128 * h; scale = 0.08838834764831845f; }
        else if (MODE == 1) { Qp = (const bf16_t*)(ws_ + WS_Q) + (size_t)q * QLD + 192 * h; Kp = (const bf16_t*)(ws_ + WS_K) + 192 * h; Vp = (const bf16_t*)(ws_ + WS_V) + 128 * h; ldk = KLD; ldv = VLD; ycol = 512 + 128 * h; scale = 0.07216878364870322f; }
        else { Qp = proj + (size_t)q * DINP + C_QC + 128 * h; Kp = proj + C_KC + 128 * (h / 3); Vp = proj + C_VC + 128 * (h / 3); ldk = DINP; ldv = DINP; ycol = 1280 + 128 * h; scale = 0.08838834764831845f; }
        float qv[NJ];
#pragma unroll
        for (int j = 0; j < NJ; ++j) qv[j] = bf2f(Qp[64 * j + lane]) * scale;
        float m = -1e30f, ls = 0.f, o0 = 0.f, o1 = 0.f; int nkeys, klo = 0, r = 0, col = 0, r0 = 0, c0 = 0; float slope = 0.f;
        if (MODE == 0) { r = q >> 6; col = q & 63; r0 = min(max(r - 4, 0), 120); c0 = min(max(col - 8, 0), 48); nkeys = 128; }
        else if (MODE == 1) nkeys = S;
        else { klo = max(0, q - 128); nkeys = min(S - 1, q + 128) - klo + 1; m = sink[l * 6 + h]; ls = 1.f; slope = exp2f(-8.0f * (float)(h + 1) / 6.0f); }
        for (int kk = 0; kk < nkeys; ++kk) {
            int key; float bias = 0.f;
            if (MODE == 0) { const int krow = r0 + (kk >> 4), kcol = c0 + (kk & 15); key = krow * 64 + kcol; bias = rpb[((l * 4 + h) * 15 + (krow - r + 7)) * 31 + (kcol - col + 15)]; }
            else if (MODE == 1) key = kk;
            else { key = klo + kk; bias = -slope * fabsf((float)(q - key)); }
            float part = 0.f;
#pragma unroll
            for (int j = 0; j < NJ; ++j) part += qv[j] * bf2f(Kp[(size_t)key * ldk + 64 * j + lane]);
            const float s = wave_sum(part) + bias;
            const float mn = fmaxf(m, s), al = __expf(m - mn), p = __expf(s - mn);
            ls = ls * al + p;
            o0 = o0 * al + p * bf2f(Vp[(size_t)key * ldv + lane]); o1 = o1 * al + p * bf2f(Vp[(size_t)key * ldv + 64 + lane]);
            m = mn;
        }
        const float inv = 1.0f / ls;
        y[(size_t)q * DM + ycol + lane] = (bf16_t)(cvt_pk_bf16(o0 * inv, 0.f) & 0xffffu);
        y[(size_t)q * DM + ycol + 64 + lane] = (bf16_t)(cvt_pk_bf16(o1 * inv, 0.f) & 0xffffu);
    }
}

#define XB_TMO      128
#define XB_XCNT(j)  (256  + 64 * (j))
#define XB_XSUB(j)  (1280 + 64 * (j))
#define XB_XGEN(j)  (2304 + 64 * (j))
#define XB_TOP      3328
#define XB_TOPGEN   3392
#define XCD_BAR_WORDS 3456
#define XB_SPIN_CAP (1u << 18)

__device__ __forceinline__ unsigned xb_ld(unsigned* p)              { return __hip_atomic_load(p, __ATOMIC_RELAXED, __HIP_MEMORY_SCOPE_AGENT); }
__device__ __forceinline__ unsigned xb_add(unsigned* p, unsigned v) { return __hip_atomic_fetch_add(p, v, __ATOMIC_RELAXED, __HIP_MEMORY_SCOPE_AGENT); }
__device__ __forceinline__ unsigned xb_xcc_id() { return (unsigned)__builtin_amdgcn_s_getreg((3 << 11) | 20) & 0xFu; }
#define XB_SPIN(cond, bar) do { unsigned _sp = 0; while (cond) { __builtin_amdgcn_s_sleep(1); \
    if ((++_sp & 255u) == 0u) { if (xb_ld(&(bar)[XB_TMO])) break; if (_sp > XB_SPIN_CAP) { atomicAdd(&(bar)[XB_TMO], 1u); break; } } } } while (0)

struct XcdBarrier {
    unsigned* bar; unsigned x;
    volatile LAS unsigned* st;
};

__device__ __forceinline__ XcdBarrier xcd_barrier_post(unsigned* bar, volatile LAS unsigned* st) {
    XcdBarrier b; b.bar = bar; b.x = xb_xcc_id(); b.st = st;
    if (threadIdx.x == 0) (void)xb_add(&bar[XB_XCNT(b.x)], 1u);
    return b;
}
__device__ __forceinline__ void xcd_barrier_complete(unsigned* bar, unsigned x, unsigned& nloc, unsigned& nx) {
    const unsigned G = gridDim.x * gridDim.y * gridDim.z;
    unsigned sum, cnt, mine, sp = 0u;
    for (;;) {
        sum = 0u; cnt = 0u; mine = 0u;
#pragma unroll
        for (unsigned j = 0; j < 16; ++j) { const unsigned c = xb_ld(&bar[XB_XCNT(j)]); sum += c; cnt += (c > 0u) ? 1u : 0u; mine = (j == x) ? c : mine; }
        if (sum == G) break;
        __builtin_amdgcn_s_sleep(1);
        if ((++sp & 255u) == 0u) { if (xb_ld(&bar[XB_TMO])) break; if (sp > XB_SPIN_CAP) { atomicAdd(&bar[XB_TMO], 1u); break; } }
    }
    nloc = mine > 0u ? mine : 1u; nx = cnt > 0u ? cnt : 1u;
}

__device__ __forceinline__ void xcd_barrier(const XcdBarrier& b) {
    asm volatile("s_waitcnt vmcnt(0)" ::: "memory");
    __syncthreads();
    if (threadIdx.x == 0) {
        unsigned* bar = b.bar;
        __builtin_amdgcn_s_waitcnt(0);
        unsigned nloc = b.st[0], nx = b.st[1];
        if (nloc == 0u) { xcd_barrier_complete(bar, b.x, nloc, nx); b.st[0] = nloc; b.st[1] = nx; }
        const unsigned old = xb_add(&bar[XB_XSUB(b.x)], 1u);
        const unsigned gen = old / nloc;
        if (old + 1u == (gen + 1u) * nloc) {
            __builtin_amdgcn_fence(__ATOMIC_RELEASE, "agent");
            asm volatile("s_waitcnt vmcnt(0)" ::: "memory");
            const unsigned og = xb_add(&bar[XB_TOP], 1u);
            const unsigned tg = og / nx;
            if (og + 1u == (tg + 1u) * nx) xb_add(&bar[XB_TOPGEN], 1u);
            else XB_SPIN(xb_ld(&bar[XB_TOPGEN]) == tg, bar);
            __builtin_amdgcn_fence(__ATOMIC_ACQUIRE, "agent");
            xb_add(&bar[XB_XGEN(b.x)], 1u);
            asm volatile("s_waitcnt vmcnt(0)" ::: "memory");
        } else {
            XB_SPIN(xb_ld(&bar[XB_XGEN(b.x)]) == gen, bar);
            __builtin_amdgcn_fence(__ATOMIC_ACQUIRE, "agent");
            asm volatile("s_waitcnt vmcnt(0)" ::: "memory");
        }
    }
    __syncthreads();
}


namespace att {
typedef short bf16x8 __attribute__((ext_vector_type(8)));
typedef short s16x4 __attribute__((ext_vector_type(4)));
typedef float f32x16 __attribute__((ext_vector_type(16)));
#define ATT_SBAR() __builtin_amdgcn_sched_barrier(0)
#define ATT_BAR() do { asm volatile("s_waitcnt lgkmcnt(0)" ::: "memory"); __builtin_amdgcn_s_barrier(); asm volatile("" ::: "memory"); } while (0)
constexpr float LOG2E = 1.4426950408889634f, NEGM = -1e30f;
constexpr float DEFER_THR = 8.f;
constexpr int KVSPLIT = 4;
__device__ __forceinline__ int crow(int r, int hi) { return (r & 3) + 8 * (r >> 2) + 4 * hi; }
__device__ __forceinline__ unsigned cvtpk(float lo, float hi) { unsigned r; asm volatile("v_cvt_pk_bf16_f32 %0, %1, %2" : "=v"(r) : "v"(lo), "v"(hi)); return r; }
template <int DQK> __device__ __forceinline__ int kswz_x(int row) { return DQK == 128 ? (((row & 7) | (((row >> 4) & 1) << 3)) << 4) : (((row >> 1) & 7) << 4); }
template <int DQK> __device__ __forceinline__ int kswz(int row, int colB) { return row * (DQK * 2) + (colB ^ kswz_x<DQK>(row)); }
__device__ __forceinline__ int v_st(int k, int c) { const int kk = (k & ~0xC) | ((k & 4) << 1) | ((k & 8) >> 1); return ((kk >> 3) * 4 + (c >> 5)) * 512 + ((kk & 7) * 32 + (c & 31)) * 2; }
__device__ __forceinline__ int v_rd_base(int lane) { return ((lane & 3) << 3) | (((lane >> 2) & 3) << 6) | (((lane >> 4) & 1) << 5) | (((lane >> 5) & 1) << 8); }
constexpr int v_rd_off(int d0, int ks, int half) { return d0 * 512 + ks * 4096 + half * 2048; }
template <int OFF> __device__ __forceinline__ s16x4 tr_read(int vb) { s16x4 r; asm volatile("ds_read_b64_tr_b16 %0, %1 offset:%2" : "=&v"(r) : "v"(vb), "i"(OFF) : "memory"); return r; }
struct VFrag { s16x4 l0, h0, l1, h1, l2, h2, l3, h3; };
template <int D0> __device__ __forceinline__ void pv_read(VFrag& f, int vb) {
  f.l0 = tr_read<v_rd_off(D0, 0, 0)>(vb); f.h0 = tr_read<v_rd_off(D0, 0, 1)>(vb); f.l1 = tr_read<v_rd_off(D0, 1, 0)>(vb); f.h1 = tr_read<v_rd_off(D0, 1, 1)>(vb);
  f.l2 = tr_read<v_rd_off(D0, 2, 0)>(vb); f.h2 = tr_read<v_rd_off(D0, 2, 1)>(vb); f.l3 = tr_read<v_rd_off(D0, 3, 0)>(vb); f.h3 = tr_read<v_rd_off(D0, 3, 1)>(vb);
}
__device__ __forceinline__ void pv_mma(f32x16& od, const VFrag& f, bf16x8 pa0, bf16x8 pa1, bf16x8 pa2, bf16x8 pa3) {
#define ATT_PK(L, H) (bf16x8){L[0], L[1], L[2], L[3], H[0], H[1], H[2], H[3]}
  od = __builtin_amdgcn_mfma_f32_32x32x16_bf16(pa0, ATT_PK(f.l0, f.h0), od, 0, 0, 0);
  od = __builtin_amdgcn_mfma_f32_32x32x16_bf16(pa1, ATT_PK(f.l1, f.h1), od, 0, 0, 0);
  od = __builtin_amdgcn_mfma_f32_32x32x16_bf16(pa2, ATT_PK(f.l2, f.h2), od, 0, 0, 0);
  od = __builtin_amdgcn_mfma_f32_32x32x16_bf16(pa3, ATT_PK(f.l3, f.h3), od, 0, 0, 0);
#undef ATT_PK
}
__device__ __forceinline__ void pv_d0(f32x16* o, int vb, bf16x8 pa0, bf16x8 pa1, bf16x8 pa2, bf16x8 pa3) {
  VFrag fa, fb;
  pv_read<0>(fa, vb); pv_read<1>(fb, vb);
  asm volatile("s_waitcnt lgkmcnt(8)" ::: "memory"); ATT_SBAR(); pv_mma(o[0], fa, pa0, pa1, pa2, pa3); ATT_SBAR();
  pv_read<2>(fa, vb);
  asm volatile("s_waitcnt lgkmcnt(8)" ::: "memory"); ATT_SBAR(); pv_mma(o[1], fb, pa0, pa1, pa2, pa3); ATT_SBAR();
  pv_read<3>(fb, vb);
  asm volatile("s_waitcnt lgkmcnt(8)" ::: "memory"); ATT_SBAR(); pv_mma(o[2], fa, pa0, pa1, pa2, pa3); ATT_SBAR();
  asm volatile("s_waitcnt lgkmcnt(0)" ::: "memory"); ATT_SBAR(); pv_mma(o[3], fb, pa0, pa1, pa2, pa3);
}
typedef float f32x2 __attribute__((ext_vector_type(2)));
template <bool RAW>
__device__ __forceinline__ void softmax_tile(f32x16& p0, f32x16& p1, float Cs, float& m_reg, float& l_reg, float& alpha, bf16x8& pa0, bf16x8& pa1, bf16x8& pa2, bf16x8& pa3) {
  float pmax = fmaxf(fmaxf(p0[0], p0[1]), p1[0]);
#pragma unroll
  for (int r = 2; r < 16; r += 2) pmax = fmaxf(fmaxf(pmax, p0[r]), p0[r + 1]);
#pragma unroll
  for (int r = 1; r < 15; r += 2) pmax = fmaxf(fmaxf(pmax, p1[r]), p1[r + 1]);
  pmax = fmaxf(pmax, p1[15]);
  if (RAW) pmax *= Cs;
  float mn;
  if (__builtin_expect(__all(pmax - m_reg <= DEFER_THR * LOG2E), 1)) { mn = m_reg; alpha = 1.f; }
  else { { auto rr = __builtin_amdgcn_permlane32_swap(__float_as_uint(pmax), __float_as_uint(pmax), false, false); pmax = fmaxf(__uint_as_float(rr[0]), __uint_as_float(rr[1])); }
         mn = fmaxf(m_reg, pmax); alpha = __builtin_amdgcn_exp2f(m_reg - mn); m_reg = mn; }
#pragma unroll
  for (int r = 0; r < 16; ++r) { p0[r] = __builtin_amdgcn_exp2f(RAW ? fmaf(p0[r], Cs, -mn) : p0[r] - mn); p1[r] = __builtin_amdgcn_exp2f(RAW ? fmaf(p1[r], Cs, -mn) : p1[r] - mn); }
  f32x2 ps2 = {0.f, 0.f};
#pragma unroll
  for (int r = 0; r < 16; r += 2) { ps2 += (f32x2){p0[r], p0[r + 1]}; ps2 += (f32x2){p1[r], p1[r + 1]}; }
  l_reg = l_reg * alpha + (ps2[0] + ps2[1]);
#define ATT_PK4(P, BASE, OUT) do { unsigned a0 = cvtpk(P[BASE + 0], P[BASE + 1]), a1 = cvtpk(P[BASE + 2], P[BASE + 3]);   \
    unsigned b0 = cvtpk(P[BASE + 4], P[BASE + 5]), b1 = cvtpk(P[BASE + 6], P[BASE + 7]);                              \
    auto r0 = __builtin_amdgcn_permlane32_swap(a0, b0, false, false); auto r1 = __builtin_amdgcn_permlane32_swap(a1, b1, false, false); \
    u32x4 w = {r0[0], r1[0], r0[1], r1[1]}; OUT = *reinterpret_cast<bf16x8*>(&w); } while (0)
  ATT_PK4(p0, 0, pa0); ATT_PK4(p0, 8, pa1); ATT_PK4(p1, 0, pa2); ATT_PK4(p1, 8, pa3);
#undef ATT_PK4
}

template <int MODE>
__device__ __forceinline__ void attn_unit(unsigned char* ws_, const float* rpb, const float* sink, int l, int h, int qb, int kvq, unsigned char* lds_g) {
  constexpr int DQK = MODE == 1 ? 192 : 128, ND = DQK / 16, NCH = DQK / 64;
  constexpr int SHM_V = 64 * 128 * 2, SHM_K = 64 * DQK * 2, OFF_K = 3 * SHM_V, OFF_WS = OFF_K + 3 * SHM_K, OFF_RPB = OFF_WS + 8 * 64 * 4;
  const int tid = otid(), wid = tid >> 6, lane = tid & 63, r32 = lane & 31, hi = lane >> 5;
  LAS unsigned char* ldl = (LAS unsigned char*)lds_g;
  const bf16_t* proj = (const bf16_t*)(ws_ + WS_PROJ);
  const bf16_t *Qp, *Kp, *Vp; int ldq, ldk, ldv, ycol; float C;
  if (MODE == 0) { Qp = proj + C_QA + 128 * h; Kp = proj + C_KA + 128 * h; Vp = proj + C_VA + 128 * h; ldq = ldk = ldv = DINP; ycol = 128 * h; C = 0.08838834764831845f * LOG2E; }
  else if (MODE == 1) { Qp = (const bf16_t*)(ws_ + WS_Q) + 192 * h; Kp = (const bf16_t*)(ws_ + WS_K) + 192 * h; Vp = (const bf16_t*)(ws_ + WS_V) + 128 * h; ldq = QLD; ldk = KLD; ldv = VLD; ycol = 512 + 128 * h; C = 0.07216878364870322f * LOG2E; }
  else { Qp = proj + C_QC + 128 * h; Kp = proj + C_KC + 128 * (h / 3); Vp = proj + C_VC + 128 * (h / 3); ldq = ldk = ldv = DINP; ycol = 1280 + 128 * h; C = 0.08838834764831845f * LOG2E; }
  const int q0 = qb * 256, qi = q0 + wid * 32 + r32;
  int T0, T1, tw0, tw1, wrow = 0, qcol = 0, c0 = 0; float slope2 = 0.f;
  if (MODE == 1) { T0 = tw0 = kvq * (S / 64 / KVSPLIT); T1 = tw1 = T0 + S / 64 / KVSPLIT; }
  else if (MODE == 0) { const int R = qb * 4; T0 = min(max(R - 4, 0), 120); T1 = min(max(R - 1, 0), 120) + 8; wrow = R + (wid >> 1); tw0 = min(max(wrow - 4, 0), 120); tw1 = tw0 + 8;
                        qcol = (wid & 1) * 32 + r32; c0 = min(max(qcol - 8, 0), 48); }
  else { T0 = max(0, (q0 - 128) >> 6); T1 = min(S / 64, ((q0 + 255 + 128) >> 6) + 1); const int qw = q0 + wid * 32; tw0 = max(0, (qw - 128) >> 6); tw1 = min(S / 64, ((qw + 31 + 128) >> 6) + 1);
         slope2 = exp2f(-8.0f * (float)(h + 1) / 6.0f) * LOG2E; }
  LAS float* wsl = (LAS float*)(ldl + OFF_WS) + wid * 64; LAS float* li_l = wsl; LAS float* al_l = wsl + 32;
  LAS float* rpbL = (LAS float*)(ldl + OFF_RPB);
  if (MODE == 0) { for (int i = tid; i < 465; i += NTHREADS) rpbL[i] = rpb[(l * 4 + h) * 465 + i] * LOG2E; }
  float m_reg = -1e29f, l_reg = 0.f;
  if (MODE == 2) { m_reg = sink[l * 6 + h] * LOG2E; l_reg = hi == 0 ? 1.f : 0.f; }
  f32x16 o[4] = {}; bf16x8 qr[ND];
  { const bf16_t* Qw = Qp + (size_t)qi * ldq + hi * 8;
#pragma unroll
    for (int d0 = 0; d0 < ND; ++d0) qr[d0] = *(const bf16x8*)(Qw + d0 * 16); }
  unsigned kg[NCH], vg[2];
#pragma unroll
  for (int i = 0; i < NCH; ++i) { const int X = (wid + 8 * i) * 1024 + lane * 16, row = X / (DQK * 2), cs = X % (DQK * 2), colB = cs ^ kswz_x<DQK>(row); kg[i] = (unsigned)(row * ldk + (colB >> 1)) * 2u; }
#pragma unroll
  for (int i = 0; i < 2; ++i) { const int X = (wid + 8 * i) * 1024 + lane * 16, st = X >> 9, w = X & 511, kk = ((st >> 2) << 3) | (w >> 6), c = ((st & 3) << 5) | ((w & 63) >> 1);
    const int k = (kk & ~0xC) | ((kk & 4) << 1) | ((kk & 8) >> 1); vg[i] = (unsigned)(k * ldv + c) * 2u; }
  const int vb0 = (int)(uintptr_t)lds_g + v_rd_base(lane);
  const int kbase0 = (int)(uintptr_t)lds_g + OFF_K;
  constexpr int NKO = DQK == 192 ? 4 : ND;
  int ko[NKO];
#pragma unroll
  for (int d0 = 0; d0 < NKO; ++d0) ko[d0] = kswz<DQK>(r32, (d0 * 16 + hi * 8) * 2);
#define ATT_KO(d0_) (DQK == 192 ? ko[(d0_) & 3] + ((d0_) >> 2) * 128 : ko[(d0_) % NKO])
  const int wslab = __builtin_amdgcn_readfirstlane(wid) * 1024;
#define ATT_DMA(t, b) do { const char* kt_ = (const char*)(Kp + (size_t)(t) * 64 * ldk); const char* vt_ = (const char*)(Vp + (size_t)(t) * 64 * ldv); \
    _Pragma("unroll") for (int i_ = 0; i_ < NCH; ++i_) __builtin_amdgcn_global_load_lds((const unsigned*)(kt_ + kg[i_]), (LAS unsigned*)(ldl + OFF_K + (b) * SHM_K + wslab + i_ * 8192), 16, 0, 0); \
    _Pragma("unroll") for (int i_ = 0; i_ < 2; ++i_) __builtin_amdgcn_global_load_lds((const unsigned*)(vt_ + vg[i_]), (LAS unsigned*)(ldl + (b) * SHM_V + wslab + i_ * 8192), 16, 0, 0); } while (0)
  __syncthreads();
  ATT_DMA(T0, 0); if (T0 + 1 < T1) { ATT_DMA(T0 + 1, 1); asm volatile("s_waitcnt vmcnt(%0)" :: "n"(NCH + 2) : "memory"); } else asm volatile("s_waitcnt vmcnt(0)" ::: "memory");
  ATT_BAR();
  int b = 0, bn = 2;
#pragma unroll 1
  for (int j = T0; j < T1; ++j) {
    const bool vis_ = (j >= tw0 && j < tw1);
    if (vis_) {
      f32x16 p0 = {}, p1 = {};
      ATT_SBAR();
      {
        const int kbase = kbase0 + b * SHM_K;
        bf16x8 fa[3], fb[3];
#define ATT_KRD(d0_) do { const int ad_ = kbase + ATT_KO(d0_); \
          asm volatile("ds_read_b128 %0, %1" : "=v"(fa[(d0_) % 3]) : "v"(ad_) : "memory"); \
          asm volatile("ds_read_b128 %0, %1 offset:%2" : "=v"(fb[(d0_) % 3]) : "v"(ad_), "i"(32 * DQK * 2) : "memory"); } while (0)
        ATT_KRD(0); ATT_KRD(1);
#pragma unroll
        for (int d0 = 0; d0 < ND; ++d0) {
          if (d0 + 2 < ND) { ATT_KRD(d0 + 2); asm volatile("s_waitcnt lgkmcnt(4)" ::: "memory"); }
          else if (d0 + 1 < ND) asm volatile("s_waitcnt lgkmcnt(2)" ::: "memory");
          else asm volatile("s_waitcnt lgkmcnt(0)" ::: "memory");
          ATT_SBAR();
          p0 = __builtin_amdgcn_mfma_f32_32x32x16_bf16(fa[d0 % 3], qr[d0], p0, 0, 0, 0);
          p1 = __builtin_amdgcn_mfma_f32_32x32x16_bf16(fb[d0 % 3], qr[d0], p1, 0, 0, 0);
          ATT_SBAR(); }
#undef ATT_KRD
      }
      ATT_SBAR();
      if (MODE == 0) {
        const int dr31 = (j - wrow + 7) * 31 + 15 - qcol;
#pragma unroll
        for (int r = 0; r < 16; ++r) { const int kc = crow(r, hi);
          { const bool v = (kc >= c0) && (kc < c0 + 16); const float bb = rpbL[v ? dr31 + kc : 0]; p0[r] = v ? fmaf(p0[r], C, bb) : NEGM; }
          { const int kc1 = kc + 32; const bool v = (kc1 >= c0) && (kc1 < c0 + 16); const float bb = rpbL[v ? dr31 + kc1 : 0]; p1[r] = v ? fmaf(p1[r], C, bb) : NEGM; } }
      } else if (MODE == 2) {
        const int kb = j * 64;
#pragma unroll
        for (int r = 0; r < 16; ++r) { const int k = kb + crow(r, hi);
          { const int d = abs(qi - k); p0[r] = d <= 128 ? fmaf(p0[r], C, -slope2 * (float)d) : NEGM; }
          { const int d = abs(qi - k - 32); p1[r] = d <= 128 ? fmaf(p1[r], C, -slope2 * (float)d) : NEGM; } }
      }
      float alpha; bf16x8 pa0, pa1, pa2, pa3;
      softmax_tile<MODE == 1>(p0, p1, C, m_reg, l_reg, alpha, pa0, pa1, pa2, pa3);
      if (__any(alpha < 1.f)) { if (hi == 0) al_l[r32] = alpha; asm volatile("s_waitcnt lgkmcnt(0)" ::: "memory");
#pragma unroll
        for (int r = 0; r < 16; ++r) { const float av = al_l[crow(r, hi)];
#pragma unroll
          for (int d = 0; d < 4; ++d) o[d][r] *= av; }
        asm volatile("s_waitcnt lgkmcnt(0)" ::: "memory"); }
      ATT_SBAR();
      pv_d0(o, vb0 + b * SHM_V, pa0, pa1, pa2, pa3);
    }
#if defined(PROBE_ATT_VALU)
    if (MODE == 1) { float dx_ = m_reg;
#pragma unroll
      for (int i_ = 0; i_ < 32; ++i_) asm volatile("v_exp_f32 %0, %0" : "+v"(dx_));
      asm volatile("" :: "v"(dx_)); }
#endif
#if defined(PROBE_ATT_LDS)
    if (MODE == 1) { bf16x8 t_; const int ad_ = (int)(uintptr_t)lds_g + OFF_K + b * SHM_K + kswz<DQK>(r32, hi * 16);
#pragma unroll
      for (int i_ = 0; i_ < 24; ++i_) asm volatile("ds_read_b128 %0, %1 offset:%2" : "=v"(t_) : "v"(ad_), "i"((i_ % 12) * 32) : "memory");
      asm volatile("s_waitcnt lgkmcnt(0)" ::: "memory"); asm volatile("" :: "v"(t_)); }
#endif
#if defined(PROBE_ATT_MFMA)
    if (MODE == 1) { f32x4 da_ = {0.f, 0.f, 0.f, 0.f};
#pragma unroll
      for (int i_ = 0; i_ < 80; ++i_) da_ = __builtin_amdgcn_mfma_f32_16x16x32_bf16(qr[0], qr[1], da_, 0, 0, 0);
      asm volatile("" :: "v"(da_)); }
#endif
    ATT_SBAR();
    if (j + 2 < T1) ATT_DMA(j + 2, bn);
    if (j + 2 < T1) asm volatile("s_waitcnt vmcnt(%0)" :: "n"(NCH + 2) : "memory"); else asm volatile("s_waitcnt vmcnt(0)" ::: "memory");
    ATT_BAR();
    b = b == 2 ? 0 : b + 1; bn = bn == 2 ? 0 : bn + 1;
  }
  { auto rr = __builtin_amdgcn_permlane32_swap(__float_as_uint(l_reg), __float_as_uint(l_reg), false, false); l_reg = __uint_as_float(rr[0]) + __uint_as_float(rr[1]); }
  if (hi == 0) li_l[r32] = l_reg; asm volatile("s_waitcnt lgkmcnt(0)" ::: "memory");
  bf16_t* Ow; int ldo;
  if (MODE == 1) { Ow = (bf16_t*)(ws_ + WS_PART) + ((size_t)kvq * S + q0 + wid * 32) * VLD + 128 * h + r32; ldo = VLD;
    if (hi == 0) { float* st = (float*)(ws_ + WS_STAT) + ((size_t)(kvq * 6 + h) * S + qi) * 2; st[0] = m_reg; st[1] = l_reg; } }
  else { Ow = (bf16_t*)(ws_ + WS_Y) + (size_t)(q0 + wid * 32) * DM + ycol + r32; ldo = DM; }
#pragma unroll
  for (int r = 0; r < 16; ++r) { const int orow = crow(r, hi); const float rl = __builtin_amdgcn_rcpf(li_l[orow]);
#pragma unroll
    for (int d0 = 0; d0 < 4; ++d0) Ow[(size_t)orow * ldo + d0 * 32] = (bf16_t)(cvtpk(o[d0][r] * rl, 0.f) & 0xffffu); }
  asm volatile("s_waitcnt lgkmcnt(0)" ::: "memory");
  __syncthreads();
#undef ATT_DMA
#undef ATT_KO
}
}

#ifndef NAIVE_ATTN
#define NAIVE_ATTN 0
#endif
#ifndef MK_MULTI
#define MK_MULTI 0
#endif
constexpr int N_PHASES = 2 + 10 * DEPTH;
__device__ __forceinline__ int opq(int v) { asm volatile("" : "+s"(v)); return v; }

__global__ void __launch_bounds__(NTHREADS) fwd_megakernel(Args a) {
    extern __shared__ __attribute__((aligned(16))) unsigned char lds[];
    cg::grid_group grid = cg::this_grid();
    const int lo = a.ph_lo, hi = a.ph_hi;
    const int G = gridDim.x;
    { LAS unsigned long long* tw = (LAS unsigned long long*)((LAS unsigned char*)lds + TAB_OFF);
#pragma unroll
      for (int i = 0; i < 19; ++i) if ((int)threadIdx.x == i) tw[i] = (unsigned long long)a.in[i];
      if (threadIdx.x == 19) tw[19] = (unsigned long long)a.out;
      if (threadIdx.x == 20) tw[20] = (unsigned long long)a.ws;
      if (threadIdx.x < 4) ((LAS unsigned*)((LAS unsigned char*)lds + TAB_OFF + 192))[threadIdx.x] = 0u;
      __syncthreads(); }
    (void)xcd_barrier_post((unsigned*)(a.ws + WS_BAR), (volatile LAS unsigned*)((LAS unsigned char*)lds + TAB_OFF + 192));
    if (a.ph_lo < 0) grid.sync();
    const Tab T{(const LAS unsigned*)((LAS unsigned char*)lds + TAB_OFF)};
#define ws (T.wsp())
#define mod ((float*)(ws + WS_MOD))
#define U ((bf16_t*)(ws + WS_U))
#define PROJ ((bf16_t*)(ws + WS_PROJ))
#define Qb ((bf16_t*)(ws + WS_Q))
#define Kb ((bf16_t*)(ws + WS_K))
#define Vb ((bf16_t*)(ws + WS_V))
#define Y ((bf16_t*)(ws + WS_Y))
#define Hb ((bf16_t*)(ws + WS_H))
#define X ((float*)(ws + WS_X))
#define rope ((float*)(ws + WS_ROPE))
#define rsq ((float*)(ws + WS_RSQ))
#define rskv ((float*)(ws + WS_RSKV))
    PG8_LAS unsigned char* ldsl = (PG8_LAS unsigned char*)lds;
#ifndef PHM
#define PHM 0xFFFFF
#endif
#ifndef ATM
#define ATM 7
#endif
#define EN(b) ((PHM >> (b)) & 1)
#ifndef PROBE_PH
#define PROBE_PH -1
#endif
#ifndef PROBE_N
#define PROBE_N 2
#endif
#define REPK(k) for (int rep_ = 0; rep_ < ((k) == PROBE_PH ? PROBE_N : 1); ++rep_)
#define IN(k) (lo <= (k) && (k) < hi)
#define GBAR() do { XcdBarrier b_; b_.bar = (unsigned*)(ws + WS_BAR); b_.x = xb_xcc_id(); b_.st = (volatile LAS unsigned*)((LAS unsigned char*)lds + TAB_OFF + 192); xcd_barrier(b_); } while (0)
#define SEAM(k) do { if (IN(k) && IN((k) + 1)) GBAR(); } while (0)

#ifdef PROBE_SYNCS
    for (int i_ = 0; i_ < PROBE_SYNCS; ++i_) GBAR();
#endif
    if (EN(0) && IN(0)) REPK(0) { phase_mod(T, lds); }
    SEAM(0);
    if (EN(1) && IN(1)) REPK(1) {
        const int fb_ = opq((int)blockIdx.x), fs_ = opq(G); const bool hide_ = (fs_ == 256);
        for (int l = 0; l < DEPTH; ++l) {
            transpose_job<3>(T.in(4) + (size_t)l * DM * DIN, (bf16_t*)(ws + WS_W + (size_t)l * SZ_WL + O_WIN), DM, DIN, DINP, nullptr, lds, fb_, fs_);
            const int fh_ = (hide_ && l == 1) ? (1 << 30) : fb_, fh0_ = hide_ ? (1 << 30) : fb_;
            transpose_job<1>(T.in(8) + (size_t)l * 512 * 1152, (bf16_t*)(ws + WS_W + (size_t)l * SZ_WL + O_WUQ), 512, 1152, 1280, T.in(6) + l * 512, lds, fh0_, fs_);
            transpose_job<0>(T.in(9) + (size_t)l * 256 * 1536, (bf16_t*)(ws + WS_W + (size_t)l * SZ_WL + O_WUKV), 256, 1536, 1536, T.in(7) + l * 256, lds, fh0_, fs_);
            if (!hide_) transpose_job<0>(T.in(12) + (size_t)l * DM * DM, (bf16_t*)(ws + WS_W + (size_t)l * SZ_WL + O_WO), DM, DM, DM, T.in(11) + l * DM, lds, fb_, fs_);
            if (!(hide_ && l == 1)) transpose_job<2>(T.in(15) + (size_t)l * DM * 2 * DFF, (bf16_t*)(ws + WS_W + (size_t)l * SZ_WL + O_WGU), DM, 2 * DFF, 2 * DFF, nullptr, lds, fb_, fs_);
            transpose_job<0>(T.in(16) + (size_t)l * DFF * DM, (bf16_t*)(ws + WS_W + (size_t)l * SZ_WL + O_WDN), DFF, DM, DM, nullptr, lds, fh_, fs_);
        }
        modulate_rows(T.in(0), mod + 1 * DM, mod + 0 * DM, U);
        rope_table(rope);
    }
    SEAM(1);
#pragma unroll 1
    for (int l = 0; l < DEPTH; ++l) {
        const int pb = 2 + 10 * l;
        if (EN(2) && IN(pb + 0)) REPK(2) {
            pg8::Gemm g{U, (const bf16_t*)(ws + WS_W + (size_t)l * SZ_WL + O_WIN), S, DINP, DM, DM}; pg8::StaticOrder So; So.init(S, DINP, opq(G), opq((int)blockIdx.x));
            pg8::EpiProj E{PROJ, DINP, (float*)(ws + WS_SSQ), rope, Kb, KLD};
            pg8::gemm_phase<pg8::EpiProj, pg8::StaticOrder, true, true>(ldsl, g, So, E);
            if (opq(G) == 256 && opq((int)blockIdx.x) >= 224) {
                const int sb_ = opq((int)blockIdx.x) - 224; const size_t lo_ = (size_t)l;
                transpose_job<1>(T.in(8) + lo_ * 512 * 1152, (bf16_t*)(ws + WS_W + lo_ * SZ_WL + O_WUQ), 512, 1152, 1280, T.in(6) + lo_ * 512, lds, sb_, 32);
                transpose_job<0>(T.in(9) + lo_ * 256 * 1536, (bf16_t*)(ws + WS_W + lo_ * SZ_WL + O_WUKV), 256, 1536, 1536, T.in(7) + lo_ * 256, lds, (sb_ + 8) & 31, 32);
                transpose_job<0>(T.in(12) + lo_ * DM * DM, (bf16_t*)(ws + WS_W + lo_ * SZ_WL + O_WO), DM, DM, DM, T.in(11) + lo_ * DM, lds, sb_, 32); }
        }
        SEAM(pb + 0);
        if (EN(4) && IN(pb + 2)) REPK(4) {
            { const int bq = opq((int)blockIdx.x), Gq = opq(G);
#pragma unroll 1
              for (int it = 0; ; ++it) {
                int q0 = -1, kv0 = -1, kv1 = -1, na = -1, sw0 = -1, sw1 = -1;
                if (Gq == 256) { if (it == 0) {
                    if (bq < 96) { na = bq; q0 = bq; }
                    else if (bq < 128) { na = bq; kv0 = 2 * (bq - 96); kv1 = kv0 + 1; }
                    else if (bq < 192) { sw0 = bq - 128; q0 = 96 + (bq - 128); kv0 = 64 + 2 * (bq - 128); kv1 = kv0 + 1; }
                    else { sw0 = 64 + (bq - 192); sw1 = 128 + (bq - 192); } } }
                else { const int L = bq + it * Gq; if (L < 160) q0 = L; if (L < 192) { kv0 = L; sw0 = L; } if (L < 128) na = L; }
                if ((q0 & kv0 & na & sw0) < 0 && q0 < 0 && kv0 < 0 && na < 0 && sw0 < 0) break;
                if (q0 >= 0) { pg8::Gemm g{PROJ + C_CQ, (const bf16_t*)(ws + WS_W + (size_t)l * SZ_WL + O_WUQ), S, 1280, 512, DINP}; pg8::ListOrder So{5, 1, q0, 0};
                  pg8::EpiQ E{Qb, QLD, (const float*)(ws + WS_SSQ), rope};
                  pg8::gemm_phase<pg8::EpiQ, pg8::ListOrder, true, true>(ldsl, g, So, E); }
                if (kv0 >= 0) { pg8::Gemm g{PROJ + C_CKV, (const bf16_t*)(ws + WS_W + (size_t)l * SZ_WL + O_WUKV), S, 1536, 256, DINP}; pg8::ListOrder So{6, kv1 >= 0 ? 2 : 1, kv0, kv1};
                  pg8::EpiKV E{Kb, KLD, Vb, VLD, (const float*)(ws + WS_SSQ)};
                  pg8::gemm_phase<pg8::EpiKV, pg8::ListOrder, true, true>(ldsl, g, So, E); }
                if (na >= 0) { if (ATM & 2) att::attn_unit<0>(ws, T.in(5), T.in(10), l, na >> 5, na & 31, 0, lds); }
#pragma unroll 1
                for (int i2 = 0; i2 < 2; ++i2) { const int u = i2 ? sw1 : sw0; if (u >= 0) { if (ATM & 4) att::attn_unit<2>(ws, T.in(5), T.in(10), l, u >> 5, u & 31, 0, lds); } }
              } }
        }
        SEAM(pb + 2);
        if (EN(5) && IN(pb + 3)) REPK(5) {
#if NAIVE_ATTN
            naive_attn<0>(ws, T.in(5), T.in(10), l); naive_attn<2>(ws, T.in(5), T.in(10), l); naive_attn<1>(ws, T.in(5), T.in(10), l);
#else
            const int Gq = opq(G);
            for (int su = opq((int)blockIdx.x); su < 192 * att::KVSPLIT; su += Gq) {
                int combo, qb; if (Gq == 256) { combo = (su & 7) + 8 * (su >> 8); qb = (su & 255) >> 3; } else { combo = su >> 5; qb = su & 31; }
                unsigned char* wsp_ = ws;
                if (ATM & 1) att::attn_unit<1>(wsp_, nullptr, nullptr, l, combo >> 2, qb, combo & 3, lds);
            }
#endif
        }
        SEAM(pb + 3);
        if (EN(6) && IN(pb + 4)) phase_ynorm(ws);
        SEAM(pb + 4);
        if (EN(7) && IN(pb + 5)) {
            pg8::Gemm g{Y, (const bf16_t*)(ws + WS_W + (size_t)l * SZ_WL + O_WO), S, DM, DM, DM}; pg8::StaticOrder So; So.init(S, DM, opq(G), opq((int)blockIdx.x));
            pg8::EpiRes E{l == 0 ? T.in(0) : (const float*)X, X, mod + (size_t)l * 6 * DM + 2 * DM, ALPHA, DM};
            pg8::gemm_phase<pg8::EpiRes, pg8::StaticOrder, true, true>(ldsl, g, So, E);
        }
        SEAM(pb + 5);
#ifdef PROBE_LN
        if (EN(8) && IN(pb + 6)) phase_ln(X, (float*)(ws + WS_H), T.in(13) + l * DM, T.in(14) + l * DM, mod + (size_t)l * 6 * DM + 4 * DM, mod + (size_t)l * 6 * DM + 3 * DM, (bf16_t*)(ws + WS_PART));
#endif
        if (EN(8) && IN(pb + 6)) phase_ln(X, X, T.in(13) + l * DM, T.in(14) + l * DM, mod + (size_t)l * 6 * DM + 4 * DM, mod + (size_t)l * 6 * DM + 3 * DM, U);
        SEAM(pb + 6);
        if (EN(9) && IN(pb + 7)) REPK(9) {
            pg8::Gemm g{U, (const bf16_t*)(ws + WS_W + (size_t)l * SZ_WL + O_WGU), S, 2 * DFF, DM, DM}; pg8::StaticOrder So; So.init(S, 2 * DFF, opq(G), opq((int)blockIdx.x));
            pg8::EpiSwiglu E{Hb, DFF};
            pg8::gemm_phase<pg8::EpiSwiglu, pg8::StaticOrder, true, true>(ldsl, g, So, E);
            if (l == 0 && opq(G) == 256 && opq((int)blockIdx.x) >= 128)
                transpose_job<2>(T.in(15) + (size_t)DM * 2 * DFF, (bf16_t*)(ws + WS_W + SZ_WL + O_WGU), DM, 2 * DFF, 2 * DFF, nullptr, lds, opq((int)blockIdx.x) - 128, 128);
            if (l == 1 && opq(G) == 256 && opq((int)blockIdx.x) >= 128)
                transpose_job<0>(T.in(16) + (size_t)DFF * DM, (bf16_t*)(ws + WS_W + SZ_WL + O_WDN), DFF, DM, DM, nullptr, lds, opq((int)blockIdx.x) - 128, 128);
        }
        SEAM(pb + 7);
        if (EN(10) && IN(pb + 8)) {
            pg8::Gemm g{Hb, (const bf16_t*)(ws + WS_W + (size_t)l * SZ_WL + O_WDN), S, DM, DFF, DFF}; pg8::StaticOrder So; So.init(S, DM, opq(G), opq((int)blockIdx.x));
            pg8::EpiRes E{X, X, mod + (size_t)l * 6 * DM + 5 * DM, ALPHA, DM};
            pg8::gemm_phase<pg8::EpiRes, pg8::StaticOrder, true, true>(ldsl, g, So, E);
        }
        SEAM(pb + 8);
        if (EN(11) && IN(pb + 9)) {
            const bool last = (l == DEPTH - 1);
            const float* modn = mod + (size_t)(last ? l : l + 1) * 6 * DM;
            phase_ln(X, last ? T.out() : X, T.in(17) + l * DM, T.in(18) + l * DM, last ? nullptr : modn + 1 * DM, last ? nullptr : modn + 0 * DM, last ? nullptr : U);
        }
        SEAM(pb + 9);
    }
#undef IN
#undef SEAM
#undef ws
#undef mod
#undef U
#undef PROJ
#undef Qb
#undef Kb
#undef Vb
#undef Y
#undef Hb
#undef X
#undef rope
#undef rsq
#undef rskv
}

extern "C" void kernel_launch(void* const* d_in, const int* in_sizes, int n_in, void* d_out, int out_size, void* d_ws, size_t ws_size, hipStream_t stream) {
    static int grid = 0;
    if (grid == 0) {
        if (n_in != 19 || out_size != S * DM || ws_size < WS_END) { fprintf(stderr, "kernel_launch: unexpected shapes (n_in %d out %d ws %zu need %zu)\n", n_in, out_size, ws_size, (size_t)WS_END); grid = -1; return; }
        int dev = 0, cus = 0, per_cu = 0;
        hipGetDevice(&dev); hipDeviceGetAttribute(&cus, hipDeviceAttributeMultiprocessorCount, dev);
        if (hipFuncSetAttribute((const void*)fwd_megakernel, hipFuncAttributeMaxDynamicSharedMemorySize, LDS_BYTES) != hipSuccess) { fprintf(stderr, "kernel_launch: hipFuncSetAttribute failed\n"); grid = -1; return; }
        if (hipOccupancyMaxActiveBlocksPerMultiprocessor(&per_cu, (const void*)fwd_megakernel, NTHREADS, LDS_BYTES) != hipSuccess || per_cu < 1) { fprintf(stderr, "kernel_launch: occupancy query gave %d\n", per_cu); per_cu = 1; }
        (void)hipGetLastError();
        grid = cus;
    }
    if (grid < 0) return;
    if (hipMemsetAsync((char*)d_ws + WS_BAR, 0, 16384, stream) != hipSuccess) { fprintf(stderr, "kernel_launch: memset of the barrier words failed\n"); return; }
    Args a{};
    for (int i = 0; i < 19; ++i) a.in[i] = (const float*)d_in[i];
    a.out = (float*)d_out; a.ws = (unsigned char*)d_ws;
#if MK_MULTI
    for (int p = 0; p < N_PHASES; ++p) { a.ph_lo = p; a.ph_hi = p + 1; hipLaunchKernelGGL(fwd_megakernel, dim3(grid), dim3(NTHREADS), LDS_BYTES, stream, a); }
#else
    a.ph_lo = 0; a.ph_hi = N_PHASES;
    void* args[] = {&a};
    hipError_t e = hipLaunchCooperativeKernel((const void*)fwd_megakernel, dim3(grid), dim3(NTHREADS), args, LDS_BYTES, stream);
    if (e != hipSuccess) fprintf(stderr, "kernel_launch: cooperative launch failed: %s (grid %d)\n", hipGetErrorString(e), grid);
#endif
}
```

```cpp
#include <hip/hip_runtime.h>
#include <hip/hip_cooperative_groups.h>
#include <cstdio>
#include <cstdint>
namespace cg = cooperative_groups;
namespace pg8 {
#define PG8_LAS __attribute__((address_space(3)))
typedef unsigned short bf16_t;
typedef short bf16x8 __attribute__((ext_vector_type(8)));
typedef float f32x4 __attribute__((ext_vector_type(4)));
typedef unsigned u32x4 __attribute__((ext_vector_type(4)));
constexpr int BM = 256, BK = 64, HALF = 128, HTB = HALF * BK * 2  , STAGE_BYTES = 8 * HTB, NXCD = 8, WGM = 8;

__host__ __device__ __forceinline__ int lds_byte(int r, int c) { const int st = (r >> 4) * 2 + (c >> 5), rr = r & 15, cc = c & 31, ob = rr * 64 + cc * 2; return st * 1024 + (ob ^ (((ob >> 9) & 1) << 5)); }
__host__ __device__ __forceinline__ void stage_rc(int b, int& R, int& C) { const int st = b / 1024, sb = b % 1024, swz = sb ^ (((sb >> 9) & 1) << 5); R = (st >> 1) * 16 + swz / 64; C = (st & 1) * 32 + (swz % 64) / 2; }
__host__ __device__ __forceinline__ int perm32(int rho) { const int n = rho >> 4, i = rho & 15; return 8 * (i >> 2) + 4 * n + (i & 3); }

struct Unit { int pm, pn; };
struct Gemm { const bf16_t* A; const bf16_t* Bt; int M, N, K, lda; };

struct StaticOrder {
    int nM, nN, nwg, G, c;
    __host__ __device__ void init(int M, int N, int G_, int c_) { nM = M / BM; nN = N / BM; nwg = nM * nN; G = G_; c = c_; }
    __host__ __device__ bool next(int i, Unit& u) const {
        const long L = (long)i * G + c; if (L >= nwg) return false;
        int wgid = (int)L; { const int q = nwg / NXCD, r = nwg % NXCD, xcd = wgid % NXCD, off = wgid / NXCD; wgid = (xcd < r ? xcd * (q + 1) : r * (q + 1) + (xcd - r) * q) + off; }
        const int nig = WGM * nN, gid = wgid / nig, fm = gid * WGM, gsz = (nM - fm) < WGM ? (nM - fm) : WGM;
        u.pm = fm + ((wgid % nig) % gsz); u.pn = (wgid % nig) / gsz; return true;
    }
    __device__ __forceinline__ void a_ready(const Unit&) const {}
    __device__ __forceinline__ void done(const Unit&) const {}
};

struct ListOrder {
    int nN, n, L0, L1;
    __host__ __device__ bool next(int i, Unit& u) const { if (i >= n) return false; const int L = i == 0 ? L0 : L1; u.pm = L / nN; u.pn = L % nN; return true; }
    __device__ __forceinline__ void a_ready(const Unit&) const {}
    __device__ __forceinline__ void done(const Unit&) const {}
};
__device__ __forceinline__ unsigned cvt_pk_bf16(float lo, float hi) { unsigned r; asm volatile("v_cvt_pk_bf16_f32 %0, %1, %2" : "=v"(r) : "v"(lo), "v"(hi)); return r; }
typedef float f32x2 __attribute__((ext_vector_type(2)));
__device__ __forceinline__ u32x4 pack8(const f32x4 v0, const f32x4 v1) { u32x4 w; w.x = cvt_pk_bf16(v0[0], v0[1]); w.y = cvt_pk_bf16(v0[2], v0[3]); w.z = cvt_pk_bf16(v1[0], v1[1]); w.w = cvt_pk_bf16(v1[2], v1[3]); return w; }
struct EpiStore {
    static constexpr bool PERM = true, AFTER_DRAIN = false;
    bf16_t* O; int ldc;
    __device__ __forceinline__ void operator()(const f32x4 (&acc)[2][2][4][2], const Unit& u, int wr, int wc, int fr, int fq) const {
        const int row0 = u.pm * BM + wr * 64 + fr, col0 = u.pn * BM + wc * 32 + 8 * fq;
#pragma unroll
        for (int ai = 0; ai < 2; ++ai)
#pragma unroll
            for (int m = 0; m < 4; ++m) { bf16_t* rowp = O + (size_t)(row0 + ai * HALF + m * 16) * ldc + col0;
#pragma unroll
                for (int bj = 0; bj < 2; ++bj) *(u32x4*)(rowp + bj * HALF) = pack8(acc[ai][bj][m][0], acc[ai][bj][m][1]); }
    }
};
struct EpiProj {
    static constexpr bool PERM = true, AFTER_DRAIN = false;
    bf16_t* O; int ldc; float* ssq; const float* rope; bf16_t* Kb; int ldk;
    __device__ __forceinline__ void operator()(const f32x4 (&acc)[2][2][4][2], const Unit& u, int wr, int wc, int fr, int fq) const {
        const int row0 = u.pm * BM + wr * 64 + fr, col0 = u.pn * BM + wc * 32 + 8 * fq;
#pragma unroll
        for (int ai = 0; ai < 2; ++ai)
#pragma unroll
            for (int m = 0; m < 4; ++m) { const int row = row0 + ai * HALF + m * 16; bf16_t* rowp = O + (size_t)row * ldc + col0; float sq = 0.f;
#pragma unroll
                for (int bj = 0; bj < 2; ++bj) { const u32x4 w = pack8(acc[ai][bj][m][0], acc[ai][bj][m][1]); *(u32x4*)(rowp + bj * HALF) = w;
#pragma unroll
                    for (int e = 0; e < 4; ++e) { const float lo = __uint_as_float(w[e] << 16), hi = __uint_as_float(w[e] & 0xffff0000u); sq += lo * lo + hi * hi; } }
                if (u.pn >= 6 && u.pn <= 8) { sq += __shfl_xor(sq, 16); sq += __shfl_xor(sq, 32); if (fq == 0) ssq[((size_t)row * 3 + (u.pn - 6)) * 4 + wc] = sq; }
                if (u.pn == 9 && wc < 2) { const int ib = wc * 16 + 4 * fq; const f32x4 v0 = acc[ai][0][m][0], v1 = acc[ai][0][m][1];
                    const f32x4 c = *(const f32x4*)(rope + (size_t)row * 64 + ib), sn = *(const f32x4*)(rope + (size_t)row * 64 + 32 + ib);
                    f32x4 a, b;
                    a[0] = v0[0] * c[0] - v0[1] * sn[0]; a[1] = v0[1] * c[0] + v0[0] * sn[0];
                    a[2] = v0[2] * c[1] - v0[3] * sn[1]; a[3] = v0[3] * c[1] + v0[2] * sn[1];
                    b[0] = v1[0] * c[2] - v1[1] * sn[2]; b[1] = v1[1] * c[2] + v1[0] * sn[2];
                    b[2] = v1[2] * c[3] - v1[3] * sn[3]; b[3] = v1[3] * c[3] + v1[2] * sn[3];
                    const u32x4 w = pack8(a, b);
#pragma unroll
                    for (int h = 0; h < 6; ++h) *(u32x4*)(Kb + (size_t)row * ldk + 192 * h + 128 + wc * 32 + 8 * fq) = w; }
                if (m & 1) asm volatile("" ::: "memory"); }
    }
};
struct EpiQ {
    static constexpr bool PERM = true, AFTER_DRAIN = false;
    bf16_t* O; int ldc; const float* ssq; const float* rope;
    __device__ __forceinline__ void operator()(const f32x4 (&acc)[2][2][4][2], const Unit& u, int wr, int wc, int fr, int fq) const {
        const int row0 = u.pm * BM + wr * 64 + fr;
        float sc[2][4];
        { f32x4 q0[2][4], q1[2][4];
#pragma unroll
          for (int ai = 0; ai < 2; ++ai)
#pragma unroll
            for (int m = 0; m < 4; ++m) { const float* p = ssq + (size_t)(row0 + ai * HALF + m * 16) * 12; q0[ai][m] = *(const f32x4*)p; q1[ai][m] = *(const f32x4*)(p + 4); }
#pragma unroll
          for (int ai = 0; ai < 2; ++ai)
#pragma unroll
            for (int m = 0; m < 4; ++m) { const f32x4 a = q0[ai][m], b = q1[ai][m];
                sc[ai][m] = 1.0f / sqrtf((((a[0] + a[1]) + (a[2] + a[3])) + ((b[0] + b[1]) + (b[2] + b[3]))) * (1.0f / 512.0f) + 1e-6f); } }
#pragma unroll
        for (int ai = 0; ai < 2; ++ai)
#pragma unroll
            for (int m = 0; m < 4; ++m) { const int row = row0 + ai * HALF + m * 16; const float s = sc[ai][m];
#pragma unroll
                for (int bj = 0; bj < 2; ++bj) {
                    const int cb = u.pn * BM + bj * HALF + wc * 32, hc = cb % 192;
                    f32x4 v0 = acc[ai][bj][m][0] * s, v1 = acc[ai][bj][m][1] * s;
                    if (hc >= 128) {
                        const int ib = (hc - 128) / 2 + 4 * fq;
                        const f32x4 c = *(const f32x4*)(rope + (size_t)row * 64 + ib), sn = *(const f32x4*)(rope + (size_t)row * 64 + 32 + ib);
                        f32x4 a, b;
                        a[0] = v0[0] * c[0] - v0[1] * sn[0]; a[1] = v0[1] * c[0] + v0[0] * sn[0];
                        a[2] = v0[2] * c[1] - v0[3] * sn[1]; a[3] = v0[3] * c[1] + v0[2] * sn[1];
                        b[0] = v1[0] * c[2] - v1[1] * sn[2]; b[1] = v1[1] * c[2] + v1[0] * sn[2];
                        b[2] = v1[2] * c[3] - v1[3] * sn[3]; b[3] = v1[3] * c[3] + v1[2] * sn[3];
                        v0 = a; v1 = b;
                    }
                    *(u32x4*)(O + (size_t)row * ldc + cb + 8 * fq) = pack8(v0, v1);
                }
                if (m == 3) asm volatile("" ::: "memory"); }
    }
};
struct EpiKV {
    static constexpr bool PERM = true, AFTER_DRAIN = false;
    bf16_t* Kb; int ldk; bf16_t* Vb; int ldv; const float* ssq;
    __device__ __forceinline__ void operator()(const f32x4 (&acc)[2][2][4][2], const Unit& u, int wr, int wc, int fr, int fq) const {
        const int row0 = u.pm * BM + wr * 64 + fr, cin = wc * 32 + 8 * fq;
        f32x4 q2[2][4];
#pragma unroll
        for (int ai = 0; ai < 2; ++ai)
#pragma unroll
            for (int m = 0; m < 4; ++m) q2[ai][m] = *(const f32x4*)(ssq + (size_t)(row0 + ai * HALF + m * 16) * 12 + 8);
#pragma unroll
        for (int ai = 0; ai < 2; ++ai)
#pragma unroll
            for (int m = 0; m < 4; ++m) { const int row = row0 + ai * HALF + m * 16; const f32x4 a = q2[ai][m];
                const float s = 1.0f / sqrtf(((a[0] + a[1]) + (a[2] + a[3])) * (1.0f / 256.0f) + 1e-6f);
                *(u32x4*)(Kb + (size_t)row * ldk + 192 * u.pn + cin) = pack8(acc[ai][0][m][0] * s, acc[ai][0][m][1] * s);
                *(u32x4*)(Vb + (size_t)row * ldv + 128 * u.pn + cin) = pack8(acc[ai][1][m][0] * s, acc[ai][1][m][1] * s); }
    }
};
struct EpiRes {
    static constexpr bool PERM = false, AFTER_DRAIN = false;
    const float* xres; float* z; const float* gate; float alpha; int ldc;
    __device__ __forceinline__ void operator()(const f32x4 (&acc)[2][2][4][2], const Unit& u, int wr, int wc, int fr, int fq) const {
        const int row0 = u.pm * BM + wr * 64 + fr, col0 = u.pn * BM + wc * 32 + 4 * fq;
        f32x4 gv[2][2];
#pragma unroll
        for (int bj = 0; bj < 2; ++bj)
#pragma unroll
            for (int n = 0; n < 2; ++n) gv[bj][n] = *(const f32x4*)(gate + col0 + bj * HALF + n * 16) + 1.0f;
#pragma unroll
        for (int ai = 0; ai < 2; ++ai)
#pragma unroll
            for (int m = 0; m < 4; ++m) { const size_t off = (size_t)(row0 + ai * HALF + m * 16) * ldc + col0;
#pragma unroll
                for (int bj = 0; bj < 2; ++bj)
#pragma unroll
                    for (int n = 0; n < 2; ++n) { const f32x4 xr = *(const f32x4*)(xres + off + bj * HALF + n * 16);
                        *(f32x4*)(z + off + bj * HALF + n * 16) = xr * alpha + gv[bj][n] * acc[ai][bj][m][n]; }
                if (m == 3) asm volatile("" ::: "memory"); }
    }
};
struct EpiSwiglu {
    static constexpr bool PERM = true, AFTER_DRAIN = false;
    bf16_t* H; int ldc;
    __device__ __forceinline__ void operator()(const f32x4 (&acc)[2][2][4][2], const Unit& u, int wr, int wc, int fr, int fq) const {
        const int row0 = u.pm * BM + wr * 64 + fr, col0 = u.pn * HALF + wc * 32 + 8 * fq;
#pragma unroll
        for (int ai = 0; ai < 2; ++ai)
#pragma unroll
            for (int m = 0; m < 4; ++m) { f32x4 h[2];
#pragma unroll
                for (int n = 0; n < 2; ++n) { const f32x4 g = acc[ai][0][m][n], up = acc[ai][1][m][n];
#pragma unroll
                    for (int j = 0; j < 4; ++j) h[n][j] = g[j] * __builtin_amdgcn_rcpf(1.0f + __builtin_amdgcn_exp2f(-1.4426950408889634f * g[j])) * up[j]; }
                *(u32x4*)(H + (size_t)(row0 + ai * HALF + m * 16) * ldc + col0) = pack8(h[0], h[1]); }
    }
};
template <class Epi, class Sched, bool ALIGN_EPI = false, bool SP2 = false>
__device__ __forceinline__ void gemm_phase(PG8_LAS unsigned char* lds, const Gemm g, const Sched& S, const Epi& E) {
    int tid_ = threadIdx.x; asm volatile("" : "+v"(tid_)); const int tid = tid_, wid = __builtin_amdgcn_readfirstlane(tid >> 6), lane = tid & 63, wr = wid >> 2, wc = wid & 3, fr = lane & 15, fq = lane >> 4;
    int Kv_ = g.K, lda_ = g.lda; asm volatile("" : "+s"(Kv_), "+s"(lda_)); const int K = Kv_, nt = K / BK;
    unsigned voffA[2], voffB[2];
#pragma unroll
    for (int i = 0; i < 2; ++i) { int R, C; stage_rc(tid * 16 + i * 8192, R, C); const int Rb = Epi::PERM ? ((R & ~31) + perm32(R & 31)) : R;
        voffA[i] = (unsigned)(R * lda_ + C) * 2u; voffB[i] = (unsigned)(Rb * K + C) * 2u; }
    const size_t kstep = (size_t)(BK * 2);
    const size_t hstepA = (size_t)HALF * lda_ * 2, hstepB = (size_t)HALF * K * 2;
    const size_t tstepA = 2 * hstepA, tstepB = 2 * hstepB;
    const unsigned ldsw = (unsigned)wid * 1024u;
    const int aoff = lds_byte(wr * 64 + fr, fq * 8), boff = lds_byte(wc * 32 + fr, fq * 8);
#define PG8_SA(b, h) (((b) * 2 + (h)) * HTB)
#define PG8_SB(b, h) ((4 + (b) * 2 + (h)) * HTB)
#define PG8_STAGE(bufoff, gbase, voff) do { _Pragma("unroll") for (int _i = 0; _i < 2; ++_i) \
        __builtin_amdgcn_global_load_lds((const unsigned*)((const char*)(gbase) + (voff)[_i]), (PG8_LAS unsigned*)(lds + (bufoff) + ldsw + _i * 8192), 16, 0, 0); } while (0)
#define PG8_LDA(dst, b, h) do { _Pragma("unroll") for (int m = 0; m < 4; ++m) _Pragma("unroll") for (int k = 0; k < 2; ++k) dst[m][k] = *(const PG8_LAS bf16x8*)(lds + PG8_SA(b, h) + aoff + m * 2048 + k * 1024); } while (0)
#define PG8_LDB(dst, b, h) do { _Pragma("unroll") for (int n = 0; n < 2; ++n) _Pragma("unroll") for (int k = 0; k < 2; ++k) dst[n][k] = *(const PG8_LAS bf16x8*)(lds + PG8_SB(b, h) + boff + n * 2048 + k * 1024); } while (0)
#define PG8_MMA(ai, bj, At, Bt) do { __builtin_amdgcn_s_setprio(1); _Pragma("unroll") for (int m = 0; m < 4; ++m) _Pragma("unroll") for (int n = 0; n < 2; ++n) _Pragma("unroll") for (int k = 0; k < 2; ++k) \
        acc[ai][bj][m][n] = __builtin_amdgcn_mfma_f32_16x16x32_bf16(Bt[n][k], At[m][k], acc[ai][bj][m][n], 0, 0, 0); __builtin_amdgcn_s_setprio(0); } while (0)
#define PG8_WAIT_V(n) asm volatile("s_waitcnt vmcnt(" #n ")" ::: "memory")
#define PG8_WAIT_L(n) asm volatile("s_waitcnt lgkmcnt(" #n ")" ::: "memory")
#define PG8_BAR __builtin_amdgcn_s_barrier()
#define PG8_SCHED __builtin_amdgcn_sched_barrier(0)
    Unit cur, nxt; int ui = 0;
    if (!S.next(0, cur)) return;
    f32x4 acc[2][2][4][2];
#pragma unroll
    for (int a = 0; a < 2; ++a)
#pragma unroll
        for (int b = 0; b < 2; ++b)
#pragma unroll
            for (int m = 0; m < 4; ++m)
#pragma unroll
                for (int n = 0; n < 2; ++n) acc[a][b][m][n] = (f32x4){0.f, 0.f, 0.f, 0.f};
    bf16x8 At[4][2], B0[2][2], B1[2][2];
    const char* cA = (const char*)g.A + (size_t)cur.pm * tstepA; const char* cB = (const char*)g.Bt + (size_t)cur.pn * tstepB;
    S.a_ready(cur);
    if constexpr (SP2) {
        PG8_STAGE(PG8_SB(0, 0), cB, voffB); PG8_STAGE(PG8_SB(0, 1), cB + hstepB, voffB); PG8_STAGE(PG8_SA(0, 0), cA, voffA); PG8_STAGE(PG8_SA(0, 1), cA + hstepA, voffA);
        if (wr == 1) PG8_BAR;
        PG8_WAIT_V(2); PG8_BAR;
        PG8_STAGE(PG8_SB(1, 0), cB + kstep, voffB); PG8_STAGE(PG8_SA(1, 0), cA + kstep, voffA); PG8_STAGE(PG8_SB(1, 1), cB + hstepB + kstep, voffB);
        PG8_WAIT_V(6); PG8_BAR;
    } else {
        PG8_STAGE(PG8_SB(0, 0), cB, voffB); PG8_STAGE(PG8_SA(0, 0), cA, voffA); PG8_STAGE(PG8_SB(0, 1), cB + hstepB, voffB); PG8_STAGE(PG8_SA(0, 1), cA + hstepA, voffA);
        if (wr == 1) PG8_BAR;
        PG8_WAIT_V(4); PG8_BAR;
        PG8_STAGE(PG8_SB(1, 0), cB + kstep, voffB); PG8_STAGE(PG8_SA(1, 0), cA + kstep, voffA); PG8_STAGE(PG8_SB(1, 1), cB + hstepB + kstep, voffB);
        PG8_WAIT_V(6); PG8_BAR;
    }
    for (;;) {
        const bool has_next = S.next(ui + 1, nxt);
        const char* nA = has_next ? (const char*)g.A + (size_t)nxt.pm * tstepA : cA; const char* nB = has_next ? (const char*)g.Bt + (size_t)nxt.pn * tstepB : cB;
        for (int t = 0; t < nt; t += 2) {
            const bool last = (t == nt - 2);
            const char* a1 = cA + (size_t)(t + 1) * kstep;
            const char* a2 = last ? nA : cA + (size_t)(t + 2) * kstep; const char* b2 = last ? nB : cB + (size_t)(t + 2) * kstep;
            const char* a3 = a2 + kstep; const char* b3 = b2 + kstep;
            if (last && has_next) S.a_ready(nxt);
            if constexpr (SP2) {
            PG8_LDB(B0, 0, 0); PG8_LDB(B1, 0, 1); PG8_SCHED; PG8_LDA(At, 0, 0); PG8_STAGE(PG8_SA(1, 1), a1 + hstepA, voffA);
            PG8_WAIT_V(8); PG8_WAIT_L(0); PG8_BAR; PG8_MMA(0, 0, At, B0); PG8_MMA(0, 1, At, B1); PG8_BAR; PG8_SCHED;
            PG8_LDA(At, 0, 1); PG8_STAGE(PG8_SB(0, 0), b2, voffB); PG8_STAGE(PG8_SB(0, 1), b2 + hstepB, voffB); PG8_STAGE(PG8_SA(0, 0), a2, voffA);
            PG8_WAIT_V(8); PG8_WAIT_L(0); PG8_BAR; PG8_MMA(1, 0, At, B0); PG8_MMA(1, 1, At, B1); PG8_BAR; PG8_SCHED;
            PG8_LDB(B0, 1, 0); PG8_LDB(B1, 1, 1); PG8_SCHED; PG8_LDA(At, 1, 0); PG8_STAGE(PG8_SA(0, 1), a2 + hstepA, voffA);
            PG8_WAIT_V(8); PG8_WAIT_L(0); PG8_BAR; PG8_MMA(0, 0, At, B0); PG8_MMA(0, 1, At, B1); PG8_BAR; PG8_SCHED;
            PG8_LDA(At, 1, 1); PG8_STAGE(PG8_SB(1, 0), b3, voffB); PG8_STAGE(PG8_SB(1, 1), b3 + hstepB, voffB); PG8_STAGE(PG8_SA(1, 0), a3, voffA);
            PG8_WAIT_V(8); PG8_WAIT_L(0); PG8_BAR; PG8_MMA(1, 0, At, B0); PG8_MMA(1, 1, At, B1); PG8_BAR; PG8_SCHED;
            } else {
            PG8_LDB(B0, 0, 0); PG8_SCHED; PG8_LDA(At, 0, 0); PG8_STAGE(PG8_SA(1, 1), a1 + hstepA, voffA);
            PG8_WAIT_L(8); PG8_BAR; PG8_WAIT_L(0); PG8_MMA(0, 0, At, B0); PG8_BAR; PG8_SCHED;
            PG8_LDB(B1, 0, 1); PG8_STAGE(PG8_SB(0, 0), b2, voffB);
            PG8_BAR; PG8_WAIT_L(0); PG8_MMA(0, 1, At, B1); PG8_BAR;
            PG8_LDA(At, 0, 1); PG8_STAGE(PG8_SA(0, 0), a2, voffA);
            PG8_BAR; PG8_WAIT_L(0); PG8_MMA(1, 0, At, B0); PG8_BAR; PG8_SCHED;
            PG8_STAGE(PG8_SB(0, 1), b2 + hstepB, voffB);
            PG8_WAIT_V(6); PG8_BAR; PG8_MMA(1, 1, At, B1); PG8_BAR;
            PG8_LDB(B0, 1, 0); PG8_SCHED; PG8_LDA(At, 1, 0); PG8_STAGE(PG8_SA(0, 1), a2 + hstepA, voffA);
            PG8_WAIT_L(8); PG8_BAR; PG8_WAIT_L(0); PG8_MMA(0, 0, At, B0); PG8_BAR; PG8_SCHED;
            PG8_LDB(B1, 1, 1); PG8_STAGE(PG8_SB(1, 0), b3, voffB);
            PG8_BAR; PG8_WAIT_L(0); PG8_MMA(0, 1, At, B1); PG8_BAR;
            PG8_LDA(At, 1, 1); PG8_STAGE(PG8_SA(1, 0), a3, voffA);
            PG8_BAR; PG8_WAIT_L(0); PG8_MMA(1, 0, At, B0); PG8_BAR; PG8_SCHED;
            PG8_STAGE(PG8_SB(1, 1), b3 + hstepB, voffB);
            PG8_WAIT_V(6); PG8_BAR; PG8_MMA(1, 1, At, B1); PG8_BAR;
            }
        }
        if constexpr (ALIGN_EPI) { if (wr == 0) PG8_BAR; }
        if constexpr (!Epi::AFTER_DRAIN) { E(acc, cur, wr, wc, fr, fq); S.done(cur); }
        if (!has_next) break;
#pragma unroll
        for (int a = 0; a < 2; ++a)
#pragma unroll
            for (int b = 0; b < 2; ++b)
#pragma unroll
                for (int m = 0; m < 4; ++m)
#pragma unroll
                    for (int n = 0; n < 2; ++n) acc[a][b][m][n] = (f32x4){0.f, 0.f, 0.f, 0.f};
        cur = nxt; cA = nA; cB = nB; ++ui;
        if constexpr (ALIGN_EPI) { if (wr == 1) PG8_BAR; }
    }
    PG8_WAIT_V(0);
    if constexpr (!ALIGN_EPI) { if (wr == 0) PG8_BAR; }
    PG8_BAR;
    if constexpr (Epi::AFTER_DRAIN) { E.fused(acc, cur, wr, wc, fr, fq, lds, wid, lane); S.done(cur); }
#undef PG8_SA
#undef PG8_SB
#undef PG8_STAGE
#undef PG8_LDA
#undef PG8_LDB
#undef PG8_MMA
#undef PG8_WAIT_V
#undef PG8_WAIT_L
#undef PG8_BAR
#undef PG8_SCHED
}
}

#define LAS __attribute__((address_space(3)))
typedef unsigned short bf16_t;
typedef float f32x4 __attribute__((ext_vector_type(4)));
typedef unsigned u32x4 __attribute__((ext_vector_type(4)));
typedef unsigned u32x2 __attribute__((ext_vector_type(2)));
constexpr int S = 8192, DM = 2048, DEPTH = 2, DIN = 3648, DINP = 3840, DFF = 5632;
constexpr int QLD = 1280, KLD = 1152, VLD = 768;
constexpr int C_QA = 0, C_KA = 512, C_VA = 1024, C_CQ = 1536, C_CKV = 2048, C_KR = 2304, C_QC = 2368, C_KC = 3136, C_VC = 3392;
constexpr float ALPHA = 1.4142135623730951f;
constexpr size_t al256(size_t x) { return (x + 255) / 256 * 256; }
constexpr size_t SZ_WIN = (size_t)DINP * DM * 2, SZ_WUQ = (size_t)1280 * 512 * 2, SZ_WUKV = (size_t)1536 * 256 * 2, SZ_WO = (size_t)DM * DM * 2, SZ_WGU = (size_t)2 * DFF * DM * 2, SZ_WDN = (size_t)DM * DFF * 2;
constexpr size_t O_WIN = 0, O_WUQ = O_WIN + SZ_WIN, O_WUKV = O_WUQ + SZ_WUQ, O_WO = O_WUKV + SZ_WUKV, O_WGU = O_WO + SZ_WO, O_WDN = O_WGU + SZ_WGU, SZ_WL = O_WDN + SZ_WDN;
constexpr size_t WS_W = 0;
constexpr size_t WS_MOD = al256(WS_W + DEPTH * SZ_WL);
constexpr size_t WS_ROPE = al256(WS_MOD + (size_t)DEPTH * 6 * DM * 4);
constexpr size_t WS_RSQ = al256(WS_ROPE + (size_t)S * 64 * 4);
constexpr size_t WS_RSKV = al256(WS_RSQ + (size_t)S * 4);
constexpr size_t WS_X = al256(WS_RSKV + (size_t)S * 4);
constexpr size_t WS_U = al256(WS_X + (size_t)S * DM * 4);
constexpr size_t WS_PROJ = al256(WS_U + (size_t)S * DM * 2);
constexpr size_t WS_Q = al256(WS_PROJ + (size_t)S * DINP * 2);
constexpr size_t WS_K = al256(WS_Q + (size_t)S * QLD * 2);
constexpr size_t WS_V = al256(WS_K + (size_t)S * KLD * 2);
constexpr size_t WS_Y = al256(WS_V + (size_t)S * VLD * 2);
constexpr size_t WS_H = al256(WS_Y + (size_t)S * DM * 2);
constexpr size_t WS_PART = al256(WS_H + (size_t)S * DFF * 2);
constexpr size_t WS_STAT = al256(WS_PART + (size_t)4 * S * VLD * 2);
constexpr size_t WS_SSQ = al256(WS_STAT + (size_t)4 * 6 * S * 2 * 4);
constexpr size_t WS_BAR0_ = WS_SSQ + (size_t)S * 12 * 4;
constexpr size_t WS_BAR = al256(WS_BAR0_);
constexpr size_t WS_END = al256(WS_BAR + 16384);
constexpr int TAB_OFF = pg8::STAGE_BYTES, LDS_BYTES = pg8::STAGE_BYTES + 256;
constexpr int NTHREADS = 512;

struct Args { const float* in[19]; float* out; unsigned char* ws; int ph_lo, ph_hi; };
struct Tab {
    const LAS unsigned* t;
    __device__ __forceinline__ unsigned long long ld(int i) const { const unsigned lo = __builtin_amdgcn_readfirstlane(t[2 * i]), hi = __builtin_amdgcn_readfirstlane(t[2 * i + 1]); return ((unsigned long long)hi << 32) | lo; }
    __device__ __forceinline__ const float* in(int i) const { return (const float*)ld(i); }
    __device__ __forceinline__ float* out() const { return (float*)ld(19); }
    __device__ __forceinline__ unsigned char* wsp() const { return (unsigned char*)ld(20); }
};

__device__ __forceinline__ float bf2f(unsigned short b) { return __uint_as_float((unsigned)b << 16); }
template <int CTRL> __device__ __forceinline__ float dpp_mov(float v) { return __builtin_bit_cast(float, __builtin_amdgcn_update_dpp(0, __builtin_bit_cast(int, v), CTRL, 0xf, 0xf, true)); }
__device__ __forceinline__ float wave_sum(float v) {
    v += dpp_mov<0xB1>(v);
    v += dpp_mov<0x4E>(v);
    v += dpp_mov<0x141>(v);
    v += dpp_mov<0x140>(v);
    { auto rr = __builtin_amdgcn_permlane16_swap(__float_as_uint(v), __float_as_uint(v), false, false); v = __uint_as_float(rr[0]) + __uint_as_float(rr[1]); }
    { auto rr = __builtin_amdgcn_permlane32_swap(__float_as_uint(v), __float_as_uint(v), false, false); v = __uint_as_float(rr[0]) + __uint_as_float(rr[1]); }
    return v; }
using pg8::cvt_pk_bf16;
__device__ __forceinline__ int otid() { int t = threadIdx.x; asm volatile("" : "+v"(t)); return t; }

__device__ __forceinline__ void phase_mod(const Tab tb, unsigned char* lds_g) {
    unsigned char* ws_ = tb.wsp(); const float* in1 = tb.in(1); const float* in2 = tb.in(2); const float* in3 = tb.in(3);
    float* condL = (float*)lds_g; f32x4* red = (f32x4*)(lds_g + 8192);
    const int tid = otid();
    const float* c = in1;
    for (int i = tid; i < DM; i += NTHREADS) { const float v = c[i]; condL[i] = v / (1.0f + __expf(-v)); }
    __syncthreads();
    float* mod = (float*)(ws_ + WS_MOD);
    const int cl = tid & 31, kg = tid >> 5;
    for (int item = blockIdx.x; item < DEPTH * 96; item += gridDim.x) {
        const int l = item / 96, cgp = item % 96;
        const float* W = in2 + (size_t)l * DM * 6 * DM + (size_t)(kg * 128) * (6 * DM) + cgp * 128 + 4 * cl;
        f32x4 acc = {0.f, 0.f, 0.f, 0.f};
#pragma unroll 8
        for (int kk = 0; kk < 128; ++kk) { const f32x4 w = __builtin_nontemporal_load((const f32x4*)(W + (size_t)kk * (6 * DM))); acc += w * condL[kg * 128 + kk]; }
        red[kg * 32 + cl] = acc;
        __syncthreads();
        if (tid < 128) { float s = 0.f; const float* rf = (const float*)red;
            for (int g = 0; g < 16; ++g) s += rf[g * 128 + tid];
            mod[l * 6 * DM + cgp * 128 + tid] = s + in3[l * 6 * DM + cgp * 128 + tid]; }
        __syncthreads();
    }
}

template <int PERMT>
__device__ __forceinline__ int dst_row(int n) {
    if (PERMT == 1) { const int h = n / 192, d = n % 192; if (d < 128) return n; const int j = d - 128; return h * 192 + 128 + 2 * (j & 31) + (j >> 5); }
    if (PERMT == 3) { if (n < C_KR || n >= C_KR + 64) return n; const int j = n - C_KR; return C_KR + 2 * (j & 31) + (j >> 5); }
    if (PERMT == 2) { if (n < DFF) return 256 * (n >> 7) + (n & 127); const int m = n - DFF; return 256 * (m >> 7) + 128 + (m & 127); }
    return n;
}
template <int PERMT>
__device__ __forceinline__ void transpose_job(const float* __restrict__ src, bf16_t* __restrict__ dst, int K, int N, int Npad, const float* __restrict__ kscale, unsigned char* lds_g, int first, int stride) {
    float* T = (float*)lds_g;
    const int tid = otid(), nkt = K / 64, nnt = (N + 255) / 256, ntiles = nkt * nnt;
    for (int t = first; t < ntiles; t += stride) {
        const int k0 = (t % nkt) * 64, n0 = (t / nkt) * 256;
        { const int kk = tid >> 6, n4 = tid & 63; const bool ok = n0 + 4 * n4 < N; f32x4 v[8];
#pragma unroll
          for (int i = 0; i < 8; ++i) { const int k = k0 + kk + 8 * i; v[i] = ok ? __builtin_nontemporal_load((const f32x4*)(src + (size_t)k * N + n0 + 4 * n4)) : (f32x4){0.f, 0.f, 0.f, 0.f}; }
#pragma unroll
          for (int i = 0; i < 8; ++i) { const int k = k0 + kk + 8 * i; if (kscale) v[i] = v[i] * kscale[k];
              float* tp = T + (kk + 8 * i) * 257 + 4 * n4; tp[0] = v[i][0]; tp[1] = v[i][1]; tp[2] = v[i][2]; tp[3] = v[i][3]; } }
        __syncthreads();
        { const int n = tid >> 1, ks = tid & 1;
          if (n0 + n < N) { bf16_t* dp = dst + (size_t)dst_row<PERMT>(n0 + n) * K + k0 + 32 * ks;
#pragma unroll
            for (int eb = 0; eb < 4; ++eb) { float v[8];
#pragma unroll
              for (int e = 0; e < 8; ++e) v[e] = T[(32 * ks + 8 * eb + e) * 257 + n];
              u32x4 w; w.x = cvt_pk_bf16(v[0], v[1]); w.y = cvt_pk_bf16(v[2], v[3]); w.z = cvt_pk_bf16(v[4], v[5]); w.w = cvt_pk_bf16(v[6], v[7]);
              *(u32x4*)(dp + 8 * eb) = w; } } }
        __syncthreads();
    }
    const size_t nz = (size_t)(Npad - N) * K / 8;
    for (size_t i = (size_t)blockIdx.x * NTHREADS + tid; i < nz; i += (size_t)gridDim.x * NTHREADS) *(u32x4*)(dst + (size_t)N * K + i * 8) = (u32x4){0u, 0u, 0u, 0u};
}

__device__ __forceinline__ void modulate_rows(const float* __restrict__ x, const float* __restrict__ sc, const float* __restrict__ sh, bf16_t* __restrict__ u) {
    const size_t n8 = (size_t)S * DM / 8;
    for (size_t i = (size_t)blockIdx.x * NTHREADS + otid(); i < n8; i += (size_t)gridDim.x * NTHREADS) {
        const int col = (int)((i * 8) % DM);
        const f32x4 x0 = *(const f32x4*)(x + i * 8), x1 = *(const f32x4*)(x + i * 8 + 4);
        const f32x4 s0 = *(const f32x4*)(sc + col) + 1.0f, s1 = *(const f32x4*)(sc + col + 4) + 1.0f;
        const f32x4 h0 = *(const f32x4*)(sh + col), h1 = *(const f32x4*)(sh + col + 4);
        *(u32x4*)(u + i * 8) = pg8::pack8(x0 * s0 + h0, x1 * s1 + h1);
    }
}

__device__ __forceinline__ void rope_table(float* __restrict__ rope) {
    for (int i = blockIdx.x * NTHREADS + otid(); i < S * 32; i += gridDim.x * NTHREADS) {
        const int pos = i >> 5, j = i & 31;
        const float inv = exp2f(-(float)j * (13.287712379549449f / 32.0f));
        const float ang = (float)pos * inv;
        const double rev = (double)ang * 0.15915494309189535;
        const double fr = rev - floor(rev);
        const float ar = (float)(fr * 6.283185307179586);
        rope[(size_t)pos * 64 + j] = cosf(ar); rope[(size_t)pos * 64 + 32 + j] = sinf(ar);
    }
}

__device__ __forceinline__ void phase_prep(unsigned char* ws_) {
    const bf16_t* proj = (const bf16_t*)(ws_ + WS_PROJ); const float* rope = (const float*)(ws_ + WS_ROPE);
    float* rsq = (float*)(ws_ + WS_RSQ); float* rskv = (float*)(ws_ + WS_RSKV); bf16_t* Kb = (bf16_t*)(ws_ + WS_K);
    const int tid_o = otid(), lane = tid_o & 63, wave = tid_o >> 6;
    for (int r = blockIdx.x * 8 + wave; r < S; r += gridDim.x * 8) {
        const bf16_t* pr = proj + (size_t)r * DINP;
        { const u32x4 w = *(const u32x4*)(pr + C_CQ + 8 * lane); float ss = 0.f;
#pragma unroll
          for (int e = 0; e < 4; ++e) { const float lo = __uint_as_float(w[e] << 16), hi = __uint_as_float(w[e] & 0xffff0000u); ss += lo * lo + hi * hi; }
          ss = wave_sum(ss); if (lane == 0) rsq[r] = 1.0f / sqrtf(ss * (1.0f / 512.0f) + 1e-6f); }
        { const u32x2 w = *(const u32x2*)(pr + C_CKV + 4 * lane); float ss = 0.f;
#pragma unroll
          for (int e = 0; e < 2; ++e) { const float lo = __uint_as_float(w[e] << 16), hi = __uint_as_float(w[e] & 0xffff0000u); ss += lo * lo + hi * hi; }
          ss = wave_sum(ss); if (lane == 0) rskv[r] = 1.0f / sqrtf(ss * (1.0f / 256.0f) + 1e-6f); }
        { const int i = lane & 31; const float x1 = bf2f(pr[C_KR + i]), x2 = bf2f(pr[C_KR + 32 + i]);
          const float c = rope[(size_t)r * 64 + i], sn = rope[(size_t)r * 64 + 32 + i];
          const unsigned w = cvt_pk_bf16(x1 * c - x2 * sn, x2 * c + x1 * sn);
          const int hb = (lane >> 5) * 3;
#pragma unroll
          for (int h = 0; h < 3; ++h) *(unsigned*)(Kb + (size_t)r * KLD + (hb + h) * 192 + 128 + 2 * i) = w; }
    }
}

__device__ __forceinline__ void phase_ynorm(unsigned char* ws_) {
    bf16_t* y = (bf16_t*)(ws_ + WS_Y); const bf16_t* part = (const bf16_t*)(ws_ + WS_PART); const float* stat = (const float*)(ws_ + WS_STAT);
    const int tid_o = otid(), lane = tid_o & 63, wave = tid_o >> 6;
    const bool lowhalf = lane < 32;
    for (int r = blockIdx.x * 8 + wave; r < S; r += gridDim.x * 8) {
        bf16_t* yr = y + (size_t)r * DM;
        float v[4][8]; float ss[4];
#pragma unroll
        for (int j = 0; j < 4; ++j) {
            const bool fromPart = (j == 1) || (j == 2 && lowhalf);
            if (!fromPart) { const u32x4 w = *(const u32x4*)(yr + j * 512 + 8 * lane);
#pragma unroll
                for (int e = 0; e < 4; ++e) { v[j][2 * e] = __uint_as_float(w[e] << 16); v[j][2 * e + 1] = __uint_as_float(w[e] & 0xffff0000u); } }
            else { const int yb = j * 512 + 8 * lane - 512, h = yb >> 7; float m[4], lw[4];
#pragma unroll
                for (int i = 0; i < 4; ++i) { const float* st = stat + ((size_t)(i * 6 + h) * S + r) * 2; m[i] = st[0]; lw[i] = st[1]; }
                const float M = fmaxf(fmaxf(m[0], m[1]), fmaxf(m[2], m[3])); float W = 0.f;
#pragma unroll
                for (int i = 0; i < 4; ++i) { lw[i] *= __builtin_amdgcn_exp2f(m[i] - M); W += lw[i]; }
                const float rW = 1.0f / W;
#pragma unroll
                for (int e = 0; e < 8; ++e) v[j][e] = 0.f;
#pragma unroll
                for (int i = 0; i < 4; ++i) { const u32x4 w = *(const u32x4*)(part + ((size_t)i * S + r) * VLD + yb); const float wi = lw[i] * rW;
#pragma unroll
                    for (int e = 0; e < 4; ++e) { v[j][2 * e] += wi * __uint_as_float(w[e] << 16); v[j][2 * e + 1] += wi * __uint_as_float(w[e] & 0xffff0000u); } } }
            float sq = 0.f;
#pragma unroll
            for (int e = 0; e < 8; ++e) sq += v[j][e] * v[j][e];
            ss[j] = sq;
        }
        const float sA = wave_sum(ss[0]);
        const float sB = wave_sum(ss[1] + (lowhalf ? ss[2] : 0.f));
        const float sC = wave_sum(ss[3] + (lowhalf ? 0.f : ss[2]));
        const float rA = 1.0f / sqrtf(sA * (1.0f / 512.0f) + 1e-6f), rB = 1.0f / sqrtf(sB * (1.0f / 768.0f) + 1e-6f), rC = 1.0f / sqrtf(sC * (1.0f / 768.0f) + 1e-6f);
#pragma unroll
        for (int j = 0; j < 4; ++j) { const float sc = j == 0 ? rA : (j == 1 ? rB : (j == 2 ? (lowhalf ? rB : rC) : rC)); u32x4 o;
#pragma unroll
            for (int e = 0; e < 4; ++e) o[e] = cvt_pk_bf16(v[j][2 * e] * sc, v[j][2 * e + 1] * sc);
            *(u32x4*)(yr + j * 512 + 8 * lane) = o; }
    }
}

__device__ __forceinline__ void phase_ln(const float* z, float* xo, const float* __restrict__ g, const float* __restrict__ b, const float* __restrict__ sc, const float* __restrict__ sh, bf16_t* __restrict__ u) {
    const int tid_o = otid(), lane = tid_o & 63, wave = tid_o >> 6;
    const int stride = gridDim.x * 8;
    for (int r = blockIdx.x * 8 + wave; r < S; r += 2 * stride) {
        const bool hasB = r + stride < S; const int rr[2] = {r, hasB ? r + stride : r};
        f32x4 v[2][8]; float s[2] = {0.f, 0.f};
#pragma unroll
        for (int k = 0; k < 2; ++k) { const float* zr = z + (size_t)rr[k] * DM;
#pragma unroll
            for (int j = 0; j < 8; ++j) v[k][j] = *(const f32x4*)(zr + j * 256 + 4 * lane); }
#pragma unroll
        for (int k = 0; k < 2; ++k)
#pragma unroll
            for (int j = 0; j < 8; ++j) s[k] += (v[k][j][0] + v[k][j][1]) + (v[k][j][2] + v[k][j][3]);
        float mean[2], rstd[2];
#pragma unroll
        for (int k = 0; k < 2; ++k) { mean[k] = wave_sum(s[k]) * (1.0f / DM); float q = 0.f;
#pragma unroll
            for (int j = 0; j < 8; ++j) { const f32x4 d = v[k][j] - mean[k]; q += (d[0] * d[0] + d[1] * d[1]) + (d[2] * d[2] + d[3] * d[3]); }
            rstd[k] = 1.0f / sqrtf(wave_sum(q) * (1.0f / DM) + 1e-5f); }
#pragma unroll
        for (int j = 0; j < 8; ++j) { const int col = j * 256 + 4 * lane;
            const f32x4 gg = *(const f32x4*)(g + col), bb = *(const f32x4*)(b + col);
            f32x4 s1 = {0.f, 0.f, 0.f, 0.f}, h1 = {0.f, 0.f, 0.f, 0.f};
            if (u) { s1 = *(const f32x4*)(sc + col) + 1.0f; h1 = *(const f32x4*)(sh + col); }
#pragma unroll
            for (int k = 0; k < 2; ++k) { if (k == 1 && !hasB) continue;
                const f32x4 o = (v[k][j] - mean[k]) * rstd[k] * gg + bb;
                *(f32x4*)(xo + (size_t)rr[k] * DM + col) = o;
                if (u) { const f32x4 m = o * s1 + h1; u32x2 w; w.x = cvt_pk_bf16(m[0], m[1]); w.y = cvt_pk_bf16(m[2], m[3]); *(u32x2*)(u + (size_t)rr[k] * DM + col) = w; } } }
    }
}

template <int MODE>
__device__ __forceinline__ void naive_attn(unsigned char* ws_, const float* rpb, const float* sink, int l) {
    constexpr int DQK = MODE == 1 ? 192 : 128, NJ = DQK / 64, H = MODE == 0 ? 4 : 6;
    const bf16_t* proj = (const bf16_t*)(ws_ + WS_PROJ); bf16_t* y = (bf16_t*)(ws_ + WS_Y);
    const int tid_o = otid(), lane = tid_o & 63, wave = tid_o >> 6;
    for (int it = blockIdx.x * 8 + wave; it < S * H; it += gridDim.x * 8) {
        const int h = it / S, q = it % S;
        const bf16_t *Qp, *Kp, *Vp; int ldk, ldv, ycol; float scale;
        if (MODE == 0) { Qp = proj + (size_t)q * DINP + C_QA + 128 * h; Kp = proj + C_KA + 128 * h; Vp = proj + C_VA + 128 * h; ldk = DINP; ldv = DINP; ycol = 128 * h; scale = 0.08838834764831845f; }
        else if (MODE == 1) { Qp = (const bf16_t*)(ws_ + WS_Q) + (size_t)q * QLD + 192 * h; Kp = (const bf16_t*)(ws_ + WS_K) + 192 * h; Vp = (const bf16_t*)(ws_ + WS_V) + 128 * h; ldk = KLD; ldv = VLD; ycol = 512 + 128 * h; scale = 0.07216878364870322f; }
        else { Qp = proj + (size_t)q * DINP + C_QC + 128 * h; Kp = proj + C_KC + 128 * (h / 3); Vp = proj + C_VC + 128 * (h / 3); ldk = DINP; ldv = DINP; ycol = 1280 + 128 * h; scale = 0.08838834764831845f; }
        float qv[NJ];
#pragma unroll
        for (int j = 0; j < NJ; ++j) qv[j] = bf2f(Qp[64 * j + lane]) * scale;
        float m = -1e30f, ls = 0.f, o0 = 0.f, o1 = 0.f; int nkeys, klo = 0, r = 0, col = 0, r0 = 0, c0 = 0; float slope = 0.f;
        if (MODE == 0) { r = q >> 6; col = q & 63; r0 = min(max(r - 4, 0), 120); c0 = min(max(col - 8, 0), 48); nkeys = 128; }
        else if (MODE == 1) nkeys = S;
        else { klo = max(0, q - 128); nkeys = min(S - 1, q + 128) - klo + 1; m = sink[l * 6 + h]; ls = 1.f; slope = exp2f(-8.0f * (float)(h + 1) / 6.0f); }
        for (int kk = 0; kk < nkeys; ++kk) {
            int key; float bias = 0.f;
            if (MODE == 0) { const int krow = r0 + (kk >> 4), kcol = c0 + (kk & 15); key = krow * 64 + kcol; bias = rpb[((l * 4 + h) * 15 + (krow - r + 7)) * 31 + (kcol - col + 15)]; }
            else if (MODE == 1) key = kk;
            else { key = klo + kk; bias = -slope * fabsf((float)(q - key)); }
            float part = 0.f;
#pragma unroll
            for (int j = 0; j < NJ; ++j) part += qv[j] * bf2f(Kp[(size_t)key * ldk + 64 * j + lane]);
            const float s = wave_sum(part) + bias;
            const float mn = fmaxf(m, s), al = __expf(m - mn), p = __expf(s - mn);
            ls = ls * al + p;
            o0 = o0 * al + p * bf2f(Vp[(size_t)key * ldv + lane]); o1 = o1 * al + p * bf2f(Vp[(size_t)key * ldv + 64 + lane]);
            m = mn;
        }
        const float inv = 1.0f / ls;
        y[(size_t)q * DM + ycol + lane] = (bf16_t)(cvt_pk_bf16(o0 * inv, 0.f) & 0xffffu);
        y[(size_t)q * DM + ycol + 64 + lane] = (bf16_t)(cvt_pk_bf16(o1 * inv, 0.f) & 0xffffu);
    }
}

#define XB_TMO      128
#define XB_XCNT(j)  (256  + 64 * (j))
#define XB_XSUB(j)  (1280 + 64 * (j))
#define XB_XGEN(j)  (2304 + 64 * (j))
#define XB_TOP      3328
#define XB_TOPGEN   3392
#define XCD_BAR_WORDS 3456
#define XB_SPIN_CAP (1u << 18)

__device__ __forceinline__ unsigned xb_ld(unsigned* p)              { return __hip_atomic_load(p, __ATOMIC_RELAXED, __HIP_MEMORY_SCOPE_AGENT); }
__device__ __forceinline__ unsigned xb_add(unsigned* p, unsigned v) { return __hip_atomic_fetch_add(p, v, __ATOMIC_RELAXED, __HIP_MEMORY_SCOPE_AGENT); }
__device__ __forceinline__ unsigned xb_xcc_id() { return (unsigned)__builtin_amdgcn_s_getreg((3 << 11) | 20) & 0xFu; }
#define XB_SPIN(cond, bar) do { unsigned _sp = 0; while (cond) { __builtin_amdgcn_s_sleep(1); \
    if ((++_sp & 255u) == 0u) { if (xb_ld(&(bar)[XB_TMO])) break; if (_sp > XB_SPIN_CAP) { atomicAdd(&(bar)[XB_TMO], 1u); break; } } } } while (0)

struct XcdBarrier {
    unsigned* bar; unsigned x;
    volatile LAS unsigned* st;
};

__device__ __forceinline__ XcdBarrier xcd_barrier_post(unsigned* bar, volatile LAS unsigned* st) {
    XcdBarrier b; b.bar = bar; b.x = xb_xcc_id(); b.st = st;
    if (threadIdx.x == 0) (void)xb_add(&bar[XB_XCNT(b.x)], 1u);
    return b;
}
__device__ __forceinline__ void xcd_barrier_complete(unsigned* bar, unsigned x, unsigned& nloc, unsigned& nx) {
    const unsigned G = gridDim.x * gridDim.y * gridDim.z;
    unsigned sum, cnt, mine, sp = 0u;
    for (;;) {
        sum = 0u; cnt = 0u; mine = 0u;
#pragma unroll
        for (unsigned j = 0; j < 16; ++j) { const unsigned c = xb_ld(&bar[XB_XCNT(j)]); sum += c; cnt += (c > 0u) ? 1u : 0u; mine = (j == x) ? c : mine; }
        if (sum == G) break;
        __builtin_amdgcn_s_sleep(1);
        if ((++sp & 255u) == 0u) { if (xb_ld(&bar[XB_TMO])) break; if (sp > XB_SPIN_CAP) { atomicAdd(&bar[XB_TMO], 1u); break; } }
    }
    nloc = mine > 0u ? mine : 1u; nx = cnt > 0u ? cnt : 1u;
}

__device__ __forceinline__ void xcd_barrier(const XcdBarrier& b) {
    asm volatile("s_waitcnt vmcnt(0)" ::: "memory");
    __syncthreads();
    if (threadIdx.x == 0) {
        unsigned* bar = b.bar;
        __builtin_amdgcn_s_waitcnt(0);
        unsigned nloc = b.st[0], nx = b.st[1];
        if (nloc == 0u) { xcd_barrier_complete(bar, b.x, nloc, nx); b.st[0] = nloc; b.st[1] = nx; }
        const unsigned old = xb_add(&bar[XB_XSUB(b.x)], 1u);
        const unsigned gen = old / nloc;
        if (old + 1u == (gen + 1u) * nloc) {
            __builtin_amdgcn_fence(__ATOMIC_RELEASE, "agent");
            asm volatile("s_waitcnt vmcnt(0)" ::: "memory");
            const unsigned og = xb_add(&bar[XB_TOP], 1u);
            const unsigned tg = og / nx;
            if (og + 1u == (tg + 1u) * nx) xb_add(&bar[XB_TOPGEN], 1u);
            else XB_SPIN(xb_ld(&bar[XB_TOPGEN]) == tg, bar);
            __builtin_amdgcn_fence(__ATOMIC_ACQUIRE, "agent");
            xb_add(&bar[XB_XGEN(b.x)], 1u);
            asm volatile("s_waitcnt vmcnt(0)" ::: "memory");
        } else {
            XB_SPIN(xb_ld(&bar[XB_XGEN(b.x)]) == gen, bar);
            __builtin_amdgcn_fence(__ATOMIC_ACQUIRE, "agent");
            asm volatile("s_waitcnt vmcnt(0)" ::: "memory");
        }
    }
    __syncthreads();
}


namespace att {
typedef short bf16x8 __attribute__((ext_vector_type(8)));
typedef short s16x4 __attribute__((ext_vector_type(4)));
typedef float f32x16 __attribute__((ext_vector_type(16)));
#define ATT_SBAR() __builtin_amdgcn_sched_barrier(0)
#define ATT_BAR() do { asm volatile("s_waitcnt lgkmcnt(0)" ::: "memory"); __builtin_amdgcn_s_barrier(); asm volatile("" ::: "memory"); } while (0)
constexpr float LOG2E = 1.4426950408889634f, NEGM = -1e30f;
constexpr float DEFER_THR = 8.f;
constexpr int KVSPLIT = 4;
__device__ __forceinline__ int crow(int r, int hi) { return (r & 3) + 8 * (r >> 2) + 4 * hi; }
__device__ __forceinline__ unsigned cvtpk(float lo, float hi) { unsigned r; asm volatile("v_cvt_pk_bf16_f32 %0, %1, %2" : "=v"(r) : "v"(lo), "v"(hi)); return r; }
template <int DQK> __device__ __forceinline__ int kswz_x(int row) { return DQK == 128 ? (((row & 7) | (((row >> 4) & 1) << 3)) << 4) : (((row >> 1) & 7) << 4); }
template <int DQK> __device__ __forceinline__ int kswz(int row, int colB) { return row * (DQK * 2) + (colB ^ kswz_x<DQK>(row)); }
__device__ __forceinline__ int v_st(int k, int c) { const int kk = (k & ~0xC) | ((k & 4) << 1) | ((k & 8) >> 1); return ((kk >> 3) * 4 + (c >> 5)) * 512 + ((kk & 7) * 32 + (c & 31)) * 2; }
__device__ __forceinline__ int v_rd_base(int lane) { return ((lane & 3) << 3) | (((lane >> 2) & 3) << 6) | (((lane >> 4) & 1) << 5) | (((lane >> 5) & 1) << 8); }
constexpr int v_rd_off(int d0, int ks, int half) { return d0 * 512 + ks * 4096 + half * 2048; }
template <int OFF> __device__ __forceinline__ s16x4 tr_read(int vb) { s16x4 r; asm volatile("ds_read_b64_tr_b16 %0, %1 offset:%2" : "=&v"(r) : "v"(vb), "i"(OFF) : "memory"); return r; }
struct VFrag { s16x4 l0, h0, l1, h1, l2, h2, l3, h3; };
template <int D0> __device__ __forceinline__ void pv_read(VFrag& f, int vb) {
  f.l0 = tr_read<v_rd_off(D0, 0, 0)>(vb); f.h0 = tr_read<v_rd_off(D0, 0, 1)>(vb); f.l1 = tr_read<v_rd_off(D0, 1, 0)>(vb); f.h1 = tr_read<v_rd_off(D0, 1, 1)>(vb);
  f.l2 = tr_read<v_rd_off(D0, 2, 0)>(vb); f.h2 = tr_read<v_rd_off(D0, 2, 1)>(vb); f.l3 = tr_read<v_rd_off(D0, 3, 0)>(vb); f.h3 = tr_read<v_rd_off(D0, 3, 1)>(vb);
}
__device__ __forceinline__ void pv_mma(f32x16& od, const VFrag& f, bf16x8 pa0, bf16x8 pa1, bf16x8 pa2, bf16x8 pa3) {
#define ATT_PK(L, H) (bf16x8){L[0], L[1], L[2], L[3], H[0], H[1], H[2], H[3]}
  od = __builtin_amdgcn_mfma_f32_32x32x16_bf16(pa0, ATT_PK(f.l0, f.h0), od, 0, 0, 0);
  od = __builtin_amdgcn_mfma_f32_32x32x16_bf16(pa1, ATT_PK(f.l1, f.h1), od, 0, 0, 0);
  od = __builtin_amdgcn_mfma_f32_32x32x16_bf16(pa2, ATT_PK(f.l2, f.h2), od, 0, 0, 0);
  od = __builtin_amdgcn_mfma_f32_32x32x16_bf16(pa3, ATT_PK(f.l3, f.h3), od, 0, 0, 0);
#undef ATT_PK
}
__device__ __forceinline__ void pv_d0(f32x16* o, int vb, bf16x8 pa0, bf16x8 pa1, bf16x8 pa2, bf16x8 pa3) {
  VFrag fa, fb;
  pv_read<0>(fa, vb); pv_read<1>(fb, vb);
  asm volatile("s_waitcnt lgkmcnt(8)" ::: "memory"); ATT_SBAR(); pv_mma(o[0], fa, pa0, pa1, pa2, pa3); ATT_SBAR();
  pv_read<2>(fa, vb);
  asm volatile("s_waitcnt lgkmcnt(8)" ::: "memory"); ATT_SBAR(); pv_mma(o[1], fb, pa0, pa1, pa2, pa3); ATT_SBAR();
  pv_read<3>(fb, vb);
  asm volatile("s_waitcnt lgkmcnt(8)" ::: "memory"); ATT_SBAR(); pv_mma(o[2], fa, pa0, pa1, pa2, pa3); ATT_SBAR();
  asm volatile("s_waitcnt lgkmcnt(0)" ::: "memory"); ATT_SBAR(); pv_mma(o[3], fb, pa0, pa1, pa2, pa3);
}
typedef float f32x2 __attribute__((ext_vector_type(2)));
template <bool RAW>
__device__ __forceinline__ void softmax_tile(f32x16& p0, f32x16& p1, float Cs, float& m_reg, float& l_reg, float& alpha, bf16x8& pa0, bf16x8& pa1, bf16x8& pa2, bf16x8& pa3) {
  float pmax = fmaxf(fmaxf(p0[0], p0[1]), p1[0]);
#pragma unroll
  for (int r = 2; r < 16; r += 2) pmax = fmaxf(fmaxf(pmax, p0[r]), p0[r + 1]);
#pragma unroll
  for (int r = 1; r < 15; r += 2) pmax = fmaxf(fmaxf(pmax, p1[r]), p1[r + 1]);
  pmax = fmaxf(pmax, p1[15]);
  if (RAW) pmax *= Cs;
  float mn;
  if (__builtin_expect(__all(pmax - m_reg <= DEFER_THR * LOG2E), 1)) { mn = m_reg; alpha = 1.f; }
  else { { auto rr = __builtin_amdgcn_permlane32_swap(__float_as_uint(pmax), __float_as_uint(pmax), false, false); pmax = fmaxf(__uint_as_float(rr[0]), __uint_as_float(rr[1])); }
         mn = fmaxf(m_reg, pmax); alpha = __builtin_amdgcn_exp2f(m_reg - mn); m_reg = mn; }
#pragma unroll
  for (int r = 0; r < 16; ++r) { p0[r] = __builtin_amdgcn_exp2f(RAW ? fmaf(p0[r], Cs, -mn) : p0[r] - mn); p1[r] = __builtin_amdgcn_exp2f(RAW ? fmaf(p1[r], Cs, -mn) : p1[r] - mn); }
  f32x2 ps2 = {0.f, 0.f};
#pragma unroll
  for (int r = 0; r < 16; r += 2) { ps2 += (f32x2){p0[r], p0[r + 1]}; ps2 += (f32x2){p1[r], p1[r + 1]}; }
  l_reg = l_reg * alpha + (ps2[0] + ps2[1]);
#define ATT_PK8(P, BASE, OUT) do { u32x4 w = {cvtpk(P[BASE + 0], P[BASE + 1]), cvtpk(P[BASE + 2], P[BASE + 3]), cvtpk(P[BASE + 4], P[BASE + 5]), cvtpk(P[BASE + 6], P[BASE + 7])}; \
    OUT = *reinterpret_cast<bf16x8*>(&w); } while (0)
  ATT_PK8(p0, 0, pa0); ATT_PK8(p0, 8, pa1); ATT_PK8(p1, 0, pa2); ATT_PK8(p1, 8, pa3);
#undef ATT_PK8
}

template <int MODE>
__device__ __forceinline__ void attn_unit(unsigned char* ws_, const float* rpb, const float* sink, int l, int h, int qb, int kvq, unsigned char* lds_g) {
  constexpr int DQK = MODE == 1 ? 192 : 128, ND = DQK / 16, NCH = DQK / 64;
  constexpr int SHM_V = 64 * 128 * 2, SHM_K = 64 * DQK * 2, OFF_K = 3 * SHM_V, OFF_WS = OFF_K + 3 * SHM_K, OFF_RPB = OFF_WS + 8 * 64 * 4;
  const int tid = otid(), wid = tid >> 6, lane = tid & 63, r32 = lane & 31, hi = lane >> 5;
  LAS unsigned char* ldl = (LAS unsigned char*)lds_g;
  const bf16_t* proj = (const bf16_t*)(ws_ + WS_PROJ);
  const bf16_t *Qp, *Kp, *Vp; int ldq, ldk, ldv, ycol; float C;
  if (MODE == 0) { Qp = proj + C_QA + 128 * h; Kp = proj + C_KA + 128 * h; Vp = proj + C_VA + 128 * h; ldq = ldk = ldv = DINP; ycol = 128 * h; C = 0.08838834764831845f * LOG2E; }
  else if (MODE == 1) { Qp = (const bf16_t*)(ws_ + WS_Q) + 192 * h; Kp = (const bf16_t*)(ws_ + WS_K) + 192 * h; Vp = (const bf16_t*)(ws_ + WS_V) + 128 * h; ldq = QLD; ldk = KLD; ldv = VLD; ycol = 512 + 128 * h; C = 0.07216878364870322f * LOG2E; }
  else { Qp = proj + C_QC + 128 * h; Kp = proj + C_KC + 128 * (h / 3); Vp = proj + C_VC + 128 * (h / 3); ldq = ldk = ldv = DINP; ycol = 1280 + 128 * h; C = 0.08838834764831845f * LOG2E; }
  const int q0 = qb * 256, qi = q0 + wid * 32 + r32;
  int T0, T1, tw0, tw1, wrow = 0, qcol = 0, c0 = 0; float slope2 = 0.f;
  if (MODE == 1) { T0 = tw0 = kvq * (S / 64 / KVSPLIT); T1 = tw1 = T0 + S / 64 / KVSPLIT; }
  else if (MODE == 0) { const int R = qb * 4; T0 = min(max(R - 4, 0), 120); T1 = min(max(R - 1, 0), 120) + 8; wrow = R + (wid >> 1); tw0 = min(max(wrow - 4, 0), 120); tw1 = tw0 + 8;
                        qcol = (wid & 1) * 32 + r32; c0 = min(max(qcol - 8, 0), 48); }
  else { T0 = max(0, (q0 - 128) >> 6); T1 = min(S / 64, ((q0 + 255 + 128) >> 6) + 1); const int qw = q0 + wid * 32; tw0 = max(0, (qw - 128) >> 6); tw1 = min(S / 64, ((qw + 31 + 128) >> 6) + 1);
         slope2 = exp2f(-8.0f * (float)(h + 1) / 6.0f) * LOG2E; }
  LAS float* wsl = (LAS float*)(ldl + OFF_WS) + wid * 64; LAS float* li_l = wsl; LAS float* al_l = wsl + 32;
  LAS float* rpbL = (LAS float*)(ldl + OFF_RPB);
  if (MODE == 0) { for (int i = tid; i < 465; i += NTHREADS) rpbL[i] = rpb[(l * 4 + h) * 465 + i] * LOG2E; }
  float m_reg = -1e29f, l_reg = 0.f;
  if (MODE == 2) { m_reg = sink[l * 6 + h] * LOG2E; l_reg = hi == 0 ? 1.f : 0.f; }
  f32x16 o[4] = {}; bf16x8 qr[ND];
  { const bf16_t* Qw = Qp + (size_t)qi * ldq + hi * 8;
#pragma unroll
    for (int d0 = 0; d0 < ND; ++d0) qr[d0] = *(const bf16x8*)(Qw + d0 * 16); }
  unsigned kg[NCH], vg[2];
#pragma unroll
  for (int i = 0; i < NCH; ++i) { const int X = (wid + 8 * i) * 1024 + lane * 16, row = X / (DQK * 2), cs = X % (DQK * 2), colB = cs ^ kswz_x<DQK>(row); kg[i] = (unsigned)(row * ldk + (colB >> 1)) * 2u; }
#pragma unroll
  for (int i = 0; i < 2; ++i) { const int X = (wid + 8 * i) * 1024 + lane * 16, st = X >> 9, w = X & 511, kk = ((st >> 2) << 3) | (w >> 6), c = ((st & 3) << 5) | ((w & 63) >> 1);
    const int k = kk;
    vg[i] = (unsigned)(k * ldv + c) * 2u; }
  const int vb0 = (int)(uintptr_t)lds_g + v_rd_base(lane);
  const int kbase0 = (int)(uintptr_t)lds_g + OFF_K;
  constexpr int NKO = DQK == 192 ? 4 : ND;
  int ko[NKO];
#pragma unroll
  for (int d0 = 0; d0 < NKO; ++d0) ko[d0] = kswz<DQK>(r32, (d0 * 16 + hi * 8) * 2);
#define ATT_KO(d0_) (DQK == 192 ? ko[(d0_) & 3] + ((d0_) >> 2) * 128 : ko[(d0_) % NKO])
  const int wslab = __builtin_amdgcn_readfirstlane(wid) * 1024;
#define ATT_DMA(t, b) do { const char* kt_ = (const char*)(Kp + (size_t)(t) * 64 * ldk); const char* vt_ = (const char*)(Vp + (size_t)(t) * 64 * ldv); \
    _Pragma("unroll") for (int i_ = 0; i_ < NCH; ++i_) __builtin_amdgcn_global_load_lds((const unsigned*)(kt_ + kg[i_]), (LAS unsigned*)(ldl + OFF_K + (b) * SHM_K + wslab + i_ * 8192), 16, 0, 0); \
    _Pragma("unroll") for (int i_ = 0; i_ < 2; ++i_) __builtin_amdgcn_global_load_lds((const unsigned*)(vt_ + vg[i_]), (LAS unsigned*)(ldl + (b) * SHM_V + wslab + i_ * 8192), 16, 0, 0); } while (0)
  __syncthreads();
  ATT_DMA(T0, 0); if (T0 + 1 < T1) { ATT_DMA(T0 + 1, 1); asm volatile("s_waitcnt vmcnt(%0)" :: "n"(NCH + 2) : "memory"); } else asm volatile("s_waitcnt vmcnt(0)" ::: "memory");
  ATT_BAR();
  int b = 0, bn = 2;
#pragma unroll 1
  for (int j = T0; j < T1; ++j) {
    const bool vis_ = (j >= tw0 && j < tw1);
    if (vis_) {
      f32x16 p0 = {}, p1 = {};
      ATT_SBAR();
      {
        const int kbase = kbase0 + b * SHM_K;
        bf16x8 fa[3], fb[3];
#define ATT_KRD(d0_) do { const int ad_ = kbase + ATT_KO(d0_); \
          asm volatile("ds_read_b128 %0, %1" : "=v"(fa[(d0_) % 3]) : "v"(ad_) : "memory"); \
          asm volatile("ds_read_b128 %0, %1 offset:%2" : "=v"(fb[(d0_) % 3]) : "v"(ad_), "i"(32 * DQK * 2) : "memory"); } while (0)
        ATT_KRD(0); ATT_KRD(1);
#pragma unroll
        for (int d0 = 0; d0 < ND; ++d0) {
          if (d0 + 2 < ND) { ATT_KRD(d0 + 2); asm volatile("s_waitcnt lgkmcnt(4)" ::: "memory"); }
          else if (d0 + 1 < ND) asm volatile("s_waitcnt lgkmcnt(2)" ::: "memory");
          else asm volatile("s_waitcnt lgkmcnt(0)" ::: "memory");
          ATT_SBAR();
          p0 = __builtin_amdgcn_mfma_f32_32x32x16_bf16(fa[d0 % 3], qr[d0], p0, 0, 0, 0);
          p1 = __builtin_amdgcn_mfma_f32_32x32x16_bf16(fb[d0 % 3], qr[d0], p1, 0, 0, 0);
          ATT_SBAR(); }
#undef ATT_KRD
      }
      ATT_SBAR();
      if (MODE == 0) {
        const int dr31 = (j - wrow + 7) * 31 + 15 - qcol;
#pragma unroll
        for (int r = 0; r < 16; ++r) { const int kc = crow(r, hi);
          { const bool v = (kc >= c0) && (kc < c0 + 16); const float bb = rpbL[v ? dr31 + kc : 0]; p0[r] = v ? fmaf(p0[r], C, bb) : NEGM; }
          { const int kc1 = kc + 32; const bool v = (kc1 >= c0) && (kc1 < c0 + 16); const float bb = rpbL[v ? dr31 + kc1 : 0]; p1[r] = v ? fmaf(p1[r], C, bb) : NEGM; } }
      } else if (MODE == 2) {
        const int kb = j * 64;
#pragma unroll
        for (int r = 0; r < 16; ++r) { const int k = kb + crow(r, hi);
          { const int d = abs(qi - k); p0[r] = d <= 128 ? fmaf(p0[r], C, -slope2 * (float)d) : NEGM; }
          { const int d = abs(qi - k - 32); p1[r] = d <= 128 ? fmaf(p1[r], C, -slope2 * (float)d) : NEGM; } }
      }
      float alpha; bf16x8 pa0, pa1, pa2, pa3;
      softmax_tile<MODE == 1>(p0, p1, C, m_reg, l_reg, alpha, pa0, pa1, pa2, pa3);
      if (__any(alpha < 1.f)) { if (hi == 0) al_l[r32] = alpha; asm volatile("s_waitcnt lgkmcnt(0)" ::: "memory");
#pragma unroll
        for (int r = 0; r < 16; ++r) { const float av = al_l[crow(r, hi)];
#pragma unroll
          for (int d = 0; d < 4; ++d) o[d][r] *= av; }
        asm volatile("s_waitcnt lgkmcnt(0)" ::: "memory"); }
      ATT_SBAR();
      pv_d0(o, vb0 + b * SHM_V, pa0, pa1, pa2, pa3);
    }
#if defined(PROBE_ATT_VALU)
    if (MODE == 1) { float dx_ = m_reg;
#pragma unroll
      for (int i_ = 0; i_ < 32; ++i_) asm volatile("v_exp_f32 %0, %0" : "+v"(dx_));
      asm volatile("" :: "v"(dx_)); }
#endif
#if defined(PROBE_ATT_LDS)
    if (MODE == 1) { bf16x8 t_; const int ad_ = (int)(uintptr_t)lds_g + OFF_K + b * SHM_K + kswz<DQK>(r32, hi * 16);
#pragma unroll
      for (int i_ = 0; i_ < 24; ++i_) asm volatile("ds_read_b128 %0, %1 offset:%2" : "=v"(t_) : "v"(ad_), "i"((i_ % 12) * 32) : "memory");
      asm volatile("s_waitcnt lgkmcnt(0)" ::: "memory"); asm volatile("" :: "v"(t_)); }
#endif
#if defined(PROBE_ATT_MFMA)
    if (MODE == 1) { f32x4 da_ = {0.f, 0.f, 0.f, 0.f};
#pragma unroll
      for (int i_ = 0; i_ < 80; ++i_) da_ = __builtin_amdgcn_mfma_f32_16x16x32_bf16(qr[0], qr[1], da_, 0, 0, 0);
      asm volatile("" :: "v"(da_)); }
#endif
    ATT_SBAR();
    if (j + 2 < T1) ATT_DMA(j + 2, bn);
    if (j + 2 < T1) asm volatile("s_waitcnt vmcnt(%0)" :: "n"(NCH + 2) : "memory"); else asm volatile("s_waitcnt vmcnt(0)" ::: "memory");
    ATT_BAR();
    b = b == 2 ? 0 : b + 1; bn = bn == 2 ? 0 : bn + 1;
  }
  { auto rr = __builtin_amdgcn_permlane32_swap(__float_as_uint(l_reg), __float_as_uint(l_reg), false, false); l_reg = __uint_as_float(rr[0]) + __uint_as_float(rr[1]); }
  if (hi == 0) li_l[r32] = l_reg; asm volatile("s_waitcnt lgkmcnt(0)" ::: "memory");
  bf16_t* Ow; int ldo;
  if (MODE == 1) { Ow = (bf16_t*)(ws_ + WS_PART) + ((size_t)kvq * S + q0 + wid * 32) * VLD + 128 * h + r32; ldo = VLD;
    if (hi == 0) { float* st = (float*)(ws_ + WS_STAT) + ((size_t)(kvq * 6 + h) * S + qi) * 2; st[0] = m_reg; st[1] = l_reg; } }
  else { Ow = (bf16_t*)(ws_ + WS_Y) + (size_t)(q0 + wid * 32) * DM + ycol + r32; ldo = DM; }
#pragma unroll
  for (int r = 0; r < 16; ++r) { const int orow = crow(r, hi); const float rl = __builtin_amdgcn_rcpf(li_l[orow]);
#pragma unroll
    for (int d0 = 0; d0 < 4; ++d0) Ow[(size_t)orow * ldo + d0 * 32] = (bf16_t)(cvtpk(o[d0][r] * rl, 0.f) & 0xffffu); }
  asm volatile("s_waitcnt lgkmcnt(0)" ::: "memory");
  __syncthreads();
#undef ATT_DMA
#undef ATT_KO
}
}

#ifndef NAIVE_ATTN
#define NAIVE_ATTN 0
#endif
#ifndef MK_MULTI
#define MK_MULTI 0
#endif
constexpr int N_PHASES = 2 + 10 * DEPTH;
__device__ __forceinline__ int opq(int v) { asm volatile("" : "+s"(v)); return v; }

__global__ void __launch_bounds__(NTHREADS) fwd_megakernel(Args a) {
    extern __shared__ __attribute__((aligned(16))) unsigned char lds[];
    cg::grid_group grid = cg::this_grid();
    const int lo = a.ph_lo, hi = a.ph_hi;
    const int G = gridDim.x;
    { LAS unsigned long long* tw = (LAS unsigned long long*)((LAS unsigned char*)lds + TAB_OFF);
#pragma unroll
      for (int i = 0; i < 19; ++i) if ((int)threadIdx.x == i) tw[i] = (unsigned long long)a.in[i];
      if (threadIdx.x == 19) tw[19] = (unsigned long long)a.out;
      if (threadIdx.x == 20) tw[20] = (unsigned long long)a.ws;
      if (threadIdx.x < 4) ((LAS unsigned*)((LAS unsigned char*)lds + TAB_OFF + 192))[threadIdx.x] = 0u;
      __syncthreads(); }
    (void)xcd_barrier_post((unsigned*)(a.ws + WS_BAR), (volatile LAS unsigned*)((LAS unsigned char*)lds + TAB_OFF + 192));
    if (a.ph_lo < 0) grid.sync();
    const Tab T{(const LAS unsigned*)((LAS unsigned char*)lds + TAB_OFF)};
#define ws (T.wsp())
#define mod ((float*)(ws + WS_MOD))
#define U ((bf16_t*)(ws + WS_U))
#define PROJ ((bf16_t*)(ws + WS_PROJ))
#define Qb ((bf16_t*)(ws + WS_Q))
#define Kb ((bf16_t*)(ws + WS_K))
#define Vb ((bf16_t*)(ws + WS_V))
#define Y ((bf16_t*)(ws + WS_Y))
#define Hb ((bf16_t*)(ws + WS_H))
#define X ((float*)(ws + WS_X))
#define rope ((float*)(ws + WS_ROPE))
#define rsq ((float*)(ws + WS_RSQ))
#define rskv ((float*)(ws + WS_RSKV))
    PG8_LAS unsigned char* ldsl = (PG8_LAS unsigned char*)lds;
#ifndef PHM
#define PHM 0xFFFFF
#endif
#ifndef ATM
#define ATM 7
#endif
#define EN(b) ((PHM >> (b)) & 1)
#ifndef PROBE_PH
#define PROBE_PH -1
#endif
#ifndef PROBE_N
#define PROBE_N 2
#endif
#define REPK(k) for (int rep_ = 0; rep_ < ((k) == PROBE_PH ? PROBE_N : 1); ++rep_)
#define IN(k) (lo <= (k) && (k) < hi)
#define GBAR() do { XcdBarrier b_; b_.bar = (unsigned*)(ws + WS_BAR); b_.x = xb_xcc_id(); b_.st = (volatile LAS unsigned*)((LAS unsigned char*)lds + TAB_OFF + 192); xcd_barrier(b_); } while (0)
#define SEAM(k) do { if (IN(k) && IN((k) + 1)) GBAR(); } while (0)

#ifdef PROBE_SYNCS
    for (int i_ = 0; i_ < PROBE_SYNCS; ++i_) GBAR();
#endif
    if (EN(0) && IN(0)) REPK(0) { phase_mod(T, lds); }
    SEAM(0);
    if (EN(1) && IN(1)) REPK(1) {
        const int fb_ = opq((int)blockIdx.x), fs_ = opq(G); const bool hide_ = (fs_ == 256);
        for (int l = 0; l < DEPTH; ++l) {
            transpose_job<3>(T.in(4) + (size_t)l * DM * DIN, (bf16_t*)(ws + WS_W + (size_t)l * SZ_WL + O_WIN), DM, DIN, DINP, nullptr, lds, fb_, fs_);
            const int fh_ = (hide_ && l == 1) ? (1 << 30) : fb_, fh0_ = hide_ ? (1 << 30) : fb_;
            transpose_job<1>(T.in(8) + (size_t)l * 512 * 1152, (bf16_t*)(ws + WS_W + (size_t)l * SZ_WL + O_WUQ), 512, 1152, 1280, T.in(6) + l * 512, lds, fh0_, fs_);
            transpose_job<0>(T.in(9) + (size_t)l * 256 * 1536, (bf16_t*)(ws + WS_W + (size_t)l * SZ_WL + O_WUKV), 256, 1536, 1536, T.in(7) + l * 256, lds, fh0_, fs_);
            if (!hide_) transpose_job<0>(T.in(12) + (size_t)l * DM * DM, (bf16_t*)(ws + WS_W + (size_t)l * SZ_WL + O_WO), DM, DM, DM, T.in(11) + l * DM, lds, fb_, fs_);
            if (!(hide_ && l == 1)) transpose_job<2>(T.in(15) + (size_t)l * DM * 2 * DFF, (bf16_t*)(ws + WS_W + (size_t)l * SZ_WL + O_WGU), DM, 2 * DFF, 2 * DFF, nullptr, lds, fb_, fs_);
            transpose_job<0>(T.in(16) + (size_t)l * DFF * DM, (bf16_t*)(ws + WS_W + (size_t)l * SZ_WL + O_WDN), DFF, DM, DM, nullptr, lds, fh_, fs_);
        }
        modulate_rows(T.in(0), mod + 1 * DM, mod + 0 * DM, U);
        rope_table(rope);
    }
    SEAM(1);
#pragma unroll 1
    for (int l = 0; l < DEPTH; ++l) {
        const int pb = 2 + 10 * l;
        if (EN(2) && IN(pb + 0)) REPK(2) {
            pg8::Gemm g{U, (const bf16_t*)(ws + WS_W + (size_t)l * SZ_WL + O_WIN), S, DINP, DM, DM}; pg8::StaticOrder So; So.init(S, DINP, opq(G), opq((int)blockIdx.x));
            pg8::EpiProj E{PROJ, DINP, (float*)(ws + WS_SSQ), rope, Kb, KLD};
            pg8::gemm_phase<pg8::EpiProj, pg8::StaticOrder, true, true>(ldsl, g, So, E);
            if (opq(G) == 256 && opq((int)blockIdx.x) >= 224) {
                const int sb_ = opq((int)blockIdx.x) - 224; const size_t lo_ = (size_t)l;
                transpose_job<1>(T.in(8) + lo_ * 512 * 1152, (bf16_t*)(ws + WS_W + lo_ * SZ_WL + O_WUQ), 512, 1152, 1280, T.in(6) + lo_ * 512, lds, sb_, 32);
                transpose_job<0>(T.in(9) + lo_ * 256 * 1536, (bf16_t*)(ws + WS_W + lo_ * SZ_WL + O_WUKV), 256, 1536, 1536, T.in(7) + lo_ * 256, lds, (sb_ + 8) & 31, 32);
                transpose_job<0>(T.in(12) + lo_ * DM * DM, (bf16_t*)(ws + WS_W + lo_ * SZ_WL + O_WO), DM, DM, DM, T.in(11) + lo_ * DM, lds, sb_, 32); }
        }
        SEAM(pb + 0);
        if (EN(4) && IN(pb + 2)) REPK(4) {
            { const int bq = opq((int)blockIdx.x), Gq = opq(G);
#pragma unroll 1
              for (int it = 0; ; ++it) {
                int q0 = -1, kv0 = -1, kv1 = -1, na = -1, sw0 = -1, sw1 = -1;
                if (Gq == 256) { if (it == 0) {
                    if (bq < 96) { na = bq; q0 = bq; }
                    else if (bq < 128) { na = bq; kv0 = 2 * (bq - 96); kv1 = kv0 + 1; }
                    else if (bq < 192) { sw0 = bq - 128; q0 = 96 + (bq - 128); kv0 = 64 + 2 * (bq - 128); kv1 = kv0 + 1; }
                    else { sw0 = 64 + (bq - 192); sw1 = 128 + (bq - 192); } } }
                else { const int L = bq + it * Gq; if (L < 160) q0 = L; if (L < 192) { kv0 = L; sw0 = L; } if (L < 128) na = L; }
                if ((q0 & kv0 & na & sw0) < 0 && q0 < 0 && kv0 < 0 && na < 0 && sw0 < 0) break;
                if (q0 >= 0) { pg8::Gemm g{PROJ + C_CQ, (const bf16_t*)(ws + WS_W + (size_t)l * SZ_WL + O_WUQ), S, 1280, 512, DINP}; pg8::ListOrder So{5, 1, q0, 0};
                  pg8::EpiQ E{Qb, QLD, (const float*)(ws + WS_SSQ), rope};
                  pg8::gemm_phase<pg8::EpiQ, pg8::ListOrder, true, true>(ldsl, g, So, E); }
                if (kv0 >= 0) { pg8::Gemm g{PROJ + C_CKV, (const bf16_t*)(ws + WS_W + (size_t)l * SZ_WL + O_WUKV), S, 1536, 256, DINP}; pg8::ListOrder So{6, kv1 >= 0 ? 2 : 1, kv0, kv1};
                  pg8::EpiKV E{Kb, KLD, Vb, VLD, (const float*)(ws + WS_SSQ)};
                  pg8::gemm_phase<pg8::EpiKV, pg8::ListOrder, true, true>(ldsl, g, So, E); }
                if (na >= 0) { if (ATM & 2) att::attn_unit<0>(ws, T.in(5), T.in(10), l, na >> 5, na & 31, 0, lds); }
#pragma unroll 1
                for (int i2 = 0; i2 < 2; ++i2) { const int u = i2 ? sw1 : sw0; if (u >= 0) { if (ATM & 4) att::attn_unit<2>(ws, T.in(5), T.in(10), l, u >> 5, u & 31, 0, lds); } }
              } }
        }
        SEAM(pb + 2);
        if (EN(5) && IN(pb + 3)) REPK(5) {
#if NAIVE_ATTN
            naive_attn<0>(ws, T.in(5), T.in(10), l); naive_attn<2>(ws, T.in(5), T.in(10), l); naive_attn<1>(ws, T.in(5), T.in(10), l);
#else
            const int Gq = opq(G);
            for (int su = opq((int)blockIdx.x); su < 192 * att::KVSPLIT; su += Gq) {
                int combo, qb; if (Gq == 256) { combo = (su & 7) + 8 * (su >> 8); qb = (su & 255) >> 3; } else { combo = su >> 5; qb = su & 31; }
                unsigned char* wsp_ = ws;
                if (ATM & 1) att::attn_unit<1>(wsp_, nullptr, nullptr, l, combo >> 2, qb, combo & 3, lds);
            }
#endif
        }
        SEAM(pb + 3);
        if (EN(6) && IN(pb + 4)) phase_ynorm(ws);
        SEAM(pb + 4);
        if (EN(7) && IN(pb + 5)) {
            pg8::Gemm g{Y, (const bf16_t*)(ws + WS_W + (size_t)l * SZ_WL + O_WO), S, DM, DM, DM}; pg8::StaticOrder So; So.init(S, DM, opq(G), opq((int)blockIdx.x));
            pg8::EpiRes E{l == 0 ? T.in(0) : (const float*)X, X, mod + (size_t)l * 6 * DM + 2 * DM, ALPHA, DM};
            pg8::gemm_phase<pg8::EpiRes, pg8::StaticOrder, true, true>(ldsl, g, So, E);
        }
        SEAM(pb + 5);
#ifdef PROBE_LN
        if (EN(8) && IN(pb + 6)) phase_ln(X, (float*)(ws + WS_H), T.in(13) + l * DM, T.in(14) + l * DM, mod + (size_t)l * 6 * DM + 4 * DM, mod + (size_t)l * 6 * DM + 3 * DM, (bf16_t*)(ws + WS_PART));
#endif
        if (EN(8) && IN(pb + 6)) phase_ln(X, X, T.in(13) + l * DM, T.in(14) + l * DM, mod + (size_t)l * 6 * DM + 4 * DM, mod + (size_t)l * 6 * DM + 3 * DM, U);
        SEAM(pb + 6);
        if (EN(9) && IN(pb + 7)) REPK(9) {
            pg8::Gemm g{U, (const bf16_t*)(ws + WS_W + (size_t)l * SZ_WL + O_WGU), S, 2 * DFF, DM, DM}; pg8::StaticOrder So; So.init(S, 2 * DFF, opq(G), opq((int)blockIdx.x));
            pg8::EpiSwiglu E{Hb, DFF};
            pg8::gemm_phase<pg8::EpiSwiglu, pg8::StaticOrder, true, true>(ldsl, g, So, E);
            if (l == 0 && opq(G) == 256 && opq((int)blockIdx.x) >= 128)
                transpose_job<2>(T.in(15) + (size_t)DM * 2 * DFF, (bf16_t*)(ws + WS_W + SZ_WL + O_WGU), DM, 2 * DFF, 2 * DFF, nullptr, lds, opq((int)blockIdx.x) - 128, 128);
            if (l == 1 && opq(G) == 256 && opq((int)blockIdx.x) >= 128)
                transpose_job<0>(T.in(16) + (size_t)DFF * DM, (bf16_t*)(ws + WS_W + SZ_WL + O_WDN), DFF, DM, DM, nullptr, lds, opq((int)blockIdx.x) - 128, 128);
        }
        SEAM(pb + 7);
        if (EN(10) && IN(pb + 8)) {
            pg8::Gemm g{Hb, (const bf16_t*)(ws + WS_W + (size_t)l * SZ_WL + O_WDN), S, DM, DFF, DFF}; pg8::StaticOrder So; So.init(S, DM, opq(G), opq((int)blockIdx.x));
            pg8::EpiRes E{X, X, mod + (size_t)l * 6 * DM + 5 * DM, ALPHA, DM};
            pg8::gemm_phase<pg8::EpiRes, pg8::StaticOrder, true, true>(ldsl, g, So, E);
        }
        SEAM(pb + 8);
        if (EN(11) && IN(pb + 9)) {
            const bool last = (l == DEPTH - 1);
            const float* modn = mod + (size_t)(last ? l : l + 1) * 6 * DM;
            phase_ln(X, last ? T.out() : X, T.in(17) + l * DM, T.in(18) + l * DM, last ? nullptr : modn + 1 * DM, last ? nullptr : modn + 0 * DM, last ? nullptr : U);
        }
        SEAM(pb + 9);
    }
#undef IN
#undef SEAM
#undef ws
#undef mod
#undef U
#undef PROJ
#undef Qb
#undef Kb
#undef Vb
#undef Y
#undef Hb
#undef X
#undef rope
#undef rsq
#undef rskv
}

extern "C" void kernel_launch(void* const* d_in, const int* in_sizes, int n_in, void* d_out, int out_size, void* d_ws, size_t ws_size, hipStream_t stream) {
    static int grid = 0;
    if (grid == 0) {
        if (n_in != 19 || out_size != S * DM || ws_size < WS_END) { fprintf(stderr, "kernel_launch: unexpected shapes (n_in %d out %d ws %zu need %zu)\n", n_in, out_size, ws_size, (size_t)WS_END); grid = -1; return; }
        int dev = 0, cus = 0, per_cu = 0;
        hipGetDevice(&dev); hipDeviceGetAttribute(&cus, hipDeviceAttributeMultiprocessorCount, dev);
        if (hipFuncSetAttribute((const void*)fwd_megakernel, hipFuncAttributeMaxDynamicSharedMemorySize, LDS_BYTES) != hipSuccess) { fprintf(stderr, "kernel_launch: hipFuncSetAttribute failed\n"); grid = -1; return; }
        if (hipOccupancyMaxActiveBlocksPerMultiprocessor(&per_cu, (const void*)fwd_megakernel, NTHREADS, LDS_BYTES) != hipSuccess || per_cu < 1) { fprintf(stderr, "kernel_launch: occupancy query gave %d\n", per_cu); per_cu = 1; }
        (void)hipGetLastError();
        grid = cus;
    }
    if (grid < 0) return;
    if (hipMemsetAsync((char*)d_ws + WS_BAR, 0, 16384, stream) != hipSuccess) { fprintf(stderr, "kernel_launch: memset of the barrier words failed\n"); return; }
    Args a{};
    for (int i = 0; i < 19; ++i) a.in[i] = (const float*)d_in[i];
    a.out = (float*)d_out; a.ws = (unsigned char*)d_ws;
#if MK_MULTI
    for (int p = 0; p < N_PHASES; ++p) { a.ph_lo = p; a.ph_hi = p + 1; hipLaunchKernelGGL(fwd_megakernel, dim3(grid), dim3(NTHREADS), LDS_BYTES, stream, a); }
#else
    a.ph_lo = 0; a.ph_hi = N_PHASES;
    void* args[] = {&a};
    hipError_t e = hipLaunchCooperativeKernel((const void*)fwd_megakernel, dim3(grid), dim3(NTHREADS), args, LDS_BYTES, stream);
    if (e != hipSuccess) fprintf(stderr, "kernel_launch: cooperative launch failed: %s (grid %d)\n", hipGetErrorString(e), grid);
#endif
}
```

```cpp
#include <hip/hip_runtime.h>
#include <hip/hip_cooperative_groups.h>
#include <cstdio>
#include <cstdint>
namespace cg = cooperative_groups;
namespace pg8 {
#define PG8_LAS __attribute__((address_space(3)))
typedef unsigned short bf16_t;
typedef short bf16x8 __attribute__((ext_vector_type(8)));
typedef float f32x4 __attribute__((ext_vector_type(4)));
typedef unsigned u32x4 __attribute__((ext_vector_type(4)));
constexpr int BM = 256, BK = 64, HALF = 128, HTB = HALF * BK * 2  , STAGE_BYTES = 8 * HTB, NXCD = 8, WGM = 8;

__host__ __device__ __forceinline__ int lds_byte(int r, int c) { const int st = (r >> 4) * 2 + (c >> 5), rr = r & 15, cc = c & 31, ob = rr * 64 + cc * 2; return st * 1024 + (ob ^ (((ob >> 9) & 1) << 5)); }
__host__ __device__ __forceinline__ void stage_rc(int b, int& R, int& C) { const int st = b / 1024, sb = b % 1024, swz = sb ^ (((sb >> 9) & 1) << 5); R = (st >> 1) * 16 + swz / 64; C = (st & 1) * 32 + (swz % 64) / 2; }
__host__ __device__ __forceinline__ int perm32(int rho) { const int n = rho >> 4, i = rho & 15; return 8 * (i >> 2) + 4 * n + (i & 3); }

struct Unit { int pm, pn; };
struct Gemm { const bf16_t* A; const bf16_t* Bt; int M, N, K, lda; };

struct StaticOrder {
    int nM, nN, nwg, G, c;
    __host__ __device__ void init(int M, int N, int G_, int c_) { nM = M / BM; nN = N / BM; nwg = nM * nN; G = G_; c = c_; }
    __host__ __device__ bool next(int i, Unit& u) const {
        const long L = (long)i * G + c; if (L >= nwg) return false;
        int wgid = (int)L; { const int q = nwg / NXCD, r = nwg % NXCD, xcd = wgid % NXCD, off = wgid / NXCD; wgid = (xcd < r ? xcd * (q + 1) : r * (q + 1) + (xcd - r) * q) + off; }
        const int nig = WGM * nN, gid = wgid / nig, fm = gid * WGM, gsz = (nM - fm) < WGM ? (nM - fm) : WGM;
        u.pm = fm + ((wgid % nig) % gsz); u.pn = (wgid % nig) / gsz; return true;
    }
    __device__ __forceinline__ void a_ready(const Unit&) const {}
    __device__ __forceinline__ void done(const Unit&) const {}
};

struct ListOrder {
    int nN, n, L0, L1;
    __host__ __device__ bool next(int i, Unit& u) const { if (i >= n) return false; const int L = i == 0 ? L0 : L1; u.pm = L / nN; u.pn = L % nN; return true; }
    __device__ __forceinline__ void a_ready(const Unit&) const {}
    __device__ __forceinline__ void done(const Unit&) const {}
};
__device__ __forceinline__ unsigned cvt_pk_bf16(float lo, float hi) { unsigned r; asm volatile("v_cvt_pk_bf16_f32 %0, %1, %2" : "=v"(r) : "v"(lo), "v"(hi)); return r; }
typedef float f32x2 __attribute__((ext_vector_type(2)));
__device__ __forceinline__ u32x4 pack8(const f32x4 v0, const f32x4 v1) { u32x4 w; w.x = cvt_pk_bf16(v0[0], v0[1]); w.y = cvt_pk_bf16(v0[2], v0[3]); w.z = cvt_pk_bf16(v1[0], v1[1]); w.w = cvt_pk_bf16(v1[2], v1[3]); return w; }
struct EpiStore {
    static constexpr bool PERM = true, AFTER_DRAIN = false;
    bf16_t* O; int ldc;
    __device__ __forceinline__ void operator()(const f32x4 (&acc)[2][2][4][2], const Unit& u, int wr, int wc, int fr, int fq) const {
        const int row0 = u.pm * BM + wr * 64 + fr, col0 = u.pn * BM + wc * 32 + 8 * fq;
#pragma unroll
        for (int ai = 0; ai < 2; ++ai)
#pragma unroll
            for (int m = 0; m < 4; ++m) { bf16_t* rowp = O + (size_t)(row0 + ai * HALF + m * 16) * ldc + col0;
#pragma unroll
                for (int bj = 0; bj < 2; ++bj) *(u32x4*)(rowp + bj * HALF) = pack8(acc[ai][bj][m][0], acc[ai][bj][m][1]); }
    }
};
struct EpiProj {
    static constexpr bool PERM = true, AFTER_DRAIN = false;
    bf16_t* O; int ldc; float* ssq; const float* rope; bf16_t* Kb; int ldk;
    __device__ __forceinline__ void operator()(const f32x4 (&acc)[2][2][4][2], const Unit& u, int wr, int wc, int fr, int fq) const {
        const int row0 = u.pm * BM + wr * 64 + fr, col0 = u.pn * BM + wc * 32 + 8 * fq;
#pragma unroll
        for (int ai = 0; ai < 2; ++ai)
#pragma unroll
            for (int m = 0; m < 4; ++m) { const int row = row0 + ai * HALF + m * 16; bf16_t* rowp = O + (size_t)row * ldc + col0; float sq = 0.f;
#pragma unroll
                for (int bj = 0; bj < 2; ++bj) { const u32x4 w = pack8(acc[ai][bj][m][0], acc[ai][bj][m][1]); *(u32x4*)(rowp + bj * HALF) = w;
#pragma unroll
                    for (int e = 0; e < 4; ++e) { const float lo = __uint_as_float(w[e] << 16), hi = __uint_as_float(w[e] & 0xffff0000u); sq += lo * lo + hi * hi; } }
                if (u.pn >= 6 && u.pn <= 8) { sq += __shfl_xor(sq, 16); sq += __shfl_xor(sq, 32); if (fq == 0) ssq[((size_t)row * 3 + (u.pn - 6)) * 4 + wc] = sq; }
                if (u.pn == 9 && wc < 2) { const int ib = wc * 16 + 4 * fq; const f32x4 v0 = acc[ai][0][m][0], v1 = acc[ai][0][m][1];
                    const f32x4 c = *(const f32x4*)(rope + (size_t)row * 64 + ib), sn = *(const f32x4*)(rope + (size_t)row * 64 + 32 + ib);
                    f32x4 a, b;
                    a[0] = v0[0] * c[0] - v0[1] * sn[0]; a[1] = v0[1] * c[0] + v0[0] * sn[0];
                    a[2] = v0[2] * c[1] - v0[3] * sn[1]; a[3] = v0[3] * c[1] + v0[2] * sn[1];
                    b[0] = v1[0] * c[2] - v1[1] * sn[2]; b[1] = v1[1] * c[2] + v1[0] * sn[2];
                    b[2] = v1[2] * c[3] - v1[3] * sn[3]; b[3] = v1[3] * c[3] + v1[2] * sn[3];
                    const u32x4 w = pack8(a, b);
#pragma unroll
                    for (int h = 0; h < 6; ++h) *(u32x4*)(Kb + (size_t)row * ldk + 192 * h + 128 + wc * 32 + 8 * fq) = w; }
                if (m & 1) asm volatile("" ::: "memory"); }
    }
};
struct EpiQ {
    static constexpr bool PERM = true, AFTER_DRAIN = false;
    bf16_t* O; int ldc; const float* ssq; const float* rope;
    __device__ __forceinline__ void operator()(const f32x4 (&acc)[2][2][4][2], const Unit& u, int wr, int wc, int fr, int fq) const {
        const int row0 = u.pm * BM + wr * 64 + fr;
        float sc[2][4];
        { f32x4 q0[2][4], q1[2][4];
#pragma unroll
          for (int ai = 0; ai < 2; ++ai)
#pragma unroll
            for (int m = 0; m < 4; ++m) { const float* p = ssq + (size_t)(row0 + ai * HALF + m * 16) * 12; q0[ai][m] = *(const f32x4*)p; q1[ai][m] = *(const f32x4*)(p + 4); }
#pragma unroll
          for (int ai = 0; ai < 2; ++ai)
#pragma unroll
            for (int m = 0; m < 4; ++m) { const f32x4 a = q0[ai][m], b = q1[ai][m];
                sc[ai][m] = 1.0f / sqrtf((((a[0] + a[1]) + (a[2] + a[3])) + ((b[0] + b[1]) + (b[2] + b[3]))) * (1.0f / 512.0f) + 1e-6f); } }
#pragma unroll
        for (int ai = 0; ai < 2; ++ai)
#pragma unroll
            for (int m = 0; m < 4; ++m) { const int row = row0 + ai * HALF + m * 16; const float s = sc[ai][m];
#pragma unroll
                for (int bj = 0; bj < 2; ++bj) {
                    const int cb = u.pn * BM + bj * HALF + wc * 32, hc = cb % 192;
                    f32x4 v0 = acc[ai][bj][m][0] * s, v1 = acc[ai][bj][m][1] * s;
                    if (hc >= 128) {
                        const int ib = (hc - 128) / 2 + 4 * fq;
                        const f32x4 c = *(const f32x4*)(rope + (size_t)row * 64 + ib), sn = *(const f32x4*)(rope + (size_t)row * 64 + 32 + ib);
                        f32x4 a, b;
                        a[0] = v0[0] * c[0] - v0[1] * sn[0]; a[1] = v0[1] * c[0] + v0[0] * sn[0];
                        a[2] = v0[2] * c[1] - v0[3] * sn[1]; a[3] = v0[3] * c[1] + v0[2] * sn[1];
                        b[0] = v1[0] * c[2] - v1[1] * sn[2]; b[1] = v1[1] * c[2] + v1[0] * sn[2];
                        b[2] = v1[2] * c[3] - v1[3] * sn[3]; b[3] = v1[3] * c[3] + v1[2] * sn[3];
                        v0 = a; v1 = b;
                    }
                    *(u32x4*)(O + (size_t)row * ldc + cb + 8 * fq) = pack8(v0, v1);
                }
                if (m == 3) asm volatile("" ::: "memory"); }
    }
};
struct EpiKV {
    static constexpr bool PERM = true, AFTER_DRAIN = false;
    bf16_t* Kb; int ldk; bf16_t* Vb; int ldv; const float* ssq;
    __device__ __forceinline__ void operator()(const f32x4 (&acc)[2][2][4][2], const Unit& u, int wr, int wc, int fr, int fq) const {
        const int row0 = u.pm * BM + wr * 64 + fr, cin = wc * 32 + 8 * fq;
        f32x4 q2[2][4];
#pragma unroll
        for (int ai = 0; ai < 2; ++ai)
#pragma unroll
            for (int m = 0; m < 4; ++m) q2[ai][m] = *(const f32x4*)(ssq + (size_t)(row0 + ai * HALF + m * 16) * 12 + 8);
#pragma unroll
        for (int ai = 0; ai < 2; ++ai)
#pragma unroll
            for (int m = 0; m < 4; ++m) { const int row = row0 + ai * HALF + m * 16; const f32x4 a = q2[ai][m];
                const float s = 1.0f / sqrtf(((a[0] + a[1]) + (a[2] + a[3])) * (1.0f / 256.0f) + 1e-6f);
                *(u32x4*)(Kb + (size_t)row * ldk + 192 * u.pn + cin) = pack8(acc[ai][0][m][0] * s, acc[ai][0][m][1] * s);
                *(u32x4*)(Vb + (size_t)row * ldv + 128 * u.pn + cin) = pack8(acc[ai][1][m][0] * s, acc[ai][1][m][1] * s); }
    }
};
struct EpiRes {
    static constexpr bool PERM = false, AFTER_DRAIN = false;
    const float* xres; float* z; const float* gate; float alpha; int ldc;
    __device__ __forceinline__ void operator()(const f32x4 (&acc)[2][2][4][2], const Unit& u, int wr, int wc, int fr, int fq) const {
        const int row0 = u.pm * BM + wr * 64 + fr, col0 = u.pn * BM + wc * 32 + 4 * fq;
        f32x4 gv[2][2];
#pragma unroll
        for (int bj = 0; bj < 2; ++bj)
#pragma unroll
            for (int n = 0; n < 2; ++n) gv[bj][n] = *(const f32x4*)(gate + col0 + bj * HALF + n * 16) + 1.0f;
#pragma unroll
        for (int ai = 0; ai < 2; ++ai)
#pragma unroll
            for (int m = 0; m < 4; ++m) { const size_t off = (size_t)(row0 + ai * HALF + m * 16) * ldc + col0;
#pragma unroll
                for (int bj = 0; bj < 2; ++bj)
#pragma unroll
                    for (int n = 0; n < 2; ++n) { const f32x4 xr = *(const f32x4*)(xres + off + bj * HALF + n * 16);
                        *(f32x4*)(z + off + bj * HALF + n * 16) = xr * alpha + gv[bj][n] * acc[ai][bj][m][n]; }
                if (m == 3) asm volatile("" ::: "memory"); }
    }
};
struct EpiSwiglu {
    static constexpr bool PERM = true, AFTER_DRAIN = false;
    bf16_t* H; int ldc;
    __device__ __forceinline__ void operator()(const f32x4 (&acc)[2][2][4][2], const Unit& u, int wr, int wc, int fr, int fq) const {
        const int row0 = u.pm * BM + wr * 64 + fr, col0 = u.pn * HALF + wc * 32 + 8 * fq;
#pragma unroll
        for (int ai = 0; ai < 2; ++ai)
#pragma unroll
            for (int m = 0; m < 4; ++m) { f32x4 h[2];
#pragma unroll
                for (int n = 0; n < 2; ++n) { const f32x4 g = acc[ai][0][m][n], up = acc[ai][1][m][n];
#pragma unroll
                    for (int j = 0; j < 4; ++j) h[n][j] = g[j] * __builtin_amdgcn_rcpf(1.0f + __builtin_amdgcn_exp2f(-1.4426950408889634f * g[j])) * up[j]; }
                *(u32x4*)(H + (size_t)(row0 + ai * HALF + m * 16) * ldc + col0) = pack8(h[0], h[1]); }
    }
};
template <class Epi, class Sched, bool ALIGN_EPI = false, bool SP2 = false>
__device__ __forceinline__ void gemm_phase(PG8_LAS unsigned char* lds, const Gemm g, const Sched& S, const Epi& E) {
    int tid_ = threadIdx.x; asm volatile("" : "+v"(tid_)); const int tid = tid_, wid = __builtin_amdgcn_readfirstlane(tid >> 6), lane = tid & 63, wr = wid >> 2, wc = wid & 3, fr = lane & 15, fq = lane >> 4;
    int Kv_ = g.K, lda_ = g.lda; asm volatile("" : "+s"(Kv_), "+s"(lda_)); const int K = Kv_, nt = K / BK;
    unsigned voffA[2], voffB[2];
#pragma unroll
    for (int i = 0; i < 2; ++i) { int R, C; stage_rc(tid * 16 + i * 8192, R, C); const int Rb = Epi::PERM ? ((R & ~31) + perm32(R & 31)) : R;
        voffA[i] = (unsigned)(R * lda_ + C) * 2u; voffB[i] = (unsigned)(Rb * K + C) * 2u; }
    const size_t kstep = (size_t)(BK * 2);
    const size_t hstepA = (size_t)HALF * lda_ * 2, hstepB = (size_t)HALF * K * 2;
    const size_t tstepA = 2 * hstepA, tstepB = 2 * hstepB;
    const unsigned ldsw = (unsigned)wid * 1024u;
    const int aoff = lds_byte(wr * 64 + fr, fq * 8), boff = lds_byte(wc * 32 + fr, fq * 8);
#define PG8_SA(b, h) (((b) * 2 + (h)) * HTB)
#define PG8_SB(b, h) ((4 + (b) * 2 + (h)) * HTB)
#define PG8_STAGE(bufoff, gbase, voff) do { _Pragma("unroll") for (int _i = 0; _i < 2; ++_i) \
        __builtin_amdgcn_global_load_lds((const unsigned*)((const char*)(gbase) + (voff)[_i]), (PG8_LAS unsigned*)(lds + (bufoff) + ldsw + _i * 8192), 16, 0, 0); } while (0)
#define PG8_LDA(dst, b, h) do { _Pragma("unroll") for (int m = 0; m < 4; ++m) _Pragma("unroll") for (int k = 0; k < 2; ++k) dst[m][k] = *(const PG8_LAS bf16x8*)(lds + PG8_SA(b, h) + aoff + m * 2048 + k * 1024); } while (0)
#define PG8_LDB(dst, b, h) do { _Pragma("unroll") for (int n = 0; n < 2; ++n) _Pragma("unroll") for (int k = 0; k < 2; ++k) dst[n][k] = *(const PG8_LAS bf16x8*)(lds + PG8_SB(b, h) + boff + n * 2048 + k * 1024); } while (0)
#define PG8_MMA(ai, bj, At, Bt) do { __builtin_amdgcn_s_setprio(1); _Pragma("unroll") for (int m = 0; m < 4; ++m) _Pragma("unroll") for (int n = 0; n < 2; ++n) _Pragma("unroll") for (int k = 0; k < 2; ++k) \
        acc[ai][bj][m][n] = __builtin_amdgcn_mfma_f32_16x16x32_bf16(Bt[n][k], At[m][k], acc[ai][bj][m][n], 0, 0, 0); __builtin_amdgcn_s_setprio(0); } while (0)
#define PG8_WAIT_V(n) asm volatile("s_waitcnt vmcnt(" #n ")" ::: "memory")
#define PG8_WAIT_L(n) asm volatile("s_waitcnt lgkmcnt(" #n ")" ::: "memory")
#define PG8_BAR __builtin_amdgcn_s_barrier()
#define PG8_SCHED __builtin_amdgcn_sched_barrier(0)
    Unit cur, nxt; int ui = 0;
    if (!S.next(0, cur)) return;
    f32x4 acc[2][2][4][2];
#pragma unroll
    for (int a = 0; a < 2; ++a)
#pragma unroll
        for (int b = 0; b < 2; ++b)
#pragma unroll
            for (int m = 0; m < 4; ++m)
#pragma unroll
                for (int n = 0; n < 2; ++n) acc[a][b][m][n] = (f32x4){0.f, 0.f, 0.f, 0.f};
    bf16x8 At[4][2], B0[2][2], B1[2][2];
    const char* cA = (const char*)g.A + (size_t)cur.pm * tstepA; const char* cB = (const char*)g.Bt + (size_t)cur.pn * tstepB;
    S.a_ready(cur);
    if constexpr (SP2) {
        PG8_STAGE(PG8_SB(0, 0), cB, voffB); PG8_STAGE(PG8_SB(0, 1), cB + hstepB, voffB); PG8_STAGE(PG8_SA(0, 0), cA, voffA); PG8_STAGE(PG8_SA(0, 1), cA + hstepA, voffA);
        if (wr == 1) PG8_BAR;
        PG8_WAIT_V(2); PG8_BAR;
        PG8_STAGE(PG8_SB(1, 0), cB + kstep, voffB); PG8_STAGE(PG8_SA(1, 0), cA + kstep, voffA); PG8_STAGE(PG8_SB(1, 1), cB + hstepB + kstep, voffB);
        PG8_WAIT_V(6); PG8_BAR;
    } else {
        PG8_STAGE(PG8_SB(0, 0), cB, voffB); PG8_STAGE(PG8_SA(0, 0), cA, voffA); PG8_STAGE(PG8_SB(0, 1), cB + hstepB, voffB); PG8_STAGE(PG8_SA(0, 1), cA + hstepA, voffA);
        if (wr == 1) PG8_BAR;
        PG8_WAIT_V(4); PG8_BAR;
        PG8_STAGE(PG8_SB(1, 0), cB + kstep, voffB); PG8_STAGE(PG8_SA(1, 0), cA + kstep, voffA); PG8_STAGE(PG8_SB(1, 1), cB + hstepB + kstep, voffB);
        PG8_WAIT_V(6); PG8_BAR;
    }
    for (;;) {
        const bool has_next = S.next(ui + 1, nxt);
        const char* nA = has_next ? (const char*)g.A + (size_t)nxt.pm * tstepA : cA; const char* nB = has_next ? (const char*)g.Bt + (size_t)nxt.pn * tstepB : cB;
        for (int t = 0; t < nt; t += 2) {
            const bool last = (t == nt - 2);
            const char* a1 = cA + (size_t)(t + 1) * kstep;
            const char* a2 = last ? nA : cA + (size_t)(t + 2) * kstep; const char* b2 = last ? nB : cB + (size_t)(t + 2) * kstep;
            const char* a3 = a2 + kstep; const char* b3 = b2 + kstep;
            if (last && has_next) S.a_ready(nxt);
            if constexpr (SP2) {
            PG8_LDB(B0, 0, 0); PG8_LDB(B1, 0, 1); PG8_SCHED; PG8_LDA(At, 0, 0); PG8_STAGE(PG8_SA(1, 1), a1 + hstepA, voffA);
            PG8_WAIT_V(8); PG8_WAIT_L(0); PG8_BAR; PG8_MMA(0, 0, At, B0); PG8_MMA(0, 1, At, B1); PG8_BAR; PG8_SCHED;
            PG8_LDA(At, 0, 1); PG8_STAGE(PG8_SB(0, 0), b2, voffB); PG8_STAGE(PG8_SB(0, 1), b2 + hstepB, voffB); PG8_STAGE(PG8_SA(0, 0), a2, voffA);
            PG8_WAIT_V(8); PG8_WAIT_L(0); PG8_BAR; PG8_MMA(1, 0, At, B0); PG8_MMA(1, 1, At, B1); PG8_BAR; PG8_SCHED;
            PG8_LDB(B0, 1, 0); PG8_LDB(B1, 1, 1); PG8_SCHED; PG8_LDA(At, 1, 0); PG8_STAGE(PG8_SA(0, 1), a2 + hstepA, voffA);
            PG8_WAIT_V(8); PG8_WAIT_L(0); PG8_BAR; PG8_MMA(0, 0, At, B0); PG8_MMA(0, 1, At, B1); PG8_BAR; PG8_SCHED;
            PG8_LDA(At, 1, 1); PG8_STAGE(PG8_SB(1, 0), b3, voffB); PG8_STAGE(PG8_SB(1, 1), b3 + hstepB, voffB); PG8_STAGE(PG8_SA(1, 0), a3, voffA);
            PG8_WAIT_V(8); PG8_WAIT_L(0); PG8_BAR; PG8_MMA(1, 0, At, B0); PG8_MMA(1, 1, At, B1); PG8_BAR; PG8_SCHED;
            } else {
            PG8_LDB(B0, 0, 0); PG8_SCHED; PG8_LDA(At, 0, 0); PG8_STAGE(PG8_SA(1, 1), a1 + hstepA, voffA);
            PG8_WAIT_L(8); PG8_BAR; PG8_WAIT_L(0); PG8_MMA(0, 0, At, B0); PG8_BAR; PG8_SCHED;
            PG8_LDB(B1, 0, 1); PG8_STAGE(PG8_SB(0, 0), b2, voffB);
            PG8_BAR; PG8_WAIT_L(0); PG8_MMA(0, 1, At, B1); PG8_BAR;
            PG8_LDA(At, 0, 1); PG8_STAGE(PG8_SA(0, 0), a2, voffA);
            PG8_BAR; PG8_WAIT_L(0); PG8_MMA(1, 0, At, B0); PG8_BAR; PG8_SCHED;
            PG8_STAGE(PG8_SB(0, 1), b2 + hstepB, voffB);
            PG8_WAIT_V(6); PG8_BAR; PG8_MMA(1, 1, At, B1); PG8_BAR;
            PG8_LDB(B0, 1, 0); PG8_SCHED; PG8_LDA(At, 1, 0); PG8_STAGE(PG8_SA(0, 1), a2 + hstepA, voffA);
            PG8_WAIT_L(8); PG8_BAR; PG8_WAIT_L(0); PG8_MMA(0, 0, At, B0); PG8_BAR; PG8_SCHED;
            PG8_LDB(B1, 1, 1); PG8_STAGE(PG8_SB(1, 0), b3, voffB);
            PG8_BAR; PG8_WAIT_L(0); PG8_MMA(0, 1, At, B1); PG8_BAR;
            PG8_LDA(At, 1, 1); PG8_STAGE(PG8_SA(1, 0), a3, voffA);
            PG8_BAR; PG8_WAIT_L(0); PG8_MMA(1, 0, At, B0); PG8_BAR; PG8_SCHED;
            PG8_STAGE(PG8_SB(1, 1), b3 + hstepB, voffB);
            PG8_WAIT_V(6); PG8_BAR; PG8_MMA(1, 1, At, B1); PG8_BAR;
            }
        }
        if constexpr (ALIGN_EPI) { if (wr == 0) PG8_BAR; }
        if constexpr (!Epi::AFTER_DRAIN) { E(acc, cur, wr, wc, fr, fq); S.done(cur); }
        if (!has_next) break;
#pragma unroll
        for (int a = 0; a < 2; ++a)
#pragma unroll
            for (int b = 0; b < 2; ++b)
#pragma unroll
                for (int m = 0; m < 4; ++m)
#pragma unroll
                    for (int n = 0; n < 2; ++n) acc[a][b][m][n] = (f32x4){0.f, 0.f, 0.f, 0.f};
        cur = nxt; cA = nA; cB = nB; ++ui;
        if constexpr (ALIGN_EPI) { if (wr == 1) PG8_BAR; }
    }
    PG8_WAIT_V(0);
    if constexpr (!ALIGN_EPI) { if (wr == 0) PG8_BAR; }
    PG8_BAR;
    if constexpr (Epi::AFTER_DRAIN) { E.fused(acc, cur, wr, wc, fr, fq, lds, wid, lane); S.done(cur); }
#undef PG8_SA
#undef PG8_SB
#undef PG8_STAGE
#undef PG8_LDA
#undef PG8_LDB
#undef PG8_MMA
#undef PG8_WAIT_V
#undef PG8_WAIT_L
#undef PG8_BAR
#undef PG8_SCHED
}
}

#define LAS __attribute__((address_space(3)))
typedef unsigned short bf16_t;
typedef float f32x4 __attribute__((ext_vector_type(4)));
typedef unsigned u32x4 __attribute__((ext_vector_type(4)));
typedef unsigned u32x2 __attribute__((ext_vector_type(2)));
constexpr int S = 8192, DM = 2048, DEPTH = 2, DIN = 3648, DINP = 3840, DFF = 5632;
constexpr int QLD = 1280, KLD = 1152, VLD = 768;
constexpr int C_QA = 0, C_KA = 512, C_VA = 1024, C_CQ = 1536, C_CKV = 2048, C_KR = 2304, C_QC = 2368, C_KC = 3136, C_VC = 3392;
constexpr float ALPHA = 1.4142135623730951f;
constexpr size_t al256(size_t x) { return (x + 255) / 256 * 256; }
constexpr size_t SZ_WIN = (size_t)DINP * DM * 2, SZ_WUQ = (size_t)1280 * 512 * 2, SZ_WUKV = (size_t)1536 * 256 * 2, SZ_WO = (size_t)DM * DM * 2, SZ_WGU = (size_t)2 * DFF * DM * 2, SZ_WDN = (size_t)DM * DFF * 2;
constexpr size_t O_WIN = 0, O_WUQ = O_WIN + SZ_WIN, O_WUKV = O_WUQ + SZ_WUQ, O_WO = O_WUKV + SZ_WUKV, O_WGU = O_WO + SZ_WO, O_WDN = O_WGU + SZ_WGU, SZ_WL = O_WDN + SZ_WDN;
constexpr size_t WS_W = 0;
constexpr size_t WS_MOD = al256(WS_W + DEPTH * SZ_WL);
constexpr size_t WS_ROPE = al256(WS_MOD + (size_t)DEPTH * 6 * DM * 4);
constexpr size_t WS_RSQ = al256(WS_ROPE + (size_t)S * 64 * 4);
constexpr size_t WS_RSKV = al256(WS_RSQ + (size_t)S * 4);
constexpr size_t WS_X = al256(WS_RSKV + (size_t)S * 4);
constexpr size_t WS_U = al256(WS_X + (size_t)S * DM * 4);
constexpr size_t WS_PROJ = al256(WS_U + (size_t)S * DM * 2);
constexpr size_t WS_Q = al256(WS_PROJ + (size_t)S * DINP * 2);
constexpr size_t WS_K = al256(WS_Q + (size_t)S * QLD * 2);
constexpr size_t WS_V = al256(WS_K + (size_t)S * KLD * 2);
constexpr size_t WS_Y = al256(WS_V + (size_t)S * VLD * 2);
constexpr size_t WS_H = al256(WS_Y + (size_t)S * DM * 2);
constexpr size_t WS_PART = al256(WS_H + (size_t)S * DFF * 2);
constexpr size_t WS_STAT = al256(WS_PART + (size_t)4 * S * VLD * 2);
constexpr size_t WS_SSQ = al256(WS_STAT + (size_t)4 * 6 * S * 2 * 4);
constexpr size_t WS_BAR0_ = WS_SSQ + (size_t)S * 12 * 4;
constexpr size_t WS_BAR = al256(WS_BAR0_);
constexpr size_t WS_END = al256(WS_BAR + 16384);
constexpr int TAB_OFF = pg8::STAGE_BYTES, LDS_BYTES = pg8::STAGE_BYTES + 256;
constexpr int NTHREADS = 512;

struct Args { const float* in[19]; float* out; unsigned char* ws; int ph_lo, ph_hi; };
struct Tab {
    const LAS unsigned* t;
    __device__ __forceinline__ unsigned long long ld(int i) const { const unsigned lo = __builtin_amdgcn_readfirstlane(t[2 * i]), hi = __builtin_amdgcn_readfirstlane(t[2 * i + 1]); return ((unsigned long long)hi << 32) | lo; }
    __device__ __forceinline__ const float* in(int i) const { return (const float*)ld(i); }
    __device__ __forceinline__ float* out() const { return (float*)ld(19); }
    __device__ __forceinline__ unsigned char* wsp() const { return (unsigned char*)ld(20); }
};

__device__ __forceinline__ float bf2f(unsigned short b) { return __uint_as_float((unsigned)b << 16); }
template <int CTRL> __device__ __forceinline__ float dpp_mov(float v) { return __builtin_bit_cast(float, __builtin_amdgcn_update_dpp(0, __builtin_bit_cast(int, v), CTRL, 0xf, 0xf, true)); }
__device__ __forceinline__ float wave_sum(float v) {
    v += dpp_mov<0xB1>(v);
    v += dpp_mov<0x4E>(v);
    v += dpp_mov<0x141>(v);
    v += dpp_mov<0x140>(v);
    { auto rr = __builtin_amdgcn_permlane16_swap(__float_as_uint(v), __float_as_uint(v), false, false); v = __uint_as_float(rr[0]) + __uint_as_float(rr[1]); }
    { auto rr = __builtin_amdgcn_permlane32_swap(__float_as_uint(v), __float_as_uint(v), false, false); v = __uint_as_float(rr[0]) + __uint_as_float(rr[1]); }
    return v; }
using pg8::cvt_pk_bf16;
__device__ __forceinline__ int otid() { int t = threadIdx.x; asm volatile("" : "+v"(t)); return t; }

__device__ __forceinline__ void phase_mod(const Tab tb, unsigned char* lds_g) {
    unsigned char* ws_ = tb.wsp(); const float* in1 = tb.in(1); const float* in2 = tb.in(2); const float* in3 = tb.in(3);
    float* condL = (float*)lds_g; f32x4* red = (f32x4*)(lds_g + 8192);
    const int tid = otid();
    const float* c = in1;
    for (int i = tid; i < DM; i += NTHREADS) { const float v = c[i]; condL[i] = v / (1.0f + __expf(-v)); }
    __syncthreads();
    float* mod = (float*)(ws_ + WS_MOD);
    const int cl = tid & 31, kg = tid >> 5;
    for (int item = blockIdx.x; item < DEPTH * 96; item += gridDim.x) {
        const int l = item / 96, cgp = item % 96;
        const float* W = in2 + (size_t)l * DM * 6 * DM + (size_t)(kg * 128) * (6 * DM) + cgp * 128 + 4 * cl;
        f32x4 acc = {0.f, 0.f, 0.f, 0.f};
#pragma unroll 8
        for (int kk = 0; kk < 128; ++kk) { const f32x4 w = __builtin_nontemporal_load((const f32x4*)(W + (size_t)kk * (6 * DM))); acc += w * condL[kg * 128 + kk]; }
        red[kg * 32 + cl] = acc;
        __syncthreads();
        if (tid < 128) { float s = 0.f; const float* rf = (const float*)red;
            for (int g = 0; g < 16; ++g) s += rf[g * 128 + tid];
            mod[l * 6 * DM + cgp * 128 + tid] = s + in3[l * 6 * DM + cgp * 128 + tid]; }
        __syncthreads();
    }
}

template <int PERMT>
__device__ __forceinline__ int dst_row(int n) {
    if (PERMT == 1) { const int h = n / 192, d = n % 192; if (d < 128) return n; const int j = d - 128; return h * 192 + 128 + 2 * (j & 31) + (j >> 5); }
    if (PERMT == 3) { if (n < C_KR || n >= C_KR + 64) return n; const int j = n - C_KR; return C_KR + 2 * (j & 31) + (j >> 5); }
    if (PERMT == 2) { if (n < DFF) return 256 * (n >> 7) + (n & 127); const int m = n - DFF; return 256 * (m >> 7) + 128 + (m & 127); }
    return n;
}
template <int PERMT>
__device__ __forceinline__ void transpose_job(const float* __restrict__ src, bf16_t* __restrict__ dst, int K, int N, int Npad, const float* __restrict__ kscale, unsigned char* lds_g, int first, int stride) {
    float* T = (float*)lds_g;
    const int tid = otid(), nkt = K / 64, nnt = (N + 255) / 256, ntiles = nkt * nnt;
    for (int t = first; t < ntiles; t += stride) {
        const int k0 = (t % nkt) * 64, n0 = (t / nkt) * 256;
        { const int kk = tid >> 6, n4 = tid & 63; const bool ok = n0 + 4 * n4 < N; f32x4 v[8];
#pragma unroll
          for (int i = 0; i < 8; ++i) { const int k = k0 + kk + 8 * i; v[i] = ok ? __builtin_nontemporal_load((const f32x4*)(src + (size_t)k * N + n0 + 4 * n4)) : (f32x4){0.f, 0.f, 0.f, 0.f}; }
#pragma unroll
          for (int i = 0; i < 8; ++i) { const int k = k0 + kk + 8 * i; if (kscale) v[i] = v[i] * kscale[k];
              float* tp = T + (kk + 8 * i) * 257 + 4 * n4; tp[0] = v[i][0]; tp[1] = v[i][1]; tp[2] = v[i][2]; tp[3] = v[i][3]; } }
        __syncthreads();
        { const int n = tid >> 1, ks = tid & 1;
          if (n0 + n < N) { bf16_t* dp = dst + (size_t)dst_row<PERMT>(n0 + n) * K + k0 + 32 * ks;
#pragma unroll
            for (int eb = 0; eb < 4; ++eb) { float v[8];
#pragma unroll
              for (int e = 0; e < 8; ++e) v[e] = T[(32 * ks + 8 * eb + e) * 257 + n];
              u32x4 w; w.x = cvt_pk_bf16(v[0], v[1]); w.y = cvt_pk_bf16(v[2], v[3]); w.z = cvt_pk_bf16(v[4], v[5]); w.w = cvt_pk_bf16(v[6], v[7]);
              *(u32x4*)(dp + 8 * eb) = w; } } }
        __syncthreads();
    }
    const size_t nz = (size_t)(Npad - N) * K / 8;
    for (size_t i = (size_t)blockIdx.x * NTHREADS + tid; i < nz; i += (size_t)gridDim.x * NTHREADS) *(u32x4*)(dst + (size_t)N * K + i * 8) = (u32x4){0u, 0u, 0u, 0u};
}

__device__ __forceinline__ void modulate_rows(const float* __restrict__ x, const float* __restrict__ sc, const float* __restrict__ sh, bf16_t* __restrict__ u) {
    const size_t n8 = (size_t)S * DM / 8;
    for (size_t i = (size_t)blockIdx.x * NTHREADS + otid(); i < n8; i += (size_t)gridDim.x * NTHREADS) {
        const int col = (int)((i * 8) % DM);
        const f32x4 x0 = *(const f32x4*)(x + i * 8), x1 = *(const f32x4*)(x + i * 8 + 4);
        const f32x4 s0 = *(const f32x4*)(sc + col) + 1.0f, s1 = *(const f32x4*)(sc + col + 4) + 1.0f;
        const f32x4 h0 = *(const f32x4*)(sh + col), h1 = *(const f32x4*)(sh + col + 4);
        *(u32x4*)(u + i * 8) = pg8::pack8(x0 * s0 + h0, x1 * s1 + h1);
    }
}

__device__ __forceinline__ void rope_table(float* __restrict__ rope) {
    for (int i = blockIdx.x * NTHREADS + otid(); i < S * 32; i += gridDim.x * NTHREADS) {
        const int pos = i >> 5, j = i & 31;
        const float inv = exp2f(-(float)j * (13.287712379549449f / 32.0f));
        const float ang = (float)pos * inv;
        const double rev = (double)ang * 0.15915494309189535;
        const double fr = rev - floor(rev);
        const float ar = (float)(fr * 6.283185307179586);
        rope[(size_t)pos * 64 + j] = cosf(ar); rope[(size_t)pos * 64 + 32 + j] = sinf(ar);
    }
}

__device__ __forceinline__ void phase_prep(unsigned char* ws_) {
    const bf16_t* proj = (const bf16_t*)(ws_ + WS_PROJ); const float* rope = (const float*)(ws_ + WS_ROPE);
    float* rsq = (float*)(ws_ + WS_RSQ); float* rskv = (float*)(ws_ + WS_RSKV); bf16_t* Kb = (bf16_t*)(ws_ + WS_K);
    const int tid_o = otid(), lane = tid_o & 63, wave = tid_o >> 6;
    for (int r = blockIdx.x * 8 + wave; r < S; r += gridDim.x * 8) {
        const bf16_t* pr = proj + (size_t)r * DINP;
        { const u32x4 w = *(const u32x4*)(pr + C_CQ + 8 * lane); float ss = 0.f;
#pragma unroll
          for (int e = 0; e < 4; ++e) { const float lo = __uint_as_float(w[e] << 16), hi = __uint_as_float(w[e] & 0xffff0000u); ss += lo * lo + hi * hi; }
          ss = wave_sum(ss); if (lane == 0) rsq[r] = 1.0f / sqrtf(ss * (1.0f / 512.0f) + 1e-6f); }
        { const u32x2 w = *(const u32x2*)(pr + C_CKV + 4 * lane); float ss = 0.f;
#pragma unroll
          for (int e = 0; e < 2; ++e) { const float lo = __uint_as_float(w[e] << 16), hi = __uint_as_float(w[e] & 0xffff0000u); ss += lo * lo + hi * hi; }
          ss = wave_sum(ss); if (lane == 0) rskv[r] = 1.0f / sqrtf(ss * (1.0f / 256.0f) + 1e-6f); }
        { const int i = lane & 31; const float x1 = bf2f(pr[C_KR + i]), x2 = bf2f(pr[C_KR + 32 + i]);
          const float c = rope[(size_t)r * 64 + i], sn = rope[(size_t)r * 64 + 32 + i];
          const unsigned w = cvt_pk_bf16(x1 * c - x2 * sn, x2 * c + x1 * sn);
          const int hb = (lane >> 5) * 3;
#pragma unroll
          for (int h = 0; h < 3; ++h) *(unsigned*)(Kb + (size_t)r * KLD + (hb + h) * 192 + 128 + 2 * i) = w; }
    }
}

__device__ __forceinline__ void phase_ynorm(unsigned char* ws_) {
    bf16_t* y = (bf16_t*)(ws_ + WS_Y); const bf16_t* part = (const bf16_t*)(ws_ + WS_PART); const float* stat = (const float*)(ws_ + WS_STAT);
    const int tid_o = otid(), lane = tid_o & 63, wave = tid_o >> 6;
    const bool lowhalf = lane < 32;
    for (int r = blockIdx.x * 8 + wave; r < S; r += gridDim.x * 8) {
        bf16_t* yr = y + (size_t)r * DM;
        float v[4][8]; float ss[4];
#pragma unroll
        for (int j = 0; j < 4; ++j) {
            const bool fromPart = (j == 1) || (j == 2 && lowhalf);
            if (!fromPart) { const u32x4 w = *(const u32x4*)(yr + j * 512 + 8 * lane);
#pragma unroll
                for (int e = 0; e < 4; ++e) { v[j][2 * e] = __uint_as_float(w[e] << 16); v[j][2 * e + 1] = __uint_as_float(w[e] & 0xffff0000u); } }
            else { const int yb = j * 512 + 8 * lane - 512, h = yb >> 7; float m[4], lw[4];
#pragma unroll
                for (int i = 0; i < 4; ++i) { const float* st = stat + ((size_t)(i * 6 + h) * S + r) * 2; m[i] = st[0]; lw[i] = st[1]; }
                const float M = fmaxf(fmaxf(m[0], m[1]), fmaxf(m[2], m[3])); float W = 0.f;
#pragma unroll
                for (int i = 0; i < 4; ++i) { lw[i] *= __builtin_amdgcn_exp2f(m[i] - M); W += lw[i]; }
                const float rW = 1.0f / W;
#pragma unroll
                for (int e = 0; e < 8; ++e) v[j][e] = 0.f;
#pragma unroll
                for (int i = 0; i < 4; ++i) { const u32x4 w = *(const u32x4*)(part + ((size_t)i * S + r) * VLD + yb); const float wi = lw[i] * rW;
#pragma unroll
                    for (int e = 0; e < 4; ++e) { v[j][2 * e] += wi * __uint_as_float(w[e] << 16); v[j][2 * e + 1] += wi * __uint_as_float(w[e] & 0xffff0000u); } } }
            float sq = 0.f;
#pragma unroll
            for (int e = 0; e < 8; ++e) sq += v[j][e] * v[j][e];
            ss[j] = sq;
        }
        const float sA = wave_sum(ss[0]);
        const float sB = wave_sum(ss[1] + (lowhalf ? ss[2] : 0.f));
        const float sC = wave_sum(ss[3] + (lowhalf ? 0.f : ss[2]));
        const float rA = 1.0f / sqrtf(sA * (1.0f / 512.0f) + 1e-6f), rB = 1.0f / sqrtf(sB * (1.0f / 768.0f) + 1e-6f), rC = 1.0f / sqrtf(sC * (1.0f / 768.0f) + 1e-6f);
#pragma unroll
        for (int j = 0; j < 4; ++j) { const float sc = j == 0 ? rA : (j == 1 ? rB : (j == 2 ? (lowhalf ? rB : rC) : rC)); u32x4 o;
#pragma unroll
            for (int e = 0; e < 4; ++e) o[e] = cvt_pk_bf16(v[j][2 * e] * sc, v[j][2 * e + 1] * sc);
            *(u32x4*)(yr + j * 512 + 8 * lane) = o; }
    }
}

__device__ __forceinline__ void phase_ln(const float* z, float* xo, const float* __restrict__ g, const float* __restrict__ b, const float* __restrict__ sc, const float* __restrict__ sh, bf16_t* __restrict__ u) {
    const int tid_o = otid(), lane = tid_o & 63, wave = tid_o >> 6;
    const int stride = gridDim.x * 8;
    for (int r = blockIdx.x * 8 + wave; r < S; r += 2 * stride) {
        const bool hasB = r + stride < S; const int rr[2] = {r, hasB ? r + stride : r};
        f32x4 v[2][8]; float s[2] = {0.f, 0.f};
#pragma unroll
        for (int k = 0; k < 2; ++k) { const float* zr = z + (size_t)rr[k] * DM;
#pragma unroll
            for (int j = 0; j < 8; ++j) v[k][j] = *(const f32x4*)(zr + j * 256 + 4 * lane); }
#pragma unroll
        for (int k = 0; k < 2; ++k)
#pragma unroll
            for (int j = 0; j < 8; ++j) s[k] += (v[k][j][0] + v[k][j][1]) + (v[k][j][2] + v[k][j][3]);
        float mean[2], rstd[2];
#pragma unroll
        for (int k = 0; k < 2; ++k) { mean[k] = wave_sum(s[k]) * (1.0f / DM); float q = 0.f;
#pragma unroll
            for (int j = 0; j < 8; ++j) { const f32x4 d = v[k][j] - mean[k]; q += (d[0] * d[0] + d[1] * d[1]) + (d[2] * d[2] + d[3] * d[3]); }
            rstd[k] = 1.0f / sqrtf(wave_sum(q) * (1.0f / DM) + 1e-5f); }
#pragma unroll
        for (int j = 0; j < 8; ++j) { const int col = j * 256 + 4 * lane;
            const f32x4 gg = *(const f32x4*)(g + col), bb = *(const f32x4*)(b + col);
            f32x4 s1 = {0.f, 0.f, 0.f, 0.f}, h1 = {0.f, 0.f, 0.f, 0.f};
            if (u) { s1 = *(const f32x4*)(sc + col) + 1.0f; h1 = *(const f32x4*)(sh + col); }
#pragma unroll
            for (int k = 0; k < 2; ++k) { if (k == 1 && !hasB) continue;
                const f32x4 o = (v[k][j] - mean[k]) * rstd[k] * gg + bb;
                *(f32x4*)(xo + (size_t)rr[k] * DM + col) = o;
                if (u) { const f32x4 m = o * s1 + h1; u32x2 w; w.x = cvt_pk_bf16(m[0], m[1]); w.y = cvt_pk_bf16(m[2], m[3]); *(u32x2*)(u + (size_t)rr[k] * DM + col) = w; } } }
    }
}

template <int MODE>
__device__ __forceinline__ void naive_attn(unsigned char* ws_, const float* rpb, const float* sink, int l) {
    constexpr int DQK = MODE == 1 ? 192 : 128, NJ = DQK / 64, H = MODE == 0 ? 4 : 6;
    const bf16_t* proj = (const bf16_t*)(ws_ + WS_PROJ); bf16_t* y = (bf16_t*)(ws_ + WS_Y);
    const int tid_o = otid(), lane = tid_o & 63, wave = tid_o >> 6;
    for (int it = blockIdx.x * 8 + wave; it < S * H; it += gridDim.x * 8) {
        const int h = it / S, q = it % S;
        const bf16_t *Qp, *Kp, *Vp; int ldk, ldv, ycol; float scale;
        if (MODE == 0) { Qp = proj + (size_t)q * DINP + C_QA + 128 * h; Kp = proj + C_KA + 128 * h; Vp = proj + C_VA + 128 * h; ldk = DINP; ldv = DINP; ycol = 128 * h; scale = 0.08838834764831845f; }
        else if (MODE == 1) { Qp = (const bf16_t*)(ws_ + WS_Q) + (size_t)q * QLD + 192 * h; Kp = (const bf16_t*)(ws_ + WS_K) + 192 * h; Vp = (const bf16_t*)(ws_ + WS_V) + 128 * h; ldk = KLD; ldv = VLD; ycol = 512 + 128 * h; scale = 0.07216878364870322f; }
        else { Qp = proj + (size_t)q * DINP + C_QC + 128 * h; Kp = proj + C_KC + 128 * (h / 3); Vp = proj + C_VC + 128 * (h / 3); ldk = DINP; ldv = DINP; ycol = 1280 + 128 * h; scale = 0.08838834764831845f; }
        float qv[NJ];
#pragma unroll
        for (int j = 0; j < NJ; ++j) qv[j] = bf2f(Qp[64 * j + lane]) * scale;
        float m = -1e30f, ls = 0.f, o0 = 0.f, o1 = 0.f; int nkeys, klo = 0, r = 0, col = 0, r0 = 0, c0 = 0; float slope = 0.f;
        if (MODE == 0) { r = q >> 6; col = q & 63; r0 = min(max(r - 4, 0), 120); c0 = min(max(col - 8, 0), 48); nkeys = 128; }
        else if (MODE == 1) nkeys = S;
        else { klo = max(0, q - 128); nkeys = min(S - 1, q + 128) - klo + 1; m = sink[l * 6 + h]; ls = 1.f; slope = exp2f(-8.0f * (float)(h + 1) / 6.0f); }
        for (int kk = 0; kk < nkeys; ++kk) {
            int key; float bias = 0.f;
            if (MODE == 0) { const int krow = r0 + (kk >> 4), kcol = c0 + (kk & 15); key = krow * 64 + kcol; bias = rpb[((l * 4 + h) * 15 + (krow - r + 7)) * 31 + (kcol - col + 15)]; }
            else if (MODE == 1) key = kk;
            else { key = klo + kk; bias = -slope * fabsf((float)(q - key)); }
            float part = 0.f;
#pragma unroll
            for (int j = 0; j < NJ; ++j) part += qv[j] * bf2f(Kp[(size_t)key * ldk + 64 * j + lane]);
            const float s = wave_sum(part) + bias;
            const float mn = fmaxf(m, s), al = __expf(m - mn), p = __expf(s - mn);
            ls = ls * al + p;
            o0 = o0 * al + p * bf2f(Vp[(size_t)key * ldv + lane]); o1 = o1 * al + p * bf2f(Vp[(size_t)key * ldv + 64 + lane]);
            m = mn;
        }
        const float inv = 1.0f / ls;
        y[(size_t)q * DM + ycol + lane] = (bf16_t)(cvt_pk_bf16(o0 * inv, 0.f) & 0xffffu);
        y[(size_t)q * DM + ycol + 64 + lane] = (bf16_t)(cvt_pk_bf16(o1 * inv, 0.f) & 0xffffu);
    }
}

#define XB_TMO      128
#define XB_XCNT(j)  (256  + 64 * (j))
#define XB_XSUB(j)  (1280 + 64 * (j))
#define XB_XGEN(j)  (2304 + 64 * (j))
#define XB_TOP      3328
#define XB_TOPGEN   3392
#define XCD_BAR_WORDS 3456
#define XB_SPIN_CAP (1u << 18)

__device__ __forceinline__ unsigned xb_ld(unsigned* p)              { return __hip_atomic_load(p, __ATOMIC_RELAXED, __HIP_MEMORY_SCOPE_AGENT); }
__device__ __forceinline__ unsigned xb_add(unsigned* p, unsigned v) { return __hip_atomic_fetch_add(p, v, __ATOMIC_RELAXED, __HIP_MEMORY_SCOPE_AGENT); }
__device__ __forceinline__ unsigned xb_xcc_id() { return (unsigned)__builtin_amdgcn_s_getreg((3 << 11) | 20) & 0xFu; }
#define XB_SPIN(cond, bar) do { unsigned _sp = 0; while (cond) { __builtin_amdgcn_s_sleep(1); \
    if ((++_sp & 255u) == 0u) { if (xb_ld(&(bar)[XB_TMO])) break; if (_sp > XB_SPIN_CAP) { atomicAdd(&(bar)[XB_TMO], 1u); break; } } } } while (0)

struct XcdBarrier {
    unsigned* bar; unsigned x;
    volatile LAS unsigned* st;
};

__device__ __forceinline__ XcdBarrier xcd_barrier_post(unsigned* bar, volatile LAS unsigned* st) {
    XcdBarrier b; b.bar = bar; b.x = xb_xcc_id(); b.st = st;
    if (threadIdx.x == 0) (void)xb_add(&bar[XB_XCNT(b.x)], 1u);
    return b;
}
__device__ __forceinline__ void xcd_barrier_complete(unsigned* bar, unsigned x, unsigned& nloc, unsigned& nx) {
    const unsigned G = gridDim.x * gridDim.y * gridDim.z;
    unsigned sum, cnt, mine, sp = 0u;
    for (;;) {
        sum = 0u; cnt = 0u; mine = 0u;
#pragma unroll
        for (unsigned j = 0; j < 16; ++j) { const unsigned c = xb_ld(&bar[XB_XCNT(j)]); sum += c; cnt += (c > 0u) ? 1u : 0u; mine = (j == x) ? c : mine; }
        if (sum == G) break;
        __builtin_amdgcn_s_sleep(1);
        if ((++sp & 255u) == 0u) { if (xb_ld(&bar[XB_TMO])) break; if (sp > XB_SPIN_CAP) { atomicAdd(&bar[XB_TMO], 1u); break; } }
    }
    nloc = mine > 0u ? mine : 1u; nx = cnt > 0u ? cnt : 1u;
}

__device__ __forceinline__ void xcd_barrier(const XcdBarrier& b) {
    asm volatile("s_waitcnt vmcnt(0)" ::: "memory");
    __syncthreads();
    if (threadIdx.x == 0) {
        unsigned* bar = b.bar;
        __builtin_amdgcn_s_waitcnt(0);
        unsigned nloc = b.st[0], nx = b.st[1];
        if (nloc == 0u) { xcd_barrier_complete(bar, b.x, nloc, nx); b.st[0] = nloc; b.st[1] = nx; }
        const unsigned old = xb_add(&bar[XB_XSUB(b.x)], 1u);
        const unsigned gen = old / nloc;
        if (old + 1u == (gen + 1u) * nloc) {
            __builtin_amdgcn_fence(__ATOMIC_RELEASE, "agent");
            asm volatile("s_waitcnt vmcnt(0)" ::: "memory");
            const unsigned og = xb_add(&bar[XB_TOP], 1u);
            const unsigned tg = og / nx;
            if (og + 1u == (tg + 1u) * nx) xb_add(&bar[XB_TOPGEN], 1u);
            else XB_SPIN(xb_ld(&bar[XB_TOPGEN]) == tg, bar);
            __builtin_amdgcn_fence(__ATOMIC_ACQUIRE, "agent");
            xb_add(&bar[XB_XGEN(b.x)], 1u);
            asm volatile("s_waitcnt vmcnt(0)" ::: "memory");
        } else {
            XB_SPIN(xb_ld(&bar[XB_XGEN(b.x)]) == gen, bar);
            __builtin_amdgcn_fence(__ATOMIC_ACQUIRE, "agent");
            asm volatile("s_waitcnt vmcnt(0)" ::: "memory");
        }
    }
    __syncthreads();
}


namespace att {
typedef short bf16x8 __attribute__((ext_vector_type(8)));
typedef short s16x4 __attribute__((ext_vector_type(4)));
typedef float f32x16 __attribute__((ext_vector_type(16)));
#define ATT_SBAR() __builtin_amdgcn_sched_barrier(0)
#define ATT_BAR() do { asm volatile("s_waitcnt lgkmcnt(0)" ::: "memory"); __builtin_amdgcn_s_barrier(); asm volatile("" ::: "memory"); } while (0)
constexpr float LOG2E = 1.4426950408889634f, NEGM = -1e30f;
constexpr float DEFER_THR = 8.f;
constexpr int KVSPLIT = 4;
__device__ __forceinline__ int crow(int r, int hi) { return (r & 3) + 8 * (r >> 2) + 4 * hi; }
__device__ __forceinline__ unsigned cvtpk(float lo, float hi) { unsigned r; asm volatile("v_cvt_pk_bf16_f32 %0, %1, %2" : "=v"(r) : "v"(lo), "v"(hi)); return r; }
template <int DQK> __device__ __forceinline__ int kswz_x(int row) { return DQK == 128 ? (((row & 7) | (((row >> 4) & 1) << 3)) << 4) : (((row >> 1) & 7) << 4); }
template <int DQK> __device__ __forceinline__ int kswz(int row, int colB) { return row * (DQK * 2) + (colB ^ kswz_x<DQK>(row)); }
__device__ __forceinline__ int v_st(int k, int c) { const int kk = (k & ~0xC) | ((k & 4) << 1) | ((k & 8) >> 1); return ((kk >> 3) * 4 + (c >> 5)) * 512 + ((kk & 7) * 32 + (c & 31)) * 2; }
__device__ __forceinline__ int v_rd_base(int lane) { return ((lane & 3) << 3) | (((lane >> 2) & 3) << 6) | (((lane >> 4) & 1) << 5) | (((lane >> 5) & 1) << 8); }
constexpr int v_rd_off(int d0, int ks, int half) { return d0 * 512 + ks * 4096 + half * 2048; }
template <int OFF> __device__ __forceinline__ s16x4 tr_read(int vb) { s16x4 r; asm volatile("ds_read_b64_tr_b16 %0, %1 offset:%2" : "=&v"(r) : "v"(vb), "i"(OFF) : "memory"); return r; }
struct VFrag { s16x4 l0, h0, l1, h1, l2, h2, l3, h3; };
template <int D0> __device__ __forceinline__ void pv_read(VFrag& f, int vb) {
  f.l0 = tr_read<v_rd_off(D0, 0, 0)>(vb); f.h0 = tr_read<v_rd_off(D0, 0, 1)>(vb); f.l1 = tr_read<v_rd_off(D0, 1, 0)>(vb); f.h1 = tr_read<v_rd_off(D0, 1, 1)>(vb);
  f.l2 = tr_read<v_rd_off(D0, 2, 0)>(vb); f.h2 = tr_read<v_rd_off(D0, 2, 1)>(vb); f.l3 = tr_read<v_rd_off(D0, 3, 0)>(vb); f.h3 = tr_read<v_rd_off(D0, 3, 1)>(vb);
}
__device__ __forceinline__ void pv_mma(f32x16& od, const VFrag& f, bf16x8 pa0, bf16x8 pa1, bf16x8 pa2, bf16x8 pa3) {
#define ATT_PK(L, H) (bf16x8){L[0], L[1], L[2], L[3], H[0], H[1], H[2], H[3]}
  od = __builtin_amdgcn_mfma_f32_32x32x16_bf16(pa0, ATT_PK(f.l0, f.h0), od, 0, 0, 0);
  od = __builtin_amdgcn_mfma_f32_32x32x16_bf16(pa1, ATT_PK(f.l1, f.h1), od, 0, 0, 0);
  od = __builtin_amdgcn_mfma_f32_32x32x16_bf16(pa2, ATT_PK(f.l2, f.h2), od, 0, 0, 0);
  od = __builtin_amdgcn_mfma_f32_32x32x16_bf16(pa3, ATT_PK(f.l3, f.h3), od, 0, 0, 0);
#undef ATT_PK
}
__device__ __forceinline__ void pv_d0(f32x16* o, int vb, bf16x8 pa0, bf16x8 pa1, bf16x8 pa2, bf16x8 pa3) {
  VFrag fa, fb;
  pv_read<0>(fa, vb); pv_read<1>(fb, vb);
  asm volatile("s_waitcnt lgkmcnt(8)" ::: "memory"); ATT_SBAR(); pv_mma(o[0], fa, pa0, pa1, pa2, pa3); ATT_SBAR();
  pv_read<2>(fa, vb);
  asm volatile("s_waitcnt lgkmcnt(8)" ::: "memory"); ATT_SBAR(); pv_mma(o[1], fb, pa0, pa1, pa2, pa3); ATT_SBAR();
  pv_read<3>(fb, vb);
  asm volatile("s_waitcnt lgkmcnt(8)" ::: "memory"); ATT_SBAR(); pv_mma(o[2], fa, pa0, pa1, pa2, pa3); ATT_SBAR();
  asm volatile("s_waitcnt lgkmcnt(0)" ::: "memory"); ATT_SBAR(); pv_mma(o[3], fb, pa0, pa1, pa2, pa3);
}
typedef float f32x2 __attribute__((ext_vector_type(2)));
template <bool RAW>
__device__ __forceinline__ void softmax_tile(f32x16& p0, f32x16& p1, float Cs, float& m_reg, float& l_reg, float& alpha, bf16x8& pa0, bf16x8& pa1, bf16x8& pa2, bf16x8& pa3) {
  float pmax = fmaxf(fmaxf(p0[0], p0[1]), p1[0]);
#pragma unroll
  for (int r = 2; r < 16; r += 2) pmax = fmaxf(fmaxf(pmax, p0[r]), p0[r + 1]);
#pragma unroll
  for (int r = 1; r < 15; r += 2) pmax = fmaxf(fmaxf(pmax, p1[r]), p1[r + 1]);
  pmax = fmaxf(pmax, p1[15]);
  if (RAW) pmax *= Cs;
  float mn;
  if (__builtin_expect(__all(pmax - m_reg <= DEFER_THR * LOG2E), 1)) { mn = m_reg; alpha = 1.f; }
  else { { auto rr = __builtin_amdgcn_permlane32_swap(__float_as_uint(pmax), __float_as_uint(pmax), false, false); pmax = fmaxf(__uint_as_float(rr[0]), __uint_as_float(rr[1])); }
         mn = fmaxf(m_reg, pmax); alpha = __builtin_amdgcn_exp2f(m_reg - mn); m_reg = mn; }
#pragma unroll
  for (int r = 0; r < 16; ++r) { p0[r] = __builtin_amdgcn_exp2f(RAW ? fmaf(p0[r], Cs, -mn) : p0[r] - mn); p1[r] = __builtin_amdgcn_exp2f(RAW ? fmaf(p1[r], Cs, -mn) : p1[r] - mn); }
  f32x2 ps2 = {0.f, 0.f};
#pragma unroll
  for (int r = 0; r < 16; r += 2) { ps2 += (f32x2){p0[r], p0[r + 1]}; ps2 += (f32x2){p1[r], p1[r + 1]}; }
  l_reg = l_reg * alpha + (ps2[0] + ps2[1]);
#define ATT_PK8(P, BASE, OUT) do { u32x4 w = {cvtpk(P[BASE + 0], P[BASE + 1]), cvtpk(P[BASE + 2], P[BASE + 3]), cvtpk(P[BASE + 4], P[BASE + 5]), cvtpk(P[BASE + 6], P[BASE + 7])}; \
    OUT = *reinterpret_cast<bf16x8*>(&w); } while (0)
  ATT_PK8(p0, 0, pa0); ATT_PK8(p0, 8, pa1); ATT_PK8(p1, 0, pa2); ATT_PK8(p1, 8, pa3);
#undef ATT_PK8
}

template <int MODE>
__device__ __forceinline__ void attn_unit(unsigned char* ws_, const float* rpb, const float* sink, int l, int h, int qb, int kvq, unsigned char* lds_g) {
  constexpr int DQK = MODE == 1 ? 192 : 128, ND = DQK / 16, NCH = DQK / 64;
  constexpr int SHM_V = 64 * 128 * 2, SHM_K = 64 * DQK * 2, OFF_K = 3 * SHM_V, OFF_WS = OFF_K + 3 * SHM_K, OFF_RPB = OFF_WS + 8 * 64 * 4;
  const int tid = otid(), wid = tid >> 6, lane = tid & 63, r32 = lane & 31, hi = lane >> 5;
  LAS unsigned char* ldl = (LAS unsigned char*)lds_g;
  const bf16_t* proj = (const bf16_t*)(ws_ + WS_PROJ);
  const bf16_t *Qp, *Kp, *Vp; int ldq, ldk, ldv, ycol; float C;
  if (MODE == 0) { Qp = proj + C_QA + 128 * h; Kp = proj + C_KA + 128 * h; Vp = proj + C_VA + 128 * h; ldq = ldk = ldv = DINP; ycol = 128 * h; C = 0.08838834764831845f * LOG2E; }
  else if (MODE == 1) { Qp = (const bf16_t*)(ws_ + WS_Q) + 192 * h; Kp = (const bf16_t*)(ws_ + WS_K) + 192 * h; Vp = (const bf16_t*)(ws_ + WS_V) + 128 * h; ldq = QLD; ldk = KLD; ldv = VLD; ycol = 512 + 128 * h; C = 0.07216878364870322f * LOG2E; }
  else { Qp = proj + C_QC + 128 * h; Kp = proj + C_KC + 128 * (h / 3); Vp = proj + C_VC + 128 * (h / 3); ldq = ldk = ldv = DINP; ycol = 1280 + 128 * h; C = 0.08838834764831845f * LOG2E; }
  const int q0 = qb * 256, qi = q0 + wid * 32 + r32;
  int T0, T1, tw0, tw1, wrow = 0, qcol = 0, c0 = 0; float slope2 = 0.f;
  if (MODE == 1) { T0 = tw0 = kvq * (S / 64 / KVSPLIT); T1 = tw1 = T0 + S / 64 / KVSPLIT; }
  else if (MODE == 0) { const int R = qb * 4; T0 = min(max(R - 4, 0), 120); T1 = min(max(R - 1, 0), 120) + 8; wrow = R + (wid >> 1); tw0 = min(max(wrow - 4, 0), 120); tw1 = tw0 + 8;
                        qcol = (wid & 1) * 32 + r32; c0 = min(max(qcol - 8, 0), 48); }
  else { T0 = max(0, (q0 - 128) >> 6); T1 = min(S / 64, ((q0 + 255 + 128) >> 6) + 1); const int qw = q0 + wid * 32; tw0 = max(0, (qw - 128) >> 6); tw1 = min(S / 64, ((qw + 31 + 128) >> 6) + 1);
         slope2 = exp2f(-8.0f * (float)(h + 1) / 6.0f) * LOG2E; }
  LAS float* wsl = (LAS float*)(ldl + OFF_WS) + wid * 64; LAS float* li_l = wsl; LAS float* al_l = wsl + 32;
  LAS float* rpbL = (LAS float*)(ldl + OFF_RPB);
  if (MODE == 0) { for (int i = tid; i < 465; i += NTHREADS) rpbL[i] = rpb[(l * 4 + h) * 465 + i] * LOG2E; }
  float m_reg = -1e29f, l_reg = 0.f;
  if (MODE == 2) { m_reg = sink[l * 6 + h] * LOG2E; l_reg = hi == 0 ? 1.f : 0.f; }
  f32x16 o[4] = {}; bf16x8 qr[ND];
  { const bf16_t* Qw = Qp + (size_t)qi * ldq + hi * 8;
#pragma unroll
    for (int d0 = 0; d0 < ND; ++d0) qr[d0] = *(const bf16x8*)(Qw + d0 * 16); }
  unsigned kg[NCH], vg[2];
#pragma unroll
  for (int i = 0; i < NCH; ++i) { const int X = (wid + 8 * i) * 1024 + lane * 16, row = X / (DQK * 2), cs = X % (DQK * 2), colB = cs ^ kswz_x<DQK>(row); kg[i] = (unsigned)(row * ldk + (colB >> 1)) * 2u; }
#pragma unroll
  for (int i = 0; i < 2; ++i) { const int X = (wid + 8 * i) * 1024 + lane * 16, st = X >> 9, w = X & 511, kk = ((st >> 2) << 3) | (w >> 6), c = ((st & 3) << 5) | ((w & 63) >> 1);
    const int k = kk;
    vg[i] = (unsigned)(k * ldv + c) * 2u; }
  const int vb0 = (int)(uintptr_t)lds_g + v_rd_base(lane);
  const int kbase0 = (int)(uintptr_t)lds_g + OFF_K;
  constexpr int NKO = DQK == 192 ? 4 : ND;
  int ko[NKO];
#pragma unroll
  for (int d0 = 0; d0 < NKO; ++d0) ko[d0] = kswz<DQK>(r32, (d0 * 16 + hi * 8) * 2);
#define ATT_KO(d0_) (DQK == 192 ? ko[(d0_) & 3] + ((d0_) >> 2) * 128 : ko[(d0_) % NKO])
  const int wslab = __builtin_amdgcn_readfirstlane(wid) * 1024;
#define ATT_DMA(t, b) do { const char* kt_ = (const char*)(Kp + (size_t)(t) * 64 * ldk); const char* vt_ = (const char*)(Vp + (size_t)(t) * 64 * ldv); \
    _Pragma("unroll") for (int i_ = 0; i_ < NCH; ++i_) __builtin_amdgcn_global_load_lds((const unsigned*)(kt_ + kg[i_]), (LAS unsigned*)(ldl + OFF_K + (b) * SHM_K + wslab + i_ * 8192), 16, 0, 0); \
    _Pragma("unroll") for (int i_ = 0; i_ < 2; ++i_) __builtin_amdgcn_global_load_lds((const unsigned*)(vt_ + vg[i_]), (LAS unsigned*)(ldl + (b) * SHM_V + wslab + i_ * 8192), 16, 0, 0); } while (0)
  __syncthreads();
  ATT_DMA(T0, 0); if (T0 + 1 < T1) { ATT_DMA(T0 + 1, 1); asm volatile("s_waitcnt vmcnt(%0)" :: "n"(NCH + 2) : "memory"); } else asm volatile("s_waitcnt vmcnt(0)" ::: "memory");
  ATT_BAR();
  int b = 0, bn = 2;
#pragma unroll 1
  for (int j = T0; j < T1; ++j) {
    const bool vis_ = (j >= tw0 && j < tw1);
    if (vis_) {
      f32x16 p0 = {}, p1 = {};
      ATT_SBAR();
      {
        const int kbase = kbase0 + b * SHM_K;
        bf16x8 fa[3], fb[3];
#define ATT_KRD(d0_) do { const int ad_ = kbase + ATT_KO(d0_); \
          asm volatile("ds_read_b128 %0, %1" : "=v"(fa[(d0_) % 3]) : "v"(ad_) : "memory"); \
          asm volatile("ds_read_b128 %0, %1 offset:%2" : "=v"(fb[(d0_) % 3]) : "v"(ad_), "i"(32 * DQK * 2) : "memory"); } while (0)
        ATT_KRD(0); ATT_KRD(1);
#pragma unroll
        for (int d0 = 0; d0 < ND; ++d0) {
          if (d0 + 2 < ND) { ATT_KRD(d0 + 2); asm volatile("s_waitcnt lgkmcnt(4)" ::: "memory"); }
          else if (d0 + 1 < ND) asm volatile("s_waitcnt lgkmcnt(2)" ::: "memory");
          else asm volatile("s_waitcnt lgkmcnt(0)" ::: "memory");
          ATT_SBAR();
          p0 = __builtin_amdgcn_mfma_f32_32x32x16_bf16(fa[d0 % 3], qr[d0], p0, 0, 0, 0);
          p1 = __builtin_amdgcn_mfma_f32_32x32x16_bf16(fb[d0 % 3], qr[d0], p1, 0, 0, 0);
          ATT_SBAR(); }
#undef ATT_KRD
      }
      ATT_SBAR();
      if (MODE == 0) {
        const int dr31 = (j - wrow + 7) * 31 + 15 - qcol;
#pragma unroll
        for (int r = 0; r < 16; ++r) { const int kc = crow(r, hi);
          { const bool v = (kc >= c0) && (kc < c0 + 16); const float bb = rpbL[v ? dr31 + kc : 0]; p0[r] = v ? fmaf(p0[r], C, bb) : NEGM; }
          { const int kc1 = kc + 32; const bool v = (kc1 >= c0) && (kc1 < c0 + 16); const float bb = rpbL[v ? dr31 + kc1 : 0]; p1[r] = v ? fmaf(p1[r], C, bb) : NEGM; } }
      } else if (MODE == 2) {
        const float X = (float)(j * 64 + 4 * hi - qi), ns2 = -slope2;
#pragma unroll
        for (int r = 0; r < 16; ++r) { const float d0 = X + (float)((r & 3) + 8 * (r >> 2)), d1 = d0 + 32.0f;
          p0[r] = fabsf(d0) <= 128.0f ? fmaf(p0[r], C, fabsf(d0) * ns2) : NEGM;
          p1[r] = fabsf(d1) <= 128.0f ? fmaf(p1[r], C, fabsf(d1) * ns2) : NEGM; }
      }
      float alpha; bf16x8 pa0, pa1, pa2, pa3;
      softmax_tile<MODE == 1>(p0, p1, C, m_reg, l_reg, alpha, pa0, pa1, pa2, pa3);
      if (__any(alpha < 1.f)) { if (hi == 0) al_l[r32] = alpha; asm volatile("s_waitcnt lgkmcnt(0)" ::: "memory");
#pragma unroll
        for (int r = 0; r < 16; ++r) { const float av = al_l[crow(r, hi)];
#pragma unroll
          for (int d = 0; d < 4; ++d) o[d][r] *= av; }
        asm volatile("s_waitcnt lgkmcnt(0)" ::: "memory"); }
      ATT_SBAR();
      pv_d0(o, vb0 + b * SHM_V, pa0, pa1, pa2, pa3);
    }
#if defined(PROBE_ATT_VALU)
    if (MODE == 1) { float dx_ = m_reg;
#pragma unroll
      for (int i_ = 0; i_ < 32; ++i_) asm volatile("v_exp_f32 %0, %0" : "+v"(dx_));
      asm volatile("" :: "v"(dx_)); }
#endif
#if defined(PROBE_ATT_LDS)
    if (MODE == 1) { bf16x8 t_; const int ad_ = (int)(uintptr_t)lds_g + OFF_K + b * SHM_K + kswz<DQK>(r32, hi * 16);
#pragma unroll
      for (int i_ = 0; i_ < 24; ++i_) asm volatile("ds_read_b128 %0, %1 offset:%2" : "=v"(t_) : "v"(ad_), "i"((i_ % 12) * 32) : "memory");
      asm volatile("s_waitcnt lgkmcnt(0)" ::: "memory"); asm volatile("" :: "v"(t_)); }
#endif
#if defined(PROBE_ATT_MFMA)
    if (MODE == 1) { f32x4 da_ = {0.f, 0.f, 0.f, 0.f};
#pragma unroll
      for (int i_ = 0; i_ < 80; ++i_) da_ = __builtin_amdgcn_mfma_f32_16x16x32_bf16(qr[0], qr[1], da_, 0, 0, 0);
      asm volatile("" :: "v"(da_)); }
#endif
    ATT_SBAR();
    if (j + 2 < T1) ATT_DMA(j + 2, bn);
    if (j + 2 < T1) asm volatile("s_waitcnt vmcnt(%0)" :: "n"(NCH + 2) : "memory"); else asm volatile("s_waitcnt vmcnt(0)" ::: "memory");
    ATT_BAR();
    b = b == 2 ? 0 : b + 1; bn = bn == 2 ? 0 : bn + 1;
  }
  { auto rr = __builtin_amdgcn_permlane32_swap(__float_as_uint(l_reg), __float_as_uint(l_reg), false, false); l_reg = __uint_as_float(rr[0]) + __uint_as_float(rr[1]); }
  if (hi == 0) li_l[r32] = l_reg; asm volatile("s_waitcnt lgkmcnt(0)" ::: "memory");
  bf16_t* Ow; int ldo;
  if (MODE == 1) { Ow = (bf16_t*)(ws_ + WS_PART) + ((size_t)kvq * S + q0 + wid * 32) * VLD + 128 * h + r32; ldo = VLD;
    if (hi == 0) { float* st = (float*)(ws_ + WS_STAT) + ((size_t)(kvq * 6 + h) * S + qi) * 2; st[0] = m_reg; st[1] = l_reg; } }
  else { Ow = (bf16_t*)(ws_ + WS_Y) + (size_t)(q0 + wid * 32) * DM + ycol + r32; ldo = DM; }
#pragma unroll
  for (int r = 0; r < 16; ++r) { const int orow = crow(r, hi); const float rl = __builtin_amdgcn_rcpf(li_l[orow]);
#pragma unroll
    for (int d0 = 0; d0 < 4; ++d0) Ow[(size_t)orow * ldo + d0 * 32] = (bf16_t)(cvtpk(o[d0][r] * rl, 0.f) & 0xffffu); }
  asm volatile("s_waitcnt lgkmcnt(0)" ::: "memory");
  __syncthreads();
#undef ATT_DMA
#undef ATT_KO
}
}

#ifndef NAIVE_ATTN
#define NAIVE_ATTN 0
#endif
#ifndef MK_MULTI
#define MK_MULTI 0
#endif
constexpr int N_PHASES = 2 + 10 * DEPTH;
__device__ __forceinline__ int opq(int v) { asm volatile("" : "+s"(v)); return v; }

__global__ void __launch_bounds__(NTHREADS) fwd_megakernel(Args a) {
    extern __shared__ __attribute__((aligned(16))) unsigned char lds[];
    cg::grid_group grid = cg::this_grid();
    const int lo = a.ph_lo, hi = a.ph_hi;
    const int G = gridDim.x;
    { LAS unsigned long long* tw = (LAS unsigned long long*)((LAS unsigned char*)lds + TAB_OFF);
#pragma unroll
      for (int i = 0; i < 19; ++i) if ((int)threadIdx.x == i) tw[i] = (unsigned long long)a.in[i];
      if (threadIdx.x == 19) tw[19] = (unsigned long long)a.out;
      if (threadIdx.x == 20) tw[20] = (unsigned long long)a.ws;
      if (threadIdx.x < 4) ((LAS unsigned*)((LAS unsigned char*)lds + TAB_OFF + 192))[threadIdx.x] = 0u;
      __syncthreads(); }
    (void)xcd_barrier_post((unsigned*)(a.ws + WS_BAR), (volatile LAS unsigned*)((LAS unsigned char*)lds + TAB_OFF + 192));
    if (a.ph_lo < 0) grid.sync();
    const Tab T{(const LAS unsigned*)((LAS unsigned char*)lds + TAB_OFF)};
#define ws (T.wsp())
#define mod ((float*)(ws + WS_MOD))
#define U ((bf16_t*)(ws + WS_U))
#define PROJ ((bf16_t*)(ws + WS_PROJ))
#define Qb ((bf16_t*)(ws + WS_Q))
#define Kb ((bf16_t*)(ws + WS_K))
#define Vb ((bf16_t*)(ws + WS_V))
#define Y ((bf16_t*)(ws + WS_Y))
#define Hb ((bf16_t*)(ws + WS_H))
#define X ((float*)(ws + WS_X))
#define rope ((float*)(ws + WS_ROPE))
#define rsq ((float*)(ws + WS_RSQ))
#define rskv ((float*)(ws + WS_RSKV))
    PG8_LAS unsigned char* ldsl = (PG8_LAS unsigned char*)lds;
#ifndef PHM
#define PHM 0xFFFFF
#endif
#ifndef ATM
#define ATM 7
#endif
#define EN(b) ((PHM >> (b)) & 1)
#ifndef PROBE_PH
#define PROBE_PH -1
#endif
#ifndef PROBE_N
#define PROBE_N 2
#endif
#define REPK(k) for (int rep_ = 0; rep_ < ((k) == PROBE_PH ? PROBE_N : 1); ++rep_)
#define IN(k) (lo <= (k) && (k) < hi)
#define GBAR() do { XcdBarrier b_; b_.bar = (unsigned*)(ws + WS_BAR); b_.x = xb_xcc_id(); b_.st = (volatile LAS unsigned*)((LAS unsigned char*)lds + TAB_OFF + 192); xcd_barrier(b_); } while (0)
#define SEAM(k) do { if (IN(k) && IN((k) + 1)) GBAR(); } while (0)

#ifdef PROBE_SYNCS
    for (int i_ = 0; i_ < PROBE_SYNCS; ++i_) GBAR();
#endif
    if (EN(0) && IN(0)) REPK(0) { phase_mod(T, lds); }
    SEAM(0);
    if (EN(1) && IN(1)) REPK(1) {
        const int fb_ = opq((int)blockIdx.x), fs_ = opq(G); const bool hide_ = (fs_ == 256);
        for (int l = 0; l < DEPTH; ++l) {
            transpose_job<3>(T.in(4) + (size_t)l * DM * DIN, (bf16_t*)(ws + WS_W + (size_t)l * SZ_WL + O_WIN), DM, DIN, DINP, nullptr, lds, fb_, fs_);
            const int fh_ = (hide_ && l == 1) ? (1 << 30) : fb_, fh0_ = hide_ ? (1 << 30) : fb_;
            transpose_job<1>(T.in(8) + (size_t)l * 512 * 1152, (bf16_t*)(ws + WS_W + (size_t)l * SZ_WL + O_WUQ), 512, 1152, 1280, T.in(6) + l * 512, lds, fh0_, fs_);
            transpose_job<0>(T.in(9) + (size_t)l * 256 * 1536, (bf16_t*)(ws + WS_W + (size_t)l * SZ_WL + O_WUKV), 256, 1536, 1536, T.in(7) + l * 256, lds, fh0_, fs_);
            if (!hide_) transpose_job<0>(T.in(12) + (size_t)l * DM * DM, (bf16_t*)(ws + WS_W + (size_t)l * SZ_WL + O_WO), DM, DM, DM, T.in(11) + l * DM, lds, fb_, fs_);
            if (!(hide_ && l == 1)) transpose_job<2>(T.in(15) + (size_t)l * DM * 2 * DFF, (bf16_t*)(ws + WS_W + (size_t)l * SZ_WL + O_WGU), DM, 2 * DFF, 2 * DFF, nullptr, lds, fb_, fs_);
            transpose_job<0>(T.in(16) + (size_t)l * DFF * DM, (bf16_t*)(ws + WS_W + (size_t)l * SZ_WL + O_WDN), DFF, DM, DM, nullptr, lds, fh_, fs_);
        }
        modulate_rows(T.in(0), mod + 1 * DM, mod + 0 * DM, U);
        rope_table(rope);
    }
    SEAM(1);
#pragma unroll 1
    for (int l = 0; l < DEPTH; ++l) {
        const int pb = 2 + 10 * l;
        if (EN(2) && IN(pb + 0)) REPK(2) {
            pg8::Gemm g{U, (const bf16_t*)(ws + WS_W + (size_t)l * SZ_WL + O_WIN), S, DINP, DM, DM}; pg8::StaticOrder So; So.init(S, DINP, opq(G), opq((int)blockIdx.x));
            pg8::EpiProj E{PROJ, DINP, (float*)(ws + WS_SSQ), rope, Kb, KLD};
            pg8::gemm_phase<pg8::EpiProj, pg8::StaticOrder, true, true>(ldsl, g, So, E);
            if (opq(G) == 256 && opq((int)blockIdx.x) >= 224) {
                const int sb_ = opq((int)blockIdx.x) - 224; const size_t lo_ = (size_t)l;
                transpose_job<1>(T.in(8) + lo_ * 512 * 1152, (bf16_t*)(ws + WS_W + lo_ * SZ_WL + O_WUQ), 512, 1152, 1280, T.in(6) + lo_ * 512, lds, sb_, 32);
                transpose_job<0>(T.in(9) + lo_ * 256 * 1536, (bf16_t*)(ws + WS_W + lo_ * SZ_WL + O_WUKV), 256, 1536, 1536, T.in(7) + lo_ * 256, lds, (sb_ + 8) & 31, 32);
                transpose_job<0>(T.in(12) + lo_ * DM * DM, (bf16_t*)(ws + WS_W + lo_ * SZ_WL + O_WO), DM, DM, DM, T.in(11) + lo_ * DM, lds, sb_, 32); }
        }
        SEAM(pb + 0);
        if (EN(4) && IN(pb + 2)) REPK(4) {
            { const int bq = opq((int)blockIdx.x), Gq = opq(G);
#pragma unroll 1
              for (int it = 0; ; ++it) {
                int q0 = -1, kv0 = -1, kv1 = -1, na = -1, sw0 = -1, sw1 = -1;
                if (Gq == 256) { if (it == 0) {
                    if (bq < 96) { na = bq; q0 = bq; }
                    else if (bq < 128) { na = bq; kv0 = 2 * (bq - 96); kv1 = kv0 + 1; }
                    else if (bq < 192) { sw0 = bq - 128; q0 = 96 + (bq - 128); kv0 = 64 + 2 * (bq - 128); kv1 = kv0 + 1; }
                    else { sw0 = 64 + (bq - 192); sw1 = 128 + (bq - 192); } } }
                else { const int L = bq + it * Gq; if (L < 160) q0 = L; if (L < 192) { kv0 = L; sw0 = L; } if (L < 128) na = L; }
                if ((q0 & kv0 & na & sw0) < 0 && q0 < 0 && kv0 < 0 && na < 0 && sw0 < 0) break;
                if (q0 >= 0) { pg8::Gemm g{PROJ + C_CQ, (const bf16_t*)(ws + WS_W + (size_t)l * SZ_WL + O_WUQ), S, 1280, 512, DINP}; pg8::ListOrder So{5, 1, q0, 0};
                  pg8::EpiQ E{Qb, QLD, (const float*)(ws + WS_SSQ), rope};
                  pg8::gemm_phase<pg8::EpiQ, pg8::ListOrder, true, true>(ldsl, g, So, E); }
                if (kv0 >= 0) { pg8::Gemm g{PROJ + C_CKV, (const bf16_t*)(ws + WS_W + (size_t)l * SZ_WL + O_WUKV), S, 1536, 256, DINP}; pg8::ListOrder So{6, kv1 >= 0 ? 2 : 1, kv0, kv1};
                  pg8::EpiKV E{Kb, KLD, Vb, VLD, (const float*)(ws + WS_SSQ)};
                  pg8::gemm_phase<pg8::EpiKV, pg8::ListOrder, true, true>(ldsl, g, So, E); }
                if (na >= 0) { if (ATM & 2) att::attn_unit<0>(ws, T.in(5), T.in(10), l, na >> 5, na & 31, 0, lds); }
#pragma unroll 1
                for (int i2 = 0; i2 < 2; ++i2) { const int u = i2 ? sw1 : sw0; if (u >= 0) { if (ATM & 4) att::attn_unit<2>(ws, T.in(5), T.in(10), l, u >> 5, u & 31, 0, lds); } }
              } }
        }
        SEAM(pb + 2);
        if (EN(5) && IN(pb + 3)) REPK(5) {
#if NAIVE_ATTN
            naive_attn<0>(ws, T.in(5), T.in(10), l); naive_attn<2>(ws, T.in(5), T.in(10), l); naive_attn<1>(ws, T.in(5), T.in(10), l);
#else
            const int Gq = opq(G);
            for (int su = opq((int)blockIdx.x); su < 192 * att::KVSPLIT; su += Gq) {
                int combo, qb; if (Gq == 256) { combo = (su & 7) + 8 * (su >> 8); qb = (su & 255) >> 3; } else { combo = su >> 5; qb = su & 31; }
                unsigned char* wsp_ = ws;
                if (ATM & 1) att::attn_unit<1>(wsp_, nullptr, nullptr, l, combo >> 2, qb, combo & 3, lds);
            }
#endif
        }
        SEAM(pb + 3);
        if (EN(6) && IN(pb + 4)) phase_ynorm(ws);
        SEAM(pb + 4);
        if (EN(7) && IN(pb + 5)) {
            pg8::Gemm g{Y, (const bf16_t*)(ws + WS_W + (size_t)l * SZ_WL + O_WO), S, DM, DM, DM}; pg8::StaticOrder So; So.init(S, DM, opq(G), opq((int)blockIdx.x));
            pg8::EpiRes E{l == 0 ? T.in(0) : (const float*)X, X, mod + (size_t)l * 6 * DM + 2 * DM, ALPHA, DM};
            pg8::gemm_phase<pg8::EpiRes, pg8::StaticOrder, true, true>(ldsl, g, So, E);
        }
        SEAM(pb + 5);
#ifdef PROBE_LN
        if (EN(8) && IN(pb + 6)) phase_ln(X, (float*)(ws + WS_H), T.in(13) + l * DM, T.in(14) + l * DM, mod + (size_t)l * 6 * DM + 4 * DM, mod + (size_t)l * 6 * DM + 3 * DM, (bf16_t*)(ws + WS_PART));
#endif
        if (EN(8) && IN(pb + 6)) phase_ln(X, X, T.in(13) + l * DM, T.in(14) + l * DM, mod + (size_t)l * 6 * DM + 4 * DM, mod + (size_t)l * 6 * DM + 3 * DM, U);
        SEAM(pb + 6);
        if (EN(9) && IN(pb + 7)) REPK(9) {
            pg8::Gemm g{U, (const bf16_t*)(ws + WS_W + (size_t)l * SZ_WL + O_WGU), S, 2 * DFF, DM, DM}; pg8::StaticOrder So; So.init(S, 2 * DFF, opq(G), opq((int)blockIdx.x));
            pg8::EpiSwiglu E{Hb, DFF};
            pg8::gemm_phase<pg8::EpiSwiglu, pg8::StaticOrder, true, true>(ldsl, g, So, E);
            if (l == 0 && opq(G) == 256 && opq((int)blockIdx.x) >= 128)
                transpose_job<2>(T.in(15) + (size_t)DM * 2 * DFF, (bf16_t*)(ws + WS_W + SZ_WL + O_WGU), DM, 2 * DFF, 2 * DFF, nullptr, lds, opq((int)blockIdx.x) - 128, 128);
            if (l == 1 && opq(G) == 256 && opq((int)blockIdx.x) >= 128)
                transpose_job<0>(T.in(16) + (size_t)DFF * DM, (bf16_t*)(ws + WS_W + SZ_WL + O_WDN), DFF, DM, DM, nullptr, lds, opq((int)blockIdx.x) - 128, 128);
        }
        SEAM(pb + 7);
        if (EN(10) && IN(pb + 8)) {
            pg8::Gemm g{Hb, (const bf16_t*)(ws + WS_W + (size_t)l * SZ_WL + O_WDN), S, DM, DFF, DFF}; pg8::StaticOrder So; So.init(S, DM, opq(G), opq((int)blockIdx.x));
            pg8::EpiRes E{X, X, mod + (size_t)l * 6 * DM + 5 * DM, ALPHA, DM};
            pg8::gemm_phase<pg8::EpiRes, pg8::StaticOrder, true, true>(ldsl, g, So, E);
        }
        SEAM(pb + 8);
        if (EN(11) && IN(pb + 9)) {
            const bool last = (l == DEPTH - 1);
            const float* modn = mod + (size_t)(last ? l : l + 1) * 6 * DM;
            phase_ln(X, last ? T.out() : X, T.in(17) + l * DM, T.in(18) + l * DM, last ? nullptr : modn + 1 * DM, last ? nullptr : modn + 0 * DM, last ? nullptr : U);
        }
        SEAM(pb + 9);
    }
#undef IN
#undef SEAM
#undef ws
#undef mod
#undef U
#undef PROJ
#undef Qb
#undef Kb
#undef Vb
#undef Y
#undef Hb
#undef X
#undef rope
#undef rsq
#undef rskv
}

extern "C" void kernel_launch(void* const* d_in, const int* in_sizes, int n_in, void* d_out, int out_size, void* d_ws, size_t ws_size, hipStream_t stream) {
    static int grid = 0;
    if (grid == 0) {
        if (n_in != 19 || out_size != S * DM || ws_size < WS_END) { fprintf(stderr, "kernel_launch: unexpected shapes (n_in %d out %d ws %zu need %zu)\n", n_in, out_size, ws_size, (size_t)WS_END); grid = -1; return; }
        int dev = 0, cus = 0, per_cu = 0;
        hipGetDevice(&dev); hipDeviceGetAttribute(&cus, hipDeviceAttributeMultiprocessorCount, dev);
        if (hipFuncSetAttribute((const void*)fwd_megakernel, hipFuncAttributeMaxDynamicSharedMemorySize, LDS_BYTES) != hipSuccess) { fprintf(stderr, "kernel_launch: hipFuncSetAttribute failed\n"); grid = -1; return; }
        if (hipOccupancyMaxActiveBlocksPerMultiprocessor(&per_cu, (const void*)fwd_megakernel, NTHREADS, LDS_BYTES) != hipSuccess || per_cu < 1) { fprintf(stderr, "kernel_launch: occupancy query gave %d\n", per_cu); per_cu = 1; }
        (void)hipGetLastError();
        grid = cus;
    }
    if (grid < 0) return;
    if (hipMemsetAsync((char*)d_ws + WS_BAR, 0, 16384, stream) != hipSuccess) { fprintf(stderr, "kernel_launch: memset of the barrier words failed\n"); return; }
    Args a{};
    for (int i = 0; i < 19; ++i) a.in[i] = (const float*)d_in[i];
    a.out = (float*)d_out; a.ws = (unsigned char*)d_ws;
#if MK_MULTI
    for (int p = 0; p < N_PHASES; ++p) { a.ph_lo = p; a.ph_hi = p + 1; hipLaunchKernelGGL(fwd_megakernel, dim3(grid), dim3(NTHREADS), LDS_BYTES, stream, a); }
#else
    a.ph_lo = 0; a.ph_hi = N_PHASES;
    void* args[] = {&a};
    hipError_t e = hipLaunchCooperativeKernel((const void*)fwd_megakernel, dim3(grid), dim3(NTHREADS), args, LDS_BYTES, stream);
    if (e != hipSuccess) fprintf(stderr, "kernel_launch: cooperative launch failed: %s (grid %d)\n", hipGetErrorString(e), grid);
#endif
}
```
